# Optimizing an MI355X kernel written in HIP

```python
import math
import jax, jax.numpy as jnp
from jax import lax
import numpy as np

D_MODEL = 1024
BATCH = 2
SEQ = 16384
DEPTH = 4

GRID_W = 64
CTX_LEN = 256
N_BRANCH = 4
MIX_W = D_MODEL // 2
HEAD_DIM = 64
S5_GROUP_CH = 16
S5_GROUPS = MIX_W // S5_GROUP_CH
S5_STATE = 64
S5_DT_MIN = 1e-3
S5_DT_MAX = 1e-1
CONV_W = 3
NA_HEADS = MIX_W // HEAD_DIM
NA_ROWS = 8
NA_COLS = 16
GQA_Q_HEADS = MIX_W // HEAD_DIM
GQA_KV_HEADS = 2
GQA_KV_W = GQA_KV_HEADS * HEAD_DIM
ATTN_BLOCK = 128
WINDOW = 128
ROPE_BASE = 10000.0
ROPE_PAIRS = HEAD_DIM // 4
EPS = 1e-6
NEG_INF = -1e30
BRANCH_NAMES = ("s5", "conv", "na", "gqa")
PROJ_LAYOUT = (
    ("s5_u", MIX_W), ("s5_gate", MIX_W),
    ("conv_v", MIX_W), ("conv_b", MIX_W), ("conv_c", MIX_W), ("conv_gate", MIX_W),
    ("na_q", MIX_W), ("na_k", MIX_W), ("na_v", MIX_W), ("na_gate", MIX_W),
    ("gqa_q", MIX_W), ("gqa_k", GQA_KV_W), ("gqa_v", GQA_KV_W), ("gqa_gate", MIX_W),
    ("merge_s5", D_MODEL), ("merge_conv", D_MODEL), ("merge_na", D_MODEL), ("merge_gqa", D_MODEL),
)
N_IN = sum(size for _, size in PROJ_LAYOUT)
ALL_NAMES = tuple(name for name, _ in PROJ_LAYOUT)
CTX_KV_NAMES = ("s5_u", "na_k", "na_v", "gqa_k", "gqa_v")

kernel_name = "hybrid_s5_conv_natten_swa_dit_trunk"


def _rmsnorm(x, g):
    xf = x.astype(jnp.float32)
    y = xf * lax.rsqrt(jnp.mean(xf * xf, axis=-1, keepdims=True) + EPS)
    return (y * g.astype(jnp.float32)).astype(x.dtype)


def _adaln(cvec, w_ada, b_ada):
    mod = jax.nn.silu(cvec) @ w_ada + b_ada
    shift, scale, gate = jnp.split(mod[:, None, :], 3, axis=-1)
    return shift, scale, gate


def _project(h, w_in, names):
    out = {}
    start = 0
    for name, size in PROJ_LAYOUT:
        if name in names:
            out[name] = h @ w_in[:, start:start + size]
        start += size
    return out


def _heads(z, n_heads):
    b, n, _ = z.shape
    return z.reshape(b, n, n_heads, HEAD_DIM)


def _rope_2d(x):
    n = x.shape[1]
    t = jnp.arange(n, dtype=jnp.int32)
    row = (t // GRID_W).astype(jnp.float32)
    col = (t % GRID_W).astype(jnp.float32)
    inv = ROPE_BASE ** (-jnp.arange(ROPE_PAIRS, dtype=jnp.float32) / ROPE_PAIRS)
    ang = jnp.concatenate([row[:, None] * inv, col[:, None] * inv], axis=-1)[None, :, None, :]
    cos = jnp.cos(ang).astype(x.dtype)
    sin = jnp.sin(ang).astype(x.dtype)
    half = x.shape[-1] // 2
    x1, x2 = x[..., :half], x[..., half:]
    return jnp.concatenate([x1 * cos - x2 * sin, x2 * cos + x1 * sin], axis=-1)


def _cplx_combine(e1, e2):
    a1r, a1i, b1r, b1i = e1
    a2r, a2i, b2r, b2i = e2
    ar = a1r * a2r - a1i * a2i
    ai = a1r * a2i + a1i * a2r
    br = a2r * b1r - a2i * b1i + b2r
    bi = a2r * b1i + a2i * b1r + b2i
    return ar, ai, br, bi


def _s5_discretise(a_re, a_im, log_dt, b_re, b_im):
    f32 = jnp.float32
    a_re = a_re.astype(f32)
    a_im = a_im.astype(f32)
    dt = jnp.exp(log_dt.astype(f32))[:, None]
    mag = jnp.exp(dt * a_re)
    abr = mag * jnp.cos(dt * a_im)
    abi = mag * jnp.sin(dt * a_im)
    den = a_re * a_re + a_im * a_im
    fr = ((abr - 1.0) * a_re + abi * a_im) / den
    fi = (abi * a_re - (abr - 1.0) * a_im) / den
    b_re = b_re.astype(f32)
    b_im = b_im.astype(f32)
    bbr = fr[..., None] * b_re - fi[..., None] * b_im
    bbi = fr[..., None] * b_im + fi[..., None] * b_re
    return abr, abi, bbr, bbi


def _s5_states(ug, p, d, h0, reverse):
    abr, abi, bbr, bbi = _s5_discretise(p["s5_a_re"][d], p["s5_a_im"][d], p["s5_log_dt"][d],
                                        p["s5_b_re"][d], p["s5_b_im"][d])
    abr, abi, bbr, bbi = (t.astype(ug.dtype) for t in (abr, abi, bbr, bbi))
    xr = jnp.einsum("blgh,gph->blgp", ug, bbr)
    xi = jnp.einsum("blgh,gph->blgp", ug, bbi)
    if h0 is not None:
        h0r, h0i = h0
        first = -1 if reverse else 0
        xr = xr.at[:, first].add(abr * h0r - abi * h0i)
        xi = xi.at[:, first].add(abr * h0i + abi * h0r)
    shape = (1, ug.shape[1]) + abr.shape
    _, _, hr, hi = lax.associative_scan(
        _cplx_combine,
        (jnp.broadcast_to(abr, shape), jnp.broadcast_to(abi, shape), xr, xi),
        reverse=reverse, axis=1)
    return hr, hi


def _s5_readout(states, c_re, c_im):
    hr, hi = states
    return jnp.einsum("blgp,ghp->blgh", hr, c_re) - jnp.einsum("blgp,ghp->blgh", hi, c_im)


def _s5_output(ug, st_f, st_b, p):
    y = (_s5_readout(st_f, p["s5_c_re"][0], p["s5_c_im"][0])
         + _s5_readout(st_b, p["s5_c_re"][1], p["s5_c_im"][1])
         + p["s5_d"] * ug)
    y = jax.nn.gelu(y.reshape(ug.shape[0], ug.shape[1], MIX_W))
    return y * jax.nn.sigmoid(y @ p["s5_w_glu"])


def _groups(u):
    b, n, _ = u.shape
    return u.reshape(b, n, S5_GROUPS, S5_GROUP_CH)


def _short_conv(z, p):
    n = z["conv_v"].shape[1]
    zz = z["conv_c"] * z["conv_v"]
    pad = CONV_W // 2
    zp = jnp.pad(zz, ((0, 0), (pad, pad), (0, 0)))
    y = p["conv_b"]
    for tap in range(CONV_W):
        y = y + zp[:, tap:tap + n] * p["conv_w"][tap]
    return z["conv_b"] * y


def _ctx_attention(q, k, v, sink):
    b, n, hq, dh = q.shape
    hkv = k.shape[2]
    g = hq // hkv
    qg = q.reshape(b, n, hkv, g, dh)
    s = jnp.einsum("bqkgd,bskd->bkgqs", qg, k).astype(jnp.float32) * dh ** -0.5
    if sink is not None:
        s_sink = jnp.broadcast_to(sink.astype(jnp.float32).reshape(1, hkv, g, 1, 1), (b, hkv, g, n, 1))
        s = jnp.concatenate([s, s_sink], axis=-1)
    pr = jax.nn.softmax(s, axis=-1)[..., :k.shape[1]].astype(v.dtype)
    return jnp.einsum("bkgqs,bskd->bqkgd", pr, v).reshape(b, n, hq * dh)


def _na_latent(q, k, v, k_ctx, v_ctx, rel_bias):
    b, n, h, dh = q.shape
    rows = n // GRID_W
    kh = min(NA_ROWS, rows)
    nk = kh * GRID_W
    qg = q.reshape(b, rows, GRID_W, h, dh)
    kg = k.reshape(b, rows, GRID_W, h, dh)
    vg = v.reshape(b, rows, GRID_W, h, dh)
    qcol = jnp.arange(GRID_W, dtype=jnp.int32)
    kcol = jnp.tile(qcol, kh)
    krow = jnp.repeat(jnp.arange(kh, dtype=jnp.int32), GRID_W)
    cs = jnp.clip(qcol - NA_COLS // 2, 0, GRID_W - NA_COLS)
    col_ok = (kcol[None, :] >= cs[:, None]) & (kcol[None, :] < cs[:, None] + NA_COLS)
    dj_idx = jnp.clip(kcol[None, :] - qcol[:, None] + NA_COLS - 1, 0, 2 * NA_COLS - 2)
    scale = dh ** -0.5

    def row_block(r):
        rs = jnp.clip(r - kh // 2, 0, rows - kh)
        q_r = lax.dynamic_index_in_dim(qg, r, axis=1, keepdims=False)
        k_r = lax.dynamic_slice_in_dim(kg, rs, kh, axis=1).reshape(b, nk, h, dh)
        v_r = lax.dynamic_slice_in_dim(vg, rs, kh, axis=1).reshape(b, nk, h, dh)
        di_idx = rs + krow - r + NA_ROWS - 1
        bias = rel_bias[:, di_idx[None, :], dj_idx].astype(jnp.float32)
        s_lat = jnp.einsum("bqhd,bkhd->bhqk", q_r, k_r).astype(jnp.float32) * scale + bias
        s_lat = jnp.where(col_ok, s_lat, NEG_INF)
        s_ctx = jnp.einsum("bqhd,bkhd->bhqk", q_r, k_ctx).astype(jnp.float32) * scale
        pr = jax.nn.softmax(jnp.concatenate([s_lat, s_ctx], axis=-1), axis=-1).astype(v.dtype)
        return (jnp.einsum("bhqk,bkhd->bqhd", pr[..., :nk], v_r)
                + jnp.einsum("bhqk,bkhd->bqhd", pr[..., nk:], v_ctx))

    out = lax.map(row_block, jnp.arange(rows, dtype=jnp.int32))
    return out.transpose(1, 0, 2, 3, 4).reshape(b, n, h * dh)


def _gqa_latent(q, k, v, k_ctx, v_ctx, sink):
    b, n, hq, dh = q.shape
    hkv = k.shape[2]
    g = hq // hkv
    nb = n // ATTN_BLOCK
    span = ATTN_BLOCK + 2 * WINDOW
    pad = ((0, 0), (WINDOW, WINDOW), (0, 0), (0, 0))
    kp = jnp.pad(k, pad)
    vp = jnp.pad(v, pad)
    qi = jnp.arange(ATTN_BLOCK, dtype=jnp.int32)
    si = jnp.arange(span, dtype=jnp.int32)
    band = jnp.abs(si[None, :] - WINDOW - qi[:, None]) <= WINDOW
    sink_l = jnp.broadcast_to(sink.astype(jnp.float32).reshape(1, hkv, g, 1, 1), (b, hkv, g, ATTN_BLOCK, 1))
    n_ctx = k_ctx.shape[1]
    scale = dh ** -0.5

    def block(i):
        start = i * ATTN_BLOCK
        q_i = lax.dynamic_slice_in_dim(q, start, ATTN_BLOCK, axis=1).reshape(b, ATTN_BLOCK, hkv, g, dh)
        k_i = lax.dynamic_slice_in_dim(kp, start, span, axis=1)
        v_i = lax.dynamic_slice_in_dim(vp, start, span, axis=1)
        kpos = start - WINDOW + si
        ok = band & ((kpos >= 0) & (kpos < n))[None, :]
        s_lat = jnp.where(ok, jnp.einsum("bqkgd,bskd->bkgqs", q_i, k_i).astype(jnp.float32) * scale, NEG_INF)
        s_ctx = jnp.einsum("bqkgd,bckd->bkgqc", q_i, k_ctx).astype(jnp.float32) * scale
        pr = jax.nn.softmax(jnp.concatenate([s_lat, s_ctx, sink_l], axis=-1), axis=-1).astype(v.dtype)
        o = (jnp.einsum("bkgqs,bskd->bqkgd", pr[..., :span], v_i)
             + jnp.einsum("bkgqc,bckd->bqkgd", pr[..., span:span + n_ctx], v_ctx))
        return o.reshape(b, ATTN_BLOCK, hq * dh)

    out = lax.map(block, jnp.arange(nb, dtype=jnp.int32))
    return out.transpose(1, 0, 2, 3).reshape(b, n, hq * dh)


def _merge(z, ys, p):
    out = None
    for k, (name, y) in enumerate(zip(BRANCH_NAMES, ys)):
        gated = y * jax.nn.silu(z[name + "_gate"])
        contrib = jax.nn.sigmoid(z["merge_" + name]) * (gated @ p["w_br"][k])
        out = contrib if out is None else out + contrib
    return out @ p["w_out"]


def _layer(x, ctx, c, c_ctx, p, update_ctx):
    shift_x, scale_x, gate_x = _adaln(c, p["w_ada"], p["b_ada"])
    shift_c, scale_c, gate_c = _adaln(c_ctx[None, :], p["w_ada"], p["b_ada"])
    hx = _rmsnorm(x, p["norm_g"]) * (1.0 + scale_x) + shift_x
    hc = _rmsnorm(ctx, p["norm_g"]) * (1.0 + scale_c) + shift_c
    zx = _project(hx, p["w_in"], ALL_NAMES)
    zc = _project(hc, p["w_in"], ALL_NAMES if update_ctx else CTX_KV_NAMES)

    uc = _groups(zc["s5_u"])
    stc_f = _s5_states(uc, p, 0, None, reverse=False)
    stc_b = _s5_states(uc, p, 1, None, reverse=True)
    na_kc = _rmsnorm(_heads(zc["na_k"], NA_HEADS), p["na_k_g"])
    na_vc = _heads(zc["na_v"], NA_HEADS)
    gqa_kc = _rmsnorm(_heads(zc["gqa_k"], GQA_KV_HEADS), p["gqa_k_g"])
    gqa_vc = _heads(zc["gqa_v"], GQA_KV_HEADS)

    ux = _groups(zx["s5_u"])
    stx_f = _s5_states(ux, p, 0, (stc_f[0][:, -1], stc_f[1][:, -1]), reverse=False)
    stx_b = _s5_states(ux, p, 1, (stc_b[0][:, 0], stc_b[1][:, 0]), reverse=True)
    y_s5 = _s5_output(ux, stx_f, stx_b, p)
    y_conv = _short_conv(zx, p)
    na_q = _rmsnorm(_heads(zx["na_q"], NA_HEADS), p["na_q_g"])
    na_k = _rmsnorm(_heads(zx["na_k"], NA_HEADS), p["na_k_g"])
    na_v = _heads(zx["na_v"], NA_HEADS)
    y_na = _na_latent(na_q, na_k, na_v, na_kc, na_vc, p["na_rel_bias"])
    gqa_q = _rope_2d(_rmsnorm(_heads(zx["gqa_q"], GQA_Q_HEADS), p["gqa_q_g"]))
    gqa_k = _rope_2d(_rmsnorm(_heads(zx["gqa_k"], GQA_KV_HEADS), p["gqa_k_g"]))
    gqa_v = _heads(zx["gqa_v"], GQA_KV_HEADS)
    y_gqa = _gqa_latent(gqa_q, gqa_k, gqa_v, gqa_kc, gqa_vc, p["gqa_sink"])
    x_new = x + gate_x * _merge(zx, (y_s5, y_conv, y_na, y_gqa), p)

    if update_ctx:
        yc_s5 = _s5_output(uc, stc_f, stc_b, p)
        yc_conv = _short_conv(zc, p)
        yc_na = _ctx_attention(_rmsnorm(_heads(zc["na_q"], NA_HEADS), p["na_q_g"]), na_kc, na_vc, None)
        yc_gqa = _ctx_attention(_rmsnorm(_heads(zc["gqa_q"], GQA_Q_HEADS), p["gqa_q_g"]),
                                gqa_kc, gqa_vc, p["gqa_sink"])
        ctx = ctx + gate_c * _merge(zc, (yc_s5, yc_conv, yc_na, yc_gqa), p)
    return x_new, ctx


def setup_inputs(seed: int = 0) -> dict:
    key = jax.random.key(seed)
    ks = jax.random.split(key, 28)
    f32 = jnp.float32

    def nrm(k, shape, scale):
        return scale * jax.random.normal(k, shape, f32)

    g_p = (DEPTH, 2, S5_GROUPS, S5_STATE)
    return {
        "x": nrm(ks[0], (BATCH, SEQ, D_MODEL), 1.0),
        "c": nrm(ks[1], (BATCH, D_MODEL), 1.0),
        "ctx": nrm(ks[2], (BATCH, CTX_LEN, D_MODEL), 1.0),
        "c_ctx": nrm(ks[3], (D_MODEL,), 1.0),
        "norm_g": 1.0 + nrm(ks[4], (DEPTH, D_MODEL), 0.02),
        "w_ada": nrm(ks[5], (DEPTH, D_MODEL, 3 * D_MODEL), 0.5 * D_MODEL ** -0.5),
        "b_ada": nrm(ks[6], (DEPTH, 3 * D_MODEL), 0.02),
        "w_in": nrm(ks[7], (DEPTH, D_MODEL, N_IN), D_MODEL ** -0.5),
        "s5_a_re": -0.5 + nrm(ks[8], g_p, 0.01),
        "s5_a_im": math.pi * jnp.arange(S5_STATE, dtype=f32) + nrm(ks[9], g_p, 0.01),
        "s5_log_dt": jax.random.uniform(ks[10], (DEPTH, 2, S5_GROUPS), f32,
                                        math.log(S5_DT_MIN), math.log(S5_DT_MAX)),
        "s5_b_re": nrm(ks[11], (DEPTH, 2, S5_GROUPS, S5_STATE, S5_GROUP_CH), (2 * S5_GROUP_CH) ** -0.5),
        "s5_b_im": nrm(ks[12], (DEPTH, 2, S5_GROUPS, S5_STATE, S5_GROUP_CH), (2 * S5_GROUP_CH) ** -0.5),
        "s5_c_re": nrm(ks[13], (DEPTH, 2, S5_GROUPS, S5_GROUP_CH, S5_STATE), 0.5),
        "s5_c_im": nrm(ks[14], (DEPTH, 2, S5_GROUPS, S5_GROUP_CH, S5_STATE), 0.5),
        "s5_d": nrm(ks[15], (DEPTH, S5_GROUPS, S5_GROUP_CH), 1.0),
        "s5_w_glu": nrm(ks[16], (DEPTH, MIX_W, MIX_W), MIX_W ** -0.5),
        "conv_w": nrm(ks[17], (DEPTH, CONV_W, MIX_W), CONV_W ** -0.5),
        "conv_b": nrm(ks[18], (DEPTH, MIX_W), 0.02),
        "na_q_g": 1.0 + nrm(ks[19], (DEPTH, HEAD_DIM), 0.02),
        "na_k_g": 1.0 + nrm(ks[20], (DEPTH, HEAD_DIM), 0.02),
        "na_rel_bias": nrm(ks[21], (DEPTH, NA_HEADS, 2 * NA_ROWS - 1, 2 * NA_COLS - 1), 0.1),
        "gqa_q_g": 1.0 + nrm(ks[22], (DEPTH, HEAD_DIM), 0.02),
        "gqa_k_g": 1.0 + nrm(ks[23], (DEPTH, HEAD_DIM), 0.02),
        "gqa_sink": nrm(ks[24], (DEPTH, GQA_Q_HEADS), 0.5),
        "w_br": nrm(ks[25], (DEPTH, N_BRANCH, MIX_W, D_MODEL), MIX_W ** -0.5),
        "w_out": nrm(ks[26], (DEPTH, D_MODEL, D_MODEL), D_MODEL ** -0.5),
    }


def reference(x, c, ctx, c_ctx, norm_g, w_ada, b_ada, w_in, s5_a_re, s5_a_im, s5_log_dt,
              s5_b_re, s5_b_im, s5_c_re, s5_c_im, s5_d, s5_w_glu, conv_w, conv_b,
              na_q_g, na_k_g, na_rel_bias, gqa_q_g, gqa_k_g, gqa_sink, w_br, w_out):
    for layer in range(DEPTH):
        p = {
            "norm_g": norm_g[layer], "w_ada": w_ada[layer], "b_ada": b_ada[layer], "w_in": w_in[layer],
            "s5_a_re": s5_a_re[layer], "s5_a_im": s5_a_im[layer], "s5_log_dt": s5_log_dt[layer],
            "s5_b_re": s5_b_re[layer], "s5_b_im": s5_b_im[layer],
            "s5_c_re": s5_c_re[layer], "s5_c_im": s5_c_im[layer],
            "s5_d": s5_d[layer], "s5_w_glu": s5_w_glu[layer],
            "conv_w": conv_w[layer], "conv_b": conv_b[layer],
            "na_q_g": na_q_g[layer], "na_k_g": na_k_g[layer], "na_rel_bias": na_rel_bias[layer],
            "gqa_q_g": gqa_q_g[layer], "gqa_k_g": gqa_k_g[layer], "gqa_sink": gqa_sink[layer],
            "w_br": w_br[layer], "w_out": w_out[layer],
        }
        x, ctx = _layer(x, ctx, c, c_ctx, p, update_ctx=layer < DEPTH - 1)
    return x
```

```cpp
#include <hip/hip_runtime.h>
#include <hip/hip_cooperative_groups.h>
#include <cstdio>
namespace cg = cooperative_groups;

#ifdef ONLY
#define ONLYP(i) (ONLY == (i))
#else
#define ONLYP(i) 1
#endif
#ifndef MULTI_LAUNCH
#define MULTI_LAUNCH 0
#endif

#define DI __device__ __forceinline__
typedef unsigned short bf16_t;
typedef __attribute__((ext_vector_type(8))) short bf16x8;
typedef __attribute__((ext_vector_type(16))) float f32x16;
typedef __attribute__((ext_vector_type(2))) float f32x2;
typedef __attribute__((ext_vector_type(2))) __bf16 bfx2;
#define MFMA32(a, b, c) __builtin_amdgcn_mfma_f32_32x32x16_bf16((a), (b), (c), 0, 0, 0)

constexpr int R = 16640;
constexpr int NLAT = 16384;
constexpr int LDZ = 6400;
constexpr int LDT = 16640;
constexpr int NCH = 1040;
constexpr float LOG2E = 1.4426950408889634f;
constexpr int C_S5U = 0, C_S5G = 512, C_CV = 1024, C_CB = 1536, C_CC = 2048, C_CG = 2560, C_NQ = 3072, C_NK = 3584,
              C_NV = 4096, C_NG = 4608, C_GQ = 5120, C_GK = 5632, C_GV = 5760, C_GG = 5888;
constexpr int NPHASE = 1 + 2 * 4 * 8;

constexpr size_t al256(size_t x) { return (x + 255) & ~(size_t)255; }
constexpr size_t OFF_H = 0;
constexpr size_t OFF_Z = OFF_H + al256((size_t)R * 1024 * 2);
constexpr size_t OFF_VTN = OFF_Z + al256((size_t)R * LDZ * 2);
constexpr size_t OFF_VTG = OFF_VTN + al256((size_t)512 * LDT * 2);
constexpr size_t OFF_Y = OFF_VTG + al256((size_t)128 * LDT * 2);
constexpr size_t OFF_MIX = OFF_Y + al256((size_t)R * 512 * 2);
constexpr size_t OFF_HIN = OFF_MIX + al256((size_t)R * 1024 * 2);
constexpr size_t OFF_E = OFF_HIN + al256((size_t)NCH * 8192 * 2);
constexpr size_t OFF_CTXS = OFF_E + al256((size_t)NCH * 8192 * 4);
constexpr size_t OFF_WINT = OFF_CTXS + al256((size_t)512 * 1024 * 4);
constexpr size_t OFF_WMT = OFF_WINT + al256((size_t)4 * 6400 * 1024 * 2);
constexpr size_t OFF_WBRT = OFF_WMT + al256((size_t)4 * 4096 * 1024 * 2);
constexpr size_t OFF_WOUTT = OFF_WBRT + al256((size_t)16 * 1024 * 512 * 2);
constexpr size_t OFF_WGLUT = OFF_WOUTT + al256((size_t)4 * 1024 * 1024 * 2);
constexpr size_t OFF_S5M = OFF_WGLUT + al256((size_t)4 * 512 * 512 * 2);
constexpr size_t OFF_S5WE = OFF_S5M + al256((size_t)128 * 65536 * 2);
constexpr size_t OFF_S5R = OFF_S5WE + al256((size_t)128 * 65536 * 2);
constexpr size_t OFF_A16 = OFF_S5R + al256((size_t)128 * 65536 * 2);
constexpr size_t OFF_MOD = OFF_A16 + al256((size_t)4 * 2 * 32 * 64 * 2 * 4);
constexpr size_t OFF_ROPE = OFF_MOD + al256((size_t)4 * 3 * 3072 * 4);
constexpr size_t WS_TOTAL = OFF_ROPE + al256((size_t)256 * 16 * 2 * 4);

struct Params {
  const float *x, *c, *ctx, *c_ctx, *norm_g, *w_ada, *b_ada, *w_in, *s5_a_re, *s5_a_im, *s5_log_dt, *s5_b_re, *s5_b_im,
      *s5_c_re, *s5_c_im, *s5_d, *s5_w_glu, *conv_w, *conv_b, *na_q_g, *na_k_g, *na_rel_bias, *gqa_q_g, *gqa_k_g, *gqa_sink,
      *w_br, *w_out;
  float* out;
  char* ws;
  DI bf16_t* H() const { return (bf16_t*)(ws + OFF_H); }
  DI bf16_t* Z() const { return (bf16_t*)(ws + OFF_Z); }
  DI bf16_t* VtN() const { return (bf16_t*)(ws + OFF_VTN); }
  DI bf16_t* VtG() const { return (bf16_t*)(ws + OFF_VTG); }
  DI bf16_t* Y() const { return (bf16_t*)(ws + OFF_Y); }
  DI bf16_t* MIX() const { return (bf16_t*)(ws + OFF_MIX); }
  DI bf16_t* HIN() const { return (bf16_t*)(ws + OFF_HIN); }
  DI float* E() const { return (float*)(ws + OFF_E); }
  DI float* CTXS() const { return (float*)(ws + OFF_CTXS); }
  DI bf16_t* WinT() const { return (bf16_t*)(ws + OFF_WINT); }
  DI bf16_t* WmT() const { return (bf16_t*)(ws + OFF_WMT); }
  DI bf16_t* WbrT() const { return (bf16_t*)(ws + OFF_WBRT); }
  DI bf16_t* WoutT() const { return (bf16_t*)(ws + OFF_WOUTT); }
  DI bf16_t* WgluT() const { return (bf16_t*)(ws + OFF_WGLUT); }
  DI bf16_t* S5M() const { return (bf16_t*)(ws + OFF_S5M); }
  DI bf16_t* S5We() const { return (bf16_t*)(ws + OFF_S5WE); }
  DI bf16_t* S5R() const { return (bf16_t*)(ws + OFF_S5R); }
  DI float* A16() const { return (float*)(ws + OFF_A16); }
  DI float* MOD() const { return (float*)(ws + OFF_MOD); }
  DI float* ROPE() const { return (float*)(ws + OFF_ROPE); }
};

DI float bf2f(bf16_t v) { return __uint_as_float(((unsigned)v) << 16); }
DI unsigned pk2(float a, float b) {
  f32x2 v = {a, b};
  bfx2 r = __builtin_convertvector(v, bfx2);
  return __builtin_bit_cast(unsigned, r);
}
DI bf16_t f2bf(float a) { return (bf16_t)(pk2(a, 0.f) & 0xffffu); }
DI float lo_bf(unsigned u) { return __uint_as_float(u << 16); }
DI float hi_bf(unsigned u) { return __uint_as_float(u & 0xffff0000u); }
DI float sigmoidf_(float x) { return 1.f / (1.f + __expf(-x)); }
DI float siluf_(float x) { return x / (1.f + __expf(-x)); }
DI int crow(int i, int h) { return (i & 3) + 8 * (i >> 2) + 4 * h; }
DI bf16x8 ld16(const bf16_t* p) { return *reinterpret_cast<const bf16x8*>(p); }

template <int NI>
DI void gemm_main(f32x16 (&acc)[2][NI], const bf16_t* Abase, int lda, int akoff, int astep, const bf16_t* Bt, int ldb, int K,
                  bf16_t* sm, int tid) {
  const int lane = tid & 63, wid = tid >> 6, wm = wid >> 1, wn = wid & 1, r = lane & 31, h = lane >> 5;
  const int lrow = tid >> 3, lkc = tid & 7;
  const int aoff0 = lrow * lda + akoff, a32 = 32 * lda;
  const int boff0 = lrow * ldb + lkc * 8, b32 = 32 * ldb;
  const int soff0 = lrow * 64 + ((lkc ^ ((lrow >> 1) & 7)) * 8);
  bf16_t* As = sm;
  bf16_t* Bs = sm + 2 * 8192;
  bf16x8 ra[4], rb[2 * NI];
  const int nk = K >> 6;
#pragma unroll
  for (int i = 0; i < 4; ++i) ra[i] = ld16(Abase + aoff0 + i * a32);
#pragma unroll
  for (int i = 0; i < 2 * NI; ++i) rb[i] = ld16(Bt + boff0 + i * b32);
#pragma unroll
  for (int i = 0; i < 4; ++i) *reinterpret_cast<bf16x8*>(As + soff0 + i * 2048) = ra[i];
#pragma unroll
  for (int i = 0; i < 2 * NI; ++i) *reinterpret_cast<bf16x8*>(Bs + soff0 + i * 2048) = rb[i];
  __syncthreads();
  const int ar0 = wm * 64 + r, br0 = wn * 32 * NI + r;
  const int asw = (ar0 >> 1) & 7, bsw = (br0 >> 1) & 7;
  for (int kt = 0; kt < nk; ++kt) {
    const int cur = kt & 1;
    const bool more = (kt + 1 < nk);
    if (more) {
      const bf16_t* An_ = Abase + (size_t)(kt + 1) * astep;
      const bf16_t* Bn_ = Bt + (kt + 1) * 64;
#pragma unroll
      for (int i = 0; i < 4; ++i) ra[i] = ld16(An_ + aoff0 + i * a32);
#pragma unroll
      for (int i = 0; i < 2 * NI; ++i) rb[i] = ld16(Bn_ + boff0 + i * b32);
    }
    const bf16_t* Ac = As + cur * 8192 + ar0 * 64;
    const bf16_t* Bc = Bs + cur * 8192 + br0 * 64;
#pragma unroll
    for (int ks = 0; ks < 4; ++ks) {
      bf16x8 a[2], b[NI];
#pragma unroll
      for (int i = 0; i < 2; ++i) a[i] = *reinterpret_cast<const bf16x8*>(Ac + i * 2048 + (((ks * 2 + h) ^ asw) * 8));
#pragma unroll
      for (int i = 0; i < NI; ++i) b[i] = *reinterpret_cast<const bf16x8*>(Bc + i * 2048 + (((ks * 2 + h) ^ bsw) * 8));
#pragma unroll
      for (int mi = 0; mi < 2; ++mi)
#pragma unroll
        for (int ni = 0; ni < NI; ++ni) acc[mi][ni] = MFMA32(a[mi], b[ni], acc[mi][ni]);
    }
    if (more) {
      bf16_t* An = As + (cur ^ 1) * 8192 + soff0;
      bf16_t* Bn = Bs + (cur ^ 1) * 8192 + soff0;
#pragma unroll
      for (int i = 0; i < 4; ++i) *reinterpret_cast<bf16x8*>(An + i * 2048) = ra[i];
#pragma unroll
      for (int i = 0; i < 2 * NI; ++i) *reinterpret_cast<bf16x8*>(Bn + i * 2048) = rb[i];
    }
    __syncthreads();
  }
}

template <int NI>
DI void zero_acc(f32x16 (&acc)[2][NI]) {
#pragma unroll
  for (int a = 0; a < 2; ++a)
#pragma unroll
    for (int b = 0; b < NI; ++b)
#pragma unroll
      for (int i = 0; i < 16; ++i) acc[a][b][i] = 0.f;
}

DI void sincos_(float x, float* sn, float* cs) {
  float n = rintf(x * 0.63661977236758134f);
  float rr = fmaf(-n, 1.57079625129699707031f, x);
  rr = fmaf(-n, 7.54978941586159635335e-08f, rr);
  float r2 = rr * rr;
  float sp = rr + rr * r2 * (-1.6666654611e-1f + r2 * (8.3321608736e-3f + r2 * (-1.9515295891e-4f)));
  float cp = 1.f + r2 * (-0.5f + r2 * (4.166664568298827e-2f + r2 * (-1.388731625493765e-3f + r2 * 2.443315711809948e-5f)));
  int q = ((int)n) & 3;
  float s_ = (q & 1) ? cp : sp;
  float c_ = (q & 1) ? sp : cp;
  if (q == 1 || q == 2) c_ = -c_;
  if (q >= 2) s_ = -s_;
  *sn = s_;
  *cs = c_;
}

DI void prep_transpose(const float* src, int ld, bf16_t* dst, int K, int k0, int n0, float* tile, int tid) {
  const int nn = tid & 63, kq = tid >> 6;
#pragma unroll 4
  for (int i = 0; i < 16; ++i) {
    int kk = kq + 4 * i;
    tile[kk * 65 + nn] = src[(size_t)(k0 + kk) * ld + n0 + nn];
  }
  __syncthreads();
#pragma unroll
  for (int i = 0; i < 2; ++i) {
    int c = tid + 256 * i;
    int n2 = c >> 3, kc = c & 7;
    uint4 w;
    w.x = pk2(tile[(kc * 8 + 0) * 65 + n2], tile[(kc * 8 + 1) * 65 + n2]);
    w.y = pk2(tile[(kc * 8 + 2) * 65 + n2], tile[(kc * 8 + 3) * 65 + n2]);
    w.z = pk2(tile[(kc * 8 + 4) * 65 + n2], tile[(kc * 8 + 5) * 65 + n2]);
    w.w = pk2(tile[(kc * 8 + 6) * 65 + n2], tile[(kc * 8 + 7) * 65 + n2]);
    *reinterpret_cast<uint4*>(dst + (size_t)(n0 + n2) * K + k0 + kc * 8) = w;
  }
  __syncthreads();
}

DI void prep_s5(const Params& p, int L, int g, float* sm, int tid) {
  float* apow = sm;
  float* fco = sm + 2176;
  float* bbar = sm + 2304;
  float* Kt = sm + 4352;
  const size_t gm = (size_t)(L * 32 + g) * 65536;
  for (int d = 0; d < 2; ++d) {
    const int dg = (L * 2 + d) * 32 + g;
    if (tid < 64) {
      const int pp = tid;
      float dt = expf(p.s5_log_dt[dg]);
      float are = p.s5_a_re[dg * 64 + pp], aim = p.s5_a_im[dg * 64 + pp];
      float mag = expf(dt * are);
      float sn, cs;
      sincos_(dt * aim, &sn, &cs);
      float abr = mag * cs, abi = mag * sn;
      float den = are * are + aim * aim;
      float fr = ((abr - 1.f) * are + abi * aim) / den;
      float fi = (abi * are - (abr - 1.f) * aim) / den;
      fco[pp * 2] = fr;
      fco[pp * 2 + 1] = fi;
      float pr = 1.f, pi = 0.f;
      apow[pp * 2] = 1.f;
      apow[pp * 2 + 1] = 0.f;
      for (int t = 1; t <= 16; ++t) {
        float nr = pr * abr - pi * abi, ni = pr * abi + pi * abr;
        pr = nr; pi = ni;
        apow[(t * 64 + pp) * 2] = pr;
        apow[(t * 64 + pp) * 2 + 1] = pi;
      }
      p.A16()[(dg * 64 + pp) * 2] = pr;
      p.A16()[(dg * 64 + pp) * 2 + 1] = pi;
    }
    __syncthreads();
    for (int i = 0; i < 4; ++i) {
      int idx = tid + 256 * i;
      int pp = idx >> 4;
      float br = p.s5_b_re[(size_t)dg * 1024 + idx], bi = p.s5_b_im[(size_t)dg * 1024 + idx];
      float fr = fco[pp * 2], fi = fco[pp * 2 + 1];
      bbar[idx * 2] = fr * br - fi * bi;
      bbar[idx * 2 + 1] = fr * bi + fi * br;
    }
    __syncthreads();
    {
      const int hp = tid >> 4, hh = tid & 15;
      float kacc[16];
#pragma unroll
      for (int t = 0; t < 16; ++t) kacc[t] = 0.f;
      for (int pp = 0; pp < 64; ++pp) {
        float cr = p.s5_c_re[((size_t)dg * 16 + hp) * 64 + pp], ci = p.s5_c_im[((size_t)dg * 16 + hp) * 64 + pp];
        float br = bbar[(pp * 16 + hh) * 2], bi = bbar[(pp * 16 + hh) * 2 + 1];
        float xr = cr * br - ci * bi, xi = cr * bi + ci * br;
#pragma unroll
        for (int t = 0; t < 16; ++t) kacc[t] += xr * apow[(t * 64 + pp) * 2] - xi * apow[(t * 64 + pp) * 2 + 1];
      }
#pragma unroll
      for (int t = 0; t < 16; ++t) Kt[(d * 16 + t) * 256 + tid] = kacc[t];
    }
    for (int i = 0; i < 128; ++i) {
      int idx = tid + 256 * i;
      int k = idx & 255, nn = idx >> 8;
      int pp = nn >> 1, ri = nn & 1, j = k >> 4, hh = k & 15;
      int e = (d == 0) ? (15 - j) : j;
      float ar = apow[(e * 64 + pp) * 2], ai = apow[(e * 64 + pp) * 2 + 1];
      float br = bbar[(pp * 16 + hh) * 2], bi = bbar[(pp * 16 + hh) * 2 + 1];
      float v = ri ? (ar * bi + ai * br) : (ar * br - ai * bi);
      p.S5We()[gm + (size_t)(d * 128 + nn) * 256 + k] = f2bf(v);
    }
    for (int i = 0; i < 128; ++i) {
      int idx = tid + 256 * i;
      int kk = idx & 127, n = idx >> 7;
      int pp = kk >> 1, ri = kk & 1, t16 = n >> 4, hp = n & 15;
      int pw = (d == 0) ? (t16 + 1) : (16 - t16);
      float cr = p.s5_c_re[((size_t)dg * 16 + hp) * 64 + pp], ci = p.s5_c_im[((size_t)dg * 16 + hp) * 64 + pp];
      float ar = apow[(pw * 64 + pp) * 2], ai = apow[(pw * 64 + pp) * 2 + 1];
      float v = ri ? -(cr * ai + ci * ar) : (cr * ar - ci * ai);
      p.S5R()[gm + (size_t)n * 256 + d * 128 + kk] = f2bf(v);
    }
    __syncthreads();
  }
  for (int i = 0; i < 256; ++i) {
    int idx = tid + 256 * i;
    int k = idx & 255, n = idx >> 8;
    int t16 = n >> 4, hp = n & 15, j = k >> 4, hh = k & 15;
    float v = 0.f;
    if (j <= t16) v += Kt[(0 * 16 + (t16 - j)) * 256 + hp * 16 + hh];
    if (j >= t16) v += Kt[(1 * 16 + (j - t16)) * 256 + hp * 16 + hh];
    if (j == t16 && hp == hh) v += p.s5_d[(L * 32 + g) * 16 + hh];
    p.S5M()[gm + (size_t)n * 256 + k] = f2bf(v);
  }
  __syncthreads();
}

DI void prep_adaln(const Params& p, int L, int cb, float* sm, int tid) {
  float* sv = sm;
  float* red = sm + 3072;
  for (int idx = tid; idx < 3072; idx += 256) {
    int v = idx >> 10, k = idx & 1023;
    float cv = (v < 2) ? p.c[v * 1024 + k] : p.c_ctx[k];
    sv[idx] = siluf_(cv);
  }
  __syncthreads();
  const int cl = tid & 63, kq = tid >> 6, col = cb * 64 + cl;
  float a0 = 0.f, a1 = 0.f, a2 = 0.f;
  const float* w = p.w_ada + (size_t)L * 1024 * 3072 + col;
#pragma unroll 8
  for (int k = kq * 256; k < kq * 256 + 256; ++k) {
    float wv = w[(size_t)k * 3072];
    a0 += sv[k] * wv;
    a1 += sv[1024 + k] * wv;
    a2 += sv[2048 + k] * wv;
  }
  red[(kq * 3 + 0) * 64 + cl] = a0;
  red[(kq * 3 + 1) * 64 + cl] = a1;
  red[(kq * 3 + 2) * 64 + cl] = a2;
  __syncthreads();
  if (kq == 0) {
    float bb = p.b_ada[L * 3072 + col];
    for (int v = 0; v < 3; ++v) {
      float s = red[(0 * 3 + v) * 64 + cl] + red[(1 * 3 + v) * 64 + cl] + red[(2 * 3 + v) * 64 + cl] + red[(3 * 3 + v) * 64 + cl];
      p.MOD()[(L * 3 + v) * 3072 + col] = s + bb;
    }
  }
  __syncthreads();
}

DI void phase_prep(const Params& p, float* sm, int tid) {
  constexpr int N_S5 = 128, N_ADA = 192, N_TR_L = 3456, N_TR = 4 * N_TR_L;
  constexpr int TOTAL = N_S5 + N_ADA + 1 + N_TR;
  for (int item = blockIdx.x; item < TOTAL; item += gridDim.x) {
    if (item < N_S5) {
      prep_s5(p, item >> 5, item & 31, sm, tid);
    } else if (item < N_S5 + N_ADA) {
      int it = item - N_S5;
      prep_adaln(p, it / 48, it % 48, sm, tid);
    } else if (item == N_S5 + N_ADA) {
      for (int idx = tid; idx < 256 * 16; idx += 256) {
        int pos = idx >> 4, i = idx & 15;
        float inv = exp2f(-(float)i * (13.287712379549449f / 16.f));
        float sn, cs;
        sincos_((float)pos * inv, &sn, &cs);
        p.ROPE()[idx * 2] = cs;
        p.ROPE()[idx * 2 + 1] = sn;
      }
    } else {
      int it = item - (N_S5 + N_ADA + 1);
      int L = it / N_TR_L, tt = it % N_TR_L;
      const float* src; bf16_t* dst; int ld, K, kt, nt;
      if (tt < 1600) {
        kt = tt / 100; nt = tt % 100; src = p.w_in + (size_t)L * 1024 * 10496; ld = 10496; K = 1024;
        dst = p.WinT() + (size_t)L * 6400 * 1024;
      } else if (tt < 2624) {
        int t2 = tt - 1600; kt = t2 / 64; nt = t2 % 64; src = p.w_in + (size_t)L * 1024 * 10496 + 6400; ld = 10496; K = 1024;
        dst = p.WmT() + (size_t)L * 4096 * 1024;
      } else if (tt < 3136) {
        int t2 = tt - 2624; int kb = t2 / 128; int t3 = t2 % 128; kt = t3 / 16; nt = t3 % 16;
        src = p.w_br + (size_t)(L * 4 + kb) * 512 * 1024; ld = 1024; K = 512;
        dst = p.WbrT() + (size_t)(L * 4 + kb) * 1024 * 512;
      } else if (tt < 3392) {
        int t2 = tt - 3136; kt = t2 / 16; nt = t2 % 16; src = p.w_out + (size_t)L * 1024 * 1024; ld = 1024; K = 1024;
        dst = p.WoutT() + (size_t)L * 1024 * 1024;
      } else {
        int t2 = tt - 3392; kt = t2 / 8; nt = t2 % 8; src = p.s5_w_glu + (size_t)L * 512 * 512; ld = 512; K = 512;
        dst = p.WgluT() + (size_t)L * 512 * 512;
      }
      prep_transpose(src, ld, dst, K, kt * 64, nt * 64, sm, tid);
    }
  }
}

DI void phase_norm(const Params& p, int b, int L, int tid) {
  const int wid = tid >> 6, lane = tid & 63;
  const float* g = p.norm_g + L * 1024;
  for (int item = blockIdx.x; item < R / 4; item += gridDim.x) {
    const int row = item * 4 + wid;
    const float* src;
    const float* mod;
    if (row < NLAT) {
      src = (L == 0 ? p.x : (const float*)p.out) + ((size_t)b * NLAT + row) * 1024;
      mod = p.MOD() + (L * 3 + b) * 3072;
    } else {
      src = (L == 0 ? p.ctx : (const float*)p.CTXS()) + ((size_t)b * 256 + (row - NLAT)) * 1024;
      mod = p.MOD() + (L * 3 + 2) * 3072;
    }
    float4 v[4];
    float ss = 0.f;
#pragma unroll
    for (int j = 0; j < 4; ++j) {
      v[j] = *reinterpret_cast<const float4*>(src + j * 256 + lane * 4);
      ss += v[j].x * v[j].x + v[j].y * v[j].y + v[j].z * v[j].z + v[j].w * v[j].w;
    }
#pragma unroll
    for (int o = 32; o >= 1; o >>= 1) ss += __shfl_xor(ss, o);
    const float rs = rsqrtf(ss * (1.f / 1024.f) + 1e-6f);
#pragma unroll
    for (int j = 0; j < 4; ++j) {
      const int col = j * 256 + lane * 4;
      float4 g4 = *reinterpret_cast<const float4*>(g + col);
      float4 sh = *reinterpret_cast<const float4*>(mod + col);
      float4 sc = *reinterpret_cast<const float4*>(mod + 1024 + col);
      float y0 = v[j].x * rs * g4.x * (1.f + sc.x) + sh.x;
      float y1 = v[j].y * rs * g4.y * (1.f + sc.y) + sh.y;
      float y2 = v[j].z * rs * g4.z * (1.f + sc.z) + sh.z;
      float y3 = v[j].w * rs * g4.w * (1.f + sc.w) + sh.w;
      uint2 w;
      w.x = pk2(y0, y1);
      w.y = pk2(y2, y3);
      *reinterpret_cast<uint2*>(p.H() + (size_t)row * 1024 + col) = w;
    }
  }
}

DI void phase_p1(const Params& p, int b, int L, bf16_t* sm, int tid) {
  const int lane = tid & 63, wid = tid >> 6, wm = wid >> 1, wn = wid & 1, r = lane & 31, h = lane >> 5;
  for (int tile = blockIdx.x; tile < 130 * 50; tile += gridDim.x) {
    const int mt = tile / 50, nt = tile % 50;
    const int m0 = mt * 128, n0 = nt * 128;
    f32x16 acc[2][2];
    zero_acc<2>(acc);
    const bf16_t* Abase = p.H() + (size_t)m0 * 1024;
    gemm_main<2>(acc, Abase, 1024, (tid & 7) * 8, 64,
              p.WinT() + (size_t)L * 6400 * 1024 + (size_t)n0 * 1024, 1024, 1024, sm, tid);
    const int nw = n0 + wn * 64;
    const int mw = m0 + wm * 64;
    int kind = 0;
    const float* gvec = nullptr;
    float mult = 1.f;
    bool rope = false;
    bf16_t* vt = nullptr;
    if (nw >= C_NQ && nw < C_NK) { kind = 1; gvec = p.na_q_g + L * 64; mult = 0.125f * LOG2E; }
    else if (nw >= C_NK && nw < C_NV) { kind = 1; gvec = p.na_k_g + L * 64; }
    else if (nw >= C_NV && nw < C_NG) { kind = 2; vt = p.VtN() + (size_t)(nw - C_NV) * LDT; }
    else if (nw >= C_GQ && nw < C_GK) { kind = 1; gvec = p.gqa_q_g + L * 64; mult = 0.125f * LOG2E; rope = (m0 < NLAT); }
    else if (nw >= C_GK && nw < C_GV) { kind = 1; gvec = p.gqa_k_g + L * 64; rope = (m0 < NLAT); }
    else if (nw >= C_GV && nw < C_GG) { kind = 2; vt = p.VtG() + (size_t)(nw - C_GV) * LDT; }
    if (kind == 0) {
#pragma unroll
      for (int mi = 0; mi < 2; ++mi)
#pragma unroll
        for (int ni = 0; ni < 2; ++ni)
#pragma unroll
          for (int i = 0; i < 16; ++i) {
            int row = mw + mi * 32 + crow(i, h);
            p.Z()[(size_t)row * LDZ + nw + ni * 32 + r] = f2bf(acc[mi][ni][i]);
          }
    } else if (kind == 1) {
      const float g0 = gvec[r], g1 = gvec[32 + r];
#pragma unroll
      for (int mi = 0; mi < 2; ++mi)
#pragma unroll
        for (int i = 0; i < 16; ++i) {
          float a = acc[mi][0][i], c2 = acc[mi][1][i];
          float ss = a * a + c2 * c2;
#pragma unroll
          for (int o = 16; o >= 1; o >>= 1) ss += __shfl_xor(ss, o);
          float rs = rsqrtf(ss * (1.f / 64.f) + 1e-6f);
          a = a * rs * g0;
          c2 = c2 * rs * g1;
          int row = mw + mi * 32 + crow(i, h);
          if (rope) {
            int pos = (r < 16) ? (row >> 6) : (row & 63);
            float cs = p.ROPE()[(pos * 16 + (r & 15)) * 2], sn = p.ROPE()[(pos * 16 + (r & 15)) * 2 + 1];
            float a2 = a * cs - c2 * sn;
            float c3 = c2 * cs + a * sn;
            a = a2; c2 = c3;
          }
          p.Z()[(size_t)row * LDZ + nw + r] = f2bf(a * mult);
          p.Z()[(size_t)row * LDZ + nw + 32 + r] = f2bf(c2 * mult);
        }
    } else {
#pragma unroll
      for (int mi = 0; mi < 2; ++mi)
#pragma unroll
        for (int ni = 0; ni < 2; ++ni)
#pragma unroll
          for (int i4 = 0; i4 < 4; ++i4) {
            int row0 = mw + mi * 32 + i4 * 8 + 4 * h;
            uint2 w;
            w.x = pk2(acc[mi][ni][i4 * 4 + 0], acc[mi][ni][i4 * 4 + 1]);
            w.y = pk2(acc[mi][ni][i4 * 4 + 2], acc[mi][ni][i4 * 4 + 3]);
            *reinterpret_cast<uint2*>(vt + (size_t)(ni * 32 + r) * LDT + row0) = w;
          }
    }
  }
}

DI void phase_s5e_conv(const Params& p, int b, int L, bf16_t* sm, int tid) {
  const int lane = tid & 63, wid = tid >> 6, wm = wid >> 1, wn = wid & 1, r = lane & 31, h = lane >> 5;
  constexpr int NT_E = 32 * 9 * 2;
  constexpr int NT_C = R * 64 / 256;
  for (int item = blockIdx.x; item < NT_E + NT_C; item += gridDim.x) {
    if (item < NT_E) {
      const int g = item / 18, rem = item % 18, mt = rem >> 1, nt = rem & 1;
      const int m0 = mt * 128, n0 = nt * 128;
      f32x16 acc[2][2];
      zero_acc<2>(acc);
      const bf16_t* Ub = p.Z() + C_S5U + g * 16;
      gemm_main<2>(acc, Ub + (size_t)m0 * 16 * LDZ, 16 * LDZ, ((tid & 7) >> 1) * LDZ + (tid & 1) * 8, 4 * LDZ, p.S5We() + (size_t)(L * 32 + g) * 65536 + (size_t)n0 * 256, 256, 256, sm, tid);
#pragma unroll
      for (int mi = 0; mi < 2; ++mi)
#pragma unroll
        for (int ni = 0; ni < 2; ++ni)
#pragma unroll
          for (int i = 0; i < 16; ++i) {
            int m = m0 + wm * 64 + mi * 32 + crow(i, h);
            int n = n0 + wn * 64 + ni * 32 + r;
            if (m < NCH) p.E()[((size_t)m * 32 + g) * 256 + n] = acc[mi][ni][i];
          }
    } else {
      const int idx = (item - NT_E) * 256 + tid;
      const int row = idx >> 6, ch = (idx & 63) * 8;
      const int lo = (row < NLAT) ? 0 : NLAT, hi = (row < NLAT) ? (NLAT - 1) : (R - 1);
      const bf16_t* zr = p.Z() + (size_t)row * LDZ;
      float zz[3][8];
#pragma unroll
      for (int t = 0; t < 3; ++t) {
        int rr = row + t - 1;
        if (rr >= lo && rr <= hi) {
          uint4 cv = *reinterpret_cast<const uint4*>(p.Z() + (size_t)rr * LDZ + C_CV + ch);
          uint4 cc = *reinterpret_cast<const uint4*>(p.Z() + (size_t)rr * LDZ + C_CC + ch);
          zz[t][0] = lo_bf(cv.x) * lo_bf(cc.x); zz[t][1] = hi_bf(cv.x) * hi_bf(cc.x);
          zz[t][2] = lo_bf(cv.y) * lo_bf(cc.y); zz[t][3] = hi_bf(cv.y) * hi_bf(cc.y);
          zz[t][4] = lo_bf(cv.z) * lo_bf(cc.z); zz[t][5] = hi_bf(cv.z) * hi_bf(cc.z);
          zz[t][6] = lo_bf(cv.w) * lo_bf(cc.w); zz[t][7] = hi_bf(cv.w) * hi_bf(cc.w);
        } else {
#pragma unroll
          for (int j = 0; j < 8; ++j) zz[t][j] = 0.f;
        }
      }
      uint4 cb = *reinterpret_cast<const uint4*>(zr + C_CB + ch);
      uint4 cg_ = *reinterpret_cast<const uint4*>(zr + C_CG + ch);
      float bv[8] = {lo_bf(cb.x), hi_bf(cb.x), lo_bf(cb.y), hi_bf(cb.y), lo_bf(cb.z), hi_bf(cb.z), lo_bf(cb.w), hi_bf(cb.w)};
      float gv[8] = {lo_bf(cg_.x), hi_bf(cg_.x), lo_bf(cg_.y), hi_bf(cg_.y), lo_bf(cg_.z), hi_bf(cg_.z), lo_bf(cg_.w), hi_bf(cg_.w)};
      float o[8];
#pragma unroll
      for (int j = 0; j < 8; ++j) {
        float y = p.conv_b[L * 512 + ch + j] + zz[0][j] * p.conv_w[(L * 3 + 0) * 512 + ch + j] +
                  zz[1][j] * p.conv_w[(L * 3 + 1) * 512 + ch + j] + zz[2][j] * p.conv_w[(L * 3 + 2) * 512 + ch + j];
        o[j] = bv[j] * y * siluf_(gv[j]);
      }
      uint4 w;
      w.x = pk2(o[0], o[1]); w.y = pk2(o[2], o[3]); w.z = pk2(o[4], o[5]); w.w = pk2(o[6], o[7]);
      *reinterpret_cast<uint4*>(p.Z() + (size_t)row * LDZ + C_CG + ch) = w;
    }
  }
}

DI void phase_s5y(const Params& p, int b, int L, bf16_t* sm, int tid) {
  const int lane = tid & 63, wid = tid >> 6, wm = wid >> 1, wn = wid & 1, r = lane & 31, h = lane >> 5;
  for (int item = blockIdx.x; item < 32 * 18; item += gridDim.x) {
    const int g = item / 18, rem = item % 18, mt = rem >> 1, nt = rem & 1;
    const int m0 = mt * 128, n0 = nt * 128;
    f32x16 acc[2][2];
    zero_acc<2>(acc);
    const bf16_t* Ub = p.Z() + C_S5U + g * 16;
    gemm_main<2>(acc, Ub + (size_t)m0 * 16 * LDZ, 16 * LDZ, ((tid & 7) >> 1) * LDZ + (tid & 1) * 8, 4 * LDZ, p.S5M() + (size_t)(L * 32 + g) * 65536 + (size_t)n0 * 256, 256, 256, sm, tid);
    const bf16_t* Hb = p.HIN() + g * 256;
    gemm_main<2>(acc, Hb + (size_t)m0 * 8192, 8192, (tid & 7) * 8, 64, p.S5R() + (size_t)(L * 32 + g) * 65536 + (size_t)n0 * 256, 256, 256, sm, tid);
#pragma unroll
    for (int mi = 0; mi < 2; ++mi)
#pragma unroll
      for (int ni = 0; ni < 2; ++ni)
#pragma unroll
        for (int i = 0; i < 16; ++i) {
          int m = m0 + wm * 64 + mi * 32 + crow(i, h);
          int n = n0 + wn * 64 + ni * 32 + r;
          if (m < NCH) {
            float y = acc[mi][ni][i];
            float z = 1.5957691216057308f * (y + 0.044715f * y * y * y);
            y = y * sigmoidf_(z);
            p.Y()[(size_t)(m * 16 + (n >> 4)) * 512 + g * 16 + (n & 15)] = f2bf(y);
          }
        }
  }
}

DI void phase_glu(const Params& p, int b, int L, bf16_t* sm, int tid) {
  const int lane = tid & 63, wid = tid >> 6, wm = wid >> 1, wn = wid & 1, r = lane & 31, h = lane >> 5;
  for (int tile = blockIdx.x; tile < 130 * 4; tile += gridDim.x) {
    const int mt = tile >> 2, nt = tile & 3;
    const int m0 = mt * 128, n0 = nt * 128;
    f32x16 acc[2][2];
    zero_acc<2>(acc);
    const bf16_t* Ab = p.Y() + (size_t)m0 * 512;
    gemm_main<2>(acc, Ab, 512, (tid & 7) * 8, 64,
              p.WgluT() + (size_t)L * 512 * 512 + (size_t)n0 * 512, 512, 512, sm, tid);
#pragma unroll
    for (int mi = 0; mi < 2; ++mi)
#pragma unroll
      for (int ni = 0; ni < 2; ++ni)
#pragma unroll
        for (int i = 0; i < 16; ++i) {
          int row = m0 + wm * 64 + mi * 32 + crow(i, h);
          int col = n0 + wn * 64 + ni * 32 + r;
          float yv = bf2f(p.Y()[(size_t)row * 512 + col]);
          bf16_t* gp = p.Z() + (size_t)row * LDZ + C_S5G + col;
          float gt = bf2f(*gp);
          *gp = f2bf(yv * sigmoidf_(acc[mi][ni][i]) * siluf_(gt));
        }
  }
}

DI void attn_item(const Params& p, int L, int mode, int head, int q_row0, int na_r, const float* bias_s, int lane) {
  const int r = lane & 31, h = lane >> 5;
  int qcol, kcol, gcol;
  const bf16_t* vt;
  if (mode == 0 || mode == 2) {
    qcol = C_NQ + head * 64; kcol = C_NK + head * 64; gcol = C_NG + head * 64;
    vt = p.VtN() + (size_t)(head * 64) * LDT;
  } else {
    qcol = C_GQ + head * 64; kcol = C_GK + (head >> 2) * 64; gcol = C_GG + head * 64;
    vt = p.VtG() + (size_t)((head >> 2) * 64) * LDT;
  }
  bf16x8 qf[4];
  {
    const bf16_t* qp = p.Z() + (size_t)(q_row0 + r) * LDZ + qcol + h * 8;
#pragma unroll
    for (int ks = 0; ks < 4; ++ks) qf[ks] = ld16(qp + ks * 16);
  }
  float m_run = -1e30f, l_run = 0.f;
  f32x16 O0, O1;
#pragma unroll
  for (int i = 0; i < 16; ++i) { O0[i] = 0.f; O1[i] = 0.f; }
  const int ntiles = (mode == 0) ? 24 : (mode == 1 ? 17 : 8);
  const int rs = min(max(na_r - 4, 0), 256 - 8);
  const int qc = (q_row0 & 63) + r;
  const int cs0 = min(max(qc - 8, 0), 48);
  for (int it = 0; it < ntiles; ++it) {
    int krow0, mtype = 0;
    if (it < 8) {
      krow0 = NLAT + it * 32;
    } else if (mode == 0) {
      int kt = it - 8;
      krow0 = (rs + (kt >> 1)) * 64 + (kt & 1) * 32;
      mtype = 1;
    } else {
      krow0 = q_row0 - 128 + (it - 8) * 32;
      if (krow0 < 0 || krow0 >= NLAT) continue;
      mtype = 2;
    }
    f32x16 S;
#pragma unroll
    for (int i = 0; i < 16; ++i) S[i] = 0.f;
    {
      const bf16_t* kp = p.Z() + (size_t)(krow0 + r) * LDZ + kcol + h * 8;
#pragma unroll
      for (int ks = 0; ks < 4; ++ks) {
        bf16x8 kf = ld16(kp + ks * 16);
        S = MFMA32(kf, qf[ks], S);
      }
    }
    if (mtype == 1) {
      const int kt = it - 8;
      const int kcb = (kt & 1) * 32;
      const int di = rs + (kt >> 1) - na_r + 7;
      const float* brow = bias_s + head * 465 + di * 31;
#pragma unroll
      for (int i = 0; i < 16; ++i) {
        int kc = kcb + crow(i, h);
        bool ok = (unsigned)(kc - cs0) < 16u;
        int dj = min(max(kc - qc + 15, 0), 30);
        float bv = brow[dj];
        S[i] = ok ? (S[i] + bv) : -INFINITY;
      }
    } else if (mtype == 2) {
      const int tq = q_row0 + r;
#pragma unroll
      for (int i = 0; i < 16; ++i) {
        int tk = krow0 + crow(i, h);
        int df = tk - tq;
        bool ok = (df <= 128) && (df >= -128);
        S[i] = ok ? S[i] : -INFINITY;
      }
    }
    float mx = S[0];
#pragma unroll
    for (int i = 1; i < 16; ++i) mx = fmaxf(mx, S[i]);
    mx = fmaxf(mx, __shfl_xor(mx, 32));
    const float mn = fmaxf(m_run, mx);
    const float alpha = __builtin_amdgcn_exp2f(m_run - mn);
    m_run = mn;
    float rsum = 0.f;
#pragma unroll
    for (int i = 0; i < 16; ++i) {
      float pv = __builtin_amdgcn_exp2f(S[i] - mn);
      S[i] = pv;
      rsum += pv;
    }
    l_run = l_run * alpha + rsum;
#pragma unroll
    for (int i = 0; i < 16; ++i) { O0[i] *= alpha; O1[i] *= alpha; }
    union { bf16x8 v; unsigned u[4]; } pb0, pb1;
#pragma unroll
    for (int j = 0; j < 4; ++j) {
      pb0.u[j] = pk2(S[2 * j], S[2 * j + 1]);
      pb1.u[j] = pk2(S[8 + 2 * j], S[8 + 2 * j + 1]);
    }
    {
      const bf16_t* vp0 = vt + (size_t)r * LDT + krow0 + 4 * h;
      const bf16_t* vp1 = vt + (size_t)(32 + r) * LDT + krow0 + 4 * h;
      union { bf16x8 v; uint2 u[2]; } f;
      f.u[0] = *reinterpret_cast<const uint2*>(vp0);
      f.u[1] = *reinterpret_cast<const uint2*>(vp0 + 8);
      O0 = MFMA32(f.v, pb0.v, O0);
      f.u[0] = *reinterpret_cast<const uint2*>(vp0 + 16);
      f.u[1] = *reinterpret_cast<const uint2*>(vp0 + 24);
      O0 = MFMA32(f.v, pb1.v, O0);
      f.u[0] = *reinterpret_cast<const uint2*>(vp1);
      f.u[1] = *reinterpret_cast<const uint2*>(vp1 + 8);
      O1 = MFMA32(f.v, pb0.v, O1);
      f.u[0] = *reinterpret_cast<const uint2*>(vp1 + 16);
      f.u[1] = *reinterpret_cast<const uint2*>(vp1 + 24);
      O1 = MFMA32(f.v, pb1.v, O1);
    }
  }
  float l = l_run + __shfl_xor(l_run, 32);
  if (mode == 1 || mode == 3) l += __builtin_amdgcn_exp2f(p.gqa_sink[L * 8 + head] * LOG2E - m_run);
  const float inv = 1.f / l;
  bf16_t* gp = p.Z() + (size_t)(q_row0 + r) * LDZ + gcol + 4 * h;
#pragma unroll
  for (int i4 = 0; i4 < 4; ++i4) {
    {
      uint2 gt = *reinterpret_cast<const uint2*>(gp + i4 * 8);
      uint2 w;
      w.x = pk2(O0[i4 * 4 + 0] * inv * siluf_(lo_bf(gt.x)), O0[i4 * 4 + 1] * inv * siluf_(hi_bf(gt.x)));
      w.y = pk2(O0[i4 * 4 + 2] * inv * siluf_(lo_bf(gt.y)), O0[i4 * 4 + 3] * inv * siluf_(hi_bf(gt.y)));
      *reinterpret_cast<uint2*>(gp + i4 * 8) = w;
    }
    {
      uint2 gt = *reinterpret_cast<const uint2*>(gp + 32 + i4 * 8);
      uint2 w;
      w.x = pk2(O1[i4 * 4 + 0] * inv * siluf_(lo_bf(gt.x)), O1[i4 * 4 + 1] * inv * siluf_(hi_bf(gt.x)));
      w.y = pk2(O1[i4 * 4 + 2] * inv * siluf_(lo_bf(gt.y)), O1[i4 * 4 + 3] * inv * siluf_(hi_bf(gt.y)));
      *reinterpret_cast<uint2*>(gp + 32 + i4 * 8) = w;
    }
  }
}

DI void scan_item(const Params& p, int L, int w, int lane) {
  const int d = w >> 5, g = w & 31;
  const int dg = (L * 2 + d) * 32 + g;
  const float ar = p.A16()[(dg * 64 + lane) * 2], ai = p.A16()[(dg * 64 + lane) * 2 + 1];
  float hr = 0.f, hi = 0.f;
  const int off = g * 256 + d * 128 + lane * 2;
  float2 e[8];
#pragma unroll
  for (int u = 0; u < 8; ++u) {
    int s = u;
    int chunk = (d == 0) ? (s < 16 ? 1024 + s : s - 16) : (NCH - 1 - s);
    e[u] = *reinterpret_cast<const float2*>(p.E() + (size_t)chunk * 8192 + off);
  }
  for (int s0 = 0; s0 < NCH; s0 += 8) {
    float2 en[8];
    if (s0 + 8 < NCH) {
#pragma unroll
      for (int u = 0; u < 8; ++u) {
        int s = s0 + 8 + u;
        int chunk = (d == 0) ? (s < 16 ? 1024 + s : s - 16) : (NCH - 1 - s);
        en[u] = *reinterpret_cast<const float2*>(p.E() + (size_t)chunk * 8192 + off);
      }
    } else {
#pragma unroll
      for (int u = 0; u < 8; ++u) en[u] = make_float2(0.f, 0.f);
    }
#pragma unroll
    for (int u = 0; u < 8; ++u) {
      int s = s0 + u;
      int chunk = (d == 0) ? (s < 16 ? 1024 + s : s - 16) : (NCH - 1 - s);
      *reinterpret_cast<unsigned*>(p.HIN() + (size_t)chunk * 8192 + off) = pk2(hr, hi);
      float nr = ar * hr - ai * hi + e[u].x;
      float ni = ar * hi + ai * hr + e[u].y;
      hr = nr; hi = ni;
    }
#pragma unroll
    for (int u = 0; u < 8; ++u) e[u] = en[u];
  }
}

DI void phase_attn_scan(const Params& p, int b, int L, float* sm, int tid) {
  const int lane = tid & 63, wid = tid >> 6;
  for (int idx = tid; idx < 8 * 465; idx += 256) sm[idx] = p.na_rel_bias[L * 8 * 465 + idx] * LOG2E;
  __syncthreads();
  constexpr int N_SCAN = 16, N_ATT = 8320 / 4;
  for (int item = blockIdx.x; item < N_SCAN + N_ATT; item += gridDim.x) {
    if (item < N_SCAN) {
      scan_item(p, L, item * 4 + wid, lane);
    } else {
      const int w = (item - N_SCAN) * 4 + wid;
      if (w < 4096) {
        int half = w & 1, head = (w >> 1) & 7, rr = w >> 4;
        attn_item(p, L, 0, head, rr * 64 + half * 32, rr, sm, lane);
      } else if (w < 8192) {
        int w2 = w - 4096;
        attn_item(p, L, 1, w2 & 7, (w2 >> 3) * 32, 0, sm, lane);
      } else if (w < 8256) {
        int w2 = w - 8192;
        attn_item(p, L, 2, w2 & 7, NLAT + (w2 >> 3) * 32, 0, sm, lane);
      } else {
        int w2 = w - 8256;
        attn_item(p, L, 3, w2 & 7, NLAT + (w2 >> 3) * 32, 0, sm, lane);
      }
    }
  }
  __syncthreads();
}

DI void phase_merge(const Params& p, int b, int L, bf16_t* sm, int tid) {
  const int lane = tid & 63, wid = tid >> 6, wm = wid >> 1, wn = wid & 1, r = lane & 31, h = lane >> 5;
  for (int tile = blockIdx.x; tile < 130 * 16; tile += gridDim.x) {
    const int mt = tile >> 4, nt = tile & 15;
    const int m0 = mt * 128, n0 = nt * 64;
    f32x16 outv[2][1];
    zero_acc<1>(outv);
    for (int kb = 0; kb < 4; ++kb) {
      unsigned sg[2][8];
      {
        f32x16 acc[2][1];
        zero_acc<1>(acc);
        const bf16_t* Ab = p.H() + (size_t)m0 * 1024;
        gemm_main<1>(acc, Ab, 1024, (tid & 7) * 8, 64,
                     p.WmT() + (size_t)L * 4096 * 1024 + (size_t)(kb * 1024 + n0) * 1024, 1024, 1024, sm, tid);
#pragma unroll
        for (int mi = 0; mi < 2; ++mi)
#pragma unroll
          for (int j = 0; j < 8; ++j) sg[mi][j] = pk2(sigmoidf_(acc[mi][0][2 * j]), sigmoidf_(acc[mi][0][2 * j + 1]));
      }
      {
        f32x16 acc[2][1];
        zero_acc<1>(acc);
        const int gc = (kb == 0) ? C_S5G : (kb == 1 ? C_CG : (kb == 2 ? C_NG : C_GG));
        const bf16_t* Ab = p.Z() + (size_t)m0 * LDZ + gc;
        gemm_main<1>(acc, Ab, LDZ, (tid & 7) * 8, 64,
                     p.WbrT() + (size_t)(L * 4 + kb) * 1024 * 512 + (size_t)n0 * 512, 512, 512, sm, tid);
#pragma unroll
        for (int mi = 0; mi < 2; ++mi)
#pragma unroll
          for (int j = 0; j < 8; ++j) {
            outv[mi][0][2 * j] += lo_bf(sg[mi][j]) * acc[mi][0][2 * j];
            outv[mi][0][2 * j + 1] += hi_bf(sg[mi][j]) * acc[mi][0][2 * j + 1];
          }
      }
    }
#pragma unroll
    for (int mi = 0; mi < 2; ++mi)
#pragma unroll
      for (int i = 0; i < 16; ++i) {
        int row = m0 + wm * 64 + mi * 32 + crow(i, h);
        int col = n0 + wn * 32 + r;
        p.MIX()[(size_t)row * 1024 + col] = f2bf(outv[mi][0][i]);
      }
  }
}

DI void phase_out(const Params& p, int b, int L, bf16_t* sm, int tid) {
  const int lane = tid & 63, wid = tid >> 6, wm = wid >> 1, wn = wid & 1, r = lane & 31, h = lane >> 5;
  const int ntile = (L == 3) ? 128 * 8 : 130 * 8;
  for (int tile = blockIdx.x; tile < ntile; tile += gridDim.x) {
    const int mt = tile >> 3, nt = tile & 7;
    const int m0 = mt * 128, n0 = nt * 128;
    f32x16 acc[2][2];
    zero_acc<2>(acc);
    const bf16_t* Ab = p.MIX() + (size_t)m0 * 1024;
    gemm_main<2>(acc, Ab, 1024, (tid & 7) * 8, 64,
              p.WoutT() + (size_t)L * 1024 * 1024 + (size_t)n0 * 1024, 1024, 1024, sm, tid);
    const float* src;
    float* dst;
    const float* gate;
    if (m0 < NLAT) {
      src = (L == 0 ? p.x : (const float*)p.out) + ((size_t)b * NLAT + m0) * 1024;
      dst = p.out + ((size_t)b * NLAT + m0) * 1024;
      gate = p.MOD() + (L * 3 + b) * 3072 + 2048;
    } else {
      src = (L == 0 ? p.ctx : (const float*)p.CTXS()) + ((size_t)b * 256 + (m0 - NLAT)) * 1024;
      dst = p.CTXS() + ((size_t)b * 256 + (m0 - NLAT)) * 1024;
      gate = p.MOD() + (L * 3 + 2) * 3072 + 2048;
    }
#pragma unroll
    for (int ni = 0; ni < 2; ++ni) {
      const int col = n0 + wn * 64 + ni * 32 + r;
      const float gt = gate[col];
#pragma unroll
      for (int mi = 0; mi < 2; ++mi)
#pragma unroll
        for (int i = 0; i < 16; ++i) {
          int rl = wm * 64 + mi * 32 + crow(i, h);
          dst[(size_t)rl * 1024 + col] = src[(size_t)rl * 1024 + col] + gt * acc[mi][ni][i];
        }
    }
  }
}

__global__ void __launch_bounds__(256, 2) mega_kernel(Params p, int ph_lo, int ph_hi) {
  __shared__ __attribute__((aligned(16))) unsigned char smem_raw[65536];
  bf16_t* smb = reinterpret_cast<bf16_t*>(smem_raw);
  float* smf = reinterpret_cast<float*>(smem_raw);
  for (int ph = ph_lo; ph < ph_hi; ++ph) {
    int tid = threadIdx.x;
    asm volatile("" : "+v"(tid));
    if (ph == 0) {
#if !defined(ONLY) || ONLY == 8
      phase_prep(p, smf, tid);
#endif
    } else {
      const int q = ph - 1;
      const int b = q >> 5, L = (q & 31) >> 3, sub = q & 7;
      switch (sub) {
        case 0: if (!ONLYP(0)) {} else phase_norm(p, b, L, tid); break;
        case 1: if (!ONLYP(1)) {} else phase_p1(p, b, L, smb, tid); break;
        case 2: if (!ONLYP(2)) {} else phase_s5e_conv(p, b, L, smb, tid); break;
        case 3: if (!ONLYP(3)) {} else phase_attn_scan(p, b, L, smf, tid); break;
        case 4: if (!ONLYP(4)) {} else phase_s5y(p, b, L, smb, tid); break;
        case 5: if (!ONLYP(5)) {} else phase_glu(p, b, L, smb, tid); break;
        case 6: if (!ONLYP(6)) {} else phase_merge(p, b, L, smb, tid); break;
        default: if (!ONLYP(7)) {} else phase_out(p, b, L, smb, tid); break;
      }
    }
    if (ph + 1 < ph_hi) cg::this_grid().sync();
  }
}

extern "C" void kernel_launch(void* const* d_in, const int* in_sizes, int n_in, void* d_out, int out_size, void* d_ws,
                              size_t ws_size, hipStream_t stream) {
  Params p{};
  const float** fp = reinterpret_cast<const float**>(&p);
  for (int i = 0; i < 27; ++i) fp[i] = (const float*)d_in[i];
  p.out = (float*)d_out;
  p.ws = (char*)d_ws;
  const size_t off = WS_TOTAL;
  if (off > ws_size) {
    fprintf(stderr, "workspace too small: need %zu have %zu\n", off, ws_size);
    return;
  }
  static int grid_blocks = 0;
  if (!grid_blocks) {
    int dev = 0, cus = 0, per_cu = 0;
    hipGetDevice(&dev);
    hipDeviceGetAttribute(&cus, hipDeviceAttributeMultiprocessorCount, dev);
    hipOccupancyMaxActiveBlocksPerMultiprocessor(&per_cu, mega_kernel, 256, 0);
    if (per_cu > 2) per_cu = 2;
    if (per_cu < 1) per_cu = 1;
    grid_blocks = cus * per_cu;
  }
#if MULTI_LAUNCH
  for (int ph = 0; ph < NPHASE; ++ph) {
    hipLaunchKernelGGL(mega_kernel, dim3(grid_blocks), dim3(256), 0, stream, p, ph, ph + 1);
  }
#else
  int lo = 0, hi = NPHASE;
  void* args[] = {&p, &lo, &hi};
  hipError_t e = hipLaunchCooperativeKernel((void*)mega_kernel, dim3(grid_blocks), dim3(256), args, 0, stream);
  if (e != hipSuccess) fprintf(stderr, "cooperative launch failed: %s (grid %d)\n", hipGetErrorString(e), grid_blocks);
#endif
}
```

```cpp
#include <hip/hip_runtime.h>
#include <hip/hip_cooperative_groups.h>
#include <cstdio>
namespace cg = cooperative_groups;

#ifdef ONLY
#define ONLYP(i) (ONLY == (i))
#else
#define ONLYP(i) 1
#endif
#ifndef MULTI_LAUNCH
#define MULTI_LAUNCH 0
#endif

#define DI __device__ __forceinline__
typedef unsigned short bf16_t;
typedef __attribute__((ext_vector_type(8))) short bf16x8;
typedef __attribute__((ext_vector_type(16))) float f32x16;
typedef __attribute__((ext_vector_type(2))) float f32x2;
typedef __attribute__((ext_vector_type(2))) __bf16 bfx2;
#define MFMA32(a, b, c) __builtin_amdgcn_mfma_f32_32x32x16_bf16((a), (b), (c), 0, 0, 0)

constexpr int R = 16640;
constexpr int NLAT = 16384;
constexpr int LDZ = 6400;
constexpr int LDT = 16640;
constexpr int NCH = 1040;
constexpr float LOG2E = 1.4426950408889634f;
constexpr int C_S5U = 0, C_S5G = 512, C_CV = 1024, C_CB = 1536, C_CC = 2048, C_CG = 2560, C_NQ = 3072, C_NK = 3584,
              C_NV = 4096, C_NG = 4608, C_GQ = 5120, C_GK = 5632, C_GV = 5760, C_GG = 5888;
constexpr int NPHASE = 1 + 2 * 4 * 8;

constexpr size_t al256(size_t x) { return (x + 255) & ~(size_t)255; }
constexpr size_t OFF_H = 0;
constexpr size_t OFF_Z = OFF_H + al256((size_t)R * 1024 * 2);
constexpr size_t OFF_VTN = OFF_Z + al256((size_t)R * LDZ * 2);
constexpr size_t OFF_VTG = OFF_VTN + al256((size_t)512 * LDT * 2);
constexpr size_t OFF_Y = OFF_VTG + al256((size_t)128 * LDT * 2);
constexpr size_t OFF_MIX = OFF_Y + al256((size_t)R * 512 * 2);
constexpr size_t OFF_HIN = OFF_MIX + al256((size_t)R * 1024 * 2);
constexpr size_t OFF_E = OFF_HIN + al256((size_t)NCH * 8192 * 2);
constexpr size_t OFF_CTXS = OFF_E + al256((size_t)NCH * 8192 * 4);
constexpr size_t OFF_WINT = OFF_CTXS + al256((size_t)512 * 1024 * 4);
constexpr size_t OFF_WMT = OFF_WINT + al256((size_t)4 * 6400 * 1024 * 2);
constexpr size_t OFF_WBRT = OFF_WMT + al256((size_t)4 * 4096 * 1024 * 2);
constexpr size_t OFF_WOUTT = OFF_WBRT + al256((size_t)16 * 1024 * 512 * 2);
constexpr size_t OFF_WGLUT = OFF_WOUTT + al256((size_t)4 * 1024 * 1024 * 2);
constexpr size_t OFF_S5M = OFF_WGLUT + al256((size_t)4 * 512 * 512 * 2);
constexpr size_t OFF_S5WE = OFF_S5M + al256((size_t)128 * 65536 * 2);
constexpr size_t OFF_S5R = OFF_S5WE + al256((size_t)128 * 65536 * 2);
constexpr size_t OFF_A16 = OFF_S5R + al256((size_t)128 * 65536 * 2);
constexpr size_t OFF_MOD = OFF_A16 + al256((size_t)4 * 2 * 32 * 64 * 2 * 4);
constexpr size_t OFF_ROPE = OFF_MOD + al256((size_t)4 * 3 * 3072 * 4);
constexpr size_t OFF_BAR = OFF_ROPE + al256((size_t)256 * 16 * 2 * 4);
constexpr size_t WS_TOTAL = OFF_BAR + al256((size_t)4096 * 4);

struct Params {
  const float *x, *c, *ctx, *c_ctx, *norm_g, *w_ada, *b_ada, *w_in, *s5_a_re, *s5_a_im, *s5_log_dt, *s5_b_re, *s5_b_im,
      *s5_c_re, *s5_c_im, *s5_d, *s5_w_glu, *conv_w, *conv_b, *na_q_g, *na_k_g, *na_rel_bias, *gqa_q_g, *gqa_k_g, *gqa_sink,
      *w_br, *w_out;
  float* out;
  char* ws;
  unsigned* bar;
  DI bf16_t* H() const { return (bf16_t*)(ws + OFF_H); }
  DI bf16_t* Z() const { return (bf16_t*)(ws + OFF_Z); }
  DI bf16_t* VtN() const { return (bf16_t*)(ws + OFF_VTN); }
  DI bf16_t* VtG() const { return (bf16_t*)(ws + OFF_VTG); }
  DI bf16_t* Y() const { return (bf16_t*)(ws + OFF_Y); }
  DI bf16_t* MIX() const { return (bf16_t*)(ws + OFF_MIX); }
  DI bf16_t* HIN() const { return (bf16_t*)(ws + OFF_HIN); }
  DI float* E() const { return (float*)(ws + OFF_E); }
  DI float* CTXS() const { return (float*)(ws + OFF_CTXS); }
  DI bf16_t* WinT() const { return (bf16_t*)(ws + OFF_WINT); }
  DI bf16_t* WmT() const { return (bf16_t*)(ws + OFF_WMT); }
  DI bf16_t* WbrT() const { return (bf16_t*)(ws + OFF_WBRT); }
  DI bf16_t* WoutT() const { return (bf16_t*)(ws + OFF_WOUTT); }
  DI bf16_t* WgluT() const { return (bf16_t*)(ws + OFF_WGLUT); }
  DI bf16_t* S5M() const { return (bf16_t*)(ws + OFF_S5M); }
  DI bf16_t* S5We() const { return (bf16_t*)(ws + OFF_S5WE); }
  DI bf16_t* S5R() const { return (bf16_t*)(ws + OFF_S5R); }
  DI float* A16() const { return (float*)(ws + OFF_A16); }
  DI float* MOD() const { return (float*)(ws + OFF_MOD); }
  DI float* ROPE() const { return (float*)(ws + OFF_ROPE); }
};

DI float bf2f(bf16_t v) { return __uint_as_float(((unsigned)v) << 16); }
DI unsigned pk2(float a, float b) {
  f32x2 v = {a, b};
  bfx2 r = __builtin_convertvector(v, bfx2);
  return __builtin_bit_cast(unsigned, r);
}
DI bf16_t f2bf(float a) { return (bf16_t)(pk2(a, 0.f) & 0xffffu); }
DI float lo_bf(unsigned u) { return __uint_as_float(u << 16); }
DI float hi_bf(unsigned u) { return __uint_as_float(u & 0xffff0000u); }
DI float sigmoidf_(float x) { return 1.f / (1.f + __expf(-x)); }
DI float siluf_(float x) { return x / (1.f + __expf(-x)); }
DI int crow(int i, int h) { return (i & 3) + 8 * (i >> 2) + 4 * h; }
DI bf16x8 ld16(const bf16_t* p) { return *reinterpret_cast<const bf16x8*>(p); }

template <int NI>
DI void gemm_main(f32x16 (&acc)[2][NI], const bf16_t* Abase, int lda, int akoff, int astep, const bf16_t* Bt, int ldb, int K,
                  bf16_t* sm, int tid) {
  const int lane = tid & 63, wid = tid >> 6, wm = wid >> 1, wn = wid & 1, r = lane & 31, h = lane >> 5;
  const int lrow = tid >> 3, lkc = tid & 7;
  const int aoff0 = lrow * lda + akoff, a32 = 32 * lda;
  const int boff0 = lrow * ldb + lkc * 8, b32 = 32 * ldb;
  const int soff0 = lrow * 64 + ((lkc ^ ((lrow >> 1) & 7)) * 8);
  bf16_t* As = sm;
  bf16_t* Bs = sm + 2 * 8192;
  bf16x8 ra[4], rb[2 * NI];
  const int nk = K >> 6;
#pragma unroll
  for (int i = 0; i < 4; ++i) ra[i] = ld16(Abase + aoff0 + i * a32);
#pragma unroll
  for (int i = 0; i < 2 * NI; ++i) rb[i] = ld16(Bt + boff0 + i * b32);
#pragma unroll
  for (int i = 0; i < 4; ++i) *reinterpret_cast<bf16x8*>(As + soff0 + i * 2048) = ra[i];
#pragma unroll
  for (int i = 0; i < 2 * NI; ++i) *reinterpret_cast<bf16x8*>(Bs + soff0 + i * 2048) = rb[i];
  __syncthreads();
  const int ar0 = wm * 64 + r, br0 = wn * 32 * NI + r;
  const int asw = (ar0 >> 1) & 7, bsw = (br0 >> 1) & 7;
  for (int kt = 0; kt < nk; ++kt) {
    const int cur = kt & 1;
    const bool more = (kt + 1 < nk);
    if (more) {
      const bf16_t* An_ = Abase + (size_t)(kt + 1) * astep;
      const bf16_t* Bn_ = Bt + (kt + 1) * 64;
#pragma unroll
      for (int i = 0; i < 4; ++i) ra[i] = ld16(An_ + aoff0 + i * a32);
#pragma unroll
      for (int i = 0; i < 2 * NI; ++i) rb[i] = ld16(Bn_ + boff0 + i * b32);
    }
    const bf16_t* Ac = As + cur * 8192 + ar0 * 64;
    const bf16_t* Bc = Bs + cur * 8192 + br0 * 64;
#pragma unroll
    for (int ks = 0; ks < 4; ++ks) {
      bf16x8 a[2], b[NI];
#pragma unroll
      for (int i = 0; i < 2; ++i) a[i] = *reinterpret_cast<const bf16x8*>(Ac + i * 2048 + (((ks * 2 + h) ^ asw) * 8));
#pragma unroll
      for (int i = 0; i < NI; ++i) b[i] = *reinterpret_cast<const bf16x8*>(Bc + i * 2048 + (((ks * 2 + h) ^ bsw) * 8));
#pragma unroll
      for (int mi = 0; mi < 2; ++mi)
#pragma unroll
        for (int ni = 0; ni < NI; ++ni) acc[mi][ni] = MFMA32(a[mi], b[ni], acc[mi][ni]);
    }
    if (more) {
      bf16_t* An = As + (cur ^ 1) * 8192 + soff0;
      bf16_t* Bn = Bs + (cur ^ 1) * 8192 + soff0;
#pragma unroll
      for (int i = 0; i < 4; ++i) *reinterpret_cast<bf16x8*>(An + i * 2048) = ra[i];
#pragma unroll
      for (int i = 0; i < 2 * NI; ++i) *reinterpret_cast<bf16x8*>(Bn + i * 2048) = rb[i];
    }
    __syncthreads();
  }
}

template <int NI>
DI void zero_acc(f32x16 (&acc)[2][NI]) {
#pragma unroll
  for (int a = 0; a < 2; ++a)
#pragma unroll
    for (int b = 0; b < NI; ++b)
#pragma unroll
      for (int i = 0; i < 16; ++i) acc[a][b][i] = 0.f;
}

DI void sincos_(float x, float* sn, float* cs) {
  float n = rintf(x * 0.63661977236758134f);
  float rr = fmaf(-n, 1.57079625129699707031f, x);
  rr = fmaf(-n, 7.54978941586159635335e-08f, rr);
  float r2 = rr * rr;
  float sp = rr + rr * r2 * (-1.6666654611e-1f + r2 * (8.3321608736e-3f + r2 * (-1.9515295891e-4f)));
  float cp = 1.f + r2 * (-0.5f + r2 * (4.166664568298827e-2f + r2 * (-1.388731625493765e-3f + r2 * 2.443315711809948e-5f)));
  int q = ((int)n) & 3;
  float s_ = (q & 1) ? cp : sp;
  float c_ = (q & 1) ? sp : cp;
  if (q == 1 || q == 2) c_ = -c_;
  if (q >= 2) s_ = -s_;
  *sn = s_;
  *cs = c_;
}

DI void prep_transpose(const float* src, int ld, bf16_t* dst, int K, int k0, int n0, float* tile, int tid) {
  const int nn = tid & 63, kq = tid >> 6;
#pragma unroll 4
  for (int i = 0; i < 16; ++i) {
    int kk = kq + 4 * i;
    tile[kk * 65 + nn] = src[(size_t)(k0 + kk) * ld + n0 + nn];
  }
  __syncthreads();
#pragma unroll
  for (int i = 0; i < 2; ++i) {
    int c = tid + 256 * i;
    int n2 = c >> 3, kc = c & 7;
    uint4 w;
    w.x = pk2(tile[(kc * 8 + 0) * 65 + n2], tile[(kc * 8 + 1) * 65 + n2]);
    w.y = pk2(tile[(kc * 8 + 2) * 65 + n2], tile[(kc * 8 + 3) * 65 + n2]);
    w.z = pk2(tile[(kc * 8 + 4) * 65 + n2], tile[(kc * 8 + 5) * 65 + n2]);
    w.w = pk2(tile[(kc * 8 + 6) * 65 + n2], tile[(kc * 8 + 7) * 65 + n2]);
    *reinterpret_cast<uint4*>(dst + (size_t)(n0 + n2) * K + k0 + kc * 8) = w;
  }
  __syncthreads();
}

DI void prep_s5(const Params& p, int L, int g, float* sm, int tid) {
  float* apow = sm;
  float* fco = sm + 2176;
  float* bbar = sm + 2304;
  float* Kt = sm + 4352;
  const size_t gm = (size_t)(L * 32 + g) * 65536;
  for (int d = 0; d < 2; ++d) {
    const int dg = (L * 2 + d) * 32 + g;
    if (tid < 64) {
      const int pp = tid;
      float dt = expf(p.s5_log_dt[dg]);
      float are = p.s5_a_re[dg * 64 + pp], aim = p.s5_a_im[dg * 64 + pp];
      float mag = expf(dt * are);
      float sn, cs;
      sincos_(dt * aim, &sn, &cs);
      float abr = mag * cs, abi = mag * sn;
      float den = are * are + aim * aim;
      float fr = ((abr - 1.f) * are + abi * aim) / den;
      float fi = (abi * are - (abr - 1.f) * aim) / den;
      fco[pp * 2] = fr;
      fco[pp * 2 + 1] = fi;
      float pr = 1.f, pi = 0.f;
      apow[pp * 2] = 1.f;
      apow[pp * 2 + 1] = 0.f;
      for (int t = 1; t <= 16; ++t) {
        float nr = pr * abr - pi * abi, ni = pr * abi + pi * abr;
        pr = nr; pi = ni;
        apow[(t * 64 + pp) * 2] = pr;
        apow[(t * 64 + pp) * 2 + 1] = pi;
      }
      p.A16()[(dg * 64 + pp) * 2] = pr;
      p.A16()[(dg * 64 + pp) * 2 + 1] = pi;
    }
    __syncthreads();
    for (int i = 0; i < 4; ++i) {
      int idx = tid + 256 * i;
      int pp = idx >> 4;
      float br = p.s5_b_re[(size_t)dg * 1024 + idx], bi = p.s5_b_im[(size_t)dg * 1024 + idx];
      float fr = fco[pp * 2], fi = fco[pp * 2 + 1];
      bbar[idx * 2] = fr * br - fi * bi;
      bbar[idx * 2 + 1] = fr * bi + fi * br;
    }
    __syncthreads();
    {
      const int hp = tid >> 4, hh = tid & 15;
      float kacc[16];
#pragma unroll
      for (int t = 0; t < 16; ++t) kacc[t] = 0.f;
      for (int pp = 0; pp < 64; ++pp) {
        float cr = p.s5_c_re[((size_t)dg * 16 + hp) * 64 + pp], ci = p.s5_c_im[((size_t)dg * 16 + hp) * 64 + pp];
        float br = bbar[(pp * 16 + hh) * 2], bi = bbar[(pp * 16 + hh) * 2 + 1];
        float xr = cr * br - ci * bi, xi = cr * bi + ci * br;
#pragma unroll
        for (int t = 0; t < 16; ++t) kacc[t] += xr * apow[(t * 64 + pp) * 2] - xi * apow[(t * 64 + pp) * 2 + 1];
      }
#pragma unroll
      for (int t = 0; t < 16; ++t) Kt[(d * 16 + t) * 256 + tid] = kacc[t];
    }
    for (int i = 0; i < 128; ++i) {
      int idx = tid + 256 * i;
      int k = idx & 255, nn = idx >> 8;
      int pp = nn >> 1, ri = nn & 1, j = k >> 4, hh = k & 15;
      int e = (d == 0) ? (15 - j) : j;
      float ar = apow[(e * 64 + pp) * 2], ai = apow[(e * 64 + pp) * 2 + 1];
      float br = bbar[(pp * 16 + hh) * 2], bi = bbar[(pp * 16 + hh) * 2 + 1];
      float v = ri ? (ar * bi + ai * br) : (ar * br - ai * bi);
      p.S5We()[gm + (size_t)(d * 128 + nn) * 256 + k] = f2bf(v);
    }
    for (int i = 0; i < 128; ++i) {
      int idx = tid + 256 * i;
      int kk = idx & 127, n = idx >> 7;
      int pp = kk >> 1, ri = kk & 1, t16 = n >> 4, hp = n & 15;
      int pw = (d == 0) ? (t16 + 1) : (16 - t16);
      float cr = p.s5_c_re[((size_t)dg * 16 + hp) * 64 + pp], ci = p.s5_c_im[((size_t)dg * 16 + hp) * 64 + pp];
      float ar = apow[(pw * 64 + pp) * 2], ai = apow[(pw * 64 + pp) * 2 + 1];
      float v = ri ? -(cr * ai + ci * ar) : (cr * ar - ci * ai);
      p.S5R()[gm + (size_t)n * 256 + d * 128 + kk] = f2bf(v);
    }
    __syncthreads();
  }
  for (int i = 0; i < 256; ++i) {
    int idx = tid + 256 * i;
    int k = idx & 255, n = idx >> 8;
    int t16 = n >> 4, hp = n & 15, j = k >> 4, hh = k & 15;
    float v = 0.f;
    if (j <= t16) v += Kt[(0 * 16 + (t16 - j)) * 256 + hp * 16 + hh];
    if (j >= t16) v += Kt[(1 * 16 + (j - t16)) * 256 + hp * 16 + hh];
    if (j == t16 && hp == hh) v += p.s5_d[(L * 32 + g) * 16 + hh];
    p.S5M()[gm + (size_t)n * 256 + k] = f2bf(v);
  }
  __syncthreads();
}

DI void prep_adaln(const Params& p, int L, int cb, float* sm, int tid) {
  float* sv = sm;
  float* red = sm + 3072;
  for (int idx = tid; idx < 3072; idx += 256) {
    int v = idx >> 10, k = idx & 1023;
    float cv = (v < 2) ? p.c[v * 1024 + k] : p.c_ctx[k];
    sv[idx] = siluf_(cv);
  }
  __syncthreads();
  const int cl = tid & 63, kq = tid >> 6, col = cb * 64 + cl;
  float a0 = 0.f, a1 = 0.f, a2 = 0.f;
  const float* w = p.w_ada + (size_t)L * 1024 * 3072 + col;
#pragma unroll 8
  for (int k = kq * 256; k < kq * 256 + 256; ++k) {
    float wv = w[(size_t)k * 3072];
    a0 += sv[k] * wv;
    a1 += sv[1024 + k] * wv;
    a2 += sv[2048 + k] * wv;
  }
  red[(kq * 3 + 0) * 64 + cl] = a0;
  red[(kq * 3 + 1) * 64 + cl] = a1;
  red[(kq * 3 + 2) * 64 + cl] = a2;
  __syncthreads();
  if (kq == 0) {
    float bb = p.b_ada[L * 3072 + col];
    for (int v = 0; v < 3; ++v) {
      float s = red[(0 * 3 + v) * 64 + cl] + red[(1 * 3 + v) * 64 + cl] + red[(2 * 3 + v) * 64 + cl] + red[(3 * 3 + v) * 64 + cl];
      p.MOD()[(L * 3 + v) * 3072 + col] = s + bb;
    }
  }
  __syncthreads();
}

DI void phase_prep(const Params& p, float* sm, int tid) {
  constexpr int N_S5 = 128, N_ADA = 192, N_TR_L = 3456, N_TR = 4 * N_TR_L;
  constexpr int TOTAL = N_S5 + N_ADA + 1 + N_TR;
  for (int item = blockIdx.x; item < TOTAL; item += gridDim.x) {
    if (item < N_S5) {
      prep_s5(p, item >> 5, item & 31, sm, tid);
    } else if (item < N_S5 + N_ADA) {
      int it = item - N_S5;
      prep_adaln(p, it / 48, it % 48, sm, tid);
    } else if (item == N_S5 + N_ADA) {
      for (int idx = tid; idx < 256 * 16; idx += 256) {
        int pos = idx >> 4, i = idx & 15;
        float inv = exp2f(-(float)i * (13.287712379549449f / 16.f));
        float sn, cs;
        sincos_((float)pos * inv, &sn, &cs);
        p.ROPE()[idx * 2] = cs;
        p.ROPE()[idx * 2 + 1] = sn;
      }
    } else {
      int it = item - (N_S5 + N_ADA + 1);
      int L = it / N_TR_L, tt = it % N_TR_L;
      const float* src; bf16_t* dst; int ld, K, kt, nt;
      if (tt < 1600) {
        kt = tt / 100; nt = tt % 100; src = p.w_in + (size_t)L * 1024 * 10496; ld = 10496; K = 1024;
        dst = p.WinT() + (size_t)L * 6400 * 1024;
      } else if (tt < 2624) {
        int t2 = tt - 1600; kt = t2 / 64; nt = t2 % 64; src = p.w_in + (size_t)L * 1024 * 10496 + 6400; ld = 10496; K = 1024;
        dst = p.WmT() + (size_t)L * 4096 * 1024;
      } else if (tt < 3136) {
        int t2 = tt - 2624; int kb = t2 / 128; int t3 = t2 % 128; kt = t3 / 16; nt = t3 % 16;
        src = p.w_br + (size_t)(L * 4 + kb) * 512 * 1024; ld = 1024; K = 512;
        dst = p.WbrT() + (size_t)(L * 4 + kb) * 1024 * 512;
      } else if (tt < 3392) {
        int t2 = tt - 3136; kt = t2 / 16; nt = t2 % 16; src = p.w_out + (size_t)L * 1024 * 1024; ld = 1024; K = 1024;
        dst = p.WoutT() + (size_t)L * 1024 * 1024;
      } else {
        int t2 = tt - 3392; kt = t2 / 8; nt = t2 % 8; src = p.s5_w_glu + (size_t)L * 512 * 512; ld = 512; K = 512;
        dst = p.WgluT() + (size_t)L * 512 * 512;
      }
      prep_transpose(src, ld, dst, K, kt * 64, nt * 64, sm, tid);
    }
  }
}

DI void phase_norm(const Params& p, int b, int L, int tid) {
  const int wid = tid >> 6, lane = tid & 63;
  const float* g = p.norm_g + L * 1024;
  for (int item = blockIdx.x; item < R / 4; item += gridDim.x) {
    const int row = item * 4 + wid;
    const float* src;
    const float* mod;
    if (row < NLAT) {
      src = (L == 0 ? p.x : (const float*)p.out) + ((size_t)b * NLAT + row) * 1024;
      mod = p.MOD() + (L * 3 + b) * 3072;
    } else {
      src = (L == 0 ? p.ctx : (const float*)p.CTXS()) + ((size_t)b * 256 + (row - NLAT)) * 1024;
      mod = p.MOD() + (L * 3 + 2) * 3072;
    }
    float4 v[4];
    float ss = 0.f;
#pragma unroll
    for (int j = 0; j < 4; ++j) {
      v[j] = *reinterpret_cast<const float4*>(src + j * 256 + lane * 4);
      ss += v[j].x * v[j].x + v[j].y * v[j].y + v[j].z * v[j].z + v[j].w * v[j].w;
    }
#pragma unroll
    for (int o = 32; o >= 1; o >>= 1) ss += __shfl_xor(ss, o);
    const float rs = rsqrtf(ss * (1.f / 1024.f) + 1e-6f);
#pragma unroll
    for (int j = 0; j < 4; ++j) {
      const int col = j * 256 + lane * 4;
      float4 g4 = *reinterpret_cast<const float4*>(g + col);
      float4 sh = *reinterpret_cast<const float4*>(mod + col);
      float4 sc = *reinterpret_cast<const float4*>(mod + 1024 + col);
      float y0 = v[j].x * rs * g4.x * (1.f + sc.x) + sh.x;
      float y1 = v[j].y * rs * g4.y * (1.f + sc.y) + sh.y;
      float y2 = v[j].z * rs * g4.z * (1.f + sc.z) + sh.z;
      float y3 = v[j].w * rs * g4.w * (1.f + sc.w) + sh.w;
      uint2 w;
      w.x = pk2(y0, y1);
      w.y = pk2(y2, y3);
      *reinterpret_cast<uint2*>(p.H() + (size_t)row * 1024 + col) = w;
    }
  }
}

DI void phase_p1(const Params& p, int b, int L, bf16_t* sm, int tid) {
  const int lane = tid & 63, wid = tid >> 6, wm = wid >> 1, wn = wid & 1, r = lane & 31, h = lane >> 5;
  for (int tile = blockIdx.x; tile < 130 * 50; tile += gridDim.x) {
    const int mt = tile / 50, nt = tile % 50;
    const int m0 = mt * 128, n0 = nt * 128;
    f32x16 acc[2][2];
    zero_acc<2>(acc);
    const bf16_t* Abase = p.H() + (size_t)m0 * 1024;
    gemm_main<2>(acc, Abase, 1024, (tid & 7) * 8, 64,
              p.WinT() + (size_t)L * 6400 * 1024 + (size_t)n0 * 1024, 1024, 1024, sm, tid);
    const int nw = n0 + wn * 64;
    const int mw = m0 + wm * 64;
    int kind = 0;
    const float* gvec = nullptr;
    float mult = 1.f;
    bool rope = false;
    bf16_t* vt = nullptr;
    if (nw >= C_NQ && nw < C_NK) { kind = 1; gvec = p.na_q_g + L * 64; mult = 0.125f * LOG2E; }
    else if (nw >= C_NK && nw < C_NV) { kind = 1; gvec = p.na_k_g + L * 64; }
    else if (nw >= C_NV && nw < C_NG) { kind = 2; vt = p.VtN() + (size_t)(nw - C_NV) * LDT; }
    else if (nw >= C_GQ && nw < C_GK) { kind = 1; gvec = p.gqa_q_g + L * 64; mult = 0.125f * LOG2E; rope = (m0 < NLAT); }
    else if (nw >= C_GK && nw < C_GV) { kind = 1; gvec = p.gqa_k_g + L * 64; rope = (m0 < NLAT); }
    else if (nw >= C_GV && nw < C_GG) { kind = 2; vt = p.VtG() + (size_t)(nw - C_GV) * LDT; }
    if (kind == 0) {
#pragma unroll
      for (int mi = 0; mi < 2; ++mi)
#pragma unroll
        for (int ni = 0; ni < 2; ++ni)
#pragma unroll
          for (int i = 0; i < 16; ++i) {
            int row = mw + mi * 32 + crow(i, h);
            p.Z()[(size_t)row * LDZ + nw + ni * 32 + r] = f2bf(acc[mi][ni][i]);
          }
    } else if (kind == 1) {
      const float g0 = gvec[r], g1 = gvec[32 + r];
#pragma unroll
      for (int mi = 0; mi < 2; ++mi)
#pragma unroll
        for (int i = 0; i < 16; ++i) {
          float a = acc[mi][0][i], c2 = acc[mi][1][i];
          float ss = a * a + c2 * c2;
#pragma unroll
          for (int o = 16; o >= 1; o >>= 1) ss += __shfl_xor(ss, o);
          float rs = rsqrtf(ss * (1.f / 64.f) + 1e-6f);
          a = a * rs * g0;
          c2 = c2 * rs * g1;
          int row = mw + mi * 32 + crow(i, h);
          if (rope) {
            int pos = (r < 16) ? (row >> 6) : (row & 63);
            float cs = p.ROPE()[(pos * 16 + (r & 15)) * 2], sn = p.ROPE()[(pos * 16 + (r & 15)) * 2 + 1];
            float a2 = a * cs - c2 * sn;
            float c3 = c2 * cs + a * sn;
            a = a2; c2 = c3;
          }
          p.Z()[(size_t)row * LDZ + nw + r] = f2bf(a * mult);
          p.Z()[(size_t)row * LDZ + nw + 32 + r] = f2bf(c2 * mult);
        }
    } else {
#pragma unroll
      for (int mi = 0; mi < 2; ++mi)
#pragma unroll
        for (int ni = 0; ni < 2; ++ni)
#pragma unroll
          for (int i4 = 0; i4 < 4; ++i4) {
            int row0 = mw + mi * 32 + i4 * 8 + 4 * h;
            uint2 w;
            w.x = pk2(acc[mi][ni][i4 * 4 + 0], acc[mi][ni][i4 * 4 + 1]);
            w.y = pk2(acc[mi][ni][i4 * 4 + 2], acc[mi][ni][i4 * 4 + 3]);
            *reinterpret_cast<uint2*>(vt + (size_t)(ni * 32 + r) * LDT + row0) = w;
          }
    }
  }
}

DI void phase_s5e_conv(const Params& p, int b, int L, bf16_t* sm, int tid) {
  const int lane = tid & 63, wid = tid >> 6, wm = wid >> 1, wn = wid & 1, r = lane & 31, h = lane >> 5;
  constexpr int NT_E = 32 * 9 * 2;
  constexpr int NT_C = R * 64 / 256;
  for (int item = blockIdx.x; item < NT_E + NT_C; item += gridDim.x) {
    if (item < NT_E) {
      const int g = item / 18, rem = item % 18, mt = rem >> 1, nt = rem & 1;
      const int m0 = mt * 128, n0 = nt * 128;
      f32x16 acc[2][2];
      zero_acc<2>(acc);
      const bf16_t* Ub = p.Z() + C_S5U + g * 16;
      gemm_main<2>(acc, Ub + (size_t)m0 * 16 * LDZ, 16 * LDZ, ((tid & 7) >> 1) * LDZ + (tid & 1) * 8, 4 * LDZ, p.S5We() + (size_t)(L * 32 + g) * 65536 + (size_t)n0 * 256, 256, 256, sm, tid);
#pragma unroll
      for (int mi = 0; mi < 2; ++mi)
#pragma unroll
        for (int ni = 0; ni < 2; ++ni)
#pragma unroll
          for (int i = 0; i < 16; ++i) {
            int m = m0 + wm * 64 + mi * 32 + crow(i, h);
            int n = n0 + wn * 64 + ni * 32 + r;
            if (m < NCH) p.E()[((size_t)m * 32 + g) * 256 + n] = acc[mi][ni][i];
          }
    } else {
      const int idx = (item - NT_E) * 256 + tid;
      const int row = idx >> 6, ch = (idx & 63) * 8;
      const int lo = (row < NLAT) ? 0 : NLAT, hi = (row < NLAT) ? (NLAT - 1) : (R - 1);
      const bf16_t* zr = p.Z() + (size_t)row * LDZ;
      float zz[3][8];
#pragma unroll
      for (int t = 0; t < 3; ++t) {
        int rr = row + t - 1;
        if (rr >= lo && rr <= hi) {
          uint4 cv = *reinterpret_cast<const uint4*>(p.Z() + (size_t)rr * LDZ + C_CV + ch);
          uint4 cc = *reinterpret_cast<const uint4*>(p.Z() + (size_t)rr * LDZ + C_CC + ch);
          zz[t][0] = lo_bf(cv.x) * lo_bf(cc.x); zz[t][1] = hi_bf(cv.x) * hi_bf(cc.x);
          zz[t][2] = lo_bf(cv.y) * lo_bf(cc.y); zz[t][3] = hi_bf(cv.y) * hi_bf(cc.y);
          zz[t][4] = lo_bf(cv.z) * lo_bf(cc.z); zz[t][5] = hi_bf(cv.z) * hi_bf(cc.z);
          zz[t][6] = lo_bf(cv.w) * lo_bf(cc.w); zz[t][7] = hi_bf(cv.w) * hi_bf(cc.w);
        } else {
#pragma unroll
          for (int j = 0; j < 8; ++j) zz[t][j] = 0.f;
        }
      }
      uint4 cb = *reinterpret_cast<const uint4*>(zr + C_CB + ch);
      uint4 cg_ = *reinterpret_cast<const uint4*>(zr + C_CG + ch);
      float bv[8] = {lo_bf(cb.x), hi_bf(cb.x), lo_bf(cb.y), hi_bf(cb.y), lo_bf(cb.z), hi_bf(cb.z), lo_bf(cb.w), hi_bf(cb.w)};
      float gv[8] = {lo_bf(cg_.x), hi_bf(cg_.x), lo_bf(cg_.y), hi_bf(cg_.y), lo_bf(cg_.z), hi_bf(cg_.z), lo_bf(cg_.w), hi_bf(cg_.w)};
      float o[8];
#pragma unroll
      for (int j = 0; j < 8; ++j) {
        float y = p.conv_b[L * 512 + ch + j] + zz[0][j] * p.conv_w[(L * 3 + 0) * 512 + ch + j] +
                  zz[1][j] * p.conv_w[(L * 3 + 1) * 512 + ch + j] + zz[2][j] * p.conv_w[(L * 3 + 2) * 512 + ch + j];
        o[j] = bv[j] * y * siluf_(gv[j]);
      }
      uint4 w;
      w.x = pk2(o[0], o[1]); w.y = pk2(o[2], o[3]); w.z = pk2(o[4], o[5]); w.w = pk2(o[6], o[7]);
      *reinterpret_cast<uint4*>(p.Z() + (size_t)row * LDZ + C_CG + ch) = w;
    }
  }
}

DI void phase_s5y(const Params& p, int b, int L, bf16_t* sm, int tid) {
  const int lane = tid & 63, wid = tid >> 6, wm = wid >> 1, wn = wid & 1, r = lane & 31, h = lane >> 5;
  for (int item = blockIdx.x; item < 32 * 18; item += gridDim.x) {
    const int g = item / 18, rem = item % 18, mt = rem >> 1, nt = rem & 1;
    const int m0 = mt * 128, n0 = nt * 128;
    f32x16 acc[2][2];
    zero_acc<2>(acc);
    const bf16_t* Ub = p.Z() + C_S5U + g * 16;
    gemm_main<2>(acc, Ub + (size_t)m0 * 16 * LDZ, 16 * LDZ, ((tid & 7) >> 1) * LDZ + (tid & 1) * 8, 4 * LDZ, p.S5M() + (size_t)(L * 32 + g) * 65536 + (size_t)n0 * 256, 256, 256, sm, tid);
    const bf16_t* Hb = p.HIN() + g * 256;
    gemm_main<2>(acc, Hb + (size_t)m0 * 8192, 8192, (tid & 7) * 8, 64, p.S5R() + (size_t)(L * 32 + g) * 65536 + (size_t)n0 * 256, 256, 256, sm, tid);
#pragma unroll
    for (int mi = 0; mi < 2; ++mi)
#pragma unroll
      for (int ni = 0; ni < 2; ++ni)
#pragma unroll
        for (int i = 0; i < 16; ++i) {
          int m = m0 + wm * 64 + mi * 32 + crow(i, h);
          int n = n0 + wn * 64 + ni * 32 + r;
          if (m < NCH) {
            float y = acc[mi][ni][i];
            float z = 1.5957691216057308f * (y + 0.044715f * y * y * y);
            y = y * sigmoidf_(z);
            p.Y()[(size_t)(m * 16 + (n >> 4)) * 512 + g * 16 + (n & 15)] = f2bf(y);
          }
        }
  }
}

DI void phase_glu(const Params& p, int b, int L, bf16_t* sm, int tid) {
  const int lane = tid & 63, wid = tid >> 6, wm = wid >> 1, wn = wid & 1, r = lane & 31, h = lane >> 5;
  for (int tile = blockIdx.x; tile < 130 * 4; tile += gridDim.x) {
    const int mt = tile >> 2, nt = tile & 3;
    const int m0 = mt * 128, n0 = nt * 128;
    f32x16 acc[2][2];
    zero_acc<2>(acc);
    const bf16_t* Ab = p.Y() + (size_t)m0 * 512;
    gemm_main<2>(acc, Ab, 512, (tid & 7) * 8, 64,
              p.WgluT() + (size_t)L * 512 * 512 + (size_t)n0 * 512, 512, 512, sm, tid);
#pragma unroll
    for (int mi = 0; mi < 2; ++mi)
#pragma unroll
      for (int ni = 0; ni < 2; ++ni)
#pragma unroll
        for (int i = 0; i < 16; ++i) {
          int row = m0 + wm * 64 + mi * 32 + crow(i, h);
          int col = n0 + wn * 64 + ni * 32 + r;
          float yv = bf2f(p.Y()[(size_t)row * 512 + col]);
          bf16_t* gp = p.Z() + (size_t)row * LDZ + C_S5G + col;
          float gt = bf2f(*gp);
          *gp = f2bf(yv * sigmoidf_(acc[mi][ni][i]) * siluf_(gt));
        }
  }
}

DI void attn_item(const Params& p, int L, int mode, int head, int q_row0, int na_r, const float* bias_s, int lane) {
  const int r = lane & 31, h = lane >> 5;
  int qcol, kcol, gcol;
  const bf16_t* vt;
  if (mode == 0 || mode == 2) {
    qcol = C_NQ + head * 64; kcol = C_NK + head * 64; gcol = C_NG + head * 64;
    vt = p.VtN() + (size_t)(head * 64) * LDT;
  } else {
    qcol = C_GQ + head * 64; kcol = C_GK + (head >> 2) * 64; gcol = C_GG + head * 64;
    vt = p.VtG() + (size_t)((head >> 2) * 64) * LDT;
  }
  bf16x8 qf[4];
  {
    const bf16_t* qp = p.Z() + (size_t)(q_row0 + r) * LDZ + qcol + h * 8;
#pragma unroll
    for (int ks = 0; ks < 4; ++ks) qf[ks] = ld16(qp + ks * 16);
  }
  float m_run = -1e30f, l_run = 0.f;
  f32x16 O0, O1;
#pragma unroll
  for (int i = 0; i < 16; ++i) { O0[i] = 0.f; O1[i] = 0.f; }
  const int ntiles = (mode == 0) ? 24 : (mode == 1 ? 17 : 8);
  const int rs = min(max(na_r - 4, 0), 256 - 8);
  const int qc = (q_row0 & 63) + r;
  const int cs0 = min(max(qc - 8, 0), 48);
  for (int it = 0; it < ntiles; ++it) {
    int krow0, mtype = 0;
    if (it < 8) {
      krow0 = NLAT + it * 32;
    } else if (mode == 0) {
      int kt = it - 8;
      krow0 = (rs + (kt >> 1)) * 64 + (kt & 1) * 32;
      mtype = 1;
    } else {
      krow0 = q_row0 - 128 + (it - 8) * 32;
      if (krow0 < 0 || krow0 >= NLAT) continue;
      mtype = 2;
    }
    f32x16 S;
#pragma unroll
    for (int i = 0; i < 16; ++i) S[i] = 0.f;
    {
      const bf16_t* kp = p.Z() + (size_t)(krow0 + r) * LDZ + kcol + h * 8;
#pragma unroll
      for (int ks = 0; ks < 4; ++ks) {
        bf16x8 kf = ld16(kp + ks * 16);
        S = MFMA32(kf, qf[ks], S);
      }
    }
    if (mtype == 1) {
      const int kt = it - 8;
      const int kcb = (kt & 1) * 32;
      const int di = rs + (kt >> 1) - na_r + 7;
      const float* brow = bias_s + head * 465 + di * 31;
#pragma unroll
      for (int i = 0; i < 16; ++i) {
        int kc = kcb + crow(i, h);
        bool ok = (unsigned)(kc - cs0) < 16u;
        int dj = min(max(kc - qc + 15, 0), 30);
        float bv = brow[dj];
        S[i] = ok ? (S[i] + bv) : -INFINITY;
      }
    } else if (mtype == 2) {
      const int tq = q_row0 + r;
#pragma unroll
      for (int i = 0; i < 16; ++i) {
        int tk = krow0 + crow(i, h);
        int df = tk - tq;
        bool ok = (df <= 128) && (df >= -128);
        S[i] = ok ? S[i] : -INFINITY;
      }
    }
    float mx = S[0];
#pragma unroll
    for (int i = 1; i < 16; ++i) mx = fmaxf(mx, S[i]);
    mx = fmaxf(mx, __shfl_xor(mx, 32));
    const float mn = fmaxf(m_run, mx);
    const float alpha = __builtin_amdgcn_exp2f(m_run - mn);
    m_run = mn;
    float rsum = 0.f;
#pragma unroll
    for (int i = 0; i < 16; ++i) {
      float pv = __builtin_amdgcn_exp2f(S[i] - mn);
      S[i] = pv;
      rsum += pv;
    }
    l_run = l_run * alpha + rsum;
#pragma unroll
    for (int i = 0; i < 16; ++i) { O0[i] *= alpha; O1[i] *= alpha; }
    union { bf16x8 v; unsigned u[4]; } pb0, pb1;
#pragma unroll
    for (int j = 0; j < 4; ++j) {
      pb0.u[j] = pk2(S[2 * j], S[2 * j + 1]);
      pb1.u[j] = pk2(S[8 + 2 * j], S[8 + 2 * j + 1]);
    }
    {
      const bf16_t* vp0 = vt + (size_t)r * LDT + krow0 + 4 * h;
      const bf16_t* vp1 = vt + (size_t)(32 + r) * LDT + krow0 + 4 * h;
      union { bf16x8 v; uint2 u[2]; } f;
      f.u[0] = *reinterpret_cast<const uint2*>(vp0);
      f.u[1] = *reinterpret_cast<const uint2*>(vp0 + 8);
      O0 = MFMA32(f.v, pb0.v, O0);
      f.u[0] = *reinterpret_cast<const uint2*>(vp0 + 16);
      f.u[1] = *reinterpret_cast<const uint2*>(vp0 + 24);
      O0 = MFMA32(f.v, pb1.v, O0);
      f.u[0] = *reinterpret_cast<const uint2*>(vp1);
      f.u[1] = *reinterpret_cast<const uint2*>(vp1 + 8);
      O1 = MFMA32(f.v, pb0.v, O1);
      f.u[0] = *reinterpret_cast<const uint2*>(vp1 + 16);
      f.u[1] = *reinterpret_cast<const uint2*>(vp1 + 24);
      O1 = MFMA32(f.v, pb1.v, O1);
    }
  }
  float l = l_run + __shfl_xor(l_run, 32);
  if (mode == 1 || mode == 3) l += __builtin_amdgcn_exp2f(p.gqa_sink[L * 8 + head] * LOG2E - m_run);
  const float inv = 1.f / l;
  bf16_t* gp = p.Z() + (size_t)(q_row0 + r) * LDZ + gcol + 4 * h;
#pragma unroll
  for (int i4 = 0; i4 < 4; ++i4) {
    {
      uint2 gt = *reinterpret_cast<const uint2*>(gp + i4 * 8);
      uint2 w;
      w.x = pk2(O0[i4 * 4 + 0] * inv * siluf_(lo_bf(gt.x)), O0[i4 * 4 + 1] * inv * siluf_(hi_bf(gt.x)));
      w.y = pk2(O0[i4 * 4 + 2] * inv * siluf_(lo_bf(gt.y)), O0[i4 * 4 + 3] * inv * siluf_(hi_bf(gt.y)));
      *reinterpret_cast<uint2*>(gp + i4 * 8) = w;
    }
    {
      uint2 gt = *reinterpret_cast<const uint2*>(gp + 32 + i4 * 8);
      uint2 w;
      w.x = pk2(O1[i4 * 4 + 0] * inv * siluf_(lo_bf(gt.x)), O1[i4 * 4 + 1] * inv * siluf_(hi_bf(gt.x)));
      w.y = pk2(O1[i4 * 4 + 2] * inv * siluf_(lo_bf(gt.y)), O1[i4 * 4 + 3] * inv * siluf_(hi_bf(gt.y)));
      *reinterpret_cast<uint2*>(gp + 32 + i4 * 8) = w;
    }
  }
}

DI void scan_item(const Params& p, int L, int w, int lane) {
  const int d = w >> 5, g = w & 31;
  const int dg = (L * 2 + d) * 32 + g;
  const float ar = p.A16()[(dg * 64 + lane) * 2], ai = p.A16()[(dg * 64 + lane) * 2 + 1];
  float hr = 0.f, hi = 0.f;
  const int off = g * 256 + d * 128 + lane * 2;
  float2 e[8];
#pragma unroll
  for (int u = 0; u < 8; ++u) {
    int s = u;
    int chunk = (d == 0) ? (s < 16 ? 1024 + s : s - 16) : (NCH - 1 - s);
    e[u] = *reinterpret_cast<const float2*>(p.E() + (size_t)chunk * 8192 + off);
  }
  for (int s0 = 0; s0 < NCH; s0 += 8) {
    float2 en[8];
    if (s0 + 8 < NCH) {
#pragma unroll
      for (int u = 0; u < 8; ++u) {
        int s = s0 + 8 + u;
        int chunk = (d == 0) ? (s < 16 ? 1024 + s : s - 16) : (NCH - 1 - s);
        en[u] = *reinterpret_cast<const float2*>(p.E() + (size_t)chunk * 8192 + off);
      }
    } else {
#pragma unroll
      for (int u = 0; u < 8; ++u) en[u] = make_float2(0.f, 0.f);
    }
#pragma unroll
    for (int u = 0; u < 8; ++u) {
      int s = s0 + u;
      int chunk = (d == 0) ? (s < 16 ? 1024 + s : s - 16) : (NCH - 1 - s);
      *reinterpret_cast<unsigned*>(p.HIN() + (size_t)chunk * 8192 + off) = pk2(hr, hi);
      float nr = ar * hr - ai * hi + e[u].x;
      float ni = ar * hi + ai * hr + e[u].y;
      hr = nr; hi = ni;
    }
#pragma unroll
    for (int u = 0; u < 8; ++u) e[u] = en[u];
  }
}

DI void phase_attn_scan(const Params& p, int b, int L, float* sm, int tid) {
  const int lane = tid & 63, wid = tid >> 6;
  for (int idx = tid; idx < 8 * 465; idx += 256) sm[idx] = p.na_rel_bias[L * 8 * 465 + idx] * LOG2E;
  __syncthreads();
  constexpr int N_SCAN = 16, N_ATT = 8320 / 4;
  for (int item = blockIdx.x; item < N_SCAN + N_ATT; item += gridDim.x) {
    if (item < N_SCAN) {
      scan_item(p, L, item * 4 + wid, lane);
    } else {
      const int w = (item - N_SCAN) * 4 + wid;
      if (w < 4096) {
        int half = w & 1, head = (w >> 1) & 7, rr = w >> 4;
        attn_item(p, L, 0, head, rr * 64 + half * 32, rr, sm, lane);
      } else if (w < 8192) {
        int w2 = w - 4096;
        attn_item(p, L, 1, w2 & 7, (w2 >> 3) * 32, 0, sm, lane);
      } else if (w < 8256) {
        int w2 = w - 8192;
        attn_item(p, L, 2, w2 & 7, NLAT + (w2 >> 3) * 32, 0, sm, lane);
      } else {
        int w2 = w - 8256;
        attn_item(p, L, 3, w2 & 7, NLAT + (w2 >> 3) * 32, 0, sm, lane);
      }
    }
  }
  __syncthreads();
}

DI void phase_merge(const Params& p, int b, int L, bf16_t* sm, int tid) {
  const int lane = tid & 63, wid = tid >> 6, wm = wid >> 1, wn = wid & 1, r = lane & 31, h = lane >> 5;
  for (int tile = blockIdx.x; tile < 130 * 16; tile += gridDim.x) {
    const int mt = tile >> 4, nt = tile & 15;
    const int m0 = mt * 128, n0 = nt * 64;
    f32x16 outv[2][1];
    zero_acc<1>(outv);
    for (int kb = 0; kb < 4; ++kb) {
      unsigned sg[2][8];
      {
        f32x16 acc[2][1];
        zero_acc<1>(acc);
        const bf16_t* Ab = p.H() + (size_t)m0 * 1024;
        gemm_main<1>(acc, Ab, 1024, (tid & 7) * 8, 64,
                     p.WmT() + (size_t)L * 4096 * 1024 + (size_t)(kb * 1024 + n0) * 1024, 1024, 1024, sm, tid);
#pragma unroll
        for (int mi = 0; mi < 2; ++mi)
#pragma unroll
          for (int j = 0; j < 8; ++j) sg[mi][j] = pk2(sigmoidf_(acc[mi][0][2 * j]), sigmoidf_(acc[mi][0][2 * j + 1]));
      }
      {
        f32x16 acc[2][1];
        zero_acc<1>(acc);
        const int gc = (kb == 0) ? C_S5G : (kb == 1 ? C_CG : (kb == 2 ? C_NG : C_GG));
        const bf16_t* Ab = p.Z() + (size_t)m0 * LDZ + gc;
        gemm_main<1>(acc, Ab, LDZ, (tid & 7) * 8, 64,
                     p.WbrT() + (size_t)(L * 4 + kb) * 1024 * 512 + (size_t)n0 * 512, 512, 512, sm, tid);
#pragma unroll
        for (int mi = 0; mi < 2; ++mi)
#pragma unroll
          for (int j = 0; j < 8; ++j) {
            outv[mi][0][2 * j] += lo_bf(sg[mi][j]) * acc[mi][0][2 * j];
            outv[mi][0][2 * j + 1] += hi_bf(sg[mi][j]) * acc[mi][0][2 * j + 1];
          }
      }
    }
#pragma unroll
    for (int mi = 0; mi < 2; ++mi)
#pragma unroll
      for (int i = 0; i < 16; ++i) {
        int row = m0 + wm * 64 + mi * 32 + crow(i, h);
        int col = n0 + wn * 32 + r;
        p.MIX()[(size_t)row * 1024 + col] = f2bf(outv[mi][0][i]);
      }
  }
}

DI void phase_out(const Params& p, int b, int L, bf16_t* sm, int tid) {
  const int lane = tid & 63, wid = tid >> 6, wm = wid >> 1, wn = wid & 1, r = lane & 31, h = lane >> 5;
  const int ntile = (L == 3) ? 128 * 8 : 130 * 8;
  for (int tile = blockIdx.x; tile < ntile; tile += gridDim.x) {
    const int mt = tile >> 3, nt = tile & 7;
    const int m0 = mt * 128, n0 = nt * 128;
    f32x16 acc[2][2];
    zero_acc<2>(acc);
    const bf16_t* Ab = p.MIX() + (size_t)m0 * 1024;
    gemm_main<2>(acc, Ab, 1024, (tid & 7) * 8, 64,
              p.WoutT() + (size_t)L * 1024 * 1024 + (size_t)n0 * 1024, 1024, 1024, sm, tid);
    const float* src;
    float* dst;
    const float* gate;
    if (m0 < NLAT) {
      src = (L == 0 ? p.x : (const float*)p.out) + ((size_t)b * NLAT + m0) * 1024;
      dst = p.out + ((size_t)b * NLAT + m0) * 1024;
      gate = p.MOD() + (L * 3 + b) * 3072 + 2048;
    } else {
      src = (L == 0 ? p.ctx : (const float*)p.CTXS()) + ((size_t)b * 256 + (m0 - NLAT)) * 1024;
      dst = p.CTXS() + ((size_t)b * 256 + (m0 - NLAT)) * 1024;
      gate = p.MOD() + (L * 3 + 2) * 3072 + 2048;
    }
#pragma unroll
    for (int ni = 0; ni < 2; ++ni) {
      const int col = n0 + wn * 64 + ni * 32 + r;
      const float gt = gate[col];
#pragma unroll
      for (int mi = 0; mi < 2; ++mi)
#pragma unroll
        for (int i = 0; i < 16; ++i) {
          int rl = wm * 64 + mi * 32 + crow(i, h);
          dst[(size_t)rl * 1024 + col] = src[(size_t)rl * 1024 + col] + gt * acc[mi][ni][i];
        }
    }
  }
}

#define XB_TMO      128
#define XB_XCNT(j)  (256  + 64 * (j))
#define XB_XSUB(j)  (1280 + 64 * (j))
#define XB_XGEN(j)  (2304 + 64 * (j))
#define XB_TOP      3328
#define XB_TOPGEN   3392
#define XCD_BAR_WORDS 3456
#define XB_SPIN_CAP (1u << 18)
#define LAS __attribute__((address_space(3)))

__device__ __forceinline__ unsigned xb_ld(unsigned* p)              { return __hip_atomic_load(p, __ATOMIC_RELAXED, __HIP_MEMORY_SCOPE_AGENT); }
__device__ __forceinline__ unsigned xb_add(unsigned* p, unsigned v) { return __hip_atomic_fetch_add(p, v, __ATOMIC_RELAXED, __HIP_MEMORY_SCOPE_AGENT); }
__device__ __forceinline__ unsigned xb_xcc_id() { return (unsigned)__builtin_amdgcn_s_getreg((3 << 11) | 20) & 0xFu; }
#define XB_SPIN(cond, bar) do { unsigned _sp = 0; while (cond) { __builtin_amdgcn_s_sleep(1); \
    if ((++_sp & 255u) == 0u) { if (xb_ld(&(bar)[XB_TMO])) break; if (_sp > XB_SPIN_CAP) { atomicAdd(&(bar)[XB_TMO], 1u); break; } } } } while (0)

struct XcdBarrier {
    unsigned* bar; unsigned x;
    volatile LAS unsigned* st;
};

__device__ __forceinline__ XcdBarrier xcd_barrier_post(unsigned* bar, volatile LAS unsigned* st) {
    XcdBarrier b; b.bar = bar; b.x = xb_xcc_id(); b.st = st;
    if (threadIdx.x == 0) (void)xb_add(&bar[XB_XCNT(b.x)], 1u);
    return b;
}
__device__ __forceinline__ void xcd_barrier_complete(unsigned* bar, unsigned x, unsigned& nloc, unsigned& nx) {
    const unsigned G = gridDim.x * gridDim.y * gridDim.z;
    unsigned sum, cnt, mine, sp = 0u;
    for (;;) {
        sum = 0u; cnt = 0u; mine = 0u;
#pragma unroll
        for (unsigned j = 0; j < 16; ++j) { const unsigned c = xb_ld(&bar[XB_XCNT(j)]); sum += c; cnt += (c > 0u) ? 1u : 0u; mine = (j == x) ? c : mine; }
        if (sum == G) break;
        __builtin_amdgcn_s_sleep(1);
        if ((++sp & 255u) == 0u) { if (xb_ld(&bar[XB_TMO])) break; if (sp > XB_SPIN_CAP) { atomicAdd(&bar[XB_TMO], 1u); break; } }
    }
    nloc = mine > 0u ? mine : 1u; nx = cnt > 0u ? cnt : 1u;
}

__device__ __forceinline__ void xcd_barrier(const XcdBarrier& b) {
    asm volatile("s_waitcnt vmcnt(0)" ::: "memory");
    __syncthreads();
    if (threadIdx.x == 0) {
        unsigned* bar = b.bar;
        __builtin_amdgcn_s_waitcnt(0);
        unsigned nloc = b.st[0], nx = b.st[1];
        if (nloc == 0u) { xcd_barrier_complete(bar, b.x, nloc, nx); b.st[0] = nloc; b.st[1] = nx; }
        const unsigned old = xb_add(&bar[XB_XSUB(b.x)], 1u);
        const unsigned gen = old / nloc;
        if (old + 1u == (gen + 1u) * nloc) {
            __builtin_amdgcn_fence(__ATOMIC_RELEASE, "agent");
            asm volatile("s_waitcnt vmcnt(0)" ::: "memory");
            const unsigned og = xb_add(&bar[XB_TOP], 1u);
            const unsigned tg = og / nx;
            if (og + 1u == (tg + 1u) * nx) xb_add(&bar[XB_TOPGEN], 1u);
            else XB_SPIN(xb_ld(&bar[XB_TOPGEN]) == tg, bar);
            __builtin_amdgcn_fence(__ATOMIC_ACQUIRE, "agent");
            xb_add(&bar[XB_XGEN(b.x)], 1u);
            asm volatile("s_waitcnt vmcnt(0)" ::: "memory");
        } else {
            XB_SPIN(xb_ld(&bar[XB_XGEN(b.x)]) == gen, bar);
            __builtin_amdgcn_fence(__ATOMIC_ACQUIRE, "agent");
            asm volatile("s_waitcnt vmcnt(0)" ::: "memory");
        }
    }
    __syncthreads();
}


__global__ void __launch_bounds__(256, 2) mega_kernel(Params p, int ph_lo, int ph_hi) {
  __shared__ __attribute__((aligned(16))) unsigned char smem_raw[65536];
  bf16_t* smb = reinterpret_cast<bf16_t*>(smem_raw);
  float* smf = reinterpret_cast<float*>(smem_raw);
  __shared__ uint4 xb_words;
  if (threadIdx.x == 0) xb_words = make_uint4(0u, 0u, 0u, 0u);
  __syncthreads();
  XcdBarrier xb = xcd_barrier_post(p.bar, (volatile LAS unsigned*)&xb_words);
  if (ph_hi < 0) cg::this_grid().sync();
  for (int ph = ph_lo; ph < ph_hi; ++ph) {
    int tid = threadIdx.x;
    asm volatile("" : "+v"(tid));
    if (ph == 0) {
#if !defined(ONLY) || ONLY == 8
      phase_prep(p, smf, tid);
#endif
    } else {
      const int q = ph - 1;
      const int b = q >> 5, L = (q & 31) >> 3, sub = q & 7;
      switch (sub) {
        case 0: if (!ONLYP(0)) {} else phase_norm(p, b, L, tid); break;
        case 1: if (!ONLYP(1)) {} else phase_p1(p, b, L, smb, tid); break;
        case 2: if (!ONLYP(2)) {} else phase_s5e_conv(p, b, L, smb, tid); break;
        case 3: if (!ONLYP(3)) {} else phase_attn_scan(p, b, L, smf, tid); break;
        case 4: if (!ONLYP(4)) {} else phase_s5y(p, b, L, smb, tid); break;
        case 5: if (!ONLYP(5)) {} else phase_glu(p, b, L, smb, tid); break;
        case 6: if (!ONLYP(6)) {} else phase_merge(p, b, L, smb, tid); break;
        default: if (!ONLYP(7)) {} else phase_out(p, b, L, smb, tid); break;
      }
    }
    if (ph + 1 < ph_hi) xcd_barrier(xb);
  }
}

extern "C" void kernel_launch(void* const* d_in, const int* in_sizes, int n_in, void* d_out, int out_size, void* d_ws,
                              size_t ws_size, hipStream_t stream) {
  Params p{};
  const float** fp = reinterpret_cast<const float**>(&p);
  for (int i = 0; i < 27; ++i) fp[i] = (const float*)d_in[i];
  p.out = (float*)d_out;
  p.ws = (char*)d_ws;
  p.bar = (unsigned*)((char*)d_ws + OFF_BAR);
  const size_t off = WS_TOTAL;
  if (off > ws_size) {
    fprintf(stderr, "workspace too small: need %zu have %zu\n", off, ws_size);
    return;
  }
  static int grid_blocks = 0;
  if (!grid_blocks) {
    int dev = 0, cus = 0, per_cu = 0;
    hipGetDevice(&dev);
    hipDeviceGetAttribute(&cus, hipDeviceAttributeMultiprocessorCount, dev);
    hipOccupancyMaxActiveBlocksPerMultiprocessor(&per_cu, mega_kernel, 256, 0);
    if (per_cu > 2) per_cu = 2;
    if (per_cu < 1) per_cu = 1;
    grid_blocks = cus * per_cu;
  }
  hipMemsetAsync(p.bar, 0, 4096 * 4, stream);
#if MULTI_LAUNCH
  for (int ph = 0; ph < NPHASE; ++ph) {
    hipLaunchKernelGGL(mega_kernel, dim3(grid_blocks), dim3(256), 0, stream, p, ph, ph + 1);
  }
#else
  int lo = 0, hi = NPHASE;
  void* args[] = {&p, &lo, &hi};
  hipError_t e = hipLaunchCooperativeKernel((void*)mega_kernel, dim3(grid_blocks), dim3(256), args, 0, stream);
  if (e != hipSuccess) fprintf(stderr, "cooperative launch failed: %s (grid %d)\n", hipGetErrorString(e), grid_blocks);
#endif
}
```

```cpp
#include <hip/hip_runtime.h>
#include <hip/hip_cooperative_groups.h>
#include <cstdio>
namespace cg = cooperative_groups;

#ifdef ONLY
#define ONLYP(i) (ONLY == (i))
#else
#define ONLYP(i) 1
#endif
#ifndef MULTI_LAUNCH
#define MULTI_LAUNCH 0
#endif

#define DI __device__ __forceinline__
typedef unsigned short bf16_t;
typedef __attribute__((ext_vector_type(8))) short bf16x8;
typedef __attribute__((ext_vector_type(16))) float f32x16;
typedef __attribute__((ext_vector_type(2))) float f32x2;
typedef __attribute__((ext_vector_type(2))) __bf16 bfx2;
#define MFMA32(a, b, c) __builtin_amdgcn_mfma_f32_32x32x16_bf16((a), (b), (c), 0, 0, 0)

constexpr int R = 16640;
constexpr int NLAT = 16384;
constexpr int LDZ = 6400;
constexpr int LDT = 16640;
constexpr int NCH = 1040;
constexpr float LOG2E = 1.4426950408889634f;
constexpr int C_S5U = 0, C_S5G = 512, C_CV = 1024, C_CB = 1536, C_CC = 2048, C_CG = 2560, C_NQ = 3072, C_NK = 3584,
              C_NV = 4096, C_NG = 4608, C_GQ = 5120, C_GK = 5632, C_GV = 5760, C_GG = 5888;
constexpr int NPHASE = 1 + 2 * 4 * 8;

constexpr size_t al256(size_t x) { return (x + 255) & ~(size_t)255; }
constexpr size_t OFF_H = 0;
constexpr size_t OFF_Z = OFF_H + al256((size_t)R * 1024 * 2);
constexpr size_t OFF_VTN = OFF_Z + al256((size_t)R * LDZ * 2);
constexpr size_t OFF_VTG = OFF_VTN + al256((size_t)512 * LDT * 2);
constexpr size_t OFF_Y = OFF_VTG + al256((size_t)128 * LDT * 2);
constexpr size_t OFF_HIN = OFF_Y + al256((size_t)R * 512 * 2);
constexpr size_t OFF_E = OFF_HIN + al256((size_t)NCH * 8192 * 2);
constexpr size_t OFF_MIX = OFF_E;
constexpr size_t OFF_SG = OFF_E + al256((size_t)R * 1024 * 2);
constexpr size_t OFF_CTXS = OFF_SG + al256((size_t)R * 4096 * 2);
constexpr size_t OFF_WINT = OFF_CTXS + al256((size_t)512 * 1024 * 4);
constexpr size_t OFF_WBRT = OFF_WINT + al256((size_t)4 * 10496 * 1024 * 2);
constexpr size_t OFF_WOUTT = OFF_WBRT + al256((size_t)16 * 1024 * 512 * 2);
constexpr size_t OFF_WGLUT = OFF_WOUTT + al256((size_t)4 * 1024 * 1024 * 2);
constexpr size_t OFF_S5M = OFF_WGLUT + al256((size_t)4 * 512 * 512 * 2);
constexpr size_t OFF_S5WE = OFF_S5M + al256((size_t)128 * 65536 * 2);
constexpr size_t OFF_S5R = OFF_S5WE + al256((size_t)128 * 65536 * 2);
constexpr size_t OFF_A16 = OFF_S5R + al256((size_t)128 * 65536 * 2);
constexpr size_t OFF_MOD = OFF_A16 + al256((size_t)4 * 2 * 32 * 64 * 2 * 4);
constexpr size_t OFF_ROPE = OFF_MOD + al256((size_t)4 * 3 * 3072 * 4);
constexpr size_t OFF_BAR = OFF_ROPE + al256((size_t)256 * 16 * 2 * 4 + 64);
constexpr size_t OFF_PCTX = OFF_BAR + al256((size_t)4096 * 4);
constexpr size_t WS_TOTAL = OFF_PCTX + al256((size_t)4 * 256 * 1024 * 2);

struct Params {
  const float *x, *c, *ctx, *c_ctx, *norm_g, *w_ada, *b_ada, *w_in, *s5_a_re, *s5_a_im, *s5_log_dt, *s5_b_re, *s5_b_im,
      *s5_c_re, *s5_c_im, *s5_d, *s5_w_glu, *conv_w, *conv_b, *na_q_g, *na_k_g, *na_rel_bias, *gqa_q_g, *gqa_k_g, *gqa_sink,
      *w_br, *w_out;
  float* out;
  char* ws;
  unsigned* bar;
  DI bf16_t* H() const { return (bf16_t*)(ws + OFF_H); }
  DI bf16_t* Z() const { return (bf16_t*)(ws + OFF_Z); }
  DI bf16_t* VtN() const { return (bf16_t*)(ws + OFF_VTN); }
  DI bf16_t* VtG() const { return (bf16_t*)(ws + OFF_VTG); }
  DI bf16_t* Y() const { return (bf16_t*)(ws + OFF_Y); }
  DI bf16_t* MIX() const { return (bf16_t*)(ws + OFF_MIX); }
  DI bf16_t* HIN() const { return (bf16_t*)(ws + OFF_HIN); }
  DI float* E() const { return (float*)(ws + OFF_E); }
  DI float* CTXS() const { return (float*)(ws + OFF_CTXS); }
  DI bf16_t* WinT() const { return (bf16_t*)(ws + OFF_WINT); }
  DI bf16_t* SG() const { return (bf16_t*)(ws + OFF_SG); }
  DI bf16_t* PCTX() const { return (bf16_t*)(ws + OFF_PCTX); }
  DI bf16_t* WbrT() const { return (bf16_t*)(ws + OFF_WBRT); }
  DI bf16_t* WoutT() const { return (bf16_t*)(ws + OFF_WOUTT); }
  DI bf16_t* WgluT() const { return (bf16_t*)(ws + OFF_WGLUT); }
  DI bf16_t* S5M() const { return (bf16_t*)(ws + OFF_S5M); }
  DI bf16_t* S5We() const { return (bf16_t*)(ws + OFF_S5WE); }
  DI bf16_t* S5R() const { return (bf16_t*)(ws + OFF_S5R); }
  DI float* A16() const { return (float*)(ws + OFF_A16); }
  DI float* MOD() const { return (float*)(ws + OFF_MOD); }
  DI float* ROPE() const { return (float*)(ws + OFF_ROPE); }
};

DI float bf2f(bf16_t v) { return __uint_as_float(((unsigned)v) << 16); }
DI unsigned pk2(float a, float b) {
  f32x2 v = {a, b};
  bfx2 r = __builtin_convertvector(v, bfx2);
  return __builtin_bit_cast(unsigned, r);
}
DI bf16_t f2bf(float a) { return (bf16_t)(pk2(a, 0.f) & 0xffffu); }
DI float lo_bf(unsigned u) { return __uint_as_float(u << 16); }
DI float hi_bf(unsigned u) { return __uint_as_float(u & 0xffff0000u); }
DI float sigmoidf_(float x) { return 1.f / (1.f + __expf(-x)); }
DI float siluf_(float x) { return x / (1.f + __expf(-x)); }
DI size_t sg_index(int row, int col) { return ((size_t)((row >> 5) * 1024 + (col >> 2)) * 32 + (row & 31)) * 4 + (col & 3); }
DI int crow(int i, int h) { return (i & 3) + 8 * (i >> 2) + 4 * h; }
DI bf16x8 ld16(const bf16_t* p) { return *reinterpret_cast<const bf16x8*>(p); }


namespace pg8 {
typedef unsigned short bf16_t;
#define PG8_LAS __attribute__((address_space(3)))
typedef short bf16x8 __attribute__((ext_vector_type(8)));
typedef float f32x4 __attribute__((ext_vector_type(4)));
typedef unsigned u32x4 __attribute__((ext_vector_type(4)));
constexpr int BM = 256, BK = 64, HALF = 128, HTB = HALF * BK * 2  , STAGE_BYTES = 8 * HTB, NXCD = 8, WGM = 8;

__host__ __device__ __forceinline__ int lds_byte(int r, int c) { const int st = (r >> 4) * 2 + (c >> 5), rr = r & 15, cc = c & 31, ob = rr * 64 + cc * 2; return st * 1024 + (ob ^ (((ob >> 9) & 1) << 5)); }
__host__ __device__ __forceinline__ void stage_rc(int b, int& R, int& C) { const int st = b / 1024, sb = b % 1024, swz = sb ^ (((sb >> 9) & 1) << 5); R = (st >> 1) * 16 + swz / 64; C = (st & 1) * 32 + (swz % 64) / 2; }
__host__ __device__ __forceinline__ int perm32(int rho) { const int n = rho >> 4, i = rho & 15; return 8 * (i >> 2) + 4 * n + (i & 3); }

struct Unit { int pm, pn; };
struct Gemm { const bf16_t* A; const bf16_t* Bt; int M, N, K; };

struct StaticOrder {
    int nM, nN, nwg, G, c;
    __host__ __device__ void init(int M, int N, int G_, int c_) { nM = M / BM; nN = N / BM; nwg = nM * nN; G = G_; c = c_; }
    __host__ __device__ bool next(int i, Unit& u) const {
        const long L = (long)i * G + c; if (L >= nwg) return false;
        int wgid = (int)L; { const int q = nwg / NXCD, r = nwg % NXCD, xcd = wgid % NXCD, off = wgid / NXCD; wgid = (xcd < r ? xcd * (q + 1) : r * (q + 1) + (xcd - r) * q) + off; }
        const int nig = WGM * nN, gid = wgid / nig, fm = gid * WGM, gsz = (nM - fm) < WGM ? (nM - fm) : WGM;
        u.pm = fm + ((wgid % nig) % gsz); u.pn = (wgid % nig) / gsz; return true;
    }
    __device__ __forceinline__ void a_ready(const Unit&) const {}
    __device__ __forceinline__ void done(const Unit&) const {}
};
struct CountedOrder : StaticOrder {
    const unsigned* ready; unsigned need; unsigned* tmo;
    __device__ __forceinline__ void a_ready(const Unit& u) const {
        if (threadIdx.x < 64) {
            const unsigned long long t0 = __builtin_amdgcn_s_memrealtime(); unsigned polls = 0;
            while ((unsigned)__builtin_amdgcn_readfirstlane(__hip_atomic_load(ready + 64 * u.pm, __ATOMIC_RELAXED, __HIP_MEMORY_SCOPE_AGENT)) < need) {
                if ((++polls & 255u) == 0u && __builtin_amdgcn_readfirstlane(__hip_atomic_load(tmo, __ATOMIC_RELAXED, __HIP_MEMORY_SCOPE_AGENT)) != 0u) break;
                if (__builtin_amdgcn_s_memrealtime() - t0 > 2000000ull) {
                    if (threadIdx.x == 0) { unsigned expect = 0u; __hip_atomic_compare_exchange_strong(tmo + 1, &expect, 0x600u | (unsigned)(u.pm & 0xff), __ATOMIC_RELAXED, __ATOMIC_RELAXED, __HIP_MEMORY_SCOPE_AGENT); __hip_atomic_store(tmo, 1u, __ATOMIC_RELAXED, __HIP_MEMORY_SCOPE_AGENT); }
                    break; }
                __builtin_amdgcn_s_sleep(2); }
            __builtin_amdgcn_fence(__ATOMIC_ACQUIRE, "agent");
            asm volatile("s_waitcnt vmcnt(0)" ::: "memory");
        }
#if !defined(BROKEN_HOOK_NO_BARRIER)
        asm volatile("" ::: "memory"); __builtin_amdgcn_s_barrier(); asm volatile("" ::: "memory");
#endif
    }
};

__device__ __forceinline__ unsigned cvt_pk_bf16(float lo, float hi) { unsigned r; asm volatile("v_cvt_pk_bf16_f32 %0, %1, %2" : "=v"(r) : "v"(lo), "v"(hi)); return r; }
typedef float f32x2 __attribute__((ext_vector_type(2)));
__device__ __forceinline__ f32x2 gelu_pk(f32x2 v) {
    const f32x2 av = __builtin_elementwise_abs(v), d = av * 0.2316418882f + 1.0f;
    f32x2 t; t.x = __builtin_amdgcn_rcpf(d.x); t.y = __builtin_amdgcn_rcpf(d.y);
    f32x2 q = t * 0.5307027145f + (-0.7265760135f); q = q * t + 0.7107068705f; q = q * t + (-0.142248368f); q = q * t + 0.127414796f; q = q * t;
    const f32x2 s = (v * v) * (-0.72134752044f);
    f32x2 e; e.x = __builtin_amdgcn_exp2f(s.x); e.y = __builtin_amdgcn_exp2f(s.y);
    const f32x2 m = v * (q * e), r = v - m;
    f32x2 o; o.x = v.x < 0.f ? m.x : r.x; o.y = v.y < 0.f ? m.y : r.y; return o;
}

struct EpiF32 {
    static constexpr bool PERM = false, AFTER_DRAIN = false;
    float* C; int ldc; const float* bias;
    __device__ __forceinline__ void operator()(const f32x4 (&acc)[2][2][4][2], const Unit& u, int wr, int wc, int fr, int fq) const {
        const int row0 = u.pm * BM + wr * 64 + fr, col0 = u.pn * BM + wc * 32 + 4 * fq;
        f32x4 bv[2][2];
#pragma unroll
        for (int bj = 0; bj < 2; ++bj)
#pragma unroll
            for (int n = 0; n < 2; ++n) bv[bj][n] = bias ? *(const f32x4*)(bias + col0 + bj * HALF + n * 16) : (f32x4){0.f, 0.f, 0.f, 0.f};
#pragma unroll
        for (int ai = 0; ai < 2; ++ai)
#pragma unroll
            for (int m = 0; m < 4; ++m) { float* rowp = C + (size_t)(row0 + ai * HALF + m * 16) * ldc + col0;
#pragma unroll
                for (int bj = 0; bj < 2; ++bj)
#pragma unroll
                    for (int n = 0; n < 2; ++n) *(f32x4*)(rowp + bj * HALF + n * 16) = acc[ai][bj][m][n] + bv[bj][n]; }
    }
};
template <int ACT  > struct EpiBf16 {
    static constexpr bool PERM = true, AFTER_DRAIN = false;
    bf16_t* O; int ldc; const float* bias; int split_cols; size_t split_stride;
    __device__ __forceinline__ void operator()(const f32x4 (&acc)[2][2][4][2], const Unit& u, int wr, int wc, int fr, int fq) const {
        const int row0 = u.pm * BM + wr * 64 + fr; int colt = u.pn * BM; bf16_t* base = O;
        if (split_cols) { const int t = colt / split_cols; base += (size_t)t * split_stride; colt -= t * split_cols; }
        const int col0 = colt + wc * 32 + 8 * fq, bcol0 = u.pn * BM + wc * 32 + 8 * fq;
        f32x4 bv[2][2];
#pragma unroll
        for (int bj = 0; bj < 2; ++bj)
#pragma unroll
            for (int n = 0; n < 2; ++n) bv[bj][n] = bias ? *(const f32x4*)(bias + bcol0 + bj * HALF + 4 * n) : (f32x4){0.f, 0.f, 0.f, 0.f};
#pragma unroll
        for (int ai = 0; ai < 2; ++ai)
#pragma unroll
            for (int m = 0; m < 4; ++m) { bf16_t* rowp = base + (size_t)(row0 + ai * HALF + m * 16) * ldc + col0;
#pragma unroll
                for (int bj = 0; bj < 2; ++bj) { f32x4 v0 = acc[ai][bj][m][0] + bv[bj][0], v1 = acc[ai][bj][m][1] + bv[bj][1];
                    if (ACT == 1) { f32x2 a = gelu_pk((f32x2){v0[0], v0[1]}), b = gelu_pk((f32x2){v0[2], v0[3]}), c = gelu_pk((f32x2){v1[0], v1[1]}), d = gelu_pk((f32x2){v1[2], v1[3]});
                        v0 = (f32x4){a.x, a.y, b.x, b.y}; v1 = (f32x4){c.x, c.y, d.x, d.y}; }
                    if (ACT == 2) {
#pragma unroll
                        for (int j = 0; j < 4; ++j) { v0[j] = 0.5f * v0[j] * (1.0f + erff(v0[j] * 0.70710678f)); v1[j] = 0.5f * v1[j] * (1.0f + erff(v1[j] * 0.70710678f)); } }
                    u32x4 w; w.x = cvt_pk_bf16(v0[0], v0[1]); w.y = cvt_pk_bf16(v0[2], v0[3]); w.z = cvt_pk_bf16(v1[0], v1[1]); w.w = cvt_pk_bf16(v1[2], v1[3]);
                    *(u32x4*)(rowp + bj * HALF) = w; } }
    }
};

struct PanelStats {
    unsigned* xbuf;
    unsigned* cnt;
    unsigned* tmo;
    int ntn; float eps;
    unsigned code;
    __device__ __forceinline__ bool run(const f32x4 (&v)[2][2][4][2], const Unit& u, int wr, int wc, int fr, int fq, PG8_LAS unsigned char* lds, int wid, int lane) const {
        typedef float f32x2v __attribute__((ext_vector_type(2)));
        PG8_LAS f32x2v* P = (PG8_LAS f32x2v*)lds;
        PG8_LAS f32x2v* S = (PG8_LAS f32x2v*)(lds + 8192);
        PG8_LAS unsigned* flag = (PG8_LAS unsigned*)(lds + 8192 + 2048);
#pragma unroll
        for (int ai = 0; ai < 2; ++ai)
#pragma unroll
            for (int m = 0; m < 4; ++m) {
                float s = 0.f;
#pragma unroll
                for (int bj = 0; bj < 2; ++bj)
#pragma unroll
                    for (int n = 0; n < 2; ++n) { const f32x4 x = v[ai][bj][m][n]; s += (x[0] + x[1]) + (x[2] + x[3]); }
                s += __shfl_xor(s, 16); s += __shfl_xor(s, 32);
                const float mw = s * (1.0f / 64.0f); float q = 0.f;
#pragma unroll
                for (int bj = 0; bj < 2; ++bj)
#pragma unroll
                    for (int n = 0; n < 2; ++n) { const f32x4 d = v[ai][bj][m][n] - mw; q += (d[0] * d[0] + d[1] * d[1]) + (d[2] * d[2] + d[3] * d[3]); }
                q += __shfl_xor(q, 16); q += __shfl_xor(q, 32);
                if (fq == 0) P[(ai * HALF + wr * 64 + m * 16 + fr) * 4 + wc] = (f32x2v){mw, q};
            }
        asm volatile("s_waitcnt lgkmcnt(0)" ::: "memory"); __builtin_amdgcn_s_barrier(); asm volatile("" ::: "memory");
#if defined(BROKEN_NO_WAIT)
        if (blockIdx.x >= 64) { const long long t0 = clock64(); while (clock64() - t0 < 60000) __builtin_amdgcn_s_sleep(8); }
#endif
        const int row = wid * 32 + (lane & 31);
        if (lane < 32) {
            const f32x2v a = P[row * 4 + 0], b = P[row * 4 + 1], c = P[row * 4 + 2], d = P[row * 4 + 3];
            const float mt = (a.x + b.x + c.x + d.x) * 0.25f;
            const float da = a.x - mt, db = b.x - mt, dc = c.x - mt, dd = d.x - mt;
            const float m2 = (a.y + b.y) + (c.y + d.y) + 64.0f * ((da * da + db * db) + (dc * dc + dd * dd));
            unsigned long long* slot = (unsigned long long*)xbuf + ((size_t)(u.pm * BM + row) * 4 + u.pn);
            __hip_atomic_store(slot, ((unsigned long long)__float_as_uint(m2) << 32) | __float_as_uint(mt), __ATOMIC_RELAXED, __HIP_MEMORY_SCOPE_AGENT);
        }
        asm volatile("s_waitcnt vmcnt(0)" ::: "memory");
        if (lane == 0) __hip_atomic_fetch_add(cnt + 64 * u.pm, 1u, __ATOMIC_RELAXED, __HIP_MEMORY_SCOPE_AGENT);
        if (wid == 0) {
            bool dead = false; const unsigned long long t0 = __builtin_amdgcn_s_memrealtime(); const unsigned want = 8u * (unsigned)ntn;
            for (;;) {
#if defined(BROKEN_NO_WAIT)
                break;
#endif
                if ((unsigned)__builtin_amdgcn_readfirstlane(__hip_atomic_load(cnt + 64 * u.pm, __ATOMIC_RELAXED, __HIP_MEMORY_SCOPE_AGENT)) >= want) break;
                if (__builtin_amdgcn_s_memrealtime() - t0 > 2000000ull) {
                    if (lane == 0) { unsigned expect = 0u; __hip_atomic_compare_exchange_strong(tmo + 1, &expect, code | (unsigned)(u.pm & 0xff), __ATOMIC_RELAXED, __ATOMIC_RELAXED, __HIP_MEMORY_SCOPE_AGENT);
                                     __hip_atomic_store(tmo, 1u, __ATOMIC_RELAXED, __HIP_MEMORY_SCOPE_AGENT); }
                    dead = true; break; }
                __builtin_amdgcn_s_sleep(2);
            }
            __builtin_amdgcn_fence(__ATOMIC_ACQUIRE, "agent");
            if (lane == 0) flag[0] = dead ? 1u : 0u;
        }
        asm volatile("s_waitcnt vmcnt(0) lgkmcnt(0)" ::: "memory"); __builtin_amdgcn_s_barrier(); asm volatile("" ::: "memory");
        const bool bad = flag[0] != 0u;
        if (lane < 32) {
            const unsigned long long* slot = (const unsigned long long*)xbuf + (size_t)(u.pm * BM + row) * 4; float mt[4], m2[4]; float ms = 0.f;
#pragma unroll
            for (int t = 0; t < 4; ++t) { if (t < ntn) { const unsigned long long w = __hip_atomic_load(slot + t, __ATOMIC_RELAXED, __HIP_MEMORY_SCOPE_AGENT); mt[t] = __uint_as_float((unsigned)w); m2[t] = __uint_as_float((unsigned)(w >> 32)); } else { mt[t] = 0.f; m2[t] = 0.f; } ms += mt[t]; }
            const float mean = ms / (float)ntn; float q = 0.f;
#pragma unroll
            for (int t = 0; t < 4; ++t) if (t < ntn) { const float dm = mt[t] - mean; q += m2[t] + 256.0f * dm * dm; }
            S[row] = (f32x2v){mean, 1.0f / sqrtf(q / (256.0f * (float)ntn) + eps)};
        }
        asm volatile("s_waitcnt lgkmcnt(0)" ::: "memory"); __builtin_amdgcn_s_barrier(); asm volatile("" ::: "memory");
        return bad;
    }
};
struct EpiLnRes {
    static constexpr bool PERM = false, AFTER_DRAIN = true;
    const float* base; float* out; int ldc; const float* bias; PanelStats st; unsigned poison;
    __device__ __forceinline__ void refuse(size_t i0, size_t stride, int M, int N) const { const float q = __builtin_nanf(""); for (size_t i = i0; i < (size_t)M * N; i += stride) out[(i / N) * ldc + i % N] = q;
        if (i0 == 0) { unsigned expect = 0u; __hip_atomic_compare_exchange_strong(st.tmo + 1, &expect, 0x7f0u, __ATOMIC_RELAXED, __ATOMIC_RELAXED, __HIP_MEMORY_SCOPE_AGENT); __hip_atomic_store(st.tmo, 1u, __ATOMIC_RELAXED, __HIP_MEMORY_SCOPE_AGENT); } }
    __device__ __forceinline__ void fused(f32x4 (&acc)[2][2][4][2], const Unit& u, int wr, int wc, int fr, int fq, PG8_LAS unsigned char* lds, int wid, int lane) const {
        typedef float f32x2v __attribute__((ext_vector_type(2)));
        const PG8_LAS f32x2v* S = (const PG8_LAS f32x2v*)(lds + 8192);
        const int col0 = u.pn * BM + wc * 32 + 4 * fq;
#pragma unroll
        for (int bj = 0; bj < 2; ++bj)
#pragma unroll
            for (int n = 0; n < 2; ++n) { const f32x4 bv = bias ? *(const f32x4*)(bias + col0 + bj * HALF + n * 16) : (f32x4){0.f, 0.f, 0.f, 0.f};
#pragma unroll
                for (int ai = 0; ai < 2; ++ai)
#pragma unroll
                    for (int m = 0; m < 4; ++m) acc[ai][bj][m][n] += bv; }
        const bool bad = st.run(acc, u, wr, wc, fr, fq, lds, wid, lane) || poison != 0u;
        const float qnan = __builtin_nanf("");
#pragma unroll
        for (int ai = 0; ai < 2; ++ai)
#pragma unroll
            for (int m = 0; m < 4; ++m) { const int r = ai * HALF + wr * 64 + m * 16 + fr; const f32x2v sr = S[r]; const size_t off = (size_t)(u.pm * BM + r) * ldc + col0;
#pragma unroll
                for (int bj = 0; bj < 2; ++bj)
#pragma unroll
                    for (int n = 0; n < 2; ++n) { const f32x4 bs = *(const f32x4*)(base + off + bj * HALF + n * 16); f32x4 o = bs + (acc[ai][bj][m][n] - sr.x) * sr.y;
                        if (bad) o = (f32x4){qnan, qnan, qnan, qnan}; *(f32x4*)(out + off + bj * HALF + n * 16) = o; }
                asm volatile("" ::: "memory"); }
    }
};
struct EpiLnResLn {
    static constexpr bool PERM = false, AFTER_DRAIN = true;
    const float* base; float* out; bf16_t* xn; int ldc; const float* bias; PanelStats st1, st2; unsigned poison;
    __device__ __forceinline__ void refuse(size_t i0, size_t stride, int M, int N) const { const float q = __builtin_nanf(""); for (size_t i = i0; i < (size_t)M * N; i += stride) { const size_t o = (i / N) * ldc + i % N; out[o] = q; xn[o] = (bf16_t)0x7fc0u; }
        if (i0 == 0) { unsigned expect = 0u; __hip_atomic_compare_exchange_strong(st1.tmo + 1, &expect, 0x7f0u, __ATOMIC_RELAXED, __ATOMIC_RELAXED, __HIP_MEMORY_SCOPE_AGENT); __hip_atomic_store(st1.tmo, 1u, __ATOMIC_RELAXED, __HIP_MEMORY_SCOPE_AGENT); } }
    __device__ __forceinline__ void fused(f32x4 (&acc)[2][2][4][2], const Unit& u, int wr, int wc, int fr, int fq, PG8_LAS unsigned char* lds, int wid, int lane) const {
        typedef float f32x2v __attribute__((ext_vector_type(2))); typedef unsigned u32x2v __attribute__((ext_vector_type(2)));
        const PG8_LAS f32x2v* S = (const PG8_LAS f32x2v*)(lds + 8192);
        const int col0 = u.pn * BM + wc * 32 + 4 * fq;
#pragma unroll
        for (int bj = 0; bj < 2; ++bj)
#pragma unroll
            for (int n = 0; n < 2; ++n) { const f32x4 bv = bias ? *(const f32x4*)(bias + col0 + bj * HALF + n * 16) : (f32x4){0.f, 0.f, 0.f, 0.f};
#pragma unroll
                for (int ai = 0; ai < 2; ++ai)
#pragma unroll
                    for (int m = 0; m < 4; ++m) acc[ai][bj][m][n] += bv; }
        bool bad = st1.run(acc, u, wr, wc, fr, fq, lds, wid, lane) || poison != 0u;
        const float qnan = __builtin_nanf("");
#pragma unroll
        for (int ai = 0; ai < 2; ++ai)
#pragma unroll
            for (int m = 0; m < 4; ++m) { const int r = ai * HALF + wr * 64 + m * 16 + fr; const f32x2v sr = S[r]; const size_t off = (size_t)(u.pm * BM + r) * ldc + col0;
#pragma unroll
                for (int bj = 0; bj < 2; ++bj)
#pragma unroll
                    for (int n = 0; n < 2; ++n) { const f32x4 bs = *(const f32x4*)(base + off + bj * HALF + n * 16); acc[ai][bj][m][n] = bs + (acc[ai][bj][m][n] - sr.x) * sr.y; }
                asm volatile("" : "+v"(acc[ai][0][m][0]), "+v"(acc[ai][0][m][1]), "+v"(acc[ai][1][m][0]), "+v"(acc[ai][1][m][1]));
                if (m & 1) asm volatile("" ::: "memory"); }
        const bool bad1 = bad;
        bad = st2.run(acc, u, wr, wc, fr, fq, lds, wid, lane) || bad;
#pragma unroll
        for (int ai = 0; ai < 2; ++ai)
#pragma unroll
            for (int m = 0; m < 4; ++m) { const int r = ai * HALF + wr * 64 + m * 16 + fr; const f32x2v sr = S[r]; const size_t off = (size_t)(u.pm * BM + r) * ldc + col0;
#pragma unroll
                for (int bj = 0; bj < 2; ++bj)
#pragma unroll
                    for (int n = 0; n < 2; ++n) { const f32x4 x1 = acc[ai][bj][m][n]; *(f32x4*)(out + off + bj * HALF + n * 16) = bad1 ? (f32x4){qnan, qnan, qnan, qnan} : x1;
                        const f32x4 o = (x1 - sr.x) * sr.y; u32x2v w; w.x = cvt_pk_bf16(o[0], o[1]); w.y = cvt_pk_bf16(o[2], o[3]);
                        if (bad) { w.x = 0x7fc07fc0u; w.y = 0x7fc07fc0u; } *(u32x2v*)(xn + off + bj * HALF + n * 16) = w; }
                asm volatile("" ::: "memory"); }
    }
};

template <class Epi, class Sched, bool STAMP = false>
__device__ __forceinline__ void gemm_phase(PG8_LAS unsigned char* lds, const Gemm g, const Sched& S, const Epi& E, unsigned long long* stamps) {
    int tid_ = threadIdx.x; asm volatile("" : "+v"(tid_)); const int tid = tid_, wid = __builtin_amdgcn_readfirstlane(tid >> 6), lane = tid & 63, wr = wid >> 2, wc = wid & 3, fr = lane & 15, fq = lane >> 4;
    const int K = g.K, nt = K / BK;
    int ts_lo = 0, ts_hi = 0, nts = 0; const unsigned long long rt_entry = STAMP ? (unsigned long long)wall_clock64() : 0ull;
#define PG8_STAMP() do { if (STAMP && wid == 0 && nts < 64) { const unsigned long long _c = (unsigned long long)clock64(); \
        ts_lo = (lane == nts) ? (int)(unsigned)_c : ts_lo; ts_hi = (lane == nts) ? (int)(unsigned)(_c >> 32) : ts_hi; ++nts; } } while (0)
    PG8_STAMP();
    unsigned voffA[2], voffB[2];
#pragma unroll
    for (int i = 0; i < 2; ++i) { int R, C; stage_rc(tid * 16 + i * 8192, R, C); const int Rb = Epi::PERM ? ((R & ~31) + perm32(R & 31)) : R;
        voffA[i] = (unsigned)(R * K + C) * 2u; voffB[i] = (unsigned)(Rb * K + C) * 2u; }
    const size_t kstep = (size_t)(BK * 2);
    const size_t hstep = (size_t)HALF * K * 2;
    const size_t tstep = 2 * hstep;
    const unsigned ldsw = (unsigned)wid * 1024u;
    const int aoff = lds_byte(wr * 64 + fr, fq * 8), boff = lds_byte(wc * 32 + fr, fq * 8);
#define PG8_SA(b, h) (((b) * 2 + (h)) * HTB)
#define PG8_SB(b, h) ((4 + (b) * 2 + (h)) * HTB)
#define PG8_STAGE(bufoff, gbase, voff) do { _Pragma("unroll") for (int _i = 0; _i < 2; ++_i) \
        __builtin_amdgcn_global_load_lds((const unsigned*)((const char*)(gbase) + (voff)[_i]), (PG8_LAS unsigned*)(lds + (bufoff) + ldsw + _i * 8192), 16, 0, 0); } while (0)
#define PG8_LDA(dst, b, h) do { _Pragma("unroll") for (int m = 0; m < 4; ++m) _Pragma("unroll") for (int k = 0; k < 2; ++k) dst[m][k] = *(const PG8_LAS bf16x8*)(lds + PG8_SA(b, h) + aoff + m * 2048 + k * 1024); } while (0)
#define PG8_LDB(dst, b, h) do { _Pragma("unroll") for (int n = 0; n < 2; ++n) _Pragma("unroll") for (int k = 0; k < 2; ++k) dst[n][k] = *(const PG8_LAS bf16x8*)(lds + PG8_SB(b, h) + boff + n * 2048 + k * 1024); } while (0)
#define PG8_MMA(ai, bj, At, Bt) do { __builtin_amdgcn_s_setprio(1); _Pragma("unroll") for (int m = 0; m < 4; ++m) _Pragma("unroll") for (int n = 0; n < 2; ++n) _Pragma("unroll") for (int k = 0; k < 2; ++k) \
        acc[ai][bj][m][n] = __builtin_amdgcn_mfma_f32_16x16x32_bf16(Bt[n][k], At[m][k], acc[ai][bj][m][n], 0, 0, 0); __builtin_amdgcn_s_setprio(0); } while (0)
#define PG8_WAIT_V(n) asm volatile("s_waitcnt vmcnt(" #n ")" ::: "memory")
#define PG8_WAIT_L(n) asm volatile("s_waitcnt lgkmcnt(" #n ")" ::: "memory")
#define PG8_BAR __builtin_amdgcn_s_barrier()
#define PG8_SCHED __builtin_amdgcn_sched_barrier(0)
    Unit cur, nxt; int ui = 0;
    if (!S.next(0, cur)) return;
    f32x4 acc[2][2][4][2];
#pragma unroll
    for (int a = 0; a < 2; ++a)
#pragma unroll
        for (int b = 0; b < 2; ++b)
#pragma unroll
            for (int m = 0; m < 4; ++m)
#pragma unroll
                for (int n = 0; n < 2; ++n) acc[a][b][m][n] = (f32x4){0.f, 0.f, 0.f, 0.f};
    bf16x8 At[4][2], B0[2][2], B1[2][2];
    const char* cA = (const char*)g.A + (size_t)cur.pm * tstep; const char* cB = (const char*)g.Bt + (size_t)cur.pn * tstep;
    S.a_ready(cur);
    PG8_STAGE(PG8_SB(0, 0), cB, voffB); PG8_STAGE(PG8_SA(0, 0), cA, voffA); PG8_STAGE(PG8_SB(0, 1), cB + hstep, voffB); PG8_STAGE(PG8_SA(0, 1), cA + hstep, voffA);
    if (wr == 1) PG8_BAR;
    PG8_WAIT_V(4); PG8_BAR;
    PG8_STAGE(PG8_SB(1, 0), cB + kstep, voffB); PG8_STAGE(PG8_SA(1, 0), cA + kstep, voffA); PG8_STAGE(PG8_SB(1, 1), cB + hstep + kstep, voffB);
    PG8_WAIT_V(6); PG8_BAR;
    PG8_STAMP();
    for (;;) {
        const bool has_next = S.next(ui + 1, nxt);
        const char* nA = has_next ? (const char*)g.A + (size_t)nxt.pm * tstep : cA; const char* nB = has_next ? (const char*)g.Bt + (size_t)nxt.pn * tstep : cB;
        for (int t = 0; t < nt; t += 2) {
            const bool last = (t == nt - 2);
            const char* a1 = cA + (size_t)(t + 1) * kstep;
            const char* a2 = last ? nA : cA + (size_t)(t + 2) * kstep; const char* b2 = last ? nB : cB + (size_t)(t + 2) * kstep;
            const char* a3 = a2 + kstep; const char* b3 = b2 + kstep;
            if (last && has_next) S.a_ready(nxt);
            PG8_LDB(B0, 0, 0); PG8_SCHED; PG8_LDA(At, 0, 0); PG8_STAGE(PG8_SA(1, 1), a1 + hstep, voffA);
            PG8_WAIT_L(8); PG8_BAR; PG8_WAIT_L(0); PG8_MMA(0, 0, At, B0); PG8_BAR; PG8_SCHED;
            PG8_LDB(B1, 0, 1); PG8_STAGE(PG8_SB(0, 0), b2, voffB);
            PG8_BAR; PG8_WAIT_L(0); PG8_MMA(0, 1, At, B1); PG8_BAR;
            PG8_LDA(At, 0, 1); PG8_STAGE(PG8_SA(0, 0), a2, voffA);
            PG8_BAR; PG8_WAIT_L(0); PG8_MMA(1, 0, At, B0); PG8_BAR; PG8_SCHED;
            PG8_STAGE(PG8_SB(0, 1), b2 + hstep, voffB);
            PG8_WAIT_V(6); PG8_BAR; PG8_MMA(1, 1, At, B1); PG8_BAR;
            PG8_LDB(B0, 1, 0); PG8_SCHED; PG8_LDA(At, 1, 0); PG8_STAGE(PG8_SA(0, 1), a2 + hstep, voffA);
            PG8_WAIT_L(8); PG8_BAR; PG8_WAIT_L(0); PG8_MMA(0, 0, At, B0); PG8_BAR; PG8_SCHED;
            PG8_LDB(B1, 1, 1); PG8_STAGE(PG8_SB(1, 0), b3, voffB);
            PG8_BAR; PG8_WAIT_L(0); PG8_MMA(0, 1, At, B1); PG8_BAR;
            PG8_LDA(At, 1, 1); PG8_STAGE(PG8_SA(1, 0), a3, voffA);
            PG8_BAR; PG8_WAIT_L(0); PG8_MMA(1, 0, At, B0); PG8_BAR; PG8_SCHED;
            PG8_STAGE(PG8_SB(1, 1), b3 + hstep, voffB);
            PG8_WAIT_V(6); PG8_BAR; PG8_MMA(1, 1, At, B1); PG8_BAR;
        }
        PG8_STAMP();
        if constexpr (!Epi::AFTER_DRAIN) { E(acc, cur, wr, wc, fr, fq); S.done(cur); }
        PG8_STAMP();
        if (!has_next) break;
#pragma unroll
        for (int a = 0; a < 2; ++a)
#pragma unroll
            for (int b = 0; b < 2; ++b)
#pragma unroll
                for (int m = 0; m < 4; ++m)
#pragma unroll
                    for (int n = 0; n < 2; ++n) acc[a][b][m][n] = (f32x4){0.f, 0.f, 0.f, 0.f};
        cur = nxt; cA = nA; cB = nB; ++ui;
    }
    PG8_WAIT_V(0);
    if (wr == 0) PG8_BAR;
    PG8_BAR;
    if constexpr (Epi::AFTER_DRAIN) { E.fused(acc, cur, wr, wc, fr, fq, lds, wid, lane); S.done(cur); }
    PG8_STAMP();
    if (STAMP && wid == 0) { stamps[lane] = lane < nts ? (((unsigned long long)(unsigned)ts_hi << 32) | (unsigned)ts_lo) : 0ull;
        if (lane == 62) stamps[62] = rt_entry; if (lane == 63) stamps[63] = (unsigned long long)wall_clock64(); }
#undef PG8_STAMP
#undef PG8_SA
#undef PG8_SB
#undef PG8_STAGE
#undef PG8_LDA
#undef PG8_LDB
#undef PG8_MMA
#undef PG8_WAIT_V
#undef PG8_WAIT_L
#undef PG8_BAR
#undef PG8_SCHED
}
}

DI bf16x8 ld16_sum4(const bf16_t* p, size_t slab) {
  union { bf16x8 v; unsigned u[4]; } a, b, c, d, o;
  a.v = ld16(p); b.v = ld16(p + slab); c.v = ld16(p + 2 * slab); d.v = ld16(p + 3 * slab);
#pragma unroll
  for (int i = 0; i < 4; ++i)
    o.u[i] = pk2(lo_bf(a.u[i]) + lo_bf(b.u[i]) + lo_bf(c.u[i]) + lo_bf(d.u[i]), hi_bf(a.u[i]) + hi_bf(b.u[i]) + hi_bf(c.u[i]) + hi_bf(d.u[i]));
  return o.v;
}

template <int NI, bool TR = false, bool PF2 = true, bool ASUM4 = false>
DI void gemm_main(f32x16 (&acc)[2][NI], const bf16_t* Abase, int lda, int akoff, int astep, const bf16_t* Bt, int ldb, int K,
                  bf16_t* sm, int tid, bool act, size_t aslab = 0) {
  if (!act) {
    __syncthreads();
    for (int kt = 0; kt < (K >> 6); ++kt) __syncthreads();
    return;
  }
  const int lane = tid & 63, wid = tid >> 6, wm = wid >> 1, wn = wid & 1, r = lane & 31, h = lane >> 5;
  const int lrow = tid >> 3, lkc = tid & 7;
  const int aoff0 = lrow * lda + akoff, a32 = 32 * lda;
  const int boff0 = lrow * ldb + lkc * 8, b32 = 32 * ldb;
  const int soff0 = lrow * 64 + ((lkc ^ ((lrow >> 1) & 7)) * 8);
  bf16_t* As = sm;
  bf16_t* Bs = sm + 2 * 8192;
  bf16x8 ra0[4], rb0[2 * NI], ra1[4], rb1[2 * NI];
  const int nk = K >> 6;
#define GM_LOAD(RA, RB, t)                                                                          \
  {                                                                                                 \
    const bf16_t* An_ = Abase + (size_t)(t) * astep;                                                \
    const bf16_t* Bn_ = Bt + (t) * 64;                                                              \
    _Pragma("unroll") for (int i = 0; i < 4; ++i) RA[i] = ASUM4 ? ld16_sum4(An_ + aoff0 + i * a32, aslab) : ld16(An_ + aoff0 + i * a32); \
    _Pragma("unroll") for (int i = 0; i < 2 * NI; ++i) RB[i] = ld16(Bn_ + boff0 + i * b32);         \
  }
#define GM_STORE(RA, RB, buf)                                                                       \
  {                                                                                                 \
    bf16_t* An = As + (buf) * 8192 + soff0;                                                         \
    bf16_t* Bn = Bs + (buf) * 8192 + soff0;                                                         \
    _Pragma("unroll") for (int i = 0; i < 4; ++i) *reinterpret_cast<bf16x8*>(An + i * 2048) = RA[i];        \
    _Pragma("unroll") for (int i = 0; i < 2 * NI; ++i) *reinterpret_cast<bf16x8*>(Bn + i * 2048) = RB[i];   \
  }
#define GM_COMPUTE(buf)                                                                             \
  {                                                                                                 \
    const bf16_t* Ac = As + (buf) * 8192 + ar0 * 64;                                                \
    const bf16_t* Bc = Bs + (buf) * 8192 + br0 * 64;                                                \
    _Pragma("unroll") for (int ks = 0; ks < 4; ++ks) {                                              \
      bf16x8 a[2], b[NI];                                                                           \
      _Pragma("unroll") for (int i = 0; i < 2; ++i)                                                 \
        a[i] = *reinterpret_cast<const bf16x8*>(Ac + i * 2048 + (((ks * 2 + h) ^ asw) * 8));        \
      _Pragma("unroll") for (int i = 0; i < NI; ++i)                                                \
        b[i] = *reinterpret_cast<const bf16x8*>(Bc + i * 2048 + (((ks * 2 + h) ^ bsw) * 8));        \
      _Pragma("unroll") for (int mi = 0; mi < 2; ++mi)                                              \
        _Pragma("unroll") for (int ni = 0; ni < NI; ++ni)                                           \
          acc[mi][ni] = TR ? MFMA32(b[ni], a[mi], acc[mi][ni]) : MFMA32(a[mi], b[ni], acc[mi][ni]); \
    }                                                                                               \
  }
  const int ar0 = wm * 64 + r, br0 = wn * 32 * NI + r;
  const int asw = (ar0 >> 1) & 7, bsw = (br0 >> 1) & 7;
  if (!PF2) {
    GM_LOAD(ra0, rb0, 0)
    GM_STORE(ra0, rb0, 0)
    __syncthreads();
    for (int kt = 0; kt < nk; kt += 2) {
      GM_LOAD(ra0, rb0, kt + 1)
      GM_COMPUTE(0)
      GM_STORE(ra0, rb0, 1)
      __syncthreads();
      if (kt + 2 < nk) GM_LOAD(ra0, rb0, kt + 2)
      GM_COMPUTE(1)
      if (kt + 2 < nk) GM_STORE(ra0, rb0, 0)
      __syncthreads();
    }
    return;
  }
  GM_LOAD(ra0, rb0, 0)
  GM_LOAD(ra1, rb1, 1)
  GM_STORE(ra0, rb0, 0)
  __syncthreads();
  for (int kt = 0; kt < nk; kt += 2) {
    if (kt + 2 < nk) GM_LOAD(ra0, rb0, kt + 2)
    GM_COMPUTE(0)
    GM_STORE(ra1, rb1, 1)
    __syncthreads();
    if (kt + 3 < nk) GM_LOAD(ra1, rb1, kt + 3)
    GM_COMPUTE(1)
    if (kt + 2 < nk) GM_STORE(ra0, rb0, 0)
    __syncthreads();
  }
#undef GM_LOAD
#undef GM_STORE
#undef GM_COMPUTE
}

template <int NI>
DI void zero_acc(f32x16 (&acc)[2][NI]) {
#pragma unroll
  for (int a = 0; a < 2; ++a)
#pragma unroll
    for (int b = 0; b < NI; ++b)
#pragma unroll
      for (int i = 0; i < 16; ++i) acc[a][b][i] = 0.f;
}

DI void sincos_(float x, float* sn, float* cs) {
  float n = rintf(x * 0.63661977236758134f);
  float rr = fmaf(-n, 1.57079625129699707031f, x);
  rr = fmaf(-n, 7.54978941586159635335e-08f, rr);
  float r2 = rr * rr;
  float sp = rr + rr * r2 * (-1.6666654611e-1f + r2 * (8.3321608736e-3f + r2 * (-1.9515295891e-4f)));
  float cp = 1.f + r2 * (-0.5f + r2 * (4.166664568298827e-2f + r2 * (-1.388731625493765e-3f + r2 * 2.443315711809948e-5f)));
  int q = ((int)n) & 3;
  float s_ = (q & 1) ? cp : sp;
  float c_ = (q & 1) ? sp : cp;
  if (q == 1 || q == 2) c_ = -c_;
  if (q >= 2) s_ = -s_;
  *sn = s_;
  *cs = c_;
}

#define VSUB_SETUP                                                                                             \
  const int sub = tid >> 8, vt = tid & 255;                                                                    \
  const int vgrid = gridDim.x * 2, vb = blockIdx.x * 2 + sub;                                                  \
  bf16_t* smv = sm + sub * 32768;                                                                              \
  const int lane = vt & 63, wid = vt >> 6, wm = wid >> 1, wn = wid & 1, r = lane & 31, h = lane >> 5;          \
  (void)lane; (void)wm; (void)wn; (void)r; (void)h; (void)smv; (void)vgrid; (void)vb;

DI void prep_transpose(const float* src, int ld, bf16_t* dst, int K, int k0, int n0, float* tile, int tid) {
  const int nn = tid & 63, kq = tid >> 6;
#pragma unroll 4
  for (int i = 0; i < 8; ++i) {
    int kk = kq + 8 * i;
    tile[kk * 65 + nn] = src[(size_t)(k0 + kk) * ld + n0 + nn];
  }
  __syncthreads();
  {
    int n2 = tid >> 3, kc = tid & 7;
    uint4 w;
    w.x = pk2(tile[(kc * 8 + 0) * 65 + n2], tile[(kc * 8 + 1) * 65 + n2]);
    w.y = pk2(tile[(kc * 8 + 2) * 65 + n2], tile[(kc * 8 + 3) * 65 + n2]);
    w.z = pk2(tile[(kc * 8 + 4) * 65 + n2], tile[(kc * 8 + 5) * 65 + n2]);
    w.w = pk2(tile[(kc * 8 + 6) * 65 + n2], tile[(kc * 8 + 7) * 65 + n2]);
    *reinterpret_cast<uint4*>(dst + (size_t)(n0 + n2) * K + k0 + kc * 8) = w;
  }
  __syncthreads();
}

DI void prep_s5(const Params& p, int L, int g, float* sm, int tid) {
  float* apow = sm;
  float* fco = sm + 2176;
  float* bbar = sm + 2304;
  float* Kt = sm + 4352;
  const size_t gm = (size_t)(L * 32 + g) * 65536;
  for (int d = 0; d < 2; ++d) {
    const int dg = (L * 2 + d) * 32 + g;
    if (tid < 64) {
      const int pp = tid;
      float dt = expf(p.s5_log_dt[dg]);
      float are = p.s5_a_re[dg * 64 + pp], aim = p.s5_a_im[dg * 64 + pp];
      float mag = expf(dt * are);
      float sn, cs;
      sincos_(dt * aim, &sn, &cs);
      float abr = mag * cs, abi = mag * sn;
      float den = are * are + aim * aim;
      float fr = ((abr - 1.f) * are + abi * aim) / den;
      float fi = (abi * are - (abr - 1.f) * aim) / den;
      fco[pp * 2] = fr;
      fco[pp * 2 + 1] = fi;
      float pr = 1.f, pi = 0.f;
      apow[pp * 2] = 1.f;
      apow[pp * 2 + 1] = 0.f;
      for (int t = 1; t <= 16; ++t) {
        float nr = pr * abr - pi * abi, ni = pr * abi + pi * abr;
        pr = nr; pi = ni;
        apow[(t * 64 + pp) * 2] = pr;
        apow[(t * 64 + pp) * 2 + 1] = pi;
      }
      p.A16()[(dg * 64 + pp) * 2] = pr;
      p.A16()[(dg * 64 + pp) * 2 + 1] = pi;
    }
    __syncthreads();
    for (int i = 0; i < 2; ++i) {
      int idx = tid + 512 * i;
      int pp = idx >> 4;
      float br = p.s5_b_re[(size_t)dg * 1024 + idx], bi = p.s5_b_im[(size_t)dg * 1024 + idx];
      float fr = fco[pp * 2], fi = fco[pp * 2 + 1];
      bbar[idx * 2] = fr * br - fi * bi;
      bbar[idx * 2 + 1] = fr * bi + fi * br;
    }
    __syncthreads();
    {
      const int th = tid >> 8, hp = (tid >> 4) & 15, hh = tid & 15;
      float kacc[8];
#pragma unroll
      for (int t = 0; t < 8; ++t) kacc[t] = 0.f;
      for (int pp = 0; pp < 64; ++pp) {
        float cr = p.s5_c_re[((size_t)dg * 16 + hp) * 64 + pp], ci = p.s5_c_im[((size_t)dg * 16 + hp) * 64 + pp];
        float br = bbar[(pp * 16 + hh) * 2], bi = bbar[(pp * 16 + hh) * 2 + 1];
        float xr = cr * br - ci * bi, xi = cr * bi + ci * br;
#pragma unroll
        for (int t = 0; t < 8; ++t)
          kacc[t] += xr * apow[((th * 8 + t) * 64 + pp) * 2] - xi * apow[((th * 8 + t) * 64 + pp) * 2 + 1];
      }
#pragma unroll
      for (int t = 0; t < 8; ++t) Kt[(d * 16 + th * 8 + t) * 256 + (tid & 255)] = kacc[t];
    }
    for (int i = 0; i < 64; ++i) {
      int idx = tid + 512 * i;
      int k = idx & 255, nn = idx >> 8;
      int pp = nn >> 1, ri = nn & 1, j = k >> 4, hh = k & 15;
      int e = (d == 0) ? (15 - j) : j;
      float ar = apow[(e * 64 + pp) * 2], ai = apow[(e * 64 + pp) * 2 + 1];
      float br = bbar[(pp * 16 + hh) * 2], bi = bbar[(pp * 16 + hh) * 2 + 1];
      float v = ri ? (ar * bi + ai * br) : (ar * br - ai * bi);
      p.S5We()[gm + (size_t)(d * 128 + nn) * 256 + k] = f2bf(v);
    }
    for (int i = 0; i < 64; ++i) {
      int idx = tid + 512 * i;
      int kk = idx & 127, n = idx >> 7;
      int pp = kk >> 1, ri = kk & 1, t16 = n >> 4, hp = n & 15;
      int pw = (d == 0) ? (t16 + 1) : (16 - t16);
      float cr = p.s5_c_re[((size_t)dg * 16 + hp) * 64 + pp], ci = p.s5_c_im[((size_t)dg * 16 + hp) * 64 + pp];
      float ar = apow[(pw * 64 + pp) * 2], ai = apow[(pw * 64 + pp) * 2 + 1];
      float v = ri ? -(cr * ai + ci * ar) : (cr * ar - ci * ai);
      p.S5R()[gm + (size_t)n * 256 + d * 128 + kk] = f2bf(v);
    }
    __syncthreads();
  }
  for (int i = 0; i < 128; ++i) {
    int idx = tid + 512 * i;
    int k = idx & 255, n = idx >> 8;
    int t16 = n >> 4, hp = n & 15, j = k >> 4, hh = k & 15;
    float v = 0.f;
    if (j <= t16) v += Kt[(0 * 16 + (t16 - j)) * 256 + hp * 16 + hh];
    if (j >= t16) v += Kt[(1 * 16 + (j - t16)) * 256 + hp * 16 + hh];
    if (j == t16 && hp == hh) v += p.s5_d[(L * 32 + g) * 16 + hh];
    p.S5M()[gm + (size_t)n * 256 + k] = f2bf(v);
  }
  __syncthreads();
}

DI void prep_adaln(const Params& p, int L, int cb, float* sm, int tid) {
  float* sv = sm;
  float* red = sm + 3072;
  for (int idx = tid; idx < 3072; idx += 512) {
    int v = idx >> 10, k = idx & 1023;
    float cv = (v < 2) ? p.c[v * 1024 + k] : p.c_ctx[k];
    sv[idx] = siluf_(cv);
  }
  __syncthreads();
  const int cl = tid & 63, kq = tid >> 6, col = cb * 64 + cl;
  float a0 = 0.f, a1 = 0.f, a2 = 0.f;
  const float* w = p.w_ada + (size_t)L * 1024 * 3072 + col;
#pragma unroll 8
  for (int k = kq * 128; k < kq * 128 + 128; ++k) {
    float wv = w[(size_t)k * 3072];
    a0 += sv[k] * wv;
    a1 += sv[1024 + k] * wv;
    a2 += sv[2048 + k] * wv;
  }
  red[(kq * 3 + 0) * 64 + cl] = a0;
  red[(kq * 3 + 1) * 64 + cl] = a1;
  red[(kq * 3 + 2) * 64 + cl] = a2;
  __syncthreads();
  if (kq == 0) {
    float bb = p.b_ada[L * 3072 + col];
    for (int v = 0; v < 3; ++v) {
      float s = 0.f;
      for (int q = 0; q < 8; ++q) s += red[(q * 3 + v) * 64 + cl];
      p.MOD()[(L * 3 + v) * 3072 + col] = s + bb;
    }
  }
  __syncthreads();
}

DI void phase_prep(const Params& p, float* sm, int tid) {
  constexpr int N_S5 = 128, N_ADA = 192, N_TR_L = 3456, N_TR = 4 * N_TR_L;
  constexpr int TOTAL = N_S5 + N_ADA + 1 + N_TR;
  for (int item = blockIdx.x; item < TOTAL; item += gridDim.x) {
    if (item < N_S5) {
      prep_s5(p, item >> 5, item & 31, sm, tid);
    } else if (item < N_S5 + N_ADA) {
      int it = item - N_S5;
      prep_adaln(p, it / 48, it % 48, sm, tid);
    } else if (item == N_S5 + N_ADA) {
      for (int idx = tid; idx < 256 * 16; idx += 512) {
        int pos = idx >> 4, i = idx & 15;
        float inv = exp2f(-(float)i * (13.287712379549449f / 16.f));
        float sn, cs;
        sincos_((float)pos * inv, &sn, &cs);
        p.ROPE()[idx * 2] = cs;
        p.ROPE()[idx * 2 + 1] = sn;
      }
      if (tid < 8) {
        const int LL = tid >> 1, ty = tid & 1;
        const float* gq = (ty ? p.gqa_q_g : p.na_q_g) + LL * 64;
        const float* gk = (ty ? p.gqa_k_g : p.na_k_g) + LL * 64;
        float mq = 0.f, mk = 0.f, mb = 0.f;
        for (int j = 0; j < 64; ++j) { mq = fmaxf(mq, fabsf(gq[j])); mk = fmaxf(mk, fabsf(gk[j])); }
        if (!ty) for (int j = 0; j < 8 * 465; ++j) mb = fmaxf(mb, fabsf(p.na_rel_bias[LL * 8 * 465 + j]));
        p.ROPE()[8192 + tid] = fminf(8.f * LOG2E * mq * mk + LOG2E * mb, 100.f);
      }
    } else {
      int it = item - (N_S5 + N_ADA + 1);
      int L = it / N_TR_L, tt = it % N_TR_L;
      const float* src; bf16_t* dst; int ld, K, kt, nt;
      if (tt < 2624) {
        kt = tt / 164; nt = tt % 164; src = p.w_in + (size_t)L * 1024 * 10496; ld = 10496; K = 1024;
        dst = p.WinT() + (size_t)L * 10496 * 1024;
      } else if (tt < 3136) {
        int t2 = tt - 2624; int kb = t2 / 128; int t3 = t2 % 128; kt = t3 / 16; nt = t3 % 16;
        src = p.w_br + (size_t)(L * 4 + kb) * 512 * 1024; ld = 1024; K = 512;
        dst = p.WbrT() + (size_t)(L * 4 + kb) * 1024 * 512;
      } else if (tt < 3392) {
        int t2 = tt - 3136; kt = t2 / 16; nt = t2 % 16; src = p.w_out + (size_t)L * 1024 * 1024; ld = 1024; K = 1024;
        dst = p.WoutT() + (size_t)L * 1024 * 1024;
      } else {
        int t2 = tt - 3392; kt = t2 / 8; nt = t2 % 8; src = p.s5_w_glu + (size_t)L * 512 * 512; ld = 512; K = 512;
        dst = p.WgluT() + (size_t)L * 512 * 512;
      }
      prep_transpose(src, ld, dst, K, kt * 64, nt * 64, sm, tid);
    }
  }
}

DI void phase_norm(const Params& p, int b, int L, int tid) {
  const int wid = tid >> 6, lane = tid & 63;
  const float* g = p.norm_g + L * 1024;
  for (int item = blockIdx.x; item < R / 16; item += gridDim.x) {
    const int row = item * 16 + wid * 2;
    const float* src;
    const float* mod;
    if (row < NLAT) {
      src = (L == 0 ? p.x : (const float*)p.out) + ((size_t)b * NLAT + row) * 1024;
      mod = p.MOD() + (L * 3 + b) * 3072;
    } else {
      src = (L == 0 ? p.ctx : (const float*)p.CTXS()) + ((size_t)b * 256 + (row - NLAT)) * 1024;
      mod = p.MOD() + (L * 3 + 2) * 3072;
    }
    float4 v0[4], v1[4], g4[4], sh[4], sc[4];
#pragma unroll
    for (int j = 0; j < 4; ++j) {
      const int col = j * 256 + lane * 4;
      v0[j] = *reinterpret_cast<const float4*>(src + col);
      v1[j] = *reinterpret_cast<const float4*>(src + 1024 + col);
      g4[j] = *reinterpret_cast<const float4*>(g + col);
      sh[j] = *reinterpret_cast<const float4*>(mod + col);
      sc[j] = *reinterpret_cast<const float4*>(mod + 1024 + col);
    }
    float s0 = 0.f, s1 = 0.f;
#pragma unroll
    for (int j = 0; j < 4; ++j) {
      s0 += v0[j].x * v0[j].x + v0[j].y * v0[j].y + v0[j].z * v0[j].z + v0[j].w * v0[j].w;
      s1 += v1[j].x * v1[j].x + v1[j].y * v1[j].y + v1[j].z * v1[j].z + v1[j].w * v1[j].w;
    }
#pragma unroll
    for (int o = 32; o >= 1; o >>= 1) { s0 += __shfl_xor(s0, o); s1 += __shfl_xor(s1, o); }
    const float r0 = rsqrtf(s0 * (1.f / 1024.f) + 1e-6f), r1 = rsqrtf(s1 * (1.f / 1024.f) + 1e-6f);
#pragma unroll
    for (int j = 0; j < 4; ++j) {
      const int col = j * 256 + lane * 4;
      const float m0 = g4[j].x * (1.f + sc[j].x), m1 = g4[j].y * (1.f + sc[j].y), m2 = g4[j].z * (1.f + sc[j].z), m3 = g4[j].w * (1.f + sc[j].w);
      uint2 w;
      w.x = pk2(v0[j].x * r0 * m0 + sh[j].x, v0[j].y * r0 * m1 + sh[j].y);
      w.y = pk2(v0[j].z * r0 * m2 + sh[j].z, v0[j].w * r0 * m3 + sh[j].w);
      *reinterpret_cast<uint2*>(p.H() + (size_t)row * 1024 + col) = w;
      w.x = pk2(v1[j].x * r1 * m0 + sh[j].x, v1[j].y * r1 * m1 + sh[j].y);
      w.y = pk2(v1[j].z * r1 * m2 + sh[j].z, v1[j].w * r1 * m3 + sh[j].w);
      *reinterpret_cast<uint2*>(p.H() + (size_t)(row + 1) * 1024 + col) = w;
    }
  }
}

struct EpiGlu {
  static constexpr bool PERM = true, AFTER_DRAIN = false;
  const bf16_t* Y; bf16_t* Zg;
  DI void operator()(const pg8::f32x4 (&acc)[2][2][4][2], const pg8::Unit& u, int wr, int wc, int fr, int fq) const {
    const int row0 = u.pm * 256 + wr * 64 + fr, col0 = u.pn * 256 + wc * 32 + 8 * fq;
#pragma unroll
    for (int ai = 0; ai < 2; ++ai)
#pragma unroll
      for (int mh = 0; mh < 2; ++mh) {
        uint4 yv[4], gv[4];
#pragma unroll
        for (int q = 0; q < 4; ++q) {
          const int m = mh * 2 + (q >> 1), bj = q & 1;
          const int row = row0 + ai * 128 + m * 16, col = col0 + bj * 128;
          yv[q] = *reinterpret_cast<const uint4*>(Y + (size_t)row * 512 + col);
          gv[q] = *reinterpret_cast<const uint4*>(Zg + (size_t)row * LDZ + col);
        }
#pragma unroll
        for (int q = 0; q < 4; ++q) {
          const int m = mh * 2 + (q >> 1), bj = q & 1;
          const int row = row0 + ai * 128 + m * 16, col = col0 + bj * 128;
          const pg8::f32x4 a0 = acc[ai][bj][m][0], a1 = acc[ai][bj][m][1];
          uint4 w;
          w.x = pk2(lo_bf(yv[q].x) * sigmoidf_(a0[0]) * siluf_(lo_bf(gv[q].x)), hi_bf(yv[q].x) * sigmoidf_(a0[1]) * siluf_(hi_bf(gv[q].x)));
          w.y = pk2(lo_bf(yv[q].y) * sigmoidf_(a0[2]) * siluf_(lo_bf(gv[q].y)), hi_bf(yv[q].y) * sigmoidf_(a0[3]) * siluf_(hi_bf(gv[q].y)));
          w.z = pk2(lo_bf(yv[q].z) * sigmoidf_(a1[0]) * siluf_(lo_bf(gv[q].z)), hi_bf(yv[q].z) * sigmoidf_(a1[1]) * siluf_(hi_bf(gv[q].z)));
          w.w = pk2(lo_bf(yv[q].w) * sigmoidf_(a1[2]) * siluf_(lo_bf(gv[q].w)), hi_bf(yv[q].w) * sigmoidf_(a1[3]) * siluf_(hi_bf(gv[q].w)));
          *reinterpret_cast<uint4*>(Zg + (size_t)row * LDZ + col) = w;
        }
        asm volatile("" ::: "memory");
      }
  }
};
struct EpiOutRes {
  static constexpr bool PERM = false, AFTER_DRAIN = false;
  const float* src; float* dst; const float* gate;
  DI void operator()(const pg8::f32x4 (&acc)[2][2][4][2], const pg8::Unit& u, int wr, int wc, int fr, int fq) const {
    const int row0 = u.pm * 256 + wr * 64 + fr, col0 = u.pn * 256 + wc * 32 + 4 * fq;
    pg8::f32x4 gv[2][2];
#pragma unroll
    for (int bj = 0; bj < 2; ++bj)
#pragma unroll
      for (int n = 0; n < 2; ++n) gv[bj][n] = *reinterpret_cast<const pg8::f32x4*>(gate + col0 + bj * 128 + n * 16);
#pragma unroll
    for (int ai = 0; ai < 2; ++ai)
#pragma unroll
      for (int mh = 0; mh < 2; ++mh) {
        pg8::f32x4 xv[8];
#pragma unroll
        for (int q = 0; q < 8; ++q) {
          const int m = mh * 2 + (q >> 2), bj = (q >> 1) & 1, n = q & 1;
          xv[q] = *reinterpret_cast<const pg8::f32x4*>(src + (size_t)(row0 + ai * 128 + m * 16) * 1024 + col0 + bj * 128 + n * 16);
        }
#pragma unroll
        for (int q = 0; q < 8; ++q) {
          const int m = mh * 2 + (q >> 2), bj = (q >> 1) & 1, n = q & 1;
          *reinterpret_cast<pg8::f32x4*>(dst + (size_t)(row0 + ai * 128 + m * 16) * 1024 + col0 + bj * 128 + n * 16) =
              xv[q] + gv[bj][n] * acc[ai][bj][m][n];
        }
        asm volatile("" ::: "memory");
      }
  }
};

#define LDS3(ptr) ((__attribute__((address_space(3))) unsigned char*)(ptr))

typedef unsigned u32x4_t __attribute__((ext_vector_type(4)));
typedef unsigned u32x2_t __attribute__((ext_vector_type(2)));
struct EpiP1 {
  static constexpr bool PERM = true, AFTER_DRAIN = false;
  bf16_t* Zp; bf16_t* SGp;
  DI void operator()(const pg8::f32x4 (&acc)[2][2][4][2], const pg8::Unit& u, int wr, int wc, int fr, int fq) const {
    const int row0 = u.pm * 256 + wr * 64 + fr;
    const int colt = u.pn * 256;
    const int col0 = wc * 32 + 8 * fq;
    if (colt < LDZ) {
#pragma unroll
      for (int ai = 0; ai < 2; ++ai)
#pragma unroll
        for (int m = 0; m < 4; ++m) {
          bf16_t* rowp = Zp + (size_t)(row0 + ai * 128 + m * 16) * LDZ + colt + col0;
#pragma unroll
          for (int bj = 0; bj < 2; ++bj) {
            const pg8::f32x4 v0 = acc[ai][bj][m][0], v1 = acc[ai][bj][m][1];
            u32x4_t w4 = {pk2(v0[0], v0[1]), pk2(v0[2], v0[3]), pk2(v1[0], v1[1]), pk2(v1[2], v1[3])};
            __builtin_nontemporal_store(w4, reinterpret_cast<u32x4_t*>(rowp + bj * 128));
          }
        }
    } else {
      const int gcol0 = colt - LDZ + col0;
#pragma unroll
      for (int ai = 0; ai < 2; ++ai)
#pragma unroll
        for (int m = 0; m < 4; ++m) {
          const int row = row0 + ai * 128 + m * 16;
#pragma unroll
          for (int bj = 0; bj < 2; ++bj) {
            const pg8::f32x4 v0 = acc[ai][bj][m][0], v1 = acc[ai][bj][m][1];
            u32x2_t w0v = {pk2(sigmoidf_(v0[0]), sigmoidf_(v0[1])), pk2(sigmoidf_(v0[2]), sigmoidf_(v0[3]))};
            u32x2_t w1v = {pk2(sigmoidf_(v1[0]), sigmoidf_(v1[1])), pk2(sigmoidf_(v1[2]), sigmoidf_(v1[3]))};
            bf16_t* q0 = SGp + sg_index(row, gcol0 + bj * 128);
            __builtin_nontemporal_store(w0v, reinterpret_cast<u32x2_t*>(q0));
            __builtin_nontemporal_store(w1v, reinterpret_cast<u32x2_t*>(q0 + 128));
          }
        }
    }
  }
};
constexpr int P1_UNITS_Z = 65 * 25, P1_UNITS_ALL = 65 * 41, P1_UNITS_MAIN = 2560, GLU_UNITS = 65 * 2;
struct P1Order {
  int lo, hi, G, c;
  DI static void map_unit(int wgid, int nM, int nN, pg8::Unit& u) {
    const int nwg = nM * nN;
    { const int q = nwg / pg8::NXCD, r = nwg % pg8::NXCD, xcd = wgid % pg8::NXCD, off = wgid / pg8::NXCD;
      wgid = (xcd < r ? xcd * (q + 1) : r * (q + 1) + (xcd - r) * q) + off; }
    const int nig = pg8::WGM * nN, gid = wgid / nig, fm = gid * pg8::WGM, gsz = (nM - fm) < pg8::WGM ? (nM - fm) : pg8::WGM;
    u.pm = fm + ((wgid % nig) % gsz); u.pn = (wgid % nig) / gsz;
  }
  DI bool next(int i, pg8::Unit& u) const {
    const int idx = lo + i * G + c;
    if (idx >= hi) return false;
    if (idx < P1_UNITS_Z) map_unit(idx, 65, 25, u);
    else { map_unit(idx - P1_UNITS_Z, 65, 16, u); u.pn += 25; }
    return true;
  }
  DI void a_ready(const pg8::Unit&) const {}
  DI void done(const pg8::Unit&) const {}
  DI int lda(const pg8::Gemm& g) const { return g.K; }
  DI const char* abase(const pg8::Gemm& g, const pg8::Unit& u) const { return (const char*)g.A + (size_t)u.pm * (size_t)pg8::BM * g.K * 2; }
  DI const char* bbase(const pg8::Gemm& g, const pg8::Unit& u) const { return (const char*)g.Bt + (size_t)u.pn * (size_t)pg8::BM * g.K * 2; }
};
DI bool p1_deferral() { return gridDim.x >= (unsigned)(GLU_UNITS + (P1_UNITS_ALL - P1_UNITS_MAIN)); }
DI void phase_p1(const Params& p, int b, int L, unsigned char* smraw) {
  P1Order S{0, p1_deferral() ? P1_UNITS_MAIN : P1_UNITS_ALL, (int)gridDim.x, (int)blockIdx.x};
  pg8::Gemm g{p.H(), p.WinT() + (size_t)L * 10496 * 1024, R, 10496, 1024};
  EpiP1 E{p.Z(), p.SG()};
  pg8::gemm_phase<EpiP1, P1Order, false>(LDS3(smraw), g, S, E, nullptr);
}

DI void post_item(const Params& p, int L, int rb, int slot, int lane) {
  int col; const float* gvec = nullptr; float mult = 1.f; bool rope = false; bf16_t* vt = nullptr;
  const bool latent = (rb * 64) < NLAT;
  if (slot < 8) { col = C_NQ + slot * 64; gvec = p.na_q_g + L * 64; mult = 0.125f * LOG2E; }
  else if (slot < 16) { col = C_NK + (slot - 8) * 64; gvec = p.na_k_g + L * 64; }
  else if (slot < 24) { col = C_GQ + (slot - 16) * 64; gvec = p.gqa_q_g + L * 64; mult = 0.125f * LOG2E; rope = latent; }
  else if (slot < 26) { col = C_GK + (slot - 24) * 64; gvec = p.gqa_k_g + L * 64; rope = latent; }
  else if (slot < 34) { col = C_NV + (slot - 26) * 64; vt = p.VtN() + (size_t)((slot - 26) * 64) * LDT; }
  else { col = C_GV + (slot - 34) * 64; vt = p.VtG() + (size_t)((slot - 34) * 64) * LDT; }
  if (vt) {
    const int row = rb * 64 + lane;
    const bf16_t* zp = p.Z() + (size_t)row * LDZ + col;
    uint4 raw[8];
#pragma unroll
    for (int j = 0; j < 8; ++j) raw[j] = *reinterpret_cast<const uint4*>(zp + j * 8);
    const int prow = (row & ~12) | ((row & 4) << 1) | ((row & 8) >> 1);
#pragma unroll
    for (int j = 0; j < 8; ++j) {
      const unsigned w[4] = {raw[j].x, raw[j].y, raw[j].z, raw[j].w};
#pragma unroll
      for (int q = 0; q < 4; ++q) {
        vt[(size_t)(j * 8 + q * 2) * LDT + prow] = (bf16_t)(w[q] & 0xffffu);
        vt[(size_t)(j * 8 + q * 2 + 1) * LDT + prow] = (bf16_t)(w[q] >> 16);
      }
    }
    return;
  }
  const int c = lane & 7, rsub = lane >> 3;
  float gv[8];
#pragma unroll
  for (int e = 0; e < 8; ++e) gv[e] = gvec[c * 8 + e] * mult;
  uint4 rawv[8];
#pragma unroll
  for (int ps = 0; ps < 8; ++ps)
    rawv[ps] = *reinterpret_cast<const uint4*>(p.Z() + (size_t)(rb * 64 + ps * 8 + rsub) * LDZ + col + c * 8);
#pragma unroll
  for (int ps = 0; ps < 8; ++ps) {
    const int row = rb * 64 + ps * 8 + rsub;
    bf16_t* zp = p.Z() + (size_t)row * LDZ + col + c * 8;
    const uint4 raw = rawv[ps];
    float x[8] = {lo_bf(raw.x), hi_bf(raw.x), lo_bf(raw.y), hi_bf(raw.y), lo_bf(raw.z), hi_bf(raw.z), lo_bf(raw.w), hi_bf(raw.w)};
    float ss = 0.f;
#pragma unroll
    for (int e = 0; e < 8; ++e) ss += x[e] * x[e];
    ss += __shfl_xor(ss, 1);
    ss += __shfl_xor(ss, 2);
    ss += __shfl_xor(ss, 4);
    const float rs = rsqrtf(ss * (1.f / 64.f) + 1e-6f);
#pragma unroll
    for (int e = 0; e < 8; ++e) x[e] = x[e] * rs * gv[e];
    if (rope) {
      const int pos = ((c & 3) < 2) ? (row >> 6) : (row & 63);
      const float* rt = p.ROPE() + (size_t)pos * 32 + ((c & 1) * 8) * 2;
#pragma unroll
      for (int e = 0; e < 8; ++e) {
        const float other = __shfl_xor(x[e], 4);
        const float cs = rt[e * 2], sn = rt[e * 2 + 1];
        x[e] = (c < 4) ? (x[e] * cs - other * sn) : (x[e] * cs + other * sn);
      }
    }
    uint4 w;
    w.x = pk2(x[0], x[1]); w.y = pk2(x[2], x[3]); w.z = pk2(x[4], x[5]); w.w = pk2(x[6], x[7]);
    *reinterpret_cast<uint4*>(zp) = w;
  }
}

DI void phase_s5e_conv_post(const Params& p, int b, int L, bf16_t* sm, int tid) {
  {
    VSUB_SETUP
    constexpr int NT_E = 32 * 9 * 2;
    const int nit = (NT_E + vgrid - 1) / vgrid;
    for (int it = 0; it < nit; ++it) {
      int item = it * vgrid + vb;
      const bool act = item < NT_E;
      if (!act) item = NT_E - 1;
      const int g = item / 18, rem = item % 18, mt = rem >> 1, nt = rem & 1;
      const int m0 = mt * 128, n0 = nt * 128;
      f32x16 acc[2][2];
      zero_acc<2>(acc);
      const bf16_t* Ub = p.Z() + C_S5U + g * 16;
      gemm_main<2>(acc, Ub + (size_t)m0 * 16 * LDZ, 16 * LDZ, ((vt & 7) >> 1) * LDZ + (vt & 1) * 8, 4 * LDZ,
                   p.S5We() + (size_t)(L * 32 + g) * 65536 + (size_t)n0 * 256, 256, 256, smv, vt, act);
      if (act) {
#pragma unroll
        for (int mi = 0; mi < 2; ++mi)
#pragma unroll
          for (int ni = 0; ni < 2; ++ni)
#pragma unroll
            for (int i = 0; i < 16; ++i) {
              int m = m0 + wm * 64 + mi * 32 + crow(i, h);
              int n = n0 + wn * 64 + ni * 32 + r;
              if (m < NCH) p.E()[((size_t)m * 32 + g) * 256 + n] = acc[mi][ni][i];
            }
      }
    }
  }
  constexpr int NT_C = R * 64 / 512;
  constexpr int NT_P = 260 * 36 / 8;
  for (int item = blockIdx.x; item < NT_C; item += 2 * gridDim.x) {
    uint4 cv[2][3], cc[2][3], cb[2], cgt[2];
    int rowv[2], chv[2];
    bool val[2];
#pragma unroll
    for (int u = 0; u < 2; ++u) {
      const int it2 = item + u * gridDim.x;
      val[u] = it2 < NT_C;
      const int idx = (val[u] ? it2 : item) * 512 + tid;
      const int row = idx >> 6, ch = (idx & 63) * 8;
      rowv[u] = row; chv[u] = ch;
      const int lo = (row < NLAT) ? 0 : NLAT, hi = (row < NLAT) ? (NLAT - 1) : (R - 1);
#pragma unroll
      for (int t = 0; t < 3; ++t) {
        int rr = row + t - 1;
        if (rr >= lo && rr <= hi) {
          cv[u][t] = *reinterpret_cast<const uint4*>(p.Z() + (size_t)rr * LDZ + C_CV + ch);
          cc[u][t] = *reinterpret_cast<const uint4*>(p.Z() + (size_t)rr * LDZ + C_CC + ch);
        } else {
          cv[u][t] = make_uint4(0u, 0u, 0u, 0u);
          cc[u][t] = make_uint4(0u, 0u, 0u, 0u);
        }
      }
      cb[u] = *reinterpret_cast<const uint4*>(p.Z() + (size_t)row * LDZ + C_CB + ch);
      cgt[u] = *reinterpret_cast<const uint4*>(p.Z() + (size_t)row * LDZ + C_CG + ch);
    }
#pragma unroll
    for (int u = 0; u < 2; ++u) {
      if (!val[u]) continue;
      const int row = rowv[u], ch = chv[u];
      float zz[3][8];
#pragma unroll
      for (int t = 0; t < 3; ++t) {
        const uint4 a = cv[u][t], c2 = cc[u][t];
        zz[t][0] = lo_bf(a.x) * lo_bf(c2.x); zz[t][1] = hi_bf(a.x) * hi_bf(c2.x);
        zz[t][2] = lo_bf(a.y) * lo_bf(c2.y); zz[t][3] = hi_bf(a.y) * hi_bf(c2.y);
        zz[t][4] = lo_bf(a.z) * lo_bf(c2.z); zz[t][5] = hi_bf(a.z) * hi_bf(c2.z);
        zz[t][6] = lo_bf(a.w) * lo_bf(c2.w); zz[t][7] = hi_bf(a.w) * hi_bf(c2.w);
      }
      const uint4 b4 = cb[u], g4 = cgt[u];
      float bv[8] = {lo_bf(b4.x), hi_bf(b4.x), lo_bf(b4.y), hi_bf(b4.y), lo_bf(b4.z), hi_bf(b4.z), lo_bf(b4.w), hi_bf(b4.w)};
      float gv[8] = {lo_bf(g4.x), hi_bf(g4.x), lo_bf(g4.y), hi_bf(g4.y), lo_bf(g4.z), hi_bf(g4.z), lo_bf(g4.w), hi_bf(g4.w)};
      float o[8];
#pragma unroll
      for (int j = 0; j < 8; ++j) {
        float y = p.conv_b[L * 512 + ch + j] + zz[0][j] * p.conv_w[(L * 3 + 0) * 512 + ch + j] +
                  zz[1][j] * p.conv_w[(L * 3 + 1) * 512 + ch + j] + zz[2][j] * p.conv_w[(L * 3 + 2) * 512 + ch + j];
        o[j] = bv[j] * y * siluf_(gv[j]);
      }
      uint4 w;
      w.x = pk2(o[0], o[1]); w.y = pk2(o[2], o[3]); w.z = pk2(o[4], o[5]); w.w = pk2(o[6], o[7]);
      *reinterpret_cast<uint4*>(p.Z() + (size_t)row * LDZ + C_CG + ch) = w;
    }
  }
  for (int item = blockIdx.x; item < NT_P; item += gridDim.x) {
    const int w = item * 8 + (tid >> 6);
    post_item(p, L, w / 36, w % 36, tid & 63);
  }
}

DI void phase_s5y(const Params& p, int b, int L, bf16_t* sm, int tid) {
  VSUB_SETUP
  constexpr int NT = 32 * 18;
  const int nit = (NT + vgrid - 1) / vgrid;
  for (int it = 0; it < nit; ++it) {
    int item = it * vgrid + vb;
    const bool act = item < NT;
    if (!act) item = NT - 1;
    const int g = item / 18, rem = item % 18, mt = rem >> 1, nt = rem & 1;
    const int m0 = mt * 128, n0 = nt * 128;
    f32x16 acc[2][2];
    zero_acc<2>(acc);
    const bf16_t* Ub = p.Z() + C_S5U + g * 16;
    gemm_main<2>(acc, Ub + (size_t)m0 * 16 * LDZ, 16 * LDZ, ((vt & 7) >> 1) * LDZ + (vt & 1) * 8, 4 * LDZ,
                 p.S5M() + (size_t)(L * 32 + g) * 65536 + (size_t)n0 * 256, 256, 256, smv, vt, act);
    const bf16_t* Hb = p.HIN() + g * 256;
    gemm_main<2>(acc, Hb + (size_t)m0 * 8192, 8192, (vt & 7) * 8, 64,
                 p.S5R() + (size_t)(L * 32 + g) * 65536 + (size_t)n0 * 256, 256, 256, smv, vt, act);
    if (act) {
#pragma unroll
      for (int mi = 0; mi < 2; ++mi)
#pragma unroll
        for (int ni = 0; ni < 2; ++ni)
#pragma unroll
          for (int i = 0; i < 16; ++i) {
            int m = m0 + wm * 64 + mi * 32 + crow(i, h);
            int n = n0 + wn * 64 + ni * 32 + r;
            if (m < NCH) {
              float y = acc[mi][ni][i];
              float z = 1.5957691216057308f * (y + 0.044715f * y * y * y);
              y = y * sigmoidf_(z);
              p.Y()[(size_t)(m * 16 + (n >> 4)) * 512 + g * 16 + (n & 15)] = f2bf(y);
            }
          }
    }
  }
}

DI void phase_glu(const Params& p, int b, int L, unsigned char* smraw) {
  if (p1_deferral() && blockIdx.x >= (unsigned)GLU_UNITS) {
    P1Order S{P1_UNITS_MAIN, P1_UNITS_ALL, (int)gridDim.x - GLU_UNITS, (int)blockIdx.x - GLU_UNITS};
    pg8::Gemm g{p.H(), p.WinT() + (size_t)L * 10496 * 1024, R, 10496, 1024};
    EpiP1 E{p.Z(), p.SG()};
    pg8::gemm_phase<EpiP1, P1Order, false>(LDS3(smraw), g, S, E, nullptr);
    return;
  }
  pg8::StaticOrder S;
  S.init(R, 512, gridDim.x, blockIdx.x);
  pg8::Gemm g{p.Y(), p.WgluT() + (size_t)L * 512 * 512, R, 512, 512};
  EpiGlu E{p.Y(), p.Z() + C_S5G};
  pg8::gemm_phase<EpiGlu, pg8::StaticOrder, false>(LDS3(smraw), g, S, E, nullptr);
}

DI void attn_item(const Params& p, int L, int mode, int head, int q_row0, int na_r, const float* bias_s, bf16_t* wl, int lane) {
  const int r = lane & 31, h = lane >> 5;
  int qcol, kcol, gcol;
  const bf16_t* vt;
  if (mode == 0 || mode == 2) {
    qcol = C_NQ + head * 64; kcol = C_NK + head * 64; gcol = C_NG + head * 64;
    vt = p.VtN() + (size_t)(head * 64) * LDT;
  } else {
    qcol = C_GQ + head * 64; kcol = C_GK + (head >> 2) * 64; gcol = C_GG + head * 64;
    vt = p.VtG() + (size_t)((head >> 2) * 64) * LDT;
  }
  bf16_t* Ql = wl + 4096 + lane * 8;
  {
    const bf16_t* qp = p.Z() + (size_t)(q_row0 + r) * LDZ + qcol + h * 8;
#pragma unroll
    for (int ks = 0; ks < 4; ++ks) {
      *reinterpret_cast<bf16x8*>(Ql + ks * 512) = ld16(qp + (size_t)32 * LDZ + ks * 16);
      *reinterpret_cast<bf16x8*>(Ql + 2048 + ks * 512) = ld16(qp + ks * 16);
    }
  }
  float la = 0.f, lb = 0.f;
  const float shf = p.ROPE()[8192 + L * 2 + ((mode == 0 || mode == 2) ? 0 : 1)];
  f32x16 OA0, OA1, OB0, OB1;
#pragma unroll
  for (int i = 0; i < 16; ++i) { OA0[i] = 0.f; OA1[i] = 0.f; OB0[i] = 0.f; OB1[i] = 0.f; }
  const int rs = min(max(na_r - 4, 0), 256 - 8);
  const int csA = min(max(r - 8, 0), 48), csB = min(max(r + 24, 0), 48);
  int kt_lo = 0, nband = 0;
  if (mode == 0) nband = 16;
  else if (mode == 1) {
    kt_lo = max(0, (128 - q_row0) >> 5);
    int kt_hi = min(10, (NLAT - q_row0 + 128) >> 5);
    nband = kt_hi - kt_lo;
  }
  const int ntiles = 8 + nband;
  auto tile_row = [&](int j) -> int {
    if (j < 8) return NLAT + j * 32;
    const int kt = kt_lo + j - 8;
    if (mode == 0) return (rs + (kt >> 1)) * 64 + (kt & 1) * 32;
    return q_row0 - 128 + kt * 32;
  };
  const bf16_t* kg = p.Z() + (size_t)(lane >> 3) * LDZ + kcol + (lane & 7) * 8;
  const bf16_t* vg = vt + (size_t)(lane >> 2) * LDT + (lane & 3) * 8;
  bf16_t* Kl = wl;
  bf16_t* Vl = wl + 2048;
  const int kstE = (lane >> 3) * 64 + (((lane & 7) ^ ((lane >> 4) & 7)) * 8);
  const int kstO = ((lane >> 3) + 8) * 64 + (((lane & 7) ^ (((lane >> 4) + 4) & 7)) * 8);
  const int vst0 = (lane >> 2) * 32 + (((lane & 3) ^ ((lane >> 4) & 3)) * 8);
#define KST(i) ((((i) & 1) ? kstO : kstE) + ((i) >> 1) * 1024)
#define VST(i) (vst0 + (i) * 512)
  const int krd = r * 64, ksw = (r >> 1) & 7;
  const int vrd0 = r * 32, vrd1 = (32 + r) * 32, vsw = (r >> 2) & 3;
  bf16x8 rk[4], rv[4];
  {
    const int t0r = tile_row(0);
#pragma unroll
    for (int i = 0; i < 4; ++i) {
      rk[i] = ld16(kg + (size_t)(t0r + 8 * i) * LDZ);
      rv[i] = ld16(vg + (size_t)(16 * i) * LDT + t0r);
    }
#pragma unroll
    for (int i = 0; i < 4; ++i) {
      *reinterpret_cast<bf16x8*>(Kl + KST(i)) = rk[i];
      *reinterpret_cast<bf16x8*>(Vl + VST(i)) = rv[i];
    }
  }
  for (int j = 0; j < ntiles; ++j) {
    const int krow0 = tile_row(j);
    const bool more = (j + 1 < ntiles);
    if (more) {
      const int tn = tile_row(j + 1);
#pragma unroll
      for (int i = 0; i < 4; ++i) {
        rk[i] = ld16(kg + (size_t)(tn + 8 * i) * LDZ);
        rv[i] = ld16(vg + (size_t)(16 * i) * LDT + tn);
      }
    }
    f32x16 SA, SB;
#pragma unroll
    for (int i = 0; i < 16; ++i) { SA[i] = -shf; SB[i] = -shf; }
#pragma unroll
    for (int ks = 0; ks < 4; ++ks) {
      bf16x8 kf = *reinterpret_cast<const bf16x8*>(Kl + krd + (((ks * 2 + h) ^ ksw) * 8));
      SA = MFMA32(kf, *reinterpret_cast<const bf16x8*>(Ql + 2048 + ks * 512), SA);
      SB = MFMA32(kf, *reinterpret_cast<const bf16x8*>(Ql + ks * 512), SB);
    }
    union { bf16x8 v; unsigned u[4]; } pa0, pa1, pb0, pb1;
#define SOFTMAX_TILE(S_, cs_, qoff_, lsum_, p0_, p1_)                                                      \
    {                                                                                                      \
      if (j >= 8 && mode == 0) {                                                                           \
        const int kt = j - 8;                                                                              \
        const int kcb = (kt & 1) * 32;                                                                     \
        const int di = rs + (kt >> 1) - na_r + 7;                                                          \
        const float* brow = bias_s + 64 + head * 465 + di * 31 + (kcb + 4 * h - (r + qoff_) + 15);        \
        const int t0 = kcb + 4 * h - cs_;                                                                  \
        _Pragma("unroll") for (int i = 0; i < 16; ++i) {                                                   \
          const int ci = (i & 3) + 8 * (i >> 2);                                                           \
          S_[i] = ((unsigned)(t0 + ci) < 16u) ? (S_[i] + brow[ci]) : -INFINITY;                            \
        }                                                                                                  \
      } else if (j >= 8) {                                                                                 \
        const int d0 = krow0 + 4 * h - (q_row0 + qoff_ + r);                                               \
        _Pragma("unroll") for (int i = 0; i < 16; ++i) {                                                   \
          const int df = d0 + (i & 3) + 8 * (i >> 2);                                                      \
          S_[i] = (df <= 128 && df >= -128) ? S_[i] : -INFINITY;                                           \
        }                                                                                                  \
      }                                                                                                    \
      float rsum = 0.f;                                                                                    \
      _Pragma("unroll") for (int i = 0; i < 16; ++i) {                                                     \
        float pv = __builtin_amdgcn_exp2f(S_[i]);                                                          \
        S_[i] = pv;                                                                                        \
        rsum += pv;                                                                                        \
      }                                                                                                    \
      lsum_ += rsum;                                                                                       \
      _Pragma("unroll") for (int q = 0; q < 4; ++q) {                                                      \
        p0_.u[q] = pk2(S_[2 * q], S_[2 * q + 1]);                                                          \
        p1_.u[q] = pk2(S_[8 + 2 * q], S_[8 + 2 * q + 1]);                                                  \
      }                                                                                                    \
    }
    SOFTMAX_TILE(SA, csA, 0, la, pa0, pa1)
    asm volatile("" : "+v"(pa0.u[0]), "+v"(pa0.u[1]), "+v"(pa0.u[2]), "+v"(pa0.u[3]), "+v"(pa1.u[0]), "+v"(pa1.u[1]), "+v"(pa1.u[2]), "+v"(pa1.u[3]));
    SOFTMAX_TILE(SB, csB, 32, lb, pb0, pb1)
#undef SOFTMAX_TILE
    {
      bf16x8 v00 = *reinterpret_cast<const bf16x8*>(Vl + vrd0 + (((0 + h) ^ vsw) * 8));
      bf16x8 v01 = *reinterpret_cast<const bf16x8*>(Vl + vrd0 + (((2 + h) ^ vsw) * 8));
      OA0 = MFMA32(v00, pa0.v, OA0); OB0 = MFMA32(v00, pb0.v, OB0);
      OA0 = MFMA32(v01, pa1.v, OA0); OB0 = MFMA32(v01, pb1.v, OB0);
      bf16x8 v10 = *reinterpret_cast<const bf16x8*>(Vl + vrd1 + (((0 + h) ^ vsw) * 8));
      bf16x8 v11 = *reinterpret_cast<const bf16x8*>(Vl + vrd1 + (((2 + h) ^ vsw) * 8));
      OA1 = MFMA32(v10, pa0.v, OA1); OB1 = MFMA32(v10, pb0.v, OB1);
      OA1 = MFMA32(v11, pa1.v, OA1); OB1 = MFMA32(v11, pb1.v, OB1);
    }
    if (more) {
#pragma unroll
      for (int i = 0; i < 4; ++i) {
        *reinterpret_cast<bf16x8*>(Kl + KST(i)) = rk[i];
        *reinterpret_cast<bf16x8*>(Vl + VST(i)) = rv[i];
      }
    }
  }
  float l_a = la + __shfl_xor(la, 32), l_b = lb + __shfl_xor(lb, 32);
  if (mode == 1 || mode == 3) {
    const float sk = __builtin_amdgcn_exp2f(p.gqa_sink[L * 8 + head] * LOG2E - shf);
    l_a += sk; l_b += sk;
  }
  const float inva = 1.f / l_a, invb = 1.f / l_b;
  bf16_t* gpa = p.Z() + (size_t)(q_row0 + r) * LDZ + gcol + 4 * h;
  bf16_t* gpb = gpa + (size_t)32 * LDZ;
  {
    uint2 gA0[4], gA1[4], gB0[4], gB1[4];
#pragma unroll
    for (int i4 = 0; i4 < 4; ++i4) {
      gA0[i4] = *reinterpret_cast<const uint2*>(gpa + i4 * 8);
      gA1[i4] = *reinterpret_cast<const uint2*>(gpa + 32 + i4 * 8);
      gB0[i4] = *reinterpret_cast<const uint2*>(gpb + i4 * 8);
      gB1[i4] = *reinterpret_cast<const uint2*>(gpb + 32 + i4 * 8);
    }
#define ATT_OUT(O, G, gp, inv, off)                                                                                 \
    {                                                                                                               \
      const uint2 gt = G[i4];                                                                                       \
      uint2 w;                                                                                                      \
      w.x = pk2(O[i4 * 4 + 0] * inv * siluf_(lo_bf(gt.x)), O[i4 * 4 + 1] * inv * siluf_(hi_bf(gt.x)));              \
      w.y = pk2(O[i4 * 4 + 2] * inv * siluf_(lo_bf(gt.y)), O[i4 * 4 + 3] * inv * siluf_(hi_bf(gt.y)));              \
      *reinterpret_cast<uint2*>(gp + off + i4 * 8) = w;                                                             \
    }
#pragma unroll
    for (int i4 = 0; i4 < 4; ++i4) {
      ATT_OUT(OA0, gA0, gpa, inva, 0)
      ATT_OUT(OA1, gA1, gpa, inva, 32)
      ATT_OUT(OB0, gB0, gpb, invb, 0)
      ATT_OUT(OB1, gB1, gpb, invb, 32)
    }
#undef ATT_OUT
  }
#undef KST
#undef VST
}

DI void scan_wg(const Params& p, int L, int dgi, float* sm, int tid) {
  const int lane = tid & 63, w = tid >> 6;
  const int d = dgi >> 5, g = dgi & 31;
  const int dg = (L * 2 + d) * 32 + g;
  const float ar = p.A16()[(dg * 64 + lane) * 2], ai = p.A16()[(dg * 64 + lane) * 2 + 1];
  const int off = g * 256 + d * 128 + lane * 2;
  const int s_lo = w * 130;
  auto chunk_of = [&](int s) -> int { return (d == 0) ? (s < 16 ? 1024 + s : s - 16) : (NCH - 1 - s); };
  float hr = 0.f, hi = 0.f, pr = 1.f, pi = 0.f;
  float2 e[10], en[10];
#pragma unroll
  for (int u = 0; u < 10; ++u) e[u] = *reinterpret_cast<const float2*>(p.E() + (size_t)chunk_of(s_lo + u) * 8192 + off);
  for (int s0 = 0; s0 < 130; s0 += 10) {
    const int sn = (s0 + 10 < 130) ? (s0 + 10) : s0;
#pragma unroll
    for (int u = 0; u < 10; ++u) en[u] = *reinterpret_cast<const float2*>(p.E() + (size_t)chunk_of(s_lo + sn + u) * 8192 + off);
#pragma unroll
    for (int u = 0; u < 10; ++u) {
      float nr = ar * hr - ai * hi + e[u].x, ni = ar * hi + ai * hr + e[u].y;
      hr = nr; hi = ni;
      float qr = pr * ar - pi * ai, qi = pr * ai + pi * ar;
      pr = qr; pi = qi;
    }
#pragma unroll
    for (int u = 0; u < 10; ++u) e[u] = en[u];
  }
  sm[(w * 64 + lane) * 2] = hr;
  sm[(w * 64 + lane) * 2 + 1] = hi;
  __syncthreads();
  float cr = 0.f, ci = 0.f;
  for (int v = 0; v < w; ++v) {
    float tr = sm[(v * 64 + lane) * 2], ti = sm[(v * 64 + lane) * 2 + 1];
    float nr = pr * cr - pi * ci + tr, ni = pr * ci + pi * cr + ti;
    cr = nr; ci = ni;
  }
  __syncthreads();
  hr = cr; hi = ci;
#pragma unroll
  for (int u = 0; u < 10; ++u) e[u] = *reinterpret_cast<const float2*>(p.E() + (size_t)chunk_of(s_lo + u) * 8192 + off);
  for (int s0 = 0; s0 < 130; s0 += 10) {
    const int sn = (s0 + 10 < 130) ? (s0 + 10) : s0;
#pragma unroll
    for (int u = 0; u < 10; ++u) en[u] = *reinterpret_cast<const float2*>(p.E() + (size_t)chunk_of(s_lo + sn + u) * 8192 + off);
#pragma unroll
    for (int u = 0; u < 10; ++u) {
      *reinterpret_cast<unsigned*>(p.HIN() + (size_t)chunk_of(s_lo + s0 + u) * 8192 + off) = pk2(hr, hi);
      float nr = ar * hr - ai * hi + e[u].x, ni = ar * hi + ai * hr + e[u].y;
      hr = nr; hi = ni;
    }
#pragma unroll
    for (int u = 0; u < 10; ++u) e[u] = en[u];
  }
}

DI void phase_attn_scan(const Params& p, int b, int L, float* sm, int tid) {
  const int lane = tid & 63, wid = tid >> 6;
  float* bias_s = sm + 32768;
  bf16_t* wl = reinterpret_cast<bf16_t*>(sm) + wid * 8192;
  for (int idx = tid; idx < 8 * 465; idx += 512) bias_s[64 + idx] = p.na_rel_bias[L * 8 * 465 + idx] * LOG2E;
  __syncthreads();
  constexpr int N_SCAN = 64, N_ATT = 4096 / 8;
  for (int item = blockIdx.x; item < N_SCAN; item += gridDim.x) scan_wg(p, L, item, sm + 32768 + 3840, tid);
  int lat_it = 0, ci = 0;
  for (;;) {
    int item;
    const int lat = (int)blockIdx.x + lat_it * (int)gridDim.x;
    if (lat < N_ATT) { item = lat; ++lat_it; }
    else {
      while (ci < 8 && (unsigned)((64 + ci) % gridDim.x) != blockIdx.x) ++ci;
      if (ci >= 8) break;
      item = N_ATT + ci;
      ++ci;
    }
    int mode, head, q_row0, na_r = 0;
    if (item < N_ATT) {
      const int w = item * 8 + wid;
      if (w < 2048) { mode = 0; head = w & 7; na_r = w >> 3; q_row0 = na_r * 64; }
      else { const int w2 = w - 2048; mode = 1; head = w2 & 7; q_row0 = (w2 >> 3) * 64; }
    } else {
      const int cj = item - N_ATT;
      const int w2 = (cj & 3) * 8 + wid;
      mode = (cj < 4) ? 2 : 3; head = w2 & 7; q_row0 = NLAT + (w2 >> 3) * 64;
    }
    attn_item(p, L, mode, head, q_row0, na_r, bias_s, wl, lane);
  }
  __syncthreads();
}

DI void phase_merge(const Params& p, int b, int L, bf16_t* sm, int tid) {
  VSUB_SETUP
  constexpr int NT = 128 * 8;
  const int nit = (NT + vgrid - 1) / vgrid;
  for (int it = 0; it < nit; ++it) {
    int tile = it * vgrid + vb;
    const bool act = tile < NT;
    if (!act) tile = NT - 1;
    const int mt = tile >> 3, nt = tile & 7;
    const int m0 = mt * 128, n0 = nt * 128;
    f32x16 outv[2][2];
    zero_acc<2>(outv);
    for (int kb = 0; kb < 4; ++kb) {
      f32x16 acc[2][2];
      zero_acc<2>(acc);
      const int gc = (kb == 0) ? C_S5G : (kb == 1 ? C_CG : (kb == 2 ? C_NG : C_GG));
      const bf16_t* Ab = p.Z() + (size_t)m0 * LDZ + gc;
      gemm_main<2, true, false>(acc, Ab, LDZ, (vt & 7) * 8, 64, p.WbrT() + (size_t)(L * 4 + kb) * 1024 * 512 + (size_t)n0 * 512, 512,
                         512, smv, vt, act);
      if (act) {
#pragma unroll
        for (int mi = 0; mi < 2; ++mi) {
          const bf16_t* sgp = p.SG() + sg_index(m0 + wm * 64 + mi * 32 + r, kb * 1024 + n0 + wn * 64 + 4 * h);
#pragma unroll
          for (int ni = 0; ni < 2; ++ni)
#pragma unroll
            for (int i4 = 0; i4 < 4; ++i4) {
              uint2 sv = *reinterpret_cast<const uint2*>(sgp + (ni * 8 + i4 * 2) * 128);
              outv[mi][ni][i4 * 4 + 0] += lo_bf(sv.x) * acc[mi][ni][i4 * 4 + 0];
              outv[mi][ni][i4 * 4 + 1] += hi_bf(sv.x) * acc[mi][ni][i4 * 4 + 1];
              outv[mi][ni][i4 * 4 + 2] += lo_bf(sv.y) * acc[mi][ni][i4 * 4 + 2];
              outv[mi][ni][i4 * 4 + 3] += hi_bf(sv.y) * acc[mi][ni][i4 * 4 + 3];
            }
        }
      }
    }
    if (act) {
#pragma unroll
      for (int mi = 0; mi < 2; ++mi) {
        bf16_t* op = p.MIX() + (size_t)(m0 + wm * 64 + mi * 32 + r) * 1024 + n0 + wn * 64 + 4 * h;
#pragma unroll
        for (int ni = 0; ni < 2; ++ni)
#pragma unroll
          for (int i4 = 0; i4 < 4; ++i4) {
            uint2 w;
            w.x = pk2(outv[mi][ni][i4 * 4 + 0], outv[mi][ni][i4 * 4 + 1]);
            w.y = pk2(outv[mi][ni][i4 * 4 + 2], outv[mi][ni][i4 * 4 + 3]);
            *reinterpret_cast<uint2*>(op + ni * 32 + i4 * 8) = w;
          }
      }
    }
  }
  constexpr int NTC = 2 * 16 * 4;
  const int nitc = (L == 3) ? 0 : (NTC + vgrid - 1) / vgrid;
  for (int it = 0; it < nitc; ++it) {
    int item = it * vgrid + vb;
    const bool act = item < NTC;
    if (!act) item = NTC - 1;
    const int kb = item & 3, nt = (item >> 2) & 15, mt = item >> 6;
    const int m0 = NLAT + mt * 128, n0 = nt * 64;
    f32x16 acc[2][1];
    zero_acc<1>(acc);
    const int gc = (kb == 0) ? C_S5G : (kb == 1 ? C_CG : (kb == 2 ? C_NG : C_GG));
    gemm_main<1, true>(acc, p.Z() + (size_t)m0 * LDZ + gc, LDZ, (vt & 7) * 8, 64,
                       p.WbrT() + (size_t)(L * 4 + kb) * 1024 * 512 + (size_t)n0 * 512, 512, 512, smv, vt, act);
    if (act) {
#pragma unroll
      for (int mi = 0; mi < 2; ++mi) {
        const int row = m0 + wm * 64 + mi * 32 + r;
        const bf16_t* sgp = p.SG() + sg_index(row, kb * 1024 + n0 + wn * 32 + 4 * h);
        bf16_t* op = p.PCTX() + (size_t)kb * 256 * 1024 + (size_t)(row - NLAT) * 1024 + n0 + wn * 32 + 4 * h;
#pragma unroll
        for (int i4 = 0; i4 < 4; ++i4) {
          uint2 sv = *reinterpret_cast<const uint2*>(sgp + (i4 * 2) * 128);
          uint2 w;
          w.x = pk2(lo_bf(sv.x) * acc[mi][0][i4 * 4 + 0], hi_bf(sv.x) * acc[mi][0][i4 * 4 + 1]);
          w.y = pk2(lo_bf(sv.y) * acc[mi][0][i4 * 4 + 2], hi_bf(sv.y) * acc[mi][0][i4 * 4 + 3]);
          *reinterpret_cast<uint2*>(op + i4 * 8) = w;
        }
      }
    }
  }
}

DI void phase_out(const Params& p, int b, int L, unsigned char* smraw, int tid) {
  {
    pg8::StaticOrder S;
    S.init(NLAT, 1024, gridDim.x, blockIdx.x);
    pg8::Gemm g{p.MIX(), p.WoutT() + (size_t)L * 1024 * 1024, NLAT, 1024, 1024};
    EpiOutRes E{(L == 0 ? p.x : (const float*)p.out) + (size_t)b * NLAT * 1024, p.out + (size_t)b * NLAT * 1024,
                p.MOD() + (L * 3 + b) * 3072 + 2048};
    pg8::gemm_phase<EpiOutRes, pg8::StaticOrder, false>(LDS3(smraw), g, S, E, nullptr);
  }
  if (L == 3) return;
  __syncthreads();
  bf16_t* sm = reinterpret_cast<bf16_t*>(smraw);
  VSUB_SETUP
  constexpr int NT = 2 * 8;
  const int nit = (NT + vgrid - 1) / vgrid;
  for (int it = 0; it < nit; ++it) {
    int tile = it * vgrid + vb;
    const bool act = tile < NT;
    if (!act) tile = NT - 1;
    const int mt = tile >> 3, nt = tile & 7;
    const int m0 = NLAT + mt * 128, n0 = nt * 128;
    f32x16 acc[2][2];
    zero_acc<2>(acc);
    {
      const bf16_t* Ab = p.PCTX() + (size_t)(m0 - NLAT) * 1024;
      gemm_main<2, false, false, true>(acc, Ab, 1024, (vt & 7) * 8, 64, p.WoutT() + (size_t)L * 1024 * 1024 + (size_t)n0 * 1024,
                                       1024, 1024, smv, vt, act, (size_t)256 * 1024);
    }
    if (act) {
      const float* src = (L == 0 ? p.ctx : (const float*)p.CTXS()) + ((size_t)b * 256 + (m0 - NLAT)) * 1024;
      float* dst = p.CTXS() + ((size_t)b * 256 + (m0 - NLAT)) * 1024;
      const float* gate = p.MOD() + (L * 3 + 2) * 3072 + 2048;
#pragma unroll
      for (int ni = 0; ni < 2; ++ni) {
        const int col = n0 + wn * 64 + ni * 32 + r;
        const float gt = gate[col];
#pragma unroll
        for (int mi = 0; mi < 2; ++mi) {
          float xs[16];
#pragma unroll
          for (int i = 0; i < 16; ++i) xs[i] = src[(size_t)(wm * 64 + mi * 32 + crow(i, h)) * 1024 + col];
#pragma unroll
          for (int i = 0; i < 16; ++i) dst[(size_t)(wm * 64 + mi * 32 + crow(i, h)) * 1024 + col] = xs[i] + gt * acc[mi][ni][i];
        }
      }
    }
  }
}

#define XB_TMO      128
#define XB_XCNT(j)  (256  + 64 * (j))
#define XB_XSUB(j)  (1280 + 64 * (j))
#define XB_XGEN(j)  (2304 + 64 * (j))
#define XB_TOP      3328
#define XB_TOPGEN   3392
#define XCD_BAR_WORDS 3456
#define XB_SPIN_CAP (1u << 18)
#define LAS __attribute__((address_space(3)))

__device__ __forceinline__ unsigned xb_ld(unsigned* p)              { return __hip_atomic_load(p, __ATOMIC_RELAXED, __HIP_MEMORY_SCOPE_AGENT); }
__device__ __forceinline__ unsigned xb_add(unsigned* p, unsigned v) { return __hip_atomic_fetch_add(p, v, __ATOMIC_RELAXED, __HIP_MEMORY_SCOPE_AGENT); }
__device__ __forceinline__ unsigned xb_xcc_id() { return (unsigned)__builtin_amdgcn_s_getreg((3 << 11) | 20) & 0xFu; }
#define XB_SPIN(cond, bar) do { unsigned _sp = 0; while (cond) { __builtin_amdgcn_s_sleep(1); \
    if ((++_sp & 255u) == 0u) { if (xb_ld(&(bar)[XB_TMO])) break; if (_sp > XB_SPIN_CAP) { atomicAdd(&(bar)[XB_TMO], 1u); break; } } } } while (0)

struct XcdBarrier {
    unsigned* bar; unsigned x;
    volatile LAS unsigned* st;
};

__device__ __forceinline__ XcdBarrier xcd_barrier_post(unsigned* bar, volatile LAS unsigned* st) {
    XcdBarrier b; b.bar = bar; b.x = xb_xcc_id(); b.st = st;
    if (threadIdx.x == 0) (void)xb_add(&bar[XB_XCNT(b.x)], 1u);
    return b;
}
__device__ __forceinline__ void xcd_barrier_complete(unsigned* bar, unsigned x, unsigned& nloc, unsigned& nx) {
    const unsigned G = gridDim.x * gridDim.y * gridDim.z;
    unsigned sum, cnt, mine, sp = 0u;
    for (;;) {
        sum = 0u; cnt = 0u; mine = 0u;
#pragma unroll
        for (unsigned j = 0; j < 16; ++j) { const unsigned c = xb_ld(&bar[XB_XCNT(j)]); sum += c; cnt += (c > 0u) ? 1u : 0u; mine = (j == x) ? c : mine; }
        if (sum == G) break;
        __builtin_amdgcn_s_sleep(1);
        if ((++sp & 255u) == 0u) { if (xb_ld(&bar[XB_TMO])) break; if (sp > XB_SPIN_CAP) { atomicAdd(&bar[XB_TMO], 1u); break; } }
    }
    nloc = mine > 0u ? mine : 1u; nx = cnt > 0u ? cnt : 1u;
}

__device__ __forceinline__ void xcd_barrier(const XcdBarrier& b) {
    asm volatile("s_waitcnt vmcnt(0)" ::: "memory");
    __syncthreads();
    if (threadIdx.x == 0) {
        unsigned* bar = b.bar;
        __builtin_amdgcn_s_waitcnt(0);
        unsigned nloc = b.st[0], nx = b.st[1];
        if (nloc == 0u) { xcd_barrier_complete(bar, b.x, nloc, nx); b.st[0] = nloc; b.st[1] = nx; }
        const unsigned old = xb_add(&bar[XB_XSUB(b.x)], 1u);
        const unsigned gen = old / nloc;
        if (old + 1u == (gen + 1u) * nloc) {
            __builtin_amdgcn_fence(__ATOMIC_RELEASE, "agent");
            asm volatile("s_waitcnt vmcnt(0)" ::: "memory");
            const unsigned og = xb_add(&bar[XB_TOP], 1u);
            const unsigned tg = og / nx;
            if (og + 1u == (tg + 1u) * nx) xb_add(&bar[XB_TOPGEN], 1u);
            else XB_SPIN(xb_ld(&bar[XB_TOPGEN]) == tg, bar);
            __builtin_amdgcn_fence(__ATOMIC_ACQUIRE, "agent");
            xb_add(&bar[XB_XGEN(b.x)], 1u);
            asm volatile("s_waitcnt vmcnt(0)" ::: "memory");
        } else {
            XB_SPIN(xb_ld(&bar[XB_XGEN(b.x)]) == gen, bar);
            __builtin_amdgcn_fence(__ATOMIC_ACQUIRE, "agent");
            asm volatile("s_waitcnt vmcnt(0)" ::: "memory");
        }
    }
    __syncthreads();
}


__global__ void __launch_bounds__(512, 2) mega_kernel(Params p, int ph_lo, int ph_hi) {
  __shared__ __attribute__((aligned(1024))) unsigned char smem_raw[151552];
  __shared__ uint4 xb_words;
  bf16_t* smb = reinterpret_cast<bf16_t*>(smem_raw);
  float* smf = reinterpret_cast<float*>(smem_raw);
  if (threadIdx.x == 0) xb_words = make_uint4(0u, 0u, 0u, 0u);
  __syncthreads();
  XcdBarrier xb = xcd_barrier_post(p.bar, (volatile LAS unsigned*)&xb_words);
  if (ph_hi < 0) cg::this_grid().sync();
  for (int ph = ph_lo; ph < ph_hi; ++ph) {
    int tid = threadIdx.x;
    asm volatile("" : "+v"(tid));
    if (ph == 0) {
      phase_prep(p, smf, tid);
    } else {
      const int q = ph - 1;
      const int b = q >> 5, L = (q & 31) >> 3, sub = q & 7;
      switch (sub) {
        case 0: phase_norm(p, b, L, tid); break;
        case 1: phase_p1(p, b, L, smem_raw); break;
        case 2: phase_s5e_conv_post(p, b, L, smb, tid); break;
        case 3: phase_attn_scan(p, b, L, smf, tid); break;
        case 4: phase_s5y(p, b, L, smb, tid); break;
        case 5: phase_glu(p, b, L, smem_raw); break;
        case 6: phase_merge(p, b, L, smb, tid); break;
        default: phase_out(p, b, L, smem_raw, tid); break;
      }
    }
    if (ph + 1 < ph_hi) xcd_barrier(xb);
  }
}

extern "C" void kernel_launch(void* const* d_in, const int* in_sizes, int n_in, void* d_out, int out_size, void* d_ws,
                              size_t ws_size, hipStream_t stream) {
  Params p{};
  const float** fp = reinterpret_cast<const float**>(&p);
  for (int i = 0; i < 27; ++i) fp[i] = (const float*)d_in[i];
  p.out = (float*)d_out;
  p.ws = (char*)d_ws;
  p.bar = (unsigned*)((char*)d_ws + OFF_BAR);
  if (WS_TOTAL > ws_size) {
    fprintf(stderr, "workspace too small: need %zu have %zu\n", (size_t)WS_TOTAL, ws_size);
    return;
  }
  static int grid_blocks = 0;
  if (!grid_blocks) {
    int dev = 0, cus = 0, per_cu = 0;
    (void)hipGetDevice(&dev);
    (void)hipDeviceGetAttribute(&cus, hipDeviceAttributeMultiprocessorCount, dev);
    (void)hipOccupancyMaxActiveBlocksPerMultiprocessor(&per_cu, mega_kernel, 512, 0);
    if (per_cu > 1) per_cu = 1;
    if (per_cu < 1) per_cu = 1;
    grid_blocks = cus * per_cu;
  }
  (void)hipMemsetAsync(p.bar, 0, 4096 * 4, stream);
#if MULTI_LAUNCH
  for (int ph = 0; ph < NPHASE; ++ph) {
    hipLaunchKernelGGL(mega_kernel, dim3(grid_blocks), dim3(512), 0, stream, p, ph, ph + 1);
  }
#else
  int lo = 0, hi = NPHASE;
  void* args[] = {&p, &lo, &hi};
  hipError_t e = hipLaunchCooperativeKernel((void*)mega_kernel, dim3(grid_blocks), dim3(512), args, 0, stream);
  if (e != hipSuccess) fprintf(stderr, "cooperative launch failed: %s (grid %d)\n", hipGetErrorString(e), grid_blocks);
#endif
}
```

```cpp
#include <hip/hip_runtime.h>
#include <hip/hip_cooperative_groups.h>
#include <cstdio>
namespace cg = cooperative_groups;

#ifdef ONLY
#define ONLYP(i) (ONLY == (i))
#else
#define ONLYP(i) 1
#endif
#ifndef MULTI_LAUNCH
#define MULTI_LAUNCH 0
#endif

#define DI __device__ __forceinline__
typedef unsigned short bf16_t;
typedef __attribute__((ext_vector_type(8))) short bf16x8;
typedef __attribute__((ext_vector_type(16))) float f32x16;
typedef __attribute__((ext_vector_type(2))) float f32x2;
typedef __attribute__((ext_vector_type(2))) __bf16 bfx2;
#define MFMA32(a, b, c) __builtin_amdgcn_mfma_f32_32x32x16_bf16((a), (b), (c), 0, 0, 0)

constexpr int R = 16640;
constexpr int NLAT = 16384;
constexpr int LDZ = 6400;
constexpr int LDT = 16640;
constexpr int NCH = 1040;
constexpr float LOG2E = 1.4426950408889634f;
constexpr int C_S5U = 0, C_S5G = 512, C_CV = 1024, C_CB = 1536, C_CC = 2048, C_CG = 2560, C_NQ = 3072, C_NK = 3584,
              C_NV = 4096, C_NG = 4608, C_GQ = 5120, C_GK = 5632, C_GV = 5760, C_GG = 5888;
constexpr int NPHASE = 1 + 2 * 4 * 8;

constexpr size_t al256(size_t x) { return (x + 255) & ~(size_t)255; }
constexpr size_t OFF_H = 0;
constexpr size_t OFF_Z = OFF_H + al256((size_t)R * 1024 * 2);
constexpr size_t OFF_VTN = OFF_Z + al256((size_t)R * LDZ * 2);
constexpr size_t OFF_VTG = OFF_VTN + al256((size_t)512 * LDT * 2);
constexpr size_t OFF_Y = OFF_VTG + al256((size_t)128 * LDT * 2);
constexpr size_t OFF_HIN = OFF_Y + al256((size_t)R * 512 * 2);
constexpr size_t OFF_E = OFF_HIN + al256((size_t)NCH * 8192 * 2);
constexpr size_t OFF_MIX = OFF_E;
constexpr size_t OFF_SG = OFF_E + al256((size_t)R * 1024 * 2);
constexpr size_t OFF_CTXS = OFF_SG + al256((size_t)R * 4096 * 2);
constexpr size_t OFF_WINT = OFF_CTXS + al256((size_t)512 * 1024 * 4);
constexpr size_t OFF_WBRT = OFF_WINT + al256((size_t)4 * 10496 * 1024 * 2);
constexpr size_t OFF_WOUTT = OFF_WBRT + al256((size_t)16 * 1024 * 512 * 2);
constexpr size_t OFF_WGLUT = OFF_WOUTT + al256((size_t)4 * 1024 * 1024 * 2);
constexpr size_t OFF_S5M = OFF_WGLUT + al256((size_t)4 * 512 * 512 * 2);
constexpr size_t OFF_S5WE = OFF_S5M + al256((size_t)128 * 65536 * 2);
constexpr size_t OFF_S5R = OFF_S5WE + al256((size_t)128 * 65536 * 2);
constexpr size_t OFF_A16 = OFF_S5R + al256((size_t)128 * 65536 * 2);
constexpr size_t OFF_MOD = OFF_A16 + al256((size_t)4 * 2 * 32 * 64 * 2 * 4);
constexpr size_t OFF_ROPE = OFF_MOD + al256((size_t)4 * 3 * 3072 * 4);
constexpr size_t OFF_BAR = OFF_ROPE + al256((size_t)256 * 16 * 2 * 4 + 64);
constexpr size_t OFF_PCTX = OFF_BAR + al256((size_t)4096 * 4);
constexpr size_t WS_TOTAL = OFF_PCTX + al256((size_t)4 * 256 * 1024 * 2);

struct Params {
  const float *x, *c, *ctx, *c_ctx, *norm_g, *w_ada, *b_ada, *w_in, *s5_a_re, *s5_a_im, *s5_log_dt, *s5_b_re, *s5_b_im,
      *s5_c_re, *s5_c_im, *s5_d, *s5_w_glu, *conv_w, *conv_b, *na_q_g, *na_k_g, *na_rel_bias, *gqa_q_g, *gqa_k_g, *gqa_sink,
      *w_br, *w_out;
  float* out;
  char* ws;
  unsigned* bar;
  DI bf16_t* H() const { return (bf16_t*)(ws + OFF_H); }
  DI bf16_t* Z() const { return (bf16_t*)(ws + OFF_Z); }
  DI bf16_t* VtN() const { return (bf16_t*)(ws + OFF_VTN); }
  DI bf16_t* VtG() const { return (bf16_t*)(ws + OFF_VTG); }
  DI bf16_t* Y() const { return (bf16_t*)(ws + OFF_Y); }
  DI bf16_t* MIX() const { return (bf16_t*)(ws + OFF_MIX); }
  DI bf16_t* HIN() const { return (bf16_t*)(ws + OFF_HIN); }
  DI float* E() const { return (float*)(ws + OFF_E); }
  DI float* CTXS() const { return (float*)(ws + OFF_CTXS); }
  DI bf16_t* WinT() const { return (bf16_t*)(ws + OFF_WINT); }
  DI bf16_t* SG() const { return (bf16_t*)(ws + OFF_SG); }
  DI bf16_t* PCTX() const { return (bf16_t*)(ws + OFF_PCTX); }
  DI bf16_t* WbrT() const { return (bf16_t*)(ws + OFF_WBRT); }
  DI bf16_t* WoutT() const { return (bf16_t*)(ws + OFF_WOUTT); }
  DI bf16_t* WgluT() const { return (bf16_t*)(ws + OFF_WGLUT); }
  DI bf16_t* S5M() const { return (bf16_t*)(ws + OFF_S5M); }
  DI bf16_t* S5We() const { return (bf16_t*)(ws + OFF_S5WE); }
  DI bf16_t* S5R() const { return (bf16_t*)(ws + OFF_S5R); }
  DI float* A16() const { return (float*)(ws + OFF_A16); }
  DI float* MOD() const { return (float*)(ws + OFF_MOD); }
  DI float* ROPE() const { return (float*)(ws + OFF_ROPE); }
};

DI float bf2f(bf16_t v) { return __uint_as_float(((unsigned)v) << 16); }
DI unsigned pk2(float a, float b) {
  f32x2 v = {a, b};
  bfx2 r = __builtin_convertvector(v, bfx2);
  return __builtin_bit_cast(unsigned, r);
}
DI bf16_t f2bf(float a) { return (bf16_t)(pk2(a, 0.f) & 0xffffu); }
DI float lo_bf(unsigned u) { return __uint_as_float(u << 16); }
DI float hi_bf(unsigned u) { return __uint_as_float(u & 0xffff0000u); }
DI float sigmoidf_(float x) { return 1.f / (1.f + __expf(-x)); }
DI float siluf_(float x) { return x / (1.f + __expf(-x)); }
DI size_t sg_index(int row, int col) { return ((size_t)((row >> 5) * 1024 + (col >> 2)) * 32 + (row & 31)) * 4 + (col & 3); }
DI int crow(int i, int h) { return (i & 3) + 8 * (i >> 2) + 4 * h; }
DI bf16x8 ld16(const bf16_t* p) { return *reinterpret_cast<const bf16x8*>(p); }


namespace pg8 {
typedef unsigned short bf16_t;
#define PG8_LAS __attribute__((address_space(3)))
typedef short bf16x8 __attribute__((ext_vector_type(8)));
typedef float f32x4 __attribute__((ext_vector_type(4)));
typedef unsigned u32x4 __attribute__((ext_vector_type(4)));
constexpr int BM = 256, BK = 64, HALF = 128, HTB = HALF * BK * 2  , STAGE_BYTES = 8 * HTB, NXCD = 8, WGM = 8;

__host__ __device__ __forceinline__ int lds_byte(int r, int c) { const int st = (r >> 4) * 2 + (c >> 5), rr = r & 15, cc = c & 31, ob = rr * 64 + cc * 2; return st * 1024 + (ob ^ (((ob >> 9) & 1) << 5)); }
__host__ __device__ __forceinline__ void stage_rc(int b, int& R, int& C) { const int st = b / 1024, sb = b % 1024, swz = sb ^ (((sb >> 9) & 1) << 5); R = (st >> 1) * 16 + swz / 64; C = (st & 1) * 32 + (swz % 64) / 2; }
__host__ __device__ __forceinline__ int perm32(int rho) { const int n = rho >> 4, i = rho & 15; return 8 * (i >> 2) + 4 * n + (i & 3); }

struct Unit { int pm, pn; };
struct Gemm { const bf16_t* A; const bf16_t* Bt; int M, N, K; };

struct StaticOrder {
    int nM, nN, nwg, G, c;
    __host__ __device__ void init(int M, int N, int G_, int c_) { nM = M / BM; nN = N / BM; nwg = nM * nN; G = G_; c = c_; }
    __host__ __device__ bool next(int i, Unit& u) const {
        const long L = (long)i * G + c; if (L >= nwg) return false;
        int wgid = (int)L; { const int q = nwg / NXCD, r = nwg % NXCD, xcd = wgid % NXCD, off = wgid / NXCD; wgid = (xcd < r ? xcd * (q + 1) : r * (q + 1) + (xcd - r) * q) + off; }
        const int nig = WGM * nN, gid = wgid / nig, fm = gid * WGM, gsz = (nM - fm) < WGM ? (nM - fm) : WGM;
        u.pm = fm + ((wgid % nig) % gsz); u.pn = (wgid % nig) / gsz; return true;
    }
    __device__ __forceinline__ void a_ready(const Unit&) const {}
    __device__ __forceinline__ void done(const Unit&) const {}
};
struct CountedOrder : StaticOrder {
    const unsigned* ready; unsigned need; unsigned* tmo;
    __device__ __forceinline__ void a_ready(const Unit& u) const {
        if (threadIdx.x < 64) {
            const unsigned long long t0 = __builtin_amdgcn_s_memrealtime(); unsigned polls = 0;
            while ((unsigned)__builtin_amdgcn_readfirstlane(__hip_atomic_load(ready + 64 * u.pm, __ATOMIC_RELAXED, __HIP_MEMORY_SCOPE_AGENT)) < need) {
                if ((++polls & 255u) == 0u && __builtin_amdgcn_readfirstlane(__hip_atomic_load(tmo, __ATOMIC_RELAXED, __HIP_MEMORY_SCOPE_AGENT)) != 0u) break;
                if (__builtin_amdgcn_s_memrealtime() - t0 > 2000000ull) {
                    if (threadIdx.x == 0) { unsigned expect = 0u; __hip_atomic_compare_exchange_strong(tmo + 1, &expect, 0x600u | (unsigned)(u.pm & 0xff), __ATOMIC_RELAXED, __ATOMIC_RELAXED, __HIP_MEMORY_SCOPE_AGENT); __hip_atomic_store(tmo, 1u, __ATOMIC_RELAXED, __HIP_MEMORY_SCOPE_AGENT); }
                    break; }
                __builtin_amdgcn_s_sleep(2); }
            __builtin_amdgcn_fence(__ATOMIC_ACQUIRE, "agent");
            asm volatile("s_waitcnt vmcnt(0)" ::: "memory");
        }
#if !defined(BROKEN_HOOK_NO_BARRIER)
        asm volatile("" ::: "memory"); __builtin_amdgcn_s_barrier(); asm volatile("" ::: "memory");
#endif
    }
};

__device__ __forceinline__ unsigned cvt_pk_bf16(float lo, float hi) { unsigned r; asm volatile("v_cvt_pk_bf16_f32 %0, %1, %2" : "=v"(r) : "v"(lo), "v"(hi)); return r; }
typedef float f32x2 __attribute__((ext_vector_type(2)));
__device__ __forceinline__ f32x2 gelu_pk(f32x2 v) {
    const f32x2 av = __builtin_elementwise_abs(v), d = av * 0.2316418882f + 1.0f;
    f32x2 t; t.x = __builtin_amdgcn_rcpf(d.x); t.y = __builtin_amdgcn_rcpf(d.y);
    f32x2 q = t * 0.5307027145f + (-0.7265760135f); q = q * t + 0.7107068705f; q = q * t + (-0.142248368f); q = q * t + 0.127414796f; q = q * t;
    const f32x2 s = (v * v) * (-0.72134752044f);
    f32x2 e; e.x = __builtin_amdgcn_exp2f(s.x); e.y = __builtin_amdgcn_exp2f(s.y);
    const f32x2 m = v * (q * e), r = v - m;
    f32x2 o; o.x = v.x < 0.f ? m.x : r.x; o.y = v.y < 0.f ? m.y : r.y; return o;
}

struct EpiF32 {
    static constexpr bool PERM = false, AFTER_DRAIN = false;
    float* C; int ldc; const float* bias;
    __device__ __forceinline__ void operator()(const f32x4 (&acc)[2][2][4][2], const Unit& u, int wr, int wc, int fr, int fq) const {
        const int row0 = u.pm * BM + wr * 64 + fr, col0 = u.pn * BM + wc * 32 + 4 * fq;
        f32x4 bv[2][2];
#pragma unroll
        for (int bj = 0; bj < 2; ++bj)
#pragma unroll
            for (int n = 0; n < 2; ++n) bv[bj][n] = bias ? *(const f32x4*)(bias + col0 + bj * HALF + n * 16) : (f32x4){0.f, 0.f, 0.f, 0.f};
#pragma unroll
        for (int ai = 0; ai < 2; ++ai)
#pragma unroll
            for (int m = 0; m < 4; ++m) { float* rowp = C + (size_t)(row0 + ai * HALF + m * 16) * ldc + col0;
#pragma unroll
                for (int bj = 0; bj < 2; ++bj)
#pragma unroll
                    for (int n = 0; n < 2; ++n) *(f32x4*)(rowp + bj * HALF + n * 16) = acc[ai][bj][m][n] + bv[bj][n]; }
    }
};
template <int ACT  > struct EpiBf16 {
    static constexpr bool PERM = true, AFTER_DRAIN = false;
    bf16_t* O; int ldc; const float* bias; int split_cols; size_t split_stride;
    __device__ __forceinline__ void operator()(const f32x4 (&acc)[2][2][4][2], const Unit& u, int wr, int wc, int fr, int fq) const {
        const int row0 = u.pm * BM + wr * 64 + fr; int colt = u.pn * BM; bf16_t* base = O;
        if (split_cols) { const int t = colt / split_cols; base += (size_t)t * split_stride; colt -= t * split_cols; }
        const int col0 = colt + wc * 32 + 8 * fq, bcol0 = u.pn * BM + wc * 32 + 8 * fq;
        f32x4 bv[2][2];
#pragma unroll
        for (int bj = 0; bj < 2; ++bj)
#pragma unroll
            for (int n = 0; n < 2; ++n) bv[bj][n] = bias ? *(const f32x4*)(bias + bcol0 + bj * HALF + 4 * n) : (f32x4){0.f, 0.f, 0.f, 0.f};
#pragma unroll
        for (int ai = 0; ai < 2; ++ai)
#pragma unroll
            for (int m = 0; m < 4; ++m) { bf16_t* rowp = base + (size_t)(row0 + ai * HALF + m * 16) * ldc + col0;
#pragma unroll
                for (int bj = 0; bj < 2; ++bj) { f32x4 v0 = acc[ai][bj][m][0] + bv[bj][0], v1 = acc[ai][bj][m][1] + bv[bj][1];
                    if (ACT == 1) { f32x2 a = gelu_pk((f32x2){v0[0], v0[1]}), b = gelu_pk((f32x2){v0[2], v0[3]}), c = gelu_pk((f32x2){v1[0], v1[1]}), d = gelu_pk((f32x2){v1[2], v1[3]});
                        v0 = (f32x4){a.x, a.y, b.x, b.y}; v1 = (f32x4){c.x, c.y, d.x, d.y}; }
                    if (ACT == 2) {
#pragma unroll
                        for (int j = 0; j < 4; ++j) { v0[j] = 0.5f * v0[j] * (1.0f + erff(v0[j] * 0.70710678f)); v1[j] = 0.5f * v1[j] * (1.0f + erff(v1[j] * 0.70710678f)); } }
                    u32x4 w; w.x = cvt_pk_bf16(v0[0], v0[1]); w.y = cvt_pk_bf16(v0[2], v0[3]); w.z = cvt_pk_bf16(v1[0], v1[1]); w.w = cvt_pk_bf16(v1[2], v1[3]);
                    *(u32x4*)(rowp + bj * HALF) = w; } }
    }
};

struct PanelStats {
    unsigned* xbuf;
    unsigned* cnt;
    unsigned* tmo;
    int ntn; float eps;
    unsigned code;
    __device__ __forceinline__ bool run(const f32x4 (&v)[2][2][4][2], const Unit& u, int wr, int wc, int fr, int fq, PG8_LAS unsigned char* lds, int wid, int lane) const {
        typedef float f32x2v __attribute__((ext_vector_type(2)));
        PG8_LAS f32x2v* P = (PG8_LAS f32x2v*)lds;
        PG8_LAS f32x2v* S = (PG8_LAS f32x2v*)(lds + 8192);
        PG8_LAS unsigned* flag = (PG8_LAS unsigned*)(lds + 8192 + 2048);
#pragma unroll
        for (int ai = 0; ai < 2; ++ai)
#pragma unroll
            for (int m = 0; m < 4; ++m) {
                float s = 0.f;
#pragma unroll
                for (int bj = 0; bj < 2; ++bj)
#pragma unroll
                    for (int n = 0; n < 2; ++n) { const f32x4 x = v[ai][bj][m][n]; s += (x[0] + x[1]) + (x[2] + x[3]); }
                s += __shfl_xor(s, 16); s += __shfl_xor(s, 32);
                const float mw = s * (1.0f / 64.0f); float q = 0.f;
#pragma unroll
                for (int bj = 0; bj < 2; ++bj)
#pragma unroll
                    for (int n = 0; n < 2; ++n) { const f32x4 d = v[ai][bj][m][n] - mw; q += (d[0] * d[0] + d[1] * d[1]) + (d[2] * d[2] + d[3] * d[3]); }
                q += __shfl_xor(q, 16); q += __shfl_xor(q, 32);
                if (fq == 0) P[(ai * HALF + wr * 64 + m * 16 + fr) * 4 + wc] = (f32x2v){mw, q};
            }
        asm volatile("s_waitcnt lgkmcnt(0)" ::: "memory"); __builtin_amdgcn_s_barrier(); asm volatile("" ::: "memory");
#if defined(BROKEN_NO_WAIT)
        if (blockIdx.x >= 64) { const long long t0 = clock64(); while (clock64() - t0 < 60000) __builtin_amdgcn_s_sleep(8); }
#endif
        const int row = wid * 32 + (lane & 31);
        if (lane < 32) {
            const f32x2v a = P[row * 4 + 0], b = P[row * 4 + 1], c = P[row * 4 + 2], d = P[row * 4 + 3];
            const float mt = (a.x + b.x + c.x + d.x) * 0.25f;
            const float da = a.x - mt, db = b.x - mt, dc = c.x - mt, dd = d.x - mt;
            const float m2 = (a.y + b.y) + (c.y + d.y) + 64.0f * ((da * da + db * db) + (dc * dc + dd * dd));
            unsigned long long* slot = (unsigned long long*)xbuf + ((size_t)(u.pm * BM + row) * 4 + u.pn);
            __hip_atomic_store(slot, ((unsigned long long)__float_as_uint(m2) << 32) | __float_as_uint(mt), __ATOMIC_RELAXED, __HIP_MEMORY_SCOPE_AGENT);
        }
        asm volatile("s_waitcnt vmcnt(0)" ::: "memory");
        if (lane == 0) __hip_atomic_fetch_add(cnt + 64 * u.pm, 1u, __ATOMIC_RELAXED, __HIP_MEMORY_SCOPE_AGENT);
        if (wid == 0) {
            bool dead = false; const unsigned long long t0 = __builtin_amdgcn_s_memrealtime(); const unsigned want = 8u * (unsigned)ntn;
            for (;;) {
#if defined(BROKEN_NO_WAIT)
                break;
#endif
                if ((unsigned)__builtin_amdgcn_readfirstlane(__hip_atomic_load(cnt + 64 * u.pm, __ATOMIC_RELAXED, __HIP_MEMORY_SCOPE_AGENT)) >= want) break;
                if (__builtin_amdgcn_s_memrealtime() - t0 > 2000000ull) {
                    if (lane == 0) { unsigned expect = 0u; __hip_atomic_compare_exchange_strong(tmo + 1, &expect, code | (unsigned)(u.pm & 0xff), __ATOMIC_RELAXED, __ATOMIC_RELAXED, __HIP_MEMORY_SCOPE_AGENT);
                                     __hip_atomic_store(tmo, 1u, __ATOMIC_RELAXED, __HIP_MEMORY_SCOPE_AGENT); }
                    dead = true; break; }
                __builtin_amdgcn_s_sleep(2);
            }
            __builtin_amdgcn_fence(__ATOMIC_ACQUIRE, "agent");
            if (lane == 0) flag[0] = dead ? 1u : 0u;
        }
        asm volatile("s_waitcnt vmcnt(0) lgkmcnt(0)" ::: "memory"); __builtin_amdgcn_s_barrier(); asm volatile("" ::: "memory");
        const bool bad = flag[0] != 0u;
        if (lane < 32) {
            const unsigned long long* slot = (const unsigned long long*)xbuf + (size_t)(u.pm * BM + row) * 4; float mt[4], m2[4]; float ms = 0.f;
#pragma unroll
            for (int t = 0; t < 4; ++t) { if (t < ntn) { const unsigned long long w = __hip_atomic_load(slot + t, __ATOMIC_RELAXED, __HIP_MEMORY_SCOPE_AGENT); mt[t] = __uint_as_float((unsigned)w); m2[t] = __uint_as_float((unsigned)(w >> 32)); } else { mt[t] = 0.f; m2[t] = 0.f; } ms += mt[t]; }
            const float mean = ms / (float)ntn; float q = 0.f;
#pragma unroll
            for (int t = 0; t < 4; ++t) if (t < ntn) { const float dm = mt[t] - mean; q += m2[t] + 256.0f * dm * dm; }
            S[row] = (f32x2v){mean, 1.0f / sqrtf(q / (256.0f * (float)ntn) + eps)};
        }
        asm volatile("s_waitcnt lgkmcnt(0)" ::: "memory"); __builtin_amdgcn_s_barrier(); asm volatile("" ::: "memory");
        return bad;
    }
};
struct EpiLnRes {
    static constexpr bool PERM = false, AFTER_DRAIN = true;
    const float* base; float* out; int ldc; const float* bias; PanelStats st; unsigned poison;
    __device__ __forceinline__ void refuse(size_t i0, size_t stride, int M, int N) const { const float q = __builtin_nanf(""); for (size_t i = i0; i < (size_t)M * N; i += stride) out[(i / N) * ldc + i % N] = q;
        if (i0 == 0) { unsigned expect = 0u; __hip_atomic_compare_exchange_strong(st.tmo + 1, &expect, 0x7f0u, __ATOMIC_RELAXED, __ATOMIC_RELAXED, __HIP_MEMORY_SCOPE_AGENT); __hip_atomic_store(st.tmo, 1u, __ATOMIC_RELAXED, __HIP_MEMORY_SCOPE_AGENT); } }
    __device__ __forceinline__ void fused(f32x4 (&acc)[2][2][4][2], const Unit& u, int wr, int wc, int fr, int fq, PG8_LAS unsigned char* lds, int wid, int lane) const {
        typedef float f32x2v __attribute__((ext_vector_type(2)));
        const PG8_LAS f32x2v* S = (const PG8_LAS f32x2v*)(lds + 8192);
        const int col0 = u.pn * BM + wc * 32 + 4 * fq;
#pragma unroll
        for (int bj = 0; bj < 2; ++bj)
#pragma unroll
            for (int n = 0; n < 2; ++n) { const f32x4 bv = bias ? *(const f32x4*)(bias + col0 + bj * HALF + n * 16) : (f32x4){0.f, 0.f, 0.f, 0.f};
#pragma unroll
                for (int ai = 0; ai < 2; ++ai)
#pragma unroll
                    for (int m = 0; m < 4; ++m) acc[ai][bj][m][n] += bv; }
        const bool bad = st.run(acc, u, wr, wc, fr, fq, lds, wid, lane) || poison != 0u;
        const float qnan = __builtin_nanf("");
#pragma unroll
        for (int ai = 0; ai < 2; ++ai)
#pragma unroll
            for (int m = 0; m < 4; ++m) { const int r = ai * HALF + wr * 64 + m * 16 + fr; const f32x2v sr = S[r]; const size_t off = (size_t)(u.pm * BM + r) * ldc + col0;
#pragma unroll
                for (int bj = 0; bj < 2; ++bj)
#pragma unroll
                    for (int n = 0; n < 2; ++n) { const f32x4 bs = *(const f32x4*)(base + off + bj * HALF + n * 16); f32x4 o = bs + (acc[ai][bj][m][n] - sr.x) * sr.y;
                        if (bad) o = (f32x4){qnan, qnan, qnan, qnan}; *(f32x4*)(out + off + bj * HALF + n * 16) = o; }
                asm volatile("" ::: "memory"); }
    }
};
struct EpiLnResLn {
    static constexpr bool PERM = false, AFTER_DRAIN = true;
    const float* base; float* out; bf16_t* xn; int ldc; const float* bias; PanelStats st1, st2; unsigned poison;
    __device__ __forceinline__ void refuse(size_t i0, size_t stride, int M, int N) const { const float q = __builtin_nanf(""); for (size_t i = i0; i < (size_t)M * N; i += stride) { const size_t o = (i / N) * ldc + i % N; out[o] = q; xn[o] = (bf16_t)0x7fc0u; }
        if (i0 == 0) { unsigned expect = 0u; __hip_atomic_compare_exchange_strong(st1.tmo + 1, &expect, 0x7f0u, __ATOMIC_RELAXED, __ATOMIC_RELAXED, __HIP_MEMORY_SCOPE_AGENT); __hip_atomic_store(st1.tmo, 1u, __ATOMIC_RELAXED, __HIP_MEMORY_SCOPE_AGENT); } }
    __device__ __forceinline__ void fused(f32x4 (&acc)[2][2][4][2], const Unit& u, int wr, int wc, int fr, int fq, PG8_LAS unsigned char* lds, int wid, int lane) const {
        typedef float f32x2v __attribute__((ext_vector_type(2))); typedef unsigned u32x2v __attribute__((ext_vector_type(2)));
        const PG8_LAS f32x2v* S = (const PG8_LAS f32x2v*)(lds + 8192);
        const int col0 = u.pn * BM + wc * 32 + 4 * fq;
#pragma unroll
        for (int bj = 0; bj < 2; ++bj)
#pragma unroll
            for (int n = 0; n < 2; ++n) { const f32x4 bv = bias ? *(const f32x4*)(bias + col0 + bj * HALF + n * 16) : (f32x4){0.f, 0.f, 0.f, 0.f};
#pragma unroll
                for (int ai = 0; ai < 2; ++ai)
#pragma unroll
                    for (int m = 0; m < 4; ++m) acc[ai][bj][m][n] += bv; }
        bool bad = st1.run(acc, u, wr, wc, fr, fq, lds, wid, lane) || poison != 0u;
        const float qnan = __builtin_nanf("");
#pragma unroll
        for (int ai = 0; ai < 2; ++ai)
#pragma unroll
            for (int m = 0; m < 4; ++m) { const int r = ai * HALF + wr * 64 + m * 16 + fr; const f32x2v sr = S[r]; const size_t off = (size_t)(u.pm * BM + r) * ldc + col0;
#pragma unroll
                for (int bj = 0; bj < 2; ++bj)
#pragma unroll
                    for (int n = 0; n < 2; ++n) { const f32x4 bs = *(const f32x4*)(base + off + bj * HALF + n * 16); acc[ai][bj][m][n] = bs + (acc[ai][bj][m][n] - sr.x) * sr.y; }
                asm volatile("" : "+v"(acc[ai][0][m][0]), "+v"(acc[ai][0][m][1]), "+v"(acc[ai][1][m][0]), "+v"(acc[ai][1][m][1]));
                if (m & 1) asm volatile("" ::: "memory"); }
        const bool bad1 = bad;
        bad = st2.run(acc, u, wr, wc, fr, fq, lds, wid, lane) || bad;
#pragma unroll
        for (int ai = 0; ai < 2; ++ai)
#pragma unroll
            for (int m = 0; m < 4; ++m) { const int r = ai * HALF + wr * 64 + m * 16 + fr; const f32x2v sr = S[r]; const size_t off = (size_t)(u.pm * BM + r) * ldc + col0;
#pragma unroll
                for (int bj = 0; bj < 2; ++bj)
#pragma unroll
                    for (int n = 0; n < 2; ++n) { const f32x4 x1 = acc[ai][bj][m][n]; *(f32x4*)(out + off + bj * HALF + n * 16) = bad1 ? (f32x4){qnan, qnan, qnan, qnan} : x1;
                        const f32x4 o = (x1 - sr.x) * sr.y; u32x2v w; w.x = cvt_pk_bf16(o[0], o[1]); w.y = cvt_pk_bf16(o[2], o[3]);
                        if (bad) { w.x = 0x7fc07fc0u; w.y = 0x7fc07fc0u; } *(u32x2v*)(xn + off + bj * HALF + n * 16) = w; }
                asm volatile("" ::: "memory"); }
    }
};

template <class Epi, class Sched, bool STAMP = false>
__device__ __forceinline__ void gemm_phase(PG8_LAS unsigned char* lds, const Gemm g, const Sched& S, const Epi& E, unsigned long long* stamps) {
    int tid_ = threadIdx.x; asm volatile("" : "+v"(tid_)); const int tid = tid_, wid = __builtin_amdgcn_readfirstlane(tid >> 6), lane = tid & 63, wr = wid >> 2, wc = wid & 3, fr = lane & 15, fq = lane >> 4;
    const int K = g.K, nt = K / BK;
    int ts_lo = 0, ts_hi = 0, nts = 0; const unsigned long long rt_entry = STAMP ? (unsigned long long)wall_clock64() : 0ull;
#define PG8_STAMP() do { if (STAMP && wid == 0 && nts < 64) { const unsigned long long _c = (unsigned long long)clock64(); \
        ts_lo = (lane == nts) ? (int)(unsigned)_c : ts_lo; ts_hi = (lane == nts) ? (int)(unsigned)(_c >> 32) : ts_hi; ++nts; } } while (0)
    PG8_STAMP();
    unsigned voffA[2], voffB[2];
#pragma unroll
    for (int i = 0; i < 2; ++i) { int R, C; stage_rc(tid * 16 + i * 8192, R, C); const int Rb = Epi::PERM ? ((R & ~31) + perm32(R & 31)) : R;
        voffA[i] = (unsigned)(R * K + C) * 2u; voffB[i] = (unsigned)(Rb * K + C) * 2u; }
    const size_t kstep = (size_t)(BK * 2);
    const size_t hstep = (size_t)HALF * K * 2;
    const size_t tstep = 2 * hstep;
    const unsigned ldsw = (unsigned)wid * 1024u;
    const int aoff = lds_byte(wr * 64 + fr, fq * 8), boff = lds_byte(wc * 32 + fr, fq * 8);
#define PG8_SA(b, h) (((b) * 2 + (h)) * HTB)
#define PG8_SB(b, h) ((4 + (b) * 2 + (h)) * HTB)
#define PG8_STAGE(bufoff, gbase, voff) do { _Pragma("unroll") for (int _i = 0; _i < 2; ++_i) \
        __builtin_amdgcn_global_load_lds((const unsigned*)((const char*)(gbase) + (voff)[_i]), (PG8_LAS unsigned*)(lds + (bufoff) + ldsw + _i * 8192), 16, 0, 0); } while (0)
#define PG8_LDA(dst, b, h) do { _Pragma("unroll") for (int m = 0; m < 4; ++m) _Pragma("unroll") for (int k = 0; k < 2; ++k) dst[m][k] = *(const PG8_LAS bf16x8*)(lds + PG8_SA(b, h) + aoff + m * 2048 + k * 1024); } while (0)
#define PG8_LDB(dst, b, h) do { _Pragma("unroll") for (int n = 0; n < 2; ++n) _Pragma("unroll") for (int k = 0; k < 2; ++k) dst[n][k] = *(const PG8_LAS bf16x8*)(lds + PG8_SB(b, h) + boff + n * 2048 + k * 1024); } while (0)
#define PG8_MMA(ai, bj, At, Bt) do { __builtin_amdgcn_s_setprio(1); _Pragma("unroll") for (int m = 0; m < 4; ++m) _Pragma("unroll") for (int n = 0; n < 2; ++n) _Pragma("unroll") for (int k = 0; k < 2; ++k) \
        acc[ai][bj][m][n] = __builtin_amdgcn_mfma_f32_16x16x32_bf16(Bt[n][k], At[m][k], acc[ai][bj][m][n], 0, 0, 0); __builtin_amdgcn_s_setprio(0); } while (0)
#define PG8_WAIT_V(n) asm volatile("s_waitcnt vmcnt(" #n ")" ::: "memory")
#define PG8_WAIT_L(n) asm volatile("s_waitcnt lgkmcnt(" #n ")" ::: "memory")
#define PG8_BAR __builtin_amdgcn_s_barrier()
#define PG8_SCHED __builtin_amdgcn_sched_barrier(0)
    Unit cur, nxt; int ui = 0;
    if (!S.next(0, cur)) return;
    f32x4 acc[2][2][4][2];
#pragma unroll
    for (int a = 0; a < 2; ++a)
#pragma unroll
        for (int b = 0; b < 2; ++b)
#pragma unroll
            for (int m = 0; m < 4; ++m)
#pragma unroll
                for (int n = 0; n < 2; ++n) acc[a][b][m][n] = (f32x4){0.f, 0.f, 0.f, 0.f};
    bf16x8 At[4][2], B0[2][2], B1[2][2];
    const char* cA = (const char*)g.A + (size_t)cur.pm * tstep; const char* cB = (const char*)g.Bt + (size_t)cur.pn * tstep;
    S.a_ready(cur);
    PG8_STAGE(PG8_SB(0, 0), cB, voffB); PG8_STAGE(PG8_SA(0, 0), cA, voffA); PG8_STAGE(PG8_SB(0, 1), cB + hstep, voffB); PG8_STAGE(PG8_SA(0, 1), cA + hstep, voffA);
    if (wr == 1) PG8_BAR;
    PG8_WAIT_V(4); PG8_BAR;
    PG8_STAGE(PG8_SB(1, 0), cB + kstep, voffB); PG8_STAGE(PG8_SA(1, 0), cA + kstep, voffA); PG8_STAGE(PG8_SB(1, 1), cB + hstep + kstep, voffB);
    PG8_WAIT_V(6); PG8_BAR;
    PG8_STAMP();
    for (;;) {
        const bool has_next = S.next(ui + 1, nxt);
        const char* nA = has_next ? (const char*)g.A + (size_t)nxt.pm * tstep : cA; const char* nB = has_next ? (const char*)g.Bt + (size_t)nxt.pn * tstep : cB;
        for (int t = 0; t < nt; t += 2) {
            const bool last = (t == nt - 2);
            const char* a1 = cA + (size_t)(t + 1) * kstep;
            const char* a2 = last ? nA : cA + (size_t)(t + 2) * kstep; const char* b2 = last ? nB : cB + (size_t)(t + 2) * kstep;
            const char* a3 = a2 + kstep; const char* b3 = b2 + kstep;
            if (last && has_next) S.a_ready(nxt);
            PG8_LDB(B0, 0, 0); PG8_SCHED; PG8_LDA(At, 0, 0); PG8_STAGE(PG8_SA(1, 1), a1 + hstep, voffA);
            PG8_WAIT_L(8); PG8_BAR; PG8_WAIT_L(0); PG8_MMA(0, 0, At, B0); PG8_BAR; PG8_SCHED;
            PG8_LDB(B1, 0, 1); PG8_STAGE(PG8_SB(0, 0), b2, voffB);
            PG8_BAR; PG8_WAIT_L(0); PG8_MMA(0, 1, At, B1); PG8_BAR;
            PG8_LDA(At, 0, 1); PG8_STAGE(PG8_SA(0, 0), a2, voffA);
            PG8_BAR; PG8_WAIT_L(0); PG8_MMA(1, 0, At, B0); PG8_BAR; PG8_SCHED;
            PG8_STAGE(PG8_SB(0, 1), b2 + hstep, voffB);
            PG8_WAIT_V(6); PG8_BAR; PG8_MMA(1, 1, At, B1); PG8_BAR;
            PG8_LDB(B0, 1, 0); PG8_SCHED; PG8_LDA(At, 1, 0); PG8_STAGE(PG8_SA(0, 1), a2 + hstep, voffA);
            PG8_WAIT_L(8); PG8_BAR; PG8_WAIT_L(0); PG8_MMA(0, 0, At, B0); PG8_BAR; PG8_SCHED;
            PG8_LDB(B1, 1, 1); PG8_STAGE(PG8_SB(1, 0), b3, voffB);
            PG8_BAR; PG8_WAIT_L(0); PG8_MMA(0, 1, At, B1); PG8_BAR;
            PG8_LDA(At, 1, 1); PG8_STAGE(PG8_SA(1, 0), a3, voffA);
            PG8_BAR; PG8_WAIT_L(0); PG8_MMA(1, 0, At, B0); PG8_BAR; PG8_SCHED;
            PG8_STAGE(PG8_SB(1, 1), b3 + hstep, voffB);
            PG8_WAIT_V(6); PG8_BAR; PG8_MMA(1, 1, At, B1); PG8_BAR;
        }
        PG8_STAMP();
        if constexpr (!Epi::AFTER_DRAIN) { E(acc, cur, wr, wc, fr, fq); S.done(cur); }
        PG8_STAMP();
        if (!has_next) break;
#pragma unroll
        for (int a = 0; a < 2; ++a)
#pragma unroll
            for (int b = 0; b < 2; ++b)
#pragma unroll
                for (int m = 0; m < 4; ++m)
#pragma unroll
                    for (int n = 0; n < 2; ++n) acc[a][b][m][n] = (f32x4){0.f, 0.f, 0.f, 0.f};
        cur = nxt; cA = nA; cB = nB; ++ui;
    }
    PG8_WAIT_V(0);
    if (wr == 0) PG8_BAR;
    PG8_BAR;
    if constexpr (Epi::AFTER_DRAIN) { E.fused(acc, cur, wr, wc, fr, fq, lds, wid, lane); S.done(cur); }
    PG8_STAMP();
    if (STAMP && wid == 0) { stamps[lane] = lane < nts ? (((unsigned long long)(unsigned)ts_hi << 32) | (unsigned)ts_lo) : 0ull;
        if (lane == 62) stamps[62] = rt_entry; if (lane == 63) stamps[63] = (unsigned long long)wall_clock64(); }
#undef PG8_STAMP
#undef PG8_SA
#undef PG8_SB
#undef PG8_STAGE
#undef PG8_LDA
#undef PG8_LDB
#undef PG8_MMA
#undef PG8_WAIT_V
#undef PG8_WAIT_L
#undef PG8_BAR
#undef PG8_SCHED
}
}

DI bf16x8 ld16_sum4(const bf16_t* p, size_t slab) {
  union { bf16x8 v; unsigned u[4]; } a, b, c, d, o;
  a.v = ld16(p); b.v = ld16(p + slab); c.v = ld16(p + 2 * slab); d.v = ld16(p + 3 * slab);
#pragma unroll
  for (int i = 0; i < 4; ++i)
    o.u[i] = pk2(lo_bf(a.u[i]) + lo_bf(b.u[i]) + lo_bf(c.u[i]) + lo_bf(d.u[i]), hi_bf(a.u[i]) + hi_bf(b.u[i]) + hi_bf(c.u[i]) + hi_bf(d.u[i]));
  return o.v;
}

template <int NI, bool TR = false, bool PF2 = true, bool ASUM4 = false>
DI void gemm_main(f32x16 (&acc)[2][NI], const bf16_t* Abase, int lda, int akoff, int astep, const bf16_t* Bt, int ldb, int K,
                  bf16_t* sm, int tid, bool act, size_t aslab = 0) {
  if (!act) {
    __syncthreads();
    for (int kt = 0; kt < (K >> 6); ++kt) __syncthreads();
    return;
  }
  const int lane = tid & 63, wid = tid >> 6, wm = wid >> 1, wn = wid & 1, r = lane & 31, h = lane >> 5;
  const int lrow = tid >> 3, lkc = tid & 7;
  const int aoff0 = lrow * lda + akoff, a32 = 32 * lda;
  const int boff0 = lrow * ldb + lkc * 8, b32 = 32 * ldb;
  const int soff0 = lrow * 64 + ((lkc ^ ((lrow >> 1) & 7)) * 8);
  bf16_t* As = sm;
  bf16_t* Bs = sm + 2 * 8192;
  bf16x8 ra0[4], rb0[2 * NI], ra1[4], rb1[2 * NI];
  const int nk = K >> 6;
#define GM_LOAD(RA, RB, t)                                                                          \
  {                                                                                                 \
    const bf16_t* An_ = Abase + (size_t)(t) * astep;                                                \
    const bf16_t* Bn_ = Bt + (t) * 64;                                                              \
    _Pragma("unroll") for (int i = 0; i < 4; ++i) RA[i] = ASUM4 ? ld16_sum4(An_ + aoff0 + i * a32, aslab) : ld16(An_ + aoff0 + i * a32); \
    _Pragma("unroll") for (int i = 0; i < 2 * NI; ++i) RB[i] = ld16(Bn_ + boff0 + i * b32);         \
  }
#define GM_STORE(RA, RB, buf)                                                                       \
  {                                                                                                 \
    bf16_t* An = As + (buf) * 8192 + soff0;                                                         \
    bf16_t* Bn = Bs + (buf) * 8192 + soff0;                                                         \
    _Pragma("unroll") for (int i = 0; i < 4; ++i) *reinterpret_cast<bf16x8*>(An + i * 2048) = RA[i];        \
    _Pragma("unroll") for (int i = 0; i < 2 * NI; ++i) *reinterpret_cast<bf16x8*>(Bn + i * 2048) = RB[i];   \
  }
#define GM_COMPUTE(buf)                                                                             \
  {                                                                                                 \
    const bf16_t* Ac = As + (buf) * 8192 + ar0 * 64;                                                \
    const bf16_t* Bc = Bs + (buf) * 8192 + br0 * 64;                                                \
    _Pragma("unroll") for (int ks = 0; ks < 4; ++ks) {                                              \
      bf16x8 a[2], b[NI];                                                                           \
      _Pragma("unroll") for (int i = 0; i < 2; ++i)                                                 \
        a[i] = *reinterpret_cast<const bf16x8*>(Ac + i * 2048 + (((ks * 2 + h) ^ asw) * 8));        \
      _Pragma("unroll") for (int i = 0; i < NI; ++i)                                                \
        b[i] = *reinterpret_cast<const bf16x8*>(Bc + i * 2048 + (((ks * 2 + h) ^ bsw) * 8));        \
      _Pragma("unroll") for (int mi = 0; mi < 2; ++mi)                                              \
        _Pragma("unroll") for (int ni = 0; ni < NI; ++ni)                                           \
          acc[mi][ni] = TR ? MFMA32(b[ni], a[mi], acc[mi][ni]) : MFMA32(a[mi], b[ni], acc[mi][ni]); \
    }                                                                                               \
  }
  const int ar0 = wm * 64 + r, br0 = wn * 32 * NI + r;
  const int asw = (ar0 >> 1) & 7, bsw = (br0 >> 1) & 7;
  if (!PF2) {
    GM_LOAD(ra0, rb0, 0)
    GM_STORE(ra0, rb0, 0)
    __syncthreads();
    for (int kt = 0; kt < nk; kt += 2) {
      GM_LOAD(ra0, rb0, kt + 1)
      GM_COMPUTE(0)
      GM_STORE(ra0, rb0, 1)
      __syncthreads();
      if (kt + 2 < nk) GM_LOAD(ra0, rb0, kt + 2)
      GM_COMPUTE(1)
      if (kt + 2 < nk) GM_STORE(ra0, rb0, 0)
      __syncthreads();
    }
    return;
  }
  GM_LOAD(ra0, rb0, 0)
  GM_LOAD(ra1, rb1, 1)
  GM_STORE(ra0, rb0, 0)
  __syncthreads();
  for (int kt = 0; kt < nk; kt += 2) {
    if (kt + 2 < nk) GM_LOAD(ra0, rb0, kt + 2)
    GM_COMPUTE(0)
    GM_STORE(ra1, rb1, 1)
    __syncthreads();
    if (kt + 3 < nk) GM_LOAD(ra1, rb1, kt + 3)
    GM_COMPUTE(1)
    if (kt + 2 < nk) GM_STORE(ra0, rb0, 0)
    __syncthreads();
  }
#undef GM_LOAD
#undef GM_STORE
#undef GM_COMPUTE
}

template <int NI>
DI void zero_acc(f32x16 (&acc)[2][NI]) {
#pragma unroll
  for (int a = 0; a < 2; ++a)
#pragma unroll
    for (int b = 0; b < NI; ++b)
#pragma unroll
      for (int i = 0; i < 16; ++i) acc[a][b][i] = 0.f;
}

DI void sincos_(float x, float* sn, float* cs) {
  float n = rintf(x * 0.63661977236758134f);
  float rr = fmaf(-n, 1.57079625129699707031f, x);
  rr = fmaf(-n, 7.54978941586159635335e-08f, rr);
  float r2 = rr * rr;
  float sp = rr + rr * r2 * (-1.6666654611e-1f + r2 * (8.3321608736e-3f + r2 * (-1.9515295891e-4f)));
  float cp = 1.f + r2 * (-0.5f + r2 * (4.166664568298827e-2f + r2 * (-1.388731625493765e-3f + r2 * 2.443315711809948e-5f)));
  int q = ((int)n) & 3;
  float s_ = (q & 1) ? cp : sp;
  float c_ = (q & 1) ? sp : cp;
  if (q == 1 || q == 2) c_ = -c_;
  if (q >= 2) s_ = -s_;
  *sn = s_;
  *cs = c_;
}

#define VSUB_SETUP                                                                                             \
  const int sub = tid >> 8, vt = tid & 255;                                                                    \
  const int vgrid = gridDim.x * 2, vb = blockIdx.x * 2 + sub;                                                  \
  bf16_t* smv = sm + sub * 32768;                                                                              \
  const int lane = vt & 63, wid = vt >> 6, wm = wid >> 1, wn = wid & 1, r = lane & 31, h = lane >> 5;          \
  (void)lane; (void)wm; (void)wn; (void)r; (void)h; (void)smv; (void)vgrid; (void)vb;

DI void prep_transpose(const float* src, int ld, bf16_t* dst, int K, int k0, int n0, float* tile, int tid) {
  const int nn = tid & 63, kq = tid >> 6;
#pragma unroll 4
  for (int i = 0; i < 8; ++i) {
    int kk = kq + 8 * i;
    tile[kk * 65 + nn] = src[(size_t)(k0 + kk) * ld + n0 + nn];
  }
  __syncthreads();
  {
    int n2 = tid >> 3, kc = tid & 7;
    uint4 w;
    w.x = pk2(tile[(kc * 8 + 0) * 65 + n2], tile[(kc * 8 + 1) * 65 + n2]);
    w.y = pk2(tile[(kc * 8 + 2) * 65 + n2], tile[(kc * 8 + 3) * 65 + n2]);
    w.z = pk2(tile[(kc * 8 + 4) * 65 + n2], tile[(kc * 8 + 5) * 65 + n2]);
    w.w = pk2(tile[(kc * 8 + 6) * 65 + n2], tile[(kc * 8 + 7) * 65 + n2]);
    *reinterpret_cast<uint4*>(dst + (size_t)(n0 + n2) * K + k0 + kc * 8) = w;
  }
  __syncthreads();
}

DI void prep_s5(const Params& p, int L, int g, float* sm, int tid) {
  float* apow = sm;
  float* fco = sm + 2176;
  float* bbar = sm + 2304;
  float* Kt = sm + 4352;
  float* Cl = sm + 12544;
  const size_t gm = (size_t)(L * 32 + g) * 65536;
  for (int d = 0; d < 2; ++d) {
    const int dg = (L * 2 + d) * 32 + g;
    if (tid < 64) {
      const int pp = tid;
      float dt = expf(p.s5_log_dt[dg]);
      float are = p.s5_a_re[dg * 64 + pp], aim = p.s5_a_im[dg * 64 + pp];
      float mag = expf(dt * are);
      float sn, cs;
      sincos_(dt * aim, &sn, &cs);
      float abr = mag * cs, abi = mag * sn;
      float den = are * are + aim * aim;
      float fr = ((abr - 1.f) * are + abi * aim) / den;
      float fi = (abi * are - (abr - 1.f) * aim) / den;
      fco[pp * 2] = fr;
      fco[pp * 2 + 1] = fi;
      float pr = 1.f, pi = 0.f;
      apow[pp * 2] = 1.f;
      apow[pp * 2 + 1] = 0.f;
      for (int t = 1; t <= 16; ++t) {
        float nr = pr * abr - pi * abi, ni = pr * abi + pi * abr;
        pr = nr; pi = ni;
        apow[(t * 64 + pp) * 2] = pr;
        apow[(t * 64 + pp) * 2 + 1] = pi;
      }
      p.A16()[(dg * 64 + pp) * 2] = pr;
      p.A16()[(dg * 64 + pp) * 2 + 1] = pi;
    }
    __syncthreads();
    for (int i = 0; i < 2; ++i) {
      int idx = tid + 512 * i;
      Cl[idx * 2] = p.s5_c_re[(size_t)dg * 1024 + idx];
      Cl[idx * 2 + 1] = p.s5_c_im[(size_t)dg * 1024 + idx];
    }
    for (int i = 0; i < 2; ++i) {
      int idx = tid + 512 * i;
      int pp = idx >> 4;
      float br = p.s5_b_re[(size_t)dg * 1024 + idx], bi = p.s5_b_im[(size_t)dg * 1024 + idx];
      float fr = fco[pp * 2], fi = fco[pp * 2 + 1];
      bbar[idx * 2] = fr * br - fi * bi;
      bbar[idx * 2 + 1] = fr * bi + fi * br;
    }
    __syncthreads();
    {
      const int th = tid >> 8, hp = (tid >> 4) & 15, hh = tid & 15;
      float kacc[8];
#pragma unroll
      for (int t = 0; t < 8; ++t) kacc[t] = 0.f;
      for (int pp = 0; pp < 64; ++pp) {
        float cr = Cl[(hp * 64 + pp) * 2], ci = Cl[(hp * 64 + pp) * 2 + 1];
        float br = bbar[(pp * 16 + hh) * 2], bi = bbar[(pp * 16 + hh) * 2 + 1];
        float xr = cr * br - ci * bi, xi = cr * bi + ci * br;
#pragma unroll
        for (int t = 0; t < 8; ++t)
          kacc[t] += xr * apow[((th * 8 + t) * 64 + pp) * 2] - xi * apow[((th * 8 + t) * 64 + pp) * 2 + 1];
      }
#pragma unroll
      for (int t = 0; t < 8; ++t) Kt[(d * 16 + th * 8 + t) * 256 + (tid & 255)] = kacc[t];
    }
    for (int i = 0; i < 64; ++i) {
      int idx = tid + 512 * i;
      int k = idx & 255, nn = idx >> 8;
      int pp = nn >> 1, ri = nn & 1, j = k >> 4, hh = k & 15;
      int e = (d == 0) ? (15 - j) : j;
      float ar = apow[(e * 64 + pp) * 2], ai = apow[(e * 64 + pp) * 2 + 1];
      float br = bbar[(pp * 16 + hh) * 2], bi = bbar[(pp * 16 + hh) * 2 + 1];
      float v = ri ? (ar * bi + ai * br) : (ar * br - ai * bi);
      p.S5We()[gm + (size_t)(d * 128 + nn) * 256 + k] = f2bf(v);
    }
    for (int i = 0; i < 64; ++i) {
      int idx = tid + 512 * i;
      int kk = idx & 127, n = idx >> 7;
      int pp = kk >> 1, ri = kk & 1, t16 = n >> 4, hp = n & 15;
      int pw = (d == 0) ? (t16 + 1) : (16 - t16);
      float cr = Cl[(hp * 64 + pp) * 2], ci = Cl[(hp * 64 + pp) * 2 + 1];
      float ar = apow[(pw * 64 + pp) * 2], ai = apow[(pw * 64 + pp) * 2 + 1];
      float v = ri ? -(cr * ai + ci * ar) : (cr * ar - ci * ai);
      p.S5R()[gm + (size_t)n * 256 + d * 128 + kk] = f2bf(v);
    }
    __syncthreads();
  }
  for (int i = 0; i < 128; ++i) {
    int idx = tid + 512 * i;
    int k = idx & 255, n = idx >> 8;
    int t16 = n >> 4, hp = n & 15, j = k >> 4, hh = k & 15;
    float v = 0.f;
    if (j <= t16) v += Kt[(0 * 16 + (t16 - j)) * 256 + hp * 16 + hh];
    if (j >= t16) v += Kt[(1 * 16 + (j - t16)) * 256 + hp * 16 + hh];
    if (j == t16 && hp == hh) v += p.s5_d[(L * 32 + g) * 16 + hh];
    p.S5M()[gm + (size_t)n * 256 + k] = f2bf(v);
  }
  __syncthreads();
}

DI void prep_adaln(const Params& p, int L, int cb, float* sm, int tid) {
  float* sv = sm;
  float* red = sm + 3072;
  for (int idx = tid; idx < 3072; idx += 512) {
    int v = idx >> 10, k = idx & 1023;
    float cv = (v < 2) ? p.c[v * 1024 + k] : p.c_ctx[k];
    sv[idx] = siluf_(cv);
  }
  __syncthreads();
  const int cl = tid & 63, kq = tid >> 6, col = cb * 64 + cl;
  float a0 = 0.f, a1 = 0.f, a2 = 0.f;
  const float* w = p.w_ada + (size_t)L * 1024 * 3072 + col;
#pragma unroll 8
  for (int k = kq * 128; k < kq * 128 + 128; ++k) {
    float wv = w[(size_t)k * 3072];
    a0 += sv[k] * wv;
    a1 += sv[1024 + k] * wv;
    a2 += sv[2048 + k] * wv;
  }
  red[(kq * 3 + 0) * 64 + cl] = a0;
  red[(kq * 3 + 1) * 64 + cl] = a1;
  red[(kq * 3 + 2) * 64 + cl] = a2;
  __syncthreads();
  if (kq == 0) {
    float bb = p.b_ada[L * 3072 + col];
    for (int v = 0; v < 3; ++v) {
      float s = 0.f;
      for (int q = 0; q < 8; ++q) s += red[(q * 3 + v) * 64 + cl];
      p.MOD()[(L * 3 + v) * 3072 + col] = s + bb;
    }
  }
  __syncthreads();
}

DI void phase_prep(const Params& p, float* sm, int tid) {
  constexpr int N_S5 = 128, N_ADA = 192, N_TR_L = 3456, N_TR = 4 * N_TR_L;
  constexpr int TOTAL = N_S5 + N_ADA + 1 + N_TR;
  for (int item = blockIdx.x; item < TOTAL; item += gridDim.x) {
    if (item < N_S5) {
      prep_s5(p, item >> 5, item & 31, sm, tid);
    } else if (item < N_S5 + N_ADA) {
      int it = item - N_S5;
      prep_adaln(p, it / 48, it % 48, sm, tid);
    } else if (item == N_S5 + N_ADA) {
      for (int idx = tid; idx < 256 * 16; idx += 512) {
        int pos = idx >> 4, i = idx & 15;
        float inv = exp2f(-(float)i * (13.287712379549449f / 16.f));
        float sn, cs;
        sincos_((float)pos * inv, &sn, &cs);
        p.ROPE()[idx * 2] = cs;
        p.ROPE()[idx * 2 + 1] = sn;
      }
      {
        const int wv = tid >> 6, ln = tid & 63;
        for (int LL = 0; LL < 4; ++LL) {
          float mb = 0.f;
          for (int j = tid; j < 8 * 465; j += 512) mb = fmaxf(mb, fabsf(p.na_rel_bias[LL * 8 * 465 + j]));
#pragma unroll
          for (int o = 32; o >= 1; o >>= 1) mb = fmaxf(mb, __shfl_xor(mb, o));
          if (ln == 0) sm[LL * 8 + wv] = mb;
        }
        __syncthreads();
        {
          const int LL = wv >> 1, ty = wv & 1;
          const float* gq = (ty ? p.gqa_q_g : p.na_q_g) + LL * 64;
          const float* gk = (ty ? p.gqa_k_g : p.na_k_g) + LL * 64;
          float mq = fabsf(gq[ln]), mk = fabsf(gk[ln]);
#pragma unroll
          for (int o = 32; o >= 1; o >>= 1) { mq = fmaxf(mq, __shfl_xor(mq, o)); mk = fmaxf(mk, __shfl_xor(mk, o)); }
          if (ln == 0) {
            float mb = 0.f;
            if (!ty) for (int q = 0; q < 8; ++q) mb = fmaxf(mb, sm[LL * 8 + q]);
            p.ROPE()[8192 + wv] = fminf(8.f * LOG2E * mq * mk + LOG2E * mb, 100.f);
          }
        }
        __syncthreads();
      }
    } else {
      int it = item - (N_S5 + N_ADA + 1);
      int L = it / N_TR_L, tt = it % N_TR_L;
      const float* src; bf16_t* dst; int ld, K, kt, nt;
      if (tt < 2624) {
        kt = tt / 164; nt = tt % 164; src = p.w_in + (size_t)L * 1024 * 10496; ld = 10496; K = 1024;
        dst = p.WinT() + (size_t)L * 10496 * 1024;
      } else if (tt < 3136) {
        int t2 = tt - 2624; int kb = t2 / 128; int t3 = t2 % 128; kt = t3 / 16; nt = t3 % 16;
        src = p.w_br + (size_t)(L * 4 + kb) * 512 * 1024; ld = 1024; K = 512;
        dst = p.WbrT() + (size_t)(L * 4 + kb) * 1024 * 512;
      } else if (tt < 3392) {
        int t2 = tt - 3136; kt = t2 / 16; nt = t2 % 16; src = p.w_out + (size_t)L * 1024 * 1024; ld = 1024; K = 1024;
        dst = p.WoutT() + (size_t)L * 1024 * 1024;
      } else {
        int t2 = tt - 3392; kt = t2 / 8; nt = t2 % 8; src = p.s5_w_glu + (size_t)L * 512 * 512; ld = 512; K = 512;
        dst = p.WgluT() + (size_t)L * 512 * 512;
      }
      prep_transpose(src, ld, dst, K, kt * 64, nt * 64, sm, tid);
    }
  }
}

DI void phase_norm(const Params& p, int b, int L, int tid) {
  const int wid = tid >> 6, lane = tid & 63;
  const float* g = p.norm_g + L * 1024;
  for (int item = blockIdx.x; item < R / 8; item += gridDim.x) {
    const int row = item * 8 + wid;
    const float* src;
    const float* mod;
    if (row < NLAT) {
      src = (L == 0 ? p.x : (const float*)p.out) + ((size_t)b * NLAT + row) * 1024;
      mod = p.MOD() + (L * 3 + b) * 3072;
    } else {
      src = (L == 0 ? p.ctx : (const float*)p.CTXS()) + ((size_t)b * 256 + (row - NLAT)) * 1024;
      mod = p.MOD() + (L * 3 + 2) * 3072;
    }
    float4 v[4];
    float ss = 0.f;
#pragma unroll
    for (int j = 0; j < 4; ++j) {
      v[j] = *reinterpret_cast<const float4*>(src + j * 256 + lane * 4);
      ss += v[j].x * v[j].x + v[j].y * v[j].y + v[j].z * v[j].z + v[j].w * v[j].w;
    }
#pragma unroll
    for (int o = 32; o >= 1; o >>= 1) ss += __shfl_xor(ss, o);
    const float rs = rsqrtf(ss * (1.f / 1024.f) + 1e-6f);
#pragma unroll
    for (int j = 0; j < 4; ++j) {
      const int col = j * 256 + lane * 4;
      float4 g4 = *reinterpret_cast<const float4*>(g + col);
      float4 sh = *reinterpret_cast<const float4*>(mod + col);
      float4 sc = *reinterpret_cast<const float4*>(mod + 1024 + col);
      float y0 = v[j].x * rs * g4.x * (1.f + sc.x) + sh.x;
      float y1 = v[j].y * rs * g4.y * (1.f + sc.y) + sh.y;
      float y2 = v[j].z * rs * g4.z * (1.f + sc.z) + sh.z;
      float y3 = v[j].w * rs * g4.w * (1.f + sc.w) + sh.w;
      uint2 w;
      w.x = pk2(y0, y1);
      w.y = pk2(y2, y3);
      *reinterpret_cast<uint2*>(p.H() + (size_t)row * 1024 + col) = w;
    }
  }
}

struct EpiGlu {
  static constexpr bool PERM = true, AFTER_DRAIN = false;
  const bf16_t* Y; bf16_t* Zg;
  DI void operator()(const pg8::f32x4 (&acc)[2][2][4][2], const pg8::Unit& u, int wr, int wc, int fr, int fq) const {
    const int row0 = u.pm * 256 + wr * 64 + fr, col0 = u.pn * 256 + wc * 32 + 8 * fq;
#pragma unroll
    for (int ai = 0; ai < 2; ++ai)
#pragma unroll
      for (int mh = 0; mh < 2; ++mh) {
        uint4 yv[4], gv[4];
#pragma unroll
        for (int q = 0; q < 4; ++q) {
          const int m = mh * 2 + (q >> 1), bj = q & 1;
          const int row = row0 + ai * 128 + m * 16, col = col0 + bj * 128;
          yv[q] = *reinterpret_cast<const uint4*>(Y + (size_t)row * 512 + col);
          gv[q] = *reinterpret_cast<const uint4*>(Zg + (size_t)row * LDZ + col);
        }
#pragma unroll
        for (int q = 0; q < 4; ++q) {
          const int m = mh * 2 + (q >> 1), bj = q & 1;
          const int row = row0 + ai * 128 + m * 16, col = col0 + bj * 128;
          const pg8::f32x4 a0 = acc[ai][bj][m][0], a1 = acc[ai][bj][m][1];
          uint4 w;
          w.x = pk2(lo_bf(yv[q].x) * sigmoidf_(a0[0]) * siluf_(lo_bf(gv[q].x)), hi_bf(yv[q].x) * sigmoidf_(a0[1]) * siluf_(hi_bf(gv[q].x)));
          w.y = pk2(lo_bf(yv[q].y) * sigmoidf_(a0[2]) * siluf_(lo_bf(gv[q].y)), hi_bf(yv[q].y) * sigmoidf_(a0[3]) * siluf_(hi_bf(gv[q].y)));
          w.z = pk2(lo_bf(yv[q].z) * sigmoidf_(a1[0]) * siluf_(lo_bf(gv[q].z)), hi_bf(yv[q].z) * sigmoidf_(a1[1]) * siluf_(hi_bf(gv[q].z)));
          w.w = pk2(lo_bf(yv[q].w) * sigmoidf_(a1[2]) * siluf_(lo_bf(gv[q].w)), hi_bf(yv[q].w) * sigmoidf_(a1[3]) * siluf_(hi_bf(gv[q].w)));
          *reinterpret_cast<uint4*>(Zg + (size_t)row * LDZ + col) = w;
        }
        asm volatile("" ::: "memory");
      }
  }
};
struct EpiOutRes {
  static constexpr bool PERM = false, AFTER_DRAIN = false;
  const float* src; float* dst; const float* gate;
  DI void operator()(const pg8::f32x4 (&acc)[2][2][4][2], const pg8::Unit& u, int wr, int wc, int fr, int fq) const {
    const int row0 = u.pm * 256 + wr * 64 + fr, col0 = u.pn * 256 + wc * 32 + 4 * fq;
    pg8::f32x4 gv[2][2];
#pragma unroll
    for (int bj = 0; bj < 2; ++bj)
#pragma unroll
      for (int n = 0; n < 2; ++n) gv[bj][n] = *reinterpret_cast<const pg8::f32x4*>(gate + col0 + bj * 128 + n * 16);
#pragma unroll
    for (int ai = 0; ai < 2; ++ai)
#pragma unroll
      for (int mh = 0; mh < 2; ++mh) {
        pg8::f32x4 xv[8];
#pragma unroll
        for (int q = 0; q < 8; ++q) {
          const int m = mh * 2 + (q >> 2), bj = (q >> 1) & 1, n = q & 1;
          xv[q] = *reinterpret_cast<const pg8::f32x4*>(src + (size_t)(row0 + ai * 128 + m * 16) * 1024 + col0 + bj * 128 + n * 16);
        }
#pragma unroll
        for (int q = 0; q < 8; ++q) {
          const int m = mh * 2 + (q >> 2), bj = (q >> 1) & 1, n = q & 1;
          *reinterpret_cast<pg8::f32x4*>(dst + (size_t)(row0 + ai * 128 + m * 16) * 1024 + col0 + bj * 128 + n * 16) =
              xv[q] + gv[bj][n] * acc[ai][bj][m][n];
        }
        asm volatile("" ::: "memory");
      }
  }
};

#define LDS3(ptr) ((__attribute__((address_space(3))) unsigned char*)(ptr))

typedef unsigned u32x4_t __attribute__((ext_vector_type(4)));
typedef unsigned u32x2_t __attribute__((ext_vector_type(2)));
struct EpiP1 {
  static constexpr bool PERM = true, AFTER_DRAIN = false;
  bf16_t* Zp; bf16_t* SGp;
  DI void operator()(const pg8::f32x4 (&acc)[2][2][4][2], const pg8::Unit& u, int wr, int wc, int fr, int fq) const {
    const int row0 = u.pm * 256 + wr * 64 + fr;
    const int colt = u.pn * 256;
    const int col0 = wc * 32 + 8 * fq;
    if (colt < LDZ) {
#pragma unroll
      for (int ai = 0; ai < 2; ++ai)
#pragma unroll
        for (int m = 0; m < 4; ++m) {
          bf16_t* rowp = Zp + (size_t)(row0 + ai * 128 + m * 16) * LDZ + colt + col0;
#pragma unroll
          for (int bj = 0; bj < 2; ++bj) {
            const pg8::f32x4 v0 = acc[ai][bj][m][0], v1 = acc[ai][bj][m][1];
            u32x4_t w4 = {pk2(v0[0], v0[1]), pk2(v0[2], v0[3]), pk2(v1[0], v1[1]), pk2(v1[2], v1[3])};
            __builtin_nontemporal_store(w4, reinterpret_cast<u32x4_t*>(rowp + bj * 128));
          }
        }
    } else {
      const int gcol0 = colt - LDZ + col0;
#pragma unroll
      for (int ai = 0; ai < 2; ++ai)
#pragma unroll
        for (int m = 0; m < 4; ++m) {
          const int row = row0 + ai * 128 + m * 16;
#pragma unroll
          for (int bj = 0; bj < 2; ++bj) {
            const pg8::f32x4 v0 = acc[ai][bj][m][0], v1 = acc[ai][bj][m][1];
            u32x2_t w0v = {pk2(sigmoidf_(v0[0]), sigmoidf_(v0[1])), pk2(sigmoidf_(v0[2]), sigmoidf_(v0[3]))};
            u32x2_t w1v = {pk2(sigmoidf_(v1[0]), sigmoidf_(v1[1])), pk2(sigmoidf_(v1[2]), sigmoidf_(v1[3]))};
            bf16_t* q0 = SGp + sg_index(row, gcol0 + bj * 128);
            __builtin_nontemporal_store(w0v, reinterpret_cast<u32x2_t*>(q0));
            __builtin_nontemporal_store(w1v, reinterpret_cast<u32x2_t*>(q0 + 128));
          }
        }
    }
  }
};
constexpr int P1_UNITS_Z = 65 * 25, P1_UNITS_ALL = 65 * 41, P1_UNITS_MAIN = 2560, GLU_UNITS = 65 * 2;
struct P1Order {
  int lo, hi, G, c;
  DI static void map_unit(int wgid, int nM, int nN, pg8::Unit& u) {
    const int nwg = nM * nN;
    { const int q = nwg / pg8::NXCD, r = nwg % pg8::NXCD, xcd = wgid % pg8::NXCD, off = wgid / pg8::NXCD;
      wgid = (xcd < r ? xcd * (q + 1) : r * (q + 1) + (xcd - r) * q) + off; }
    const int nig = pg8::WGM * nN, gid = wgid / nig, fm = gid * pg8::WGM, gsz = (nM - fm) < pg8::WGM ? (nM - fm) : pg8::WGM;
    u.pm = fm + ((wgid % nig) % gsz); u.pn = (wgid % nig) / gsz;
  }
  DI bool next(int i, pg8::Unit& u) const {
    const int idx = lo + i * G + c;
    if (idx >= hi) return false;
    if (idx < P1_UNITS_Z) map_unit(idx, 65, 25, u);
    else { map_unit(idx - P1_UNITS_Z, 65, 16, u); u.pn += 25; }
    return true;
  }
  DI void a_ready(const pg8::Unit&) const {}
  DI void done(const pg8::Unit&) const {}
  DI int lda(const pg8::Gemm& g) const { return g.K; }
  DI const char* abase(const pg8::Gemm& g, const pg8::Unit& u) const { return (const char*)g.A + (size_t)u.pm * (size_t)pg8::BM * g.K * 2; }
  DI const char* bbase(const pg8::Gemm& g, const pg8::Unit& u) const { return (const char*)g.Bt + (size_t)u.pn * (size_t)pg8::BM * g.K * 2; }
};
DI bool p1_deferral() { return gridDim.x >= (unsigned)(GLU_UNITS + (P1_UNITS_ALL - P1_UNITS_MAIN)); }
DI void phase_p1(const Params& p, int b, int L, unsigned char* smraw) {
  P1Order S{0, p1_deferral() ? P1_UNITS_MAIN : P1_UNITS_ALL, (int)gridDim.x, (int)blockIdx.x};
  pg8::Gemm g{p.H(), p.WinT() + (size_t)L * 10496 * 1024, R, 10496, 1024};
  EpiP1 E{p.Z(), p.SG()};
  pg8::gemm_phase<EpiP1, P1Order, false>(LDS3(smraw), g, S, E, nullptr);
}

DI void post_item(const Params& p, int L, int rb, int slot, int lane) {
  int col; const float* gvec = nullptr; float mult = 1.f; bool rope = false; bf16_t* vt = nullptr;
  const bool latent = (rb * 64) < NLAT;
  if (slot < 8) { col = C_NQ + slot * 64; gvec = p.na_q_g + L * 64; mult = 0.125f * LOG2E; }
  else if (slot < 16) { col = C_NK + (slot - 8) * 64; gvec = p.na_k_g + L * 64; }
  else if (slot < 24) { col = C_GQ + (slot - 16) * 64; gvec = p.gqa_q_g + L * 64; mult = 0.125f * LOG2E; rope = latent; }
  else if (slot < 26) { col = C_GK + (slot - 24) * 64; gvec = p.gqa_k_g + L * 64; rope = latent; }
  else if (slot < 34) { col = C_NV + (slot - 26) * 64; vt = p.VtN() + (size_t)((slot - 26) * 64) * LDT; }
  else { col = C_GV + (slot - 34) * 64; vt = p.VtG() + (size_t)((slot - 34) * 64) * LDT; }
  if (vt) {
    const int row = rb * 64 + lane;
    const bf16_t* zp = p.Z() + (size_t)row * LDZ + col;
    uint4 raw[8];
#pragma unroll
    for (int j = 0; j < 8; ++j) raw[j] = *reinterpret_cast<const uint4*>(zp + j * 8);
    const int prow = (row & ~12) | ((row & 4) << 1) | ((row & 8) >> 1);
#pragma unroll
    for (int j = 0; j < 8; ++j) {
      const unsigned w[4] = {raw[j].x, raw[j].y, raw[j].z, raw[j].w};
#pragma unroll
      for (int q = 0; q < 4; ++q) {
        vt[(size_t)(j * 8 + q * 2) * LDT + prow] = (bf16_t)(w[q] & 0xffffu);
        vt[(size_t)(j * 8 + q * 2 + 1) * LDT + prow] = (bf16_t)(w[q] >> 16);
      }
    }
    return;
  }
  const int c = lane & 7, rsub = lane >> 3;
  float gv[8];
#pragma unroll
  for (int e = 0; e < 8; ++e) gv[e] = gvec[c * 8 + e] * mult;
  uint4 rawv[8];
#pragma unroll
  for (int ps = 0; ps < 8; ++ps)
    rawv[ps] = *reinterpret_cast<const uint4*>(p.Z() + (size_t)(rb * 64 + ps * 8 + rsub) * LDZ + col + c * 8);
#pragma unroll
  for (int ps = 0; ps < 8; ++ps) {
    const int row = rb * 64 + ps * 8 + rsub;
    bf16_t* zp = p.Z() + (size_t)row * LDZ + col + c * 8;
    const uint4 raw = rawv[ps];
    float x[8] = {lo_bf(raw.x), hi_bf(raw.x), lo_bf(raw.y), hi_bf(raw.y), lo_bf(raw.z), hi_bf(raw.z), lo_bf(raw.w), hi_bf(raw.w)};
    float ss = 0.f;
#pragma unroll
    for (int e = 0; e < 8; ++e) ss += x[e] * x[e];
    ss += __shfl_xor(ss, 1);
    ss += __shfl_xor(ss, 2);
    ss += __shfl_xor(ss, 4);
    const float rs = rsqrtf(ss * (1.f / 64.f) + 1e-6f);
#pragma unroll
    for (int e = 0; e < 8; ++e) x[e] = x[e] * rs * gv[e];
    if (rope) {
      const int pos = ((c & 3) < 2) ? (row >> 6) : (row & 63);
      const float* rt = p.ROPE() + (size_t)pos * 32 + ((c & 1) * 8) * 2;
#pragma unroll
      for (int e = 0; e < 8; ++e) {
        const float other = __shfl_xor(x[e], 4);
        const float cs = rt[e * 2], sn = rt[e * 2 + 1];
        x[e] = (c < 4) ? (x[e] * cs - other * sn) : (x[e] * cs + other * sn);
      }
    }
    uint4 w;
    w.x = pk2(x[0], x[1]); w.y = pk2(x[2], x[3]); w.z = pk2(x[4], x[5]); w.w = pk2(x[6], x[7]);
    *reinterpret_cast<uint4*>(zp) = w;
  }
}

DI void phase_s5e_conv_post(const Params& p, int b, int L, bf16_t* sm, int tid) {
  {
    VSUB_SETUP
    constexpr int NT_E = 32 * 9 * 2;
    const int nit = (NT_E + vgrid - 1) / vgrid;
    for (int it = 0; it < nit; ++it) {
      int item = it * vgrid + vb;
      const bool act = item < NT_E;
      if (!act) item = NT_E - 1;
      const int g = item / 18, rem = item % 18, mt = rem >> 1, nt = rem & 1;
      const int m0 = mt * 128, n0 = nt * 128;
      f32x16 acc[2][2];
      zero_acc<2>(acc);
      const bf16_t* Ub = p.Z() + C_S5U + g * 16;
      gemm_main<2>(acc, Ub + (size_t)m0 * 16 * LDZ, 16 * LDZ, ((vt & 7) >> 1) * LDZ + (vt & 1) * 8, 4 * LDZ,
                   p.S5We() + (size_t)(L * 32 + g) * 65536 + (size_t)n0 * 256, 256, 256, smv, vt, act);
      if (act) {
#pragma unroll
        for (int mi = 0; mi < 2; ++mi)
#pragma unroll
          for (int ni = 0; ni < 2; ++ni)
#pragma unroll
            for (int i = 0; i < 16; ++i) {
              int m = m0 + wm * 64 + mi * 32 + crow(i, h);
              int n = n0 + wn * 64 + ni * 32 + r;
              if (m < NCH) p.E()[((size_t)m * 32 + g) * 256 + n] = acc[mi][ni][i];
            }
      }
    }
  }
  constexpr int NT_C = R * 64 / 512;
  constexpr int NT_P = 260 * 36 / 8;
  for (int item = blockIdx.x; item < NT_C + NT_P; item += gridDim.x) {
    if (item >= NT_C) {
      const int w = (item - NT_C) * 8 + (tid >> 6);
      post_item(p, L, w / 36, w % 36, tid & 63);
      continue;
    }
    const int idx = item * 512 + tid;
    const int row = idx >> 6, ch = (idx & 63) * 8;
    const int lo = (row < NLAT) ? 0 : NLAT, hi = (row < NLAT) ? (NLAT - 1) : (R - 1);
    const bf16_t* zr = p.Z() + (size_t)row * LDZ;
    float zz[3][8];
#pragma unroll
    for (int t = 0; t < 3; ++t) {
      int rr = row + t - 1;
      if (rr >= lo && rr <= hi) {
        uint4 cv = *reinterpret_cast<const uint4*>(p.Z() + (size_t)rr * LDZ + C_CV + ch);
        uint4 cc = *reinterpret_cast<const uint4*>(p.Z() + (size_t)rr * LDZ + C_CC + ch);
        zz[t][0] = lo_bf(cv.x) * lo_bf(cc.x); zz[t][1] = hi_bf(cv.x) * hi_bf(cc.x);
        zz[t][2] = lo_bf(cv.y) * lo_bf(cc.y); zz[t][3] = hi_bf(cv.y) * hi_bf(cc.y);
        zz[t][4] = lo_bf(cv.z) * lo_bf(cc.z); zz[t][5] = hi_bf(cv.z) * hi_bf(cc.z);
        zz[t][6] = lo_bf(cv.w) * lo_bf(cc.w); zz[t][7] = hi_bf(cv.w) * hi_bf(cc.w);
      } else {
#pragma unroll
        for (int j = 0; j < 8; ++j) zz[t][j] = 0.f;
      }
    }
    uint4 cb = *reinterpret_cast<const uint4*>(zr + C_CB + ch);
    uint4 cg_ = *reinterpret_cast<const uint4*>(zr + C_CG + ch);
    float bv[8] = {lo_bf(cb.x), hi_bf(cb.x), lo_bf(cb.y), hi_bf(cb.y), lo_bf(cb.z), hi_bf(cb.z), lo_bf(cb.w), hi_bf(cb.w)};
    float gv[8] = {lo_bf(cg_.x), hi_bf(cg_.x), lo_bf(cg_.y), hi_bf(cg_.y), lo_bf(cg_.z), hi_bf(cg_.z), lo_bf(cg_.w), hi_bf(cg_.w)};
    float o[8];
#pragma unroll
    for (int j = 0; j < 8; ++j) {
      float y = p.conv_b[L * 512 + ch + j] + zz[0][j] * p.conv_w[(L * 3 + 0) * 512 + ch + j] +
                zz[1][j] * p.conv_w[(L * 3 + 1) * 512 + ch + j] + zz[2][j] * p.conv_w[(L * 3 + 2) * 512 + ch + j];
      o[j] = bv[j] * y * siluf_(gv[j]);
    }
    uint4 w;
    w.x = pk2(o[0], o[1]); w.y = pk2(o[2], o[3]); w.z = pk2(o[4], o[5]); w.w = pk2(o[6], o[7]);
    *reinterpret_cast<uint4*>(p.Z() + (size_t)row * LDZ + C_CG + ch) = w;
  }
}

DI void phase_s5y(const Params& p, int b, int L, bf16_t* sm, int tid) {
  VSUB_SETUP
  constexpr int NT = 32 * 18;
  const int nit = (NT + vgrid - 1) / vgrid;
  for (int it = 0; it < nit; ++it) {
    int item = it * vgrid + vb;
    const bool act = item < NT;
    if (!act) item = NT - 1;
    const int g = item / 18, rem = item % 18, mt = rem >> 1, nt = rem & 1;
    const int m0 = mt * 128, n0 = nt * 128;
    f32x16 acc[2][2];
    zero_acc<2>(acc);
    const bf16_t* Ub = p.Z() + C_S5U + g * 16;
    gemm_main<2>(acc, Ub + (size_t)m0 * 16 * LDZ, 16 * LDZ, ((vt & 7) >> 1) * LDZ + (vt & 1) * 8, 4 * LDZ,
                 p.S5M() + (size_t)(L * 32 + g) * 65536 + (size_t)n0 * 256, 256, 256, smv, vt, act);
    const bf16_t* Hb = p.HIN() + g * 256;
    gemm_main<2>(acc, Hb + (size_t)m0 * 8192, 8192, (vt & 7) * 8, 64,
                 p.S5R() + (size_t)(L * 32 + g) * 65536 + (size_t)n0 * 256, 256, 256, smv, vt, act);
    if (act) {
#pragma unroll
      for (int mi = 0; mi < 2; ++mi)
#pragma unroll
        for (int ni = 0; ni < 2; ++ni)
#pragma unroll
          for (int i = 0; i < 16; ++i) {
            int m = m0 + wm * 64 + mi * 32 + crow(i, h);
            int n = n0 + wn * 64 + ni * 32 + r;
            if (m < NCH) {
              float y = acc[mi][ni][i];
              float z = 1.5957691216057308f * (y + 0.044715f * y * y * y);
              y = y * sigmoidf_(z);
              p.Y()[(size_t)(m * 16 + (n >> 4)) * 512 + g * 16 + (n & 15)] = f2bf(y);
            }
          }
    }
  }
}

DI void phase_glu(const Params& p, int b, int L, unsigned char* smraw) {
  if (p1_deferral() && blockIdx.x >= (unsigned)GLU_UNITS) {
    P1Order S{P1_UNITS_MAIN, P1_UNITS_ALL, (int)gridDim.x - GLU_UNITS, (int)blockIdx.x - GLU_UNITS};
    pg8::Gemm g{p.H(), p.WinT() + (size_t)L * 10496 * 1024, R, 10496, 1024};
    EpiP1 E{p.Z(), p.SG()};
    pg8::gemm_phase<EpiP1, P1Order, false>(LDS3(smraw), g, S, E, nullptr);
    return;
  }
  pg8::StaticOrder S;
  S.init(R, 512, gridDim.x, blockIdx.x);
  pg8::Gemm g{p.Y(), p.WgluT() + (size_t)L * 512 * 512, R, 512, 512};
  EpiGlu E{p.Y(), p.Z() + C_S5G};
  pg8::gemm_phase<EpiGlu, pg8::StaticOrder, false>(LDS3(smraw), g, S, E, nullptr);
}

DI void attn_item(const Params& p, int L, int mode, int head, int q_row0, int na_r, const float* bias_s, bf16_t* wl, int lane) {
  const int r = lane & 31, h = lane >> 5;
  int qcol, kcol, gcol;
  const bf16_t* vt;
  if (mode == 0 || mode == 2) {
    qcol = C_NQ + head * 64; kcol = C_NK + head * 64; gcol = C_NG + head * 64;
    vt = p.VtN() + (size_t)(head * 64) * LDT;
  } else {
    qcol = C_GQ + head * 64; kcol = C_GK + (head >> 2) * 64; gcol = C_GG + head * 64;
    vt = p.VtG() + (size_t)((head >> 2) * 64) * LDT;
  }
  bf16_t* Ql = wl + 4096 + lane * 8;
  {
    const bf16_t* qp = p.Z() + (size_t)(q_row0 + r) * LDZ + qcol + h * 8;
#pragma unroll
    for (int ks = 0; ks < 4; ++ks) {
      *reinterpret_cast<bf16x8*>(Ql + ks * 512) = ld16(qp + (size_t)32 * LDZ + ks * 16);
      *reinterpret_cast<bf16x8*>(Ql + 2048 + ks * 512) = ld16(qp + ks * 16);
    }
  }
  float la = 0.f, lb = 0.f;
  const float shf = p.ROPE()[8192 + L * 2 + ((mode == 0 || mode == 2) ? 0 : 1)];
  f32x16 OA0, OA1, OB0, OB1;
#pragma unroll
  for (int i = 0; i < 16; ++i) { OA0[i] = 0.f; OA1[i] = 0.f; OB0[i] = 0.f; OB1[i] = 0.f; }
  const int rs = min(max(na_r - 4, 0), 256 - 8);
  const int csA = min(max(r - 8, 0), 48), csB = min(max(r + 24, 0), 48);
  int kt_lo = 0, nband = 0;
  if (mode == 0) nband = 16;
  else if (mode == 1) {
    kt_lo = max(0, (128 - q_row0) >> 5);
    int kt_hi = min(10, (NLAT - q_row0 + 128) >> 5);
    nband = kt_hi - kt_lo;
  }
  const int ntiles = 8 + nband;
  auto tile_row = [&](int j) -> int {
    if (j < 8) return NLAT + j * 32;
    const int kt = kt_lo + j - 8;
    if (mode == 0) return (rs + (kt >> 1)) * 64 + (kt & 1) * 32;
    return q_row0 - 128 + kt * 32;
  };
  const bf16_t* kg = p.Z() + (size_t)(lane >> 3) * LDZ + kcol + (lane & 7) * 8;
  const bf16_t* vg = vt + (size_t)(lane >> 2) * LDT + (lane & 3) * 8;
  bf16_t* Kl = wl;
  bf16_t* Vl = wl + 2048;
  const int kstE = (lane >> 3) * 64 + (((lane & 7) ^ ((lane >> 4) & 7)) * 8);
  const int kstO = ((lane >> 3) + 8) * 64 + (((lane & 7) ^ (((lane >> 4) + 4) & 7)) * 8);
  const int vst0 = (lane >> 2) * 32 + (((lane & 3) ^ ((lane >> 4) & 3)) * 8);
#define KST(i) ((((i) & 1) ? kstO : kstE) + ((i) >> 1) * 1024)
#define VST(i) (vst0 + (i) * 512)
  const int krd = r * 64, ksw = (r >> 1) & 7;
  const int vrd0 = r * 32, vrd1 = (32 + r) * 32, vsw = (r >> 2) & 3;
  bf16x8 rk[4], rv[4];
  {
    const int t0r = tile_row(0);
#pragma unroll
    for (int i = 0; i < 4; ++i) {
      rk[i] = ld16(kg + (size_t)(t0r + 8 * i) * LDZ);
      rv[i] = ld16(vg + (size_t)(16 * i) * LDT + t0r);
    }
#pragma unroll
    for (int i = 0; i < 4; ++i) {
      *reinterpret_cast<bf16x8*>(Kl + KST(i)) = rk[i];
      *reinterpret_cast<bf16x8*>(Vl + VST(i)) = rv[i];
    }
  }
  for (int j = 0; j < ntiles; ++j) {
    const int krow0 = tile_row(j);
    const bool more = (j + 1 < ntiles);
    if (more) {
      const int tn = tile_row(j + 1);
#pragma unroll
      for (int i = 0; i < 4; ++i) {
        rk[i] = ld16(kg + (size_t)(tn + 8 * i) * LDZ);
        rv[i] = ld16(vg + (size_t)(16 * i) * LDT + tn);
      }
    }
    f32x16 SA, SB;
#pragma unroll
    for (int i = 0; i < 16; ++i) { SA[i] = -shf; SB[i] = -shf; }
#pragma unroll
    for (int ks = 0; ks < 4; ++ks) {
      bf16x8 kf = *reinterpret_cast<const bf16x8*>(Kl + krd + (((ks * 2 + h) ^ ksw) * 8));
      SA = MFMA32(kf, *reinterpret_cast<const bf16x8*>(Ql + 2048 + ks * 512), SA);
      SB = MFMA32(kf, *reinterpret_cast<const bf16x8*>(Ql + ks * 512), SB);
    }
    union { bf16x8 v; unsigned u[4]; } pa0, pa1, pb0, pb1;
#define SOFTMAX_TILE(S_, cs_, qoff_, lsum_, p0_, p1_)                                                      \
    {                                                                                                      \
      if (j >= 8 && mode == 0) {                                                                           \
        const int kt = j - 8;                                                                              \
        const int kcb = (kt & 1) * 32;                                                                     \
        const int di = rs + (kt >> 1) - na_r + 7;                                                          \
        const float* brow = bias_s + 64 + head * 465 + di * 31 + (kcb + 4 * h - (r + qoff_) + 15);        \
        const int t0 = kcb + 4 * h - cs_;                                                                  \
        _Pragma("unroll") for (int i = 0; i < 16; ++i) {                                                   \
          const int ci = (i & 3) + 8 * (i >> 2);                                                           \
          S_[i] = ((unsigned)(t0 + ci) < 16u) ? (S_[i] + brow[ci]) : -INFINITY;                            \
        }                                                                                                  \
      } else if (j >= 8) {                                                                                 \
        const int d0 = krow0 + 4 * h - (q_row0 + qoff_ + r);                                               \
        _Pragma("unroll") for (int i = 0; i < 16; ++i) {                                                   \
          const int df = d0 + (i & 3) + 8 * (i >> 2);                                                      \
          S_[i] = (df <= 128 && df >= -128) ? S_[i] : -INFINITY;                                           \
        }                                                                                                  \
      }                                                                                                    \
      float rsum = 0.f;                                                                                    \
      _Pragma("unroll") for (int i = 0; i < 16; ++i) {                                                     \
        float pv = __builtin_amdgcn_exp2f(S_[i]);                                                          \
        S_[i] = pv;                                                                                        \
        rsum += pv;                                                                                        \
      }                                                                                                    \
      lsum_ += rsum;                                                                                       \
      _Pragma("unroll") for (int q = 0; q < 4; ++q) {                                                      \
        p0_.u[q] = pk2(S_[2 * q], S_[2 * q + 1]);                                                          \
        p1_.u[q] = pk2(S_[8 + 2 * q], S_[8 + 2 * q + 1]);                                                  \
      }                                                                                                    \
    }
    SOFTMAX_TILE(SA, csA, 0, la, pa0, pa1)
    asm volatile("" : "+v"(pa0.u[0]), "+v"(pa0.u[1]), "+v"(pa0.u[2]), "+v"(pa0.u[3]), "+v"(pa1.u[0]), "+v"(pa1.u[1]), "+v"(pa1.u[2]), "+v"(pa1.u[3]));
    SOFTMAX_TILE(SB, csB, 32, lb, pb0, pb1)
#undef SOFTMAX_TILE
    {
      bf16x8 v00 = *reinterpret_cast<const bf16x8*>(Vl + vrd0 + (((0 + h) ^ vsw) * 8));
      bf16x8 v01 = *reinterpret_cast<const bf16x8*>(Vl + vrd0 + (((2 + h) ^ vsw) * 8));
      OA0 = MFMA32(v00, pa0.v, OA0); OB0 = MFMA32(v00, pb0.v, OB0);
      OA0 = MFMA32(v01, pa1.v, OA0); OB0 = MFMA32(v01, pb1.v, OB0);
      bf16x8 v10 = *reinterpret_cast<const bf16x8*>(Vl + vrd1 + (((0 + h) ^ vsw) * 8));
      bf16x8 v11 = *reinterpret_cast<const bf16x8*>(Vl + vrd1 + (((2 + h) ^ vsw) * 8));
      OA1 = MFMA32(v10, pa0.v, OA1); OB1 = MFMA32(v10, pb0.v, OB1);
      OA1 = MFMA32(v11, pa1.v, OA1); OB1 = MFMA32(v11, pb1.v, OB1);
    }
    if (more) {
#pragma unroll
      for (int i = 0; i < 4; ++i) {
        *reinterpret_cast<bf16x8*>(Kl + KST(i)) = rk[i];
        *reinterpret_cast<bf16x8*>(Vl + VST(i)) = rv[i];
      }
    }
  }
  float l_a = la + __shfl_xor(la, 32), l_b = lb + __shfl_xor(lb, 32);
  if (mode == 1 || mode == 3) {
    const float sk = __builtin_amdgcn_exp2f(p.gqa_sink[L * 8 + head] * LOG2E - shf);
    l_a += sk; l_b += sk;
  }
  const float inva = 1.f / l_a, invb = 1.f / l_b;
  bf16_t* gpa = p.Z() + (size_t)(q_row0 + r) * LDZ + gcol + 4 * h;
  bf16_t* gpb = gpa + (size_t)32 * LDZ;
  {
    uint2 gA0[4], gA1[4], gB0[4], gB1[4];
#pragma unroll
    for (int i4 = 0; i4 < 4; ++i4) {
      gA0[i4] = *reinterpret_cast<const uint2*>(gpa + i4 * 8);
      gA1[i4] = *reinterpret_cast<const uint2*>(gpa + 32 + i4 * 8);
      gB0[i4] = *reinterpret_cast<const uint2*>(gpb + i4 * 8);
      gB1[i4] = *reinterpret_cast<const uint2*>(gpb + 32 + i4 * 8);
    }
#define ATT_OUT(O, G, gp, inv, off)                                                                                 \
    {                                                                                                               \
      const uint2 gt = G[i4];                                                                                       \
      uint2 w;                                                                                                      \
      w.x = pk2(O[i4 * 4 + 0] * inv * siluf_(lo_bf(gt.x)), O[i4 * 4 + 1] * inv * siluf_(hi_bf(gt.x)));              \
      w.y = pk2(O[i4 * 4 + 2] * inv * siluf_(lo_bf(gt.y)), O[i4 * 4 + 3] * inv * siluf_(hi_bf(gt.y)));              \
      *reinterpret_cast<uint2*>(gp + off + i4 * 8) = w;                                                             \
    }
#pragma unroll
    for (int i4 = 0; i4 < 4; ++i4) {
      ATT_OUT(OA0, gA0, gpa, inva, 0)
      ATT_OUT(OA1, gA1, gpa, inva, 32)
      ATT_OUT(OB0, gB0, gpb, invb, 0)
      ATT_OUT(OB1, gB1, gpb, invb, 32)
    }
#undef ATT_OUT
  }
#undef KST
#undef VST
}

DI void scan_wg(const Params& p, int L, int dgi, float* sm, int tid) {
  const int lane = tid & 63, w = tid >> 6;
  const int d = dgi >> 5, g = dgi & 31;
  const int dg = (L * 2 + d) * 32 + g;
  const float ar = p.A16()[(dg * 64 + lane) * 2], ai = p.A16()[(dg * 64 + lane) * 2 + 1];
  const int off = g * 256 + d * 128 + lane * 2;
  const int s_lo = w * 130;
  auto chunk_of = [&](int s) -> int { return (d == 0) ? (s < 16 ? 1024 + s : s - 16) : (NCH - 1 - s); };
  float hr = 0.f, hi = 0.f, pr = 1.f, pi = 0.f;
  float2 e[10], en[10];
#pragma unroll
  for (int u = 0; u < 10; ++u) e[u] = *reinterpret_cast<const float2*>(p.E() + (size_t)chunk_of(s_lo + u) * 8192 + off);
  for (int s0 = 0; s0 < 130; s0 += 10) {
    const int sn = (s0 + 10 < 130) ? (s0 + 10) : s0;
#pragma unroll
    for (int u = 0; u < 10; ++u) en[u] = *reinterpret_cast<const float2*>(p.E() + (size_t)chunk_of(s_lo + sn + u) * 8192 + off);
#pragma unroll
    for (int u = 0; u < 10; ++u) {
      float nr = ar * hr - ai * hi + e[u].x, ni = ar * hi + ai * hr + e[u].y;
      hr = nr; hi = ni;
      float qr = pr * ar - pi * ai, qi = pr * ai + pi * ar;
      pr = qr; pi = qi;
    }
#pragma unroll
    for (int u = 0; u < 10; ++u) e[u] = en[u];
  }
  sm[(w * 64 + lane) * 2] = hr;
  sm[(w * 64 + lane) * 2 + 1] = hi;
  __syncthreads();
  float cr = 0.f, ci = 0.f;
  for (int v = 0; v < w; ++v) {
    float tr = sm[(v * 64 + lane) * 2], ti = sm[(v * 64 + lane) * 2 + 1];
    float nr = pr * cr - pi * ci + tr, ni = pr * ci + pi * cr + ti;
    cr = nr; ci = ni;
  }
  __syncthreads();
  hr = cr; hi = ci;
#pragma unroll
  for (int u = 0; u < 10; ++u) e[u] = *reinterpret_cast<const float2*>(p.E() + (size_t)chunk_of(s_lo + u) * 8192 + off);
  for (int s0 = 0; s0 < 130; s0 += 10) {
    const int sn = (s0 + 10 < 130) ? (s0 + 10) : s0;
#pragma unroll
    for (int u = 0; u < 10; ++u) en[u] = *reinterpret_cast<const float2*>(p.E() + (size_t)chunk_of(s_lo + sn + u) * 8192 + off);
#pragma unroll
    for (int u = 0; u < 10; ++u) {
      *reinterpret_cast<unsigned*>(p.HIN() + (size_t)chunk_of(s_lo + s0 + u) * 8192 + off) = pk2(hr, hi);
      float nr = ar * hr - ai * hi + e[u].x, ni = ar * hi + ai * hr + e[u].y;
      hr = nr; hi = ni;
    }
#pragma unroll
    for (int u = 0; u < 10; ++u) e[u] = en[u];
  }
}

DI void phase_attn_scan(const Params& p, int b, int L, float* sm, int tid) {
  const int lane = tid & 63, wid = tid >> 6;
  float* bias_s = sm + 32768;
  bf16_t* wl = reinterpret_cast<bf16_t*>(sm) + wid * 8192;
  for (int idx = tid; idx < 8 * 465; idx += 512) bias_s[64 + idx] = p.na_rel_bias[L * 8 * 465 + idx] * LOG2E;
  __syncthreads();
  constexpr int N_SCAN = 64, N_ATT = 4096 / 8;
  for (int item = blockIdx.x; item < N_SCAN; item += gridDim.x) scan_wg(p, L, item, sm + 32768 + 3840, tid);
  int lat_it = 0, ci = 0;
  for (;;) {
    int item;
    const int lat = (int)blockIdx.x + lat_it * (int)gridDim.x;
    if (lat < N_ATT) { item = lat; ++lat_it; }
    else {
      while (ci < 8 && (unsigned)((64 + ci) % gridDim.x) != blockIdx.x) ++ci;
      if (ci >= 8) break;
      item = N_ATT + ci;
      ++ci;
    }
    int mode, head, q_row0, na_r = 0;
    if (item < N_ATT) {
      const int w = item * 8 + wid;
      if (w < 2048) { mode = 0; head = w & 7; na_r = w >> 3; q_row0 = na_r * 64; }
      else { const int w2 = w - 2048; mode = 1; head = w2 & 7; q_row0 = (w2 >> 3) * 64; }
    } else {
      const int cj = item - N_ATT;
      const int w2 = (cj & 3) * 8 + wid;
      mode = (cj < 4) ? 2 : 3; head = w2 & 7; q_row0 = NLAT + (w2 >> 3) * 64;
    }
    attn_item(p, L, mode, head, q_row0, na_r, bias_s, wl, lane);
  }
  __syncthreads();
}

DI void phase_merge(const Params& p, int b, int L, bf16_t* sm, int tid) {
  VSUB_SETUP
  constexpr int NT = 128 * 8;
  const int nit = (NT + vgrid - 1) / vgrid;
  for (int it = 0; it < nit; ++it) {
    int tile = it * vgrid + vb;
    const bool act = tile < NT;
    if (!act) tile = NT - 1;
    const int mt = tile >> 3, nt = tile & 7;
    const int m0 = mt * 128, n0 = nt * 128;
    f32x16 outv[2][2];
    zero_acc<2>(outv);
    for (int kb = 0; kb < 4; ++kb) {
      f32x16 acc[2][2];
      zero_acc<2>(acc);
      const int gc = (kb == 0) ? C_S5G : (kb == 1 ? C_CG : (kb == 2 ? C_NG : C_GG));
      const bf16_t* Ab = p.Z() + (size_t)m0 * LDZ + gc;
      gemm_main<2, true, false>(acc, Ab, LDZ, (vt & 7) * 8, 64, p.WbrT() + (size_t)(L * 4 + kb) * 1024 * 512 + (size_t)n0 * 512, 512,
                         512, smv, vt, act);
      if (act) {
#pragma unroll
        for (int mi = 0; mi < 2; ++mi) {
          const bf16_t* sgp = p.SG() + sg_index(m0 + wm * 64 + mi * 32 + r, kb * 1024 + n0 + wn * 64 + 4 * h);
#pragma unroll
          for (int ni = 0; ni < 2; ++ni)
#pragma unroll
            for (int i4 = 0; i4 < 4; ++i4) {
              uint2 sv = *reinterpret_cast<const uint2*>(sgp + (ni * 8 + i4 * 2) * 128);
              outv[mi][ni][i4 * 4 + 0] += lo_bf(sv.x) * acc[mi][ni][i4 * 4 + 0];
              outv[mi][ni][i4 * 4 + 1] += hi_bf(sv.x) * acc[mi][ni][i4 * 4 + 1];
              outv[mi][ni][i4 * 4 + 2] += lo_bf(sv.y) * acc[mi][ni][i4 * 4 + 2];
              outv[mi][ni][i4 * 4 + 3] += hi_bf(sv.y) * acc[mi][ni][i4 * 4 + 3];
            }
        }
      }
    }
    if (act) {
#pragma unroll
      for (int mi = 0; mi < 2; ++mi) {
        bf16_t* op = p.MIX() + (size_t)(m0 + wm * 64 + mi * 32 + r) * 1024 + n0 + wn * 64 + 4 * h;
#pragma unroll
        for (int ni = 0; ni < 2; ++ni)
#pragma unroll
          for (int i4 = 0; i4 < 4; ++i4) {
            uint2 w;
            w.x = pk2(outv[mi][ni][i4 * 4 + 0], outv[mi][ni][i4 * 4 + 1]);
            w.y = pk2(outv[mi][ni][i4 * 4 + 2], outv[mi][ni][i4 * 4 + 3]);
            *reinterpret_cast<uint2*>(op + ni * 32 + i4 * 8) = w;
          }
      }
    }
  }
  constexpr int NTC = 2 * 16 * 4;
  const int nitc = (L == 3) ? 0 : (NTC + vgrid - 1) / vgrid;
  for (int it = 0; it < nitc; ++it) {
    int item = it * vgrid + vb;
    const bool act = item < NTC;
    if (!act) item = NTC - 1;
    const int kb = item & 3, nt = (item >> 2) & 15, mt = item >> 6;
    const int m0 = NLAT + mt * 128, n0 = nt * 64;
    f32x16 acc[2][1];
    zero_acc<1>(acc);
    const int gc = (kb == 0) ? C_S5G : (kb == 1 ? C_CG : (kb == 2 ? C_NG : C_GG));
    gemm_main<1, true>(acc, p.Z() + (size_t)m0 * LDZ + gc, LDZ, (vt & 7) * 8, 64,
                       p.WbrT() + (size_t)(L * 4 + kb) * 1024 * 512 + (size_t)n0 * 512, 512, 512, smv, vt, act);
    if (act) {
#pragma unroll
      for (int mi = 0; mi < 2; ++mi) {
        const int row = m0 + wm * 64 + mi * 32 + r;
        const bf16_t* sgp = p.SG() + sg_index(row, kb * 1024 + n0 + wn * 32 + 4 * h);
        bf16_t* op = p.PCTX() + (size_t)kb * 256 * 1024 + (size_t)(row - NLAT) * 1024 + n0 + wn * 32 + 4 * h;
#pragma unroll
        for (int i4 = 0; i4 < 4; ++i4) {
          uint2 sv = *reinterpret_cast<const uint2*>(sgp + (i4 * 2) * 128);
          uint2 w;
          w.x = pk2(lo_bf(sv.x) * acc[mi][0][i4 * 4 + 0], hi_bf(sv.x) * acc[mi][0][i4 * 4 + 1]);
          w.y = pk2(lo_bf(sv.y) * acc[mi][0][i4 * 4 + 2], hi_bf(sv.y) * acc[mi][0][i4 * 4 + 3]);
          *reinterpret_cast<uint2*>(op + i4 * 8) = w;
        }
      }
    }
  }
}

DI void phase_out(const Params& p, int b, int L, unsigned char* smraw, int tid) {
  {
    pg8::StaticOrder S;
    S.init(NLAT, 1024, gridDim.x, blockIdx.x);
    pg8::Gemm g{p.MIX(), p.WoutT() + (size_t)L * 1024 * 1024, NLAT, 1024, 1024};
    EpiOutRes E{(L == 0 ? p.x : (const float*)p.out) + (size_t)b * NLAT * 1024, p.out + (size_t)b * NLAT * 1024,
                p.MOD() + (L * 3 + b) * 3072 + 2048};
    pg8::gemm_phase<EpiOutRes, pg8::StaticOrder, false>(LDS3(smraw), g, S, E, nullptr);
  }
  if (L == 3) return;
  __syncthreads();
  bf16_t* sm = reinterpret_cast<bf16_t*>(smraw);
  VSUB_SETUP
  constexpr int NT = 2 * 8;
  const int nit = (NT + vgrid - 1) / vgrid;
  for (int it = 0; it < nit; ++it) {
    int tile = it * vgrid + vb;
    const bool act = tile < NT;
    if (!act) tile = NT - 1;
    const int mt = tile >> 3, nt = tile & 7;
    const int m0 = NLAT + mt * 128, n0 = nt * 128;
    f32x16 acc[2][2];
    zero_acc<2>(acc);
    {
      const bf16_t* Ab = p.PCTX() + (size_t)(m0 - NLAT) * 1024;
      gemm_main<2, false, false, true>(acc, Ab, 1024, (vt & 7) * 8, 64, p.WoutT() + (size_t)L * 1024 * 1024 + (size_t)n0 * 1024,
                                       1024, 1024, smv, vt, act, (size_t)256 * 1024);
    }
    if (act) {
      const float* src = (L == 0 ? p.ctx : (const float*)p.CTXS()) + ((size_t)b * 256 + (m0 - NLAT)) * 1024;
      float* dst = p.CTXS() + ((size_t)b * 256 + (m0 - NLAT)) * 1024;
      const float* gate = p.MOD() + (L * 3 + 2) * 3072 + 2048;
#pragma unroll
      for (int ni = 0; ni < 2; ++ni) {
        const int col = n0 + wn * 64 + ni * 32 + r;
        const float gt = gate[col];
#pragma unroll
        for (int mi = 0; mi < 2; ++mi) {
          float xs[16];
#pragma unroll
          for (int i = 0; i < 16; ++i) xs[i] = src[(size_t)(wm * 64 + mi * 32 + crow(i, h)) * 1024 + col];
#pragma unroll
          for (int i = 0; i < 16; ++i) dst[(size_t)(wm * 64 + mi * 32 + crow(i, h)) * 1024 + col] = xs[i] + gt * acc[mi][ni][i];
        }
      }
    }
  }
}

#define XB_TMO      128
#define XB_XCNT(j)  (256  + 64 * (j))
#define XB_XSUB(j)  (1280 + 64 * (j))
#define XB_XGEN(j)  (2304 + 64 * (j))
#define XB_TOP      3328
#define XB_TOPGEN   3392
#define XCD_BAR_WORDS 3456
#define XB_SPIN_CAP (1u << 18)
#define LAS __attribute__((address_space(3)))

__device__ __forceinline__ unsigned xb_ld(unsigned* p)              { return __hip_atomic_load(p, __ATOMIC_RELAXED, __HIP_MEMORY_SCOPE_AGENT); }
__device__ __forceinline__ unsigned xb_add(unsigned* p, unsigned v) { return __hip_atomic_fetch_add(p, v, __ATOMIC_RELAXED, __HIP_MEMORY_SCOPE_AGENT); }
__device__ __forceinline__ unsigned xb_xcc_id() { return (unsigned)__builtin_amdgcn_s_getreg((3 << 11) | 20) & 0xFu; }
#define XB_SPIN(cond, bar) do { unsigned _sp = 0; while (cond) { __builtin_amdgcn_s_sleep(1); \
    if ((++_sp & 255u) == 0u) { if (xb_ld(&(bar)[XB_TMO])) break; if (_sp > XB_SPIN_CAP) { atomicAdd(&(bar)[XB_TMO], 1u); break; } } } } while (0)

struct XcdBarrier {
    unsigned* bar; unsigned x;
    volatile LAS unsigned* st;
};

__device__ __forceinline__ XcdBarrier xcd_barrier_post(unsigned* bar, volatile LAS unsigned* st) {
    XcdBarrier b; b.bar = bar; b.x = xb_xcc_id(); b.st = st;
    if (threadIdx.x == 0) (void)xb_add(&bar[XB_XCNT(b.x)], 1u);
    return b;
}
__device__ __forceinline__ void xcd_barrier_complete(unsigned* bar, unsigned x, unsigned& nloc, unsigned& nx) {
    const unsigned G = gridDim.x * gridDim.y * gridDim.z;
    unsigned sum, cnt, mine, sp = 0u;
    for (;;) {
        sum = 0u; cnt = 0u; mine = 0u;
#pragma unroll
        for (unsigned j = 0; j < 16; ++j) { const unsigned c = xb_ld(&bar[XB_XCNT(j)]); sum += c; cnt += (c > 0u) ? 1u : 0u; mine = (j == x) ? c : mine; }
        if (sum == G) break;
        __builtin_amdgcn_s_sleep(1);
        if ((++sp & 255u) == 0u) { if (xb_ld(&bar[XB_TMO])) break; if (sp > XB_SPIN_CAP) { atomicAdd(&bar[XB_TMO], 1u); break; } }
    }
    nloc = mine > 0u ? mine : 1u; nx = cnt > 0u ? cnt : 1u;
}

__device__ __forceinline__ void xcd_barrier(const XcdBarrier& b) {
    asm volatile("s_waitcnt vmcnt(0)" ::: "memory");
    __syncthreads();
    if (threadIdx.x == 0) {
        unsigned* bar = b.bar;
        __builtin_amdgcn_s_waitcnt(0);
        unsigned nloc = b.st[0], nx = b.st[1];
        if (nloc == 0u) { xcd_barrier_complete(bar, b.x, nloc, nx); b.st[0] = nloc; b.st[1] = nx; }
        const unsigned old = xb_add(&bar[XB_XSUB(b.x)], 1u);
        const unsigned gen = old / nloc;
        if (old + 1u == (gen + 1u) * nloc) {
            __builtin_amdgcn_fence(__ATOMIC_RELEASE, "agent");
            asm volatile("s_waitcnt vmcnt(0)" ::: "memory");
            const unsigned og = xb_add(&bar[XB_TOP], 1u);
            const unsigned tg = og / nx;
            if (og + 1u == (tg + 1u) * nx) xb_add(&bar[XB_TOPGEN], 1u);
            else XB_SPIN(xb_ld(&bar[XB_TOPGEN]) == tg, bar);
            __builtin_amdgcn_fence(__ATOMIC_ACQUIRE, "agent");
            xb_add(&bar[XB_XGEN(b.x)], 1u);
            asm volatile("s_waitcnt vmcnt(0)" ::: "memory");
        } else {
            XB_SPIN(xb_ld(&bar[XB_XGEN(b.x)]) == gen, bar);
            __builtin_amdgcn_fence(__ATOMIC_ACQUIRE, "agent");
            asm volatile("s_waitcnt vmcnt(0)" ::: "memory");
        }
    }
    __syncthreads();
}


__global__ void __launch_bounds__(512, 2) mega_kernel(Params p, int ph_lo, int ph_hi) {
  __shared__ __attribute__((aligned(1024))) unsigned char smem_raw[151552];
  __shared__ uint4 xb_words;
  bf16_t* smb = reinterpret_cast<bf16_t*>(smem_raw);
  float* smf = reinterpret_cast<float*>(smem_raw);
  if (threadIdx.x == 0) xb_words = make_uint4(0u, 0u, 0u, 0u);
  __syncthreads();
  XcdBarrier xb = xcd_barrier_post(p.bar, (volatile LAS unsigned*)&xb_words);
  if (ph_hi < 0) cg::this_grid().sync();
  for (int ph = ph_lo; ph < ph_hi; ++ph) {
    int tid = threadIdx.x;
    asm volatile("" : "+v"(tid));
    if (ph == 0) {
      phase_prep(p, smf, tid);
    } else {
      const int q = ph - 1;
      const int b = q >> 5, L = (q & 31) >> 3, sub = q & 7;
      switch (sub) {
        case 0: phase_norm(p, b, L, tid); break;
        case 1: phase_p1(p, b, L, smem_raw); break;
        case 2: phase_s5e_conv_post(p, b, L, smb, tid); break;
        case 3: phase_attn_scan(p, b, L, smf, tid); break;
        case 4: phase_s5y(p, b, L, smb, tid); break;
        case 5: phase_glu(p, b, L, smem_raw); break;
        case 6: phase_merge(p, b, L, smb, tid); break;
        default: phase_out(p, b, L, smem_raw, tid); break;
      }
    }
    if (ph + 1 < ph_hi) xcd_barrier(xb);
  }
}

extern "C" void kernel_launch(void* const* d_in, const int* in_sizes, int n_in, void* d_out, int out_size, void* d_ws,
                              size_t ws_size, hipStream_t stream) {
  Params p{};
  const float** fp = reinterpret_cast<const float**>(&p);
  for (int i = 0; i < 27; ++i) fp[i] = (const float*)d_in[i];
  p.out = (float*)d_out;
  p.ws = (char*)d_ws;
  p.bar = (unsigned*)((char*)d_ws + OFF_BAR);
  if (WS_TOTAL > ws_size) {
    fprintf(stderr, "workspace too small: need %zu have %zu\n", (size_t)WS_TOTAL, ws_size);
    return;
  }
  static int grid_blocks = 0;
  if (!grid_blocks) {
    int dev = 0, cus = 0, per_cu = 0;
    (void)hipGetDevice(&dev);
    (void)hipDeviceGetAttribute(&cus, hipDeviceAttributeMultiprocessorCount, dev);
    (void)hipOccupancyMaxActiveBlocksPerMultiprocessor(&per_cu, mega_kernel, 512, 0);
    if (per_cu > 1) per_cu = 1;
    if (per_cu < 1) per_cu = 1;
    grid_blocks = cus * per_cu;
  }
  (void)hipMemsetAsync(p.bar, 0, 4096 * 4, stream);
#if MULTI_LAUNCH
  for (int ph = 0; ph < NPHASE; ++ph) {
    hipLaunchKernelGGL(mega_kernel, dim3(grid_blocks), dim3(512), 0, stream, p, ph, ph + 1);
  }
#else
  int lo = 0, hi = NPHASE;
  void* args[] = {&p, &lo, &hi};
  hipError_t e = hipLaunchCooperativeKernel((void*)mega_kernel, dim3(grid_blocks), dim3(512), args, 0, stream);
  if (e != hipSuccess) fprintf(stderr, "cooperative launch failed: %s (grid %d)\n", hipGetErrorString(e), grid_blocks);
#endif
}
```

```cpp
#include <hip/hip_runtime.h>
#include <hip/hip_cooperative_groups.h>
#include <cstdio>
namespace cg = cooperative_groups;

#ifdef ONLY
#define ONLYP(i) (ONLY == (i))
#else
#define ONLYP(i) 1
#endif
#ifndef MULTI_LAUNCH
#define MULTI_LAUNCH 0
#endif

#define DI __device__ __forceinline__
typedef unsigned short bf16_t;
typedef __attribute__((ext_vector_type(8))) short bf16x8;
typedef __attribute__((ext_vector_type(16))) float f32x16;
typedef __attribute__((ext_vector_type(2))) float f32x2;
typedef __attribute__((ext_vector_type(2))) __bf16 bfx2;
#define MFMA32(a, b, c) __builtin_amdgcn_mfma_f32_32x32x16_bf16((a), (b), (c), 0, 0, 0)

constexpr int R = 16640;
constexpr int NLAT = 16384;
constexpr int LDZ = 6400;
constexpr int LDT = 16640;
constexpr int NCH = 1040;
constexpr float LOG2E = 1.4426950408889634f;
constexpr int C_S5U = 0, C_S5G = 512, C_CV = 1024, C_CB = 1536, C_CC = 2048, C_CG = 2560, C_NQ = 3072, C_NK = 3584,
              C_NV = 4096, C_NG = 4608, C_GQ = 5120, C_GK = 5632, C_GV = 5760, C_GG = 5888;
constexpr int NPHASE = 1 + 2 * 4 * 8;

constexpr size_t al256(size_t x) { return (x + 255) & ~(size_t)255; }
constexpr size_t OFF_H = 0;
constexpr size_t OFF_Z = OFF_H + al256((size_t)R * 1024 * 2);
constexpr size_t OFF_VTN = OFF_Z + al256((size_t)R * LDZ * 2);
constexpr size_t OFF_VTG = OFF_VTN + al256((size_t)512 * LDT * 2);
constexpr size_t OFF_Y = OFF_VTG + al256((size_t)128 * LDT * 2);
constexpr size_t OFF_HIN = OFF_Y + al256((size_t)R * 512 * 2);
constexpr size_t OFF_E = OFF_HIN + al256((size_t)NCH * 8192 * 2);
constexpr size_t OFF_MIX = OFF_E;
constexpr size_t OFF_SG = OFF_E + al256((size_t)R * 1024 * 2);
constexpr size_t OFF_CTXS = OFF_SG + al256((size_t)R * 4096 * 2);
constexpr size_t OFF_WINT = OFF_CTXS + al256((size_t)512 * 1024 * 4);
constexpr size_t OFF_WBRT = OFF_WINT + al256((size_t)4 * 10496 * 1024 * 2);
constexpr size_t OFF_WOUTT = OFF_WBRT + al256((size_t)16 * 1024 * 512 * 2);
constexpr size_t OFF_WGLUT = OFF_WOUTT + al256((size_t)4 * 1024 * 1024 * 2);
constexpr size_t OFF_S5M = OFF_WGLUT + al256((size_t)4 * 512 * 512 * 2);
constexpr size_t OFF_S5WE = OFF_S5M + al256((size_t)128 * 65536 * 2);
constexpr size_t OFF_S5R = OFF_S5WE + al256((size_t)128 * 65536 * 2);
constexpr size_t OFF_A16 = OFF_S5R + al256((size_t)128 * 65536 * 2);
constexpr size_t OFF_MOD = OFF_A16 + al256((size_t)4 * 2 * 32 * 64 * 2 * 4);
constexpr size_t OFF_ROPE = OFF_MOD + al256((size_t)4 * 3 * 3072 * 4);
constexpr size_t OFF_BAR = OFF_ROPE + al256((size_t)256 * 16 * 2 * 4 + 64);
constexpr size_t OFF_PCTX = OFF_BAR + al256((size_t)4096 * 4);
constexpr size_t WS_TOTAL = OFF_PCTX + al256((size_t)4 * 256 * 1024 * 2);

struct Params {
  const float *x, *c, *ctx, *c_ctx, *norm_g, *w_ada, *b_ada, *w_in, *s5_a_re, *s5_a_im, *s5_log_dt, *s5_b_re, *s5_b_im,
      *s5_c_re, *s5_c_im, *s5_d, *s5_w_glu, *conv_w, *conv_b, *na_q_g, *na_k_g, *na_rel_bias, *gqa_q_g, *gqa_k_g, *gqa_sink,
      *w_br, *w_out;
  float* out;
  char* ws;
  unsigned* bar;
  DI bf16_t* H() const { return (bf16_t*)(ws + OFF_H); }
  DI bf16_t* Z() const { return (bf16_t*)(ws + OFF_Z); }
  DI bf16_t* VtN() const { return (bf16_t*)(ws + OFF_VTN); }
  DI bf16_t* VtG() const { return (bf16_t*)(ws + OFF_VTG); }
  DI bf16_t* Y() const { return (bf16_t*)(ws + OFF_Y); }
  DI bf16_t* MIX() const { return (bf16_t*)(ws + OFF_MIX); }
  DI bf16_t* HIN() const { return (bf16_t*)(ws + OFF_HIN); }
  DI float* E() const { return (float*)(ws + OFF_E); }
  DI float* CTXS() const { return (float*)(ws + OFF_CTXS); }
  DI bf16_t* WinT() const { return (bf16_t*)(ws + OFF_WINT); }
  DI bf16_t* SG() const { return (bf16_t*)(ws + OFF_SG); }
  DI bf16_t* PCTX() const { return (bf16_t*)(ws + OFF_PCTX); }
  DI bf16_t* WbrT() const { return (bf16_t*)(ws + OFF_WBRT); }
  DI bf16_t* WoutT() const { return (bf16_t*)(ws + OFF_WOUTT); }
  DI bf16_t* WgluT() const { return (bf16_t*)(ws + OFF_WGLUT); }
  DI bf16_t* S5M() const { return (bf16_t*)(ws + OFF_S5M); }
  DI bf16_t* S5We() const { return (bf16_t*)(ws + OFF_S5WE); }
  DI bf16_t* S5R() const { return (bf16_t*)(ws + OFF_S5R); }
  DI float* A16() const { return (float*)(ws + OFF_A16); }
  DI float* MOD() const { return (float*)(ws + OFF_MOD); }
  DI float* ROPE() const { return (float*)(ws + OFF_ROPE); }
};

DI float bf2f(bf16_t v) { return __uint_as_float(((unsigned)v) << 16); }
DI unsigned pk2(float a, float b) {
  f32x2 v = {a, b};
  bfx2 r = __builtin_convertvector(v, bfx2);
  return __builtin_bit_cast(unsigned, r);
}
DI bf16_t f2bf(float a) { return (bf16_t)(pk2(a, 0.f) & 0xffffu); }
DI float lo_bf(unsigned u) { return __uint_as_float(u << 16); }
DI float hi_bf(unsigned u) { return __uint_as_float(u & 0xffff0000u); }
DI float sigmoidf_(float x) { return 1.f / (1.f + __expf(-x)); }
DI float siluf_(float x) { return x / (1.f + __expf(-x)); }
DI size_t sg_index(int row, int col) { return ((size_t)((row >> 5) * 1024 + (col >> 2)) * 32 + (row & 31)) * 4 + (col & 3); }
DI int crow(int i, int h) { return (i & 3) + 8 * (i >> 2) + 4 * h; }
DI bf16x8 ld16(const bf16_t* p) { return *reinterpret_cast<const bf16x8*>(p); }


namespace pg8 {
typedef unsigned short bf16_t;
#define PG8_LAS __attribute__((address_space(3)))
typedef short bf16x8 __attribute__((ext_vector_type(8)));
typedef float f32x4 __attribute__((ext_vector_type(4)));
typedef unsigned u32x4 __attribute__((ext_vector_type(4)));
constexpr int BM = 256, BK = 64, HALF = 128, HTB = HALF * BK * 2  , STAGE_BYTES = 8 * HTB, NXCD = 8, WGM = 8;

__host__ __device__ __forceinline__ int lds_byte(int r, int c) { const int st = (r >> 4) * 2 + (c >> 5), rr = r & 15, cc = c & 31, ob = rr * 64 + cc * 2; return st * 1024 + (ob ^ (((ob >> 9) & 1) << 5)); }
__host__ __device__ __forceinline__ void stage_rc(int b, int& R, int& C) { const int st = b / 1024, sb = b % 1024, swz = sb ^ (((sb >> 9) & 1) << 5); R = (st >> 1) * 16 + swz / 64; C = (st & 1) * 32 + (swz % 64) / 2; }
__host__ __device__ __forceinline__ int perm32(int rho) { const int n = rho >> 4, i = rho & 15; return 8 * (i >> 2) + 4 * n + (i & 3); }

struct Unit { int pm, pn; };
struct Gemm { const bf16_t* A; const bf16_t* Bt; int M, N, K; };

struct StaticOrder {
    int nM, nN, nwg, G, c;
    __host__ __device__ void init(int M, int N, int G_, int c_) { nM = M / BM; nN = N / BM; nwg = nM * nN; G = G_; c = c_; }
    __host__ __device__ bool next(int i, Unit& u) const {
        const long L = (long)i * G + c; if (L >= nwg) return false;
        int wgid = (int)L; { const int q = nwg / NXCD, r = nwg % NXCD, xcd = wgid % NXCD, off = wgid / NXCD; wgid = (xcd < r ? xcd * (q + 1) : r * (q + 1) + (xcd - r) * q) + off; }
        const int nig = WGM * nN, gid = wgid / nig, fm = gid * WGM, gsz = (nM - fm) < WGM ? (nM - fm) : WGM;
        u.pm = fm + ((wgid % nig) % gsz); u.pn = (wgid % nig) / gsz; return true;
    }
    __device__ __forceinline__ void a_ready(const Unit&) const {}
    __device__ __forceinline__ void done(const Unit&) const {}
};
struct CountedOrder : StaticOrder {
    const unsigned* ready; unsigned need; unsigned* tmo;
    __device__ __forceinline__ void a_ready(const Unit& u) const {
        if (threadIdx.x < 64) {
            const unsigned long long t0 = __builtin_amdgcn_s_memrealtime(); unsigned polls = 0;
            while ((unsigned)__builtin_amdgcn_readfirstlane(__hip_atomic_load(ready + 64 * u.pm, __ATOMIC_RELAXED, __HIP_MEMORY_SCOPE_AGENT)) < need) {
                if ((++polls & 255u) == 0u && __builtin_amdgcn_readfirstlane(__hip_atomic_load(tmo, __ATOMIC_RELAXED, __HIP_MEMORY_SCOPE_AGENT)) != 0u) break;
                if (__builtin_amdgcn_s_memrealtime() - t0 > 2000000ull) {
                    if (threadIdx.x == 0) { unsigned expect = 0u; __hip_atomic_compare_exchange_strong(tmo + 1, &expect, 0x600u | (unsigned)(u.pm & 0xff), __ATOMIC_RELAXED, __ATOMIC_RELAXED, __HIP_MEMORY_SCOPE_AGENT); __hip_atomic_store(tmo, 1u, __ATOMIC_RELAXED, __HIP_MEMORY_SCOPE_AGENT); }
                    break; }
                __builtin_amdgcn_s_sleep(2); }
            __builtin_amdgcn_fence(__ATOMIC_ACQUIRE, "agent");
            asm volatile("s_waitcnt vmcnt(0)" ::: "memory");
        }
#if !defined(BROKEN_HOOK_NO_BARRIER)
        asm volatile("" ::: "memory"); __builtin_amdgcn_s_barrier(); asm volatile("" ::: "memory");
#endif
    }
};

__device__ __forceinline__ unsigned cvt_pk_bf16(float lo, float hi) { unsigned r; asm volatile("v_cvt_pk_bf16_f32 %0, %1, %2" : "=v"(r) : "v"(lo), "v"(hi)); return r; }
typedef float f32x2 __attribute__((ext_vector_type(2)));
__device__ __forceinline__ f32x2 gelu_pk(f32x2 v) {
    const f32x2 av = __builtin_elementwise_abs(v), d = av * 0.2316418882f + 1.0f;
    f32x2 t; t.x = __builtin_amdgcn_rcpf(d.x); t.y = __builtin_amdgcn_rcpf(d.y);
    f32x2 q = t * 0.5307027145f + (-0.7265760135f); q = q * t + 0.7107068705f; q = q * t + (-0.142248368f); q = q * t + 0.127414796f; q = q * t;
    const f32x2 s = (v * v) * (-0.72134752044f);
    f32x2 e; e.x = __builtin_amdgcn_exp2f(s.x); e.y = __builtin_amdgcn_exp2f(s.y);
    const f32x2 m = v * (q * e), r = v - m;
    f32x2 o; o.x = v.x < 0.f ? m.x : r.x; o.y = v.y < 0.f ? m.y : r.y; return o;
}

struct EpiF32 {
    static constexpr bool PERM = false, AFTER_DRAIN = false;
    float* C; int ldc; const float* bias;
    __device__ __forceinline__ void operator()(const f32x4 (&acc)[2][2][4][2], const Unit& u, int wr, int wc, int fr, int fq) const {
        const int row0 = u.pm * BM + wr * 64 + fr, col0 = u.pn * BM + wc * 32 + 4 * fq;
        f32x4 bv[2][2];
#pragma unroll
        for (int bj = 0; bj < 2; ++bj)
#pragma unroll
            for (int n = 0; n < 2; ++n) bv[bj][n] = bias ? *(const f32x4*)(bias + col0 + bj * HALF + n * 16) : (f32x4){0.f, 0.f, 0.f, 0.f};
#pragma unroll
        for (int ai = 0; ai < 2; ++ai)
#pragma unroll
            for (int m = 0; m < 4; ++m) { float* rowp = C + (size_t)(row0 + ai * HALF + m * 16) * ldc + col0;
#pragma unroll
                for (int bj = 0; bj < 2; ++bj)
#pragma unroll
                    for (int n = 0; n < 2; ++n) *(f32x4*)(rowp + bj * HALF + n * 16) = acc[ai][bj][m][n] + bv[bj][n]; }
    }
};
template <int ACT  > struct EpiBf16 {
    static constexpr bool PERM = true, AFTER_DRAIN = false;
    bf16_t* O; int ldc; const float* bias; int split_cols; size_t split_stride;
    __device__ __forceinline__ void operator()(const f32x4 (&acc)[2][2][4][2], const Unit& u, int wr, int wc, int fr, int fq) const {
        const int row0 = u.pm * BM + wr * 64 + fr; int colt = u.pn * BM; bf16_t* base = O;
        if (split_cols) { const int t = colt / split_cols; base += (size_t)t * split_stride; colt -= t * split_cols; }
        const int col0 = colt + wc * 32 + 8 * fq, bcol0 = u.pn * BM + wc * 32 + 8 * fq;
        f32x4 bv[2][2];
#pragma unroll
        for (int bj = 0; bj < 2; ++bj)
#pragma unroll
            for (int n = 0; n < 2; ++n) bv[bj][n] = bias ? *(const f32x4*)(bias + bcol0 + bj * HALF + 4 * n) : (f32x4){0.f, 0.f, 0.f, 0.f};
#pragma unroll
        for (int ai = 0; ai < 2; ++ai)
#pragma unroll
            for (int m = 0; m < 4; ++m) { bf16_t* rowp = base + (size_t)(row0 + ai * HALF + m * 16) * ldc + col0;
#pragma unroll
                for (int bj = 0; bj < 2; ++bj) { f32x4 v0 = acc[ai][bj][m][0] + bv[bj][0], v1 = acc[ai][bj][m][1] + bv[bj][1];
                    if (ACT == 1) { f32x2 a = gelu_pk((f32x2){v0[0], v0[1]}), b = gelu_pk((f32x2){v0[2], v0[3]}), c = gelu_pk((f32x2){v1[0], v1[1]}), d = gelu_pk((f32x2){v1[2], v1[3]});
                        v0 = (f32x4){a.x, a.y, b.x, b.y}; v1 = (f32x4){c.x, c.y, d.x, d.y}; }
                    if (ACT == 2) {
#pragma unroll
                        for (int j = 0; j < 4; ++j) { v0[j] = 0.5f * v0[j] * (1.0f + erff(v0[j] * 0.70710678f)); v1[j] = 0.5f * v1[j] * (1.0f + erff(v1[j] * 0.70710678f)); } }
                    u32x4 w; w.x = cvt_pk_bf16(v0[0], v0[1]); w.y = cvt_pk_bf16(v0[2], v0[3]); w.z = cvt_pk_bf16(v1[0], v1[1]); w.w = cvt_pk_bf16(v1[2], v1[3]);
                    *(u32x4*)(rowp + bj * HALF) = w; } }
    }
};

struct PanelStats {
    unsigned* xbuf;
    unsigned* cnt;
    unsigned* tmo;
    int ntn; float eps;
    unsigned code;
    __device__ __forceinline__ bool run(const f32x4 (&v)[2][2][4][2], const Unit& u, int wr, int wc, int fr, int fq, PG8_LAS unsigned char* lds, int wid, int lane) const {
        typedef float f32x2v __attribute__((ext_vector_type(2)));
        PG8_LAS f32x2v* P = (PG8_LAS f32x2v*)lds;
        PG8_LAS f32x2v* S = (PG8_LAS f32x2v*)(lds + 8192);
        PG8_LAS unsigned* flag = (PG8_LAS unsigned*)(lds + 8192 + 2048);
#pragma unroll
        for (int ai = 0; ai < 2; ++ai)
#pragma unroll
            for (int m = 0; m < 4; ++m) {
                float s = 0.f;
#pragma unroll
                for (int bj = 0; bj < 2; ++bj)
#pragma unroll
                    for (int n = 0; n < 2; ++n) { const f32x4 x = v[ai][bj][m][n]; s += (x[0] + x[1]) + (x[2] + x[3]); }
                s += __shfl_xor(s, 16); s += __shfl_xor(s, 32);
                const float mw = s * (1.0f / 64.0f); float q = 0.f;
#pragma unroll
                for (int bj = 0; bj < 2; ++bj)
#pragma unroll
                    for (int n = 0; n < 2; ++n) { const f32x4 d = v[ai][bj][m][n] - mw; q += (d[0] * d[0] + d[1] * d[1]) + (d[2] * d[2] + d[3] * d[3]); }
                q += __shfl_xor(q, 16); q += __shfl_xor(q, 32);
                if (fq == 0) P[(ai * HALF + wr * 64 + m * 16 + fr) * 4 + wc] = (f32x2v){mw, q};
            }
        asm volatile("s_waitcnt lgkmcnt(0)" ::: "memory"); __builtin_amdgcn_s_barrier(); asm volatile("" ::: "memory");
#if defined(BROKEN_NO_WAIT)
        if (blockIdx.x >= 64) { const long long t0 = clock64(); while (clock64() - t0 < 60000) __builtin_amdgcn_s_sleep(8); }
#endif
        const int row = wid * 32 + (lane & 31);
        if (lane < 32) {
            const f32x2v a = P[row * 4 + 0], b = P[row * 4 + 1], c = P[row * 4 + 2], d = P[row * 4 + 3];
            const float mt = (a.x + b.x + c.x + d.x) * 0.25f;
            const float da = a.x - mt, db = b.x - mt, dc = c.x - mt, dd = d.x - mt;
            const float m2 = (a.y + b.y) + (c.y + d.y) + 64.0f * ((da * da + db * db) + (dc * dc + dd * dd));
            unsigned long long* slot = (unsigned long long*)xbuf + ((size_t)(u.pm * BM + row) * 4 + u.pn);
            __hip_atomic_store(slot, ((unsigned long long)__float_as_uint(m2) << 32) | __float_as_uint(mt), __ATOMIC_RELAXED, __HIP_MEMORY_SCOPE_AGENT);
        }
        asm volatile("s_waitcnt vmcnt(0)" ::: "memory");
        if (lane == 0) __hip_atomic_fetch_add(cnt + 64 * u.pm, 1u, __ATOMIC_RELAXED, __HIP_MEMORY_SCOPE_AGENT);
        if (wid == 0) {
            bool dead = false; const unsigned long long t0 = __builtin_amdgcn_s_memrealtime(); const unsigned want = 8u * (unsigned)ntn;
            for (;;) {
#if defined(BROKEN_NO_WAIT)
                break;
#endif
                if ((unsigned)__builtin_amdgcn_readfirstlane(__hip_atomic_load(cnt + 64 * u.pm, __ATOMIC_RELAXED, __HIP_MEMORY_SCOPE_AGENT)) >= want) break;
                if (__builtin_amdgcn_s_memrealtime() - t0 > 2000000ull) {
                    if (lane == 0) { unsigned expect = 0u; __hip_atomic_compare_exchange_strong(tmo + 1, &expect, code | (unsigned)(u.pm & 0xff), __ATOMIC_RELAXED, __ATOMIC_RELAXED, __HIP_MEMORY_SCOPE_AGENT);
                                     __hip_atomic_store(tmo, 1u, __ATOMIC_RELAXED, __HIP_MEMORY_SCOPE_AGENT); }
                    dead = true; break; }
                __builtin_amdgcn_s_sleep(2);
            }
            __builtin_amdgcn_fence(__ATOMIC_ACQUIRE, "agent");
            if (lane == 0) flag[0] = dead ? 1u : 0u;
        }
        asm volatile("s_waitcnt vmcnt(0) lgkmcnt(0)" ::: "memory"); __builtin_amdgcn_s_barrier(); asm volatile("" ::: "memory");
        const bool bad = flag[0] != 0u;
        if (lane < 32) {
            const unsigned long long* slot = (const unsigned long long*)xbuf + (size_t)(u.pm * BM + row) * 4; float mt[4], m2[4]; float ms = 0.f;
#pragma unroll
            for (int t = 0; t < 4; ++t) { if (t < ntn) { const unsigned long long w = __hip_atomic_load(slot + t, __ATOMIC_RELAXED, __HIP_MEMORY_SCOPE_AGENT); mt[t] = __uint_as_float((unsigned)w); m2[t] = __uint_as_float((unsigned)(w >> 32)); } else { mt[t] = 0.f; m2[t] = 0.f; } ms += mt[t]; }
            const float mean = ms / (float)ntn; float q = 0.f;
#pragma unroll
            for (int t = 0; t < 4; ++t) if (t < ntn) { const float dm = mt[t] - mean; q += m2[t] + 256.0f * dm * dm; }
            S[row] = (f32x2v){mean, 1.0f / sqrtf(q / (256.0f * (float)ntn) + eps)};
        }
        asm volatile("s_waitcnt lgkmcnt(0)" ::: "memory"); __builtin_amdgcn_s_barrier(); asm volatile("" ::: "memory");
        return bad;
    }
};
struct EpiLnRes {
    static constexpr bool PERM = false, AFTER_DRAIN = true;
    const float* base; float* out; int ldc; const float* bias; PanelStats st; unsigned poison;
    __device__ __forceinline__ void refuse(size_t i0, size_t stride, int M, int N) const { const float q = __builtin_nanf(""); for (size_t i = i0; i < (size_t)M * N; i += stride) out[(i / N) * ldc + i % N] = q;
        if (i0 == 0) { unsigned expect = 0u; __hip_atomic_compare_exchange_strong(st.tmo + 1, &expect, 0x7f0u, __ATOMIC_RELAXED, __ATOMIC_RELAXED, __HIP_MEMORY_SCOPE_AGENT); __hip_atomic_store(st.tmo, 1u, __ATOMIC_RELAXED, __HIP_MEMORY_SCOPE_AGENT); } }
    __device__ __forceinline__ void fused(f32x4 (&acc)[2][2][4][2], const Unit& u, int wr, int wc, int fr, int fq, PG8_LAS unsigned char* lds, int wid, int lane) const {
        typedef float f32x2v __attribute__((ext_vector_type(2)));
        const PG8_LAS f32x2v* S = (const PG8_LAS f32x2v*)(lds + 8192);
        const int col0 = u.pn * BM + wc * 32 + 4 * fq;
#pragma unroll
        for (int bj = 0; bj < 2; ++bj)
#pragma unroll
            for (int n = 0; n < 2; ++n) { const f32x4 bv = bias ? *(const f32x4*)(bias + col0 + bj * HALF + n * 16) : (f32x4){0.f, 0.f, 0.f, 0.f};
#pragma unroll
                for (int ai = 0; ai < 2; ++ai)
#pragma unroll
                    for (int m = 0; m < 4; ++m) acc[ai][bj][m][n] += bv; }
        const bool bad = st.run(acc, u, wr, wc, fr, fq, lds, wid, lane) || poison != 0u;
        const float qnan = __builtin_nanf("");
#pragma unroll
        for (int ai = 0; ai < 2; ++ai)
#pragma unroll
            for (int m = 0; m < 4; ++m) { const int r = ai * HALF + wr * 64 + m * 16 + fr; const f32x2v sr = S[r]; const size_t off = (size_t)(u.pm * BM + r) * ldc + col0;
#pragma unroll
                for (int bj = 0; bj < 2; ++bj)
#pragma unroll
                    for (int n = 0; n < 2; ++n) { const f32x4 bs = *(const f32x4*)(base + off + bj * HALF + n * 16); f32x4 o = bs + (acc[ai][bj][m][n] - sr.x) * sr.y;
                        if (bad) o = (f32x4){qnan, qnan, qnan, qnan}; *(f32x4*)(out + off + bj * HALF + n * 16) = o; }
                asm volatile("" ::: "memory"); }
    }
};
struct EpiLnResLn {
    static constexpr bool PERM = false, AFTER_DRAIN = true;
    const float* base; float* out; bf16_t* xn; int ldc; const float* bias; PanelStats st1, st2; unsigned poison;
    __device__ __forceinline__ void refuse(size_t i0, size_t stride, int M, int N) const { const float q = __builtin_nanf(""); for (size_t i = i0; i < (size_t)M * N; i += stride) { const size_t o = (i / N) * ldc + i % N; out[o] = q; xn[o] = (bf16_t)0x7fc0u; }
        if (i0 == 0) { unsigned expect = 0u; __hip_atomic_compare_exchange_strong(st1.tmo + 1, &expect, 0x7f0u, __ATOMIC_RELAXED, __ATOMIC_RELAXED, __HIP_MEMORY_SCOPE_AGENT); __hip_atomic_store(st1.tmo, 1u, __ATOMIC_RELAXED, __HIP_MEMORY_SCOPE_AGENT); } }
    __device__ __forceinline__ void fused(f32x4 (&acc)[2][2][4][2], const Unit& u, int wr, int wc, int fr, int fq, PG8_LAS unsigned char* lds, int wid, int lane) const {
        typedef float f32x2v __attribute__((ext_vector_type(2))); typedef unsigned u32x2v __attribute__((ext_vector_type(2)));
        const PG8_LAS f32x2v* S = (const PG8_LAS f32x2v*)(lds + 8192);
        const int col0 = u.pn * BM + wc * 32 + 4 * fq;
#pragma unroll
        for (int bj = 0; bj < 2; ++bj)
#pragma unroll
            for (int n = 0; n < 2; ++n) { const f32x4 bv = bias ? *(const f32x4*)(bias + col0 + bj * HALF + n * 16) : (f32x4){0.f, 0.f, 0.f, 0.f};
#pragma unroll
                for (int ai = 0; ai < 2; ++ai)
#pragma unroll
                    for (int m = 0; m < 4; ++m) acc[ai][bj][m][n] += bv; }
        bool bad = st1.run(acc, u, wr, wc, fr, fq, lds, wid, lane) || poison != 0u;
        const float qnan = __builtin_nanf("");
#pragma unroll
        for (int ai = 0; ai < 2; ++ai)
#pragma unroll
            for (int m = 0; m < 4; ++m) { const int r = ai * HALF + wr * 64 + m * 16 + fr; const f32x2v sr = S[r]; const size_t off = (size_t)(u.pm * BM + r) * ldc + col0;
#pragma unroll
                for (int bj = 0; bj < 2; ++bj)
#pragma unroll
                    for (int n = 0; n < 2; ++n) { const f32x4 bs = *(const f32x4*)(base + off + bj * HALF + n * 16); acc[ai][bj][m][n] = bs + (acc[ai][bj][m][n] - sr.x) * sr.y; }
                asm volatile("" : "+v"(acc[ai][0][m][0]), "+v"(acc[ai][0][m][1]), "+v"(acc[ai][1][m][0]), "+v"(acc[ai][1][m][1]));
                if (m & 1) asm volatile("" ::: "memory"); }
        const bool bad1 = bad;
        bad = st2.run(acc, u, wr, wc, fr, fq, lds, wid, lane) || bad;
#pragma unroll
        for (int ai = 0; ai < 2; ++ai)
#pragma unroll
            for (int m = 0; m < 4; ++m) { const int r = ai * HALF + wr * 64 + m * 16 + fr; const f32x2v sr = S[r]; const size_t off = (size_t)(u.pm * BM + r) * ldc + col0;
#pragma unroll
                for (int bj = 0; bj < 2; ++bj)
#pragma unroll
                    for (int n = 0; n < 2; ++n) { const f32x4 x1 = acc[ai][bj][m][n]; *(f32x4*)(out + off + bj * HALF + n * 16) = bad1 ? (f32x4){qnan, qnan, qnan, qnan} : x1;
                        const f32x4 o = (x1 - sr.x) * sr.y; u32x2v w; w.x = cvt_pk_bf16(o[0], o[1]); w.y = cvt_pk_bf16(o[2], o[3]);
                        if (bad) { w.x = 0x7fc07fc0u; w.y = 0x7fc07fc0u; } *(u32x2v*)(xn + off + bj * HALF + n * 16) = w; }
                asm volatile("" ::: "memory"); }
    }
};

template <class Epi, class Sched, bool STAMP = false>
__device__ __forceinline__ void gemm_phase(PG8_LAS unsigned char* lds, const Gemm g, const Sched& S, const Epi& E, unsigned long long* stamps) {
    int tid_ = threadIdx.x; asm volatile("" : "+v"(tid_)); const int tid = tid_, wid = __builtin_amdgcn_readfirstlane(tid >> 6), lane = tid & 63, wr = wid >> 2, wc = wid & 3, fr = lane & 15, fq = lane >> 4;
    const int K = g.K, nt = K / BK;
    int ts_lo = 0, ts_hi = 0, nts = 0; const unsigned long long rt_entry = STAMP ? (unsigned long long)wall_clock64() : 0ull;
#define PG8_STAMP() do { if (STAMP && wid == 0 && nts < 64) { const unsigned long long _c = (unsigned long long)clock64(); \
        ts_lo = (lane == nts) ? (int)(unsigned)_c : ts_lo; ts_hi = (lane == nts) ? (int)(unsigned)(_c >> 32) : ts_hi; ++nts; } } while (0)
    PG8_STAMP();
    unsigned voffA[2], voffB[2];
#pragma unroll
    for (int i = 0; i < 2; ++i) { int R, C; stage_rc(tid * 16 + i * 8192, R, C); const int Rb = Epi::PERM ? ((R & ~31) + perm32(R & 31)) : R;
        voffA[i] = (unsigned)(R * K + C) * 2u; voffB[i] = (unsigned)(Rb * K + C) * 2u; }
    const size_t kstep = (size_t)(BK * 2);
    const size_t hstep = (size_t)HALF * K * 2;
    const size_t tstep = 2 * hstep;
    const unsigned ldsw = (unsigned)wid * 1024u;
    const int aoff = lds_byte(wr * 64 + fr, fq * 8), boff = lds_byte(wc * 32 + fr, fq * 8);
#define PG8_SA(b, h) (((b) * 2 + (h)) * HTB)
#define PG8_SB(b, h) ((4 + (b) * 2 + (h)) * HTB)
#define PG8_STAGE(bufoff, gbase, voff) do { _Pragma("unroll") for (int _i = 0; _i < 2; ++_i) \
        __builtin_amdgcn_global_load_lds((const unsigned*)((const char*)(gbase) + (voff)[_i]), (PG8_LAS unsigned*)(lds + (bufoff) + ldsw + _i * 8192), 16, 0, 0); } while (0)
#define PG8_LDA(dst, b, h) do { _Pragma("unroll") for (int m = 0; m < 4; ++m) _Pragma("unroll") for (int k = 0; k < 2; ++k) dst[m][k] = *(const PG8_LAS bf16x8*)(lds + PG8_SA(b, h) + aoff + m * 2048 + k * 1024); } while (0)
#define PG8_LDB(dst, b, h) do { _Pragma("unroll") for (int n = 0; n < 2; ++n) _Pragma("unroll") for (int k = 0; k < 2; ++k) dst[n][k] = *(const PG8_LAS bf16x8*)(lds + PG8_SB(b, h) + boff + n * 2048 + k * 1024); } while (0)
#define PG8_MMA(ai, bj, At, Bt) do { __builtin_amdgcn_s_setprio(1); _Pragma("unroll") for (int m = 0; m < 4; ++m) _Pragma("unroll") for (int n = 0; n < 2; ++n) _Pragma("unroll") for (int k = 0; k < 2; ++k) \
        acc[ai][bj][m][n] = __builtin_amdgcn_mfma_f32_16x16x32_bf16(Bt[n][k], At[m][k], acc[ai][bj][m][n], 0, 0, 0); __builtin_amdgcn_s_setprio(0); } while (0)
#define PG8_WAIT_V(n) asm volatile("s_waitcnt vmcnt(" #n ")" ::: "memory")
#define PG8_WAIT_L(n) asm volatile("s_waitcnt lgkmcnt(" #n ")" ::: "memory")
#define PG8_BAR __builtin_amdgcn_s_barrier()
#define PG8_SCHED __builtin_amdgcn_sched_barrier(0)
    Unit cur, nxt; int ui = 0;
    if (!S.next(0, cur)) return;
    f32x4 acc[2][2][4][2];
#pragma unroll
    for (int a = 0; a < 2; ++a)
#pragma unroll
        for (int b = 0; b < 2; ++b)
#pragma unroll
            for (int m = 0; m < 4; ++m)
#pragma unroll
                for (int n = 0; n < 2; ++n) acc[a][b][m][n] = (f32x4){0.f, 0.f, 0.f, 0.f};
    bf16x8 At[4][2], B0[2][2], B1[2][2];
    const char* cA = (const char*)g.A + (size_t)cur.pm * tstep; const char* cB = (const char*)g.Bt + (size_t)cur.pn * tstep;
    S.a_ready(cur);
    PG8_STAGE(PG8_SB(0, 0), cB, voffB); PG8_STAGE(PG8_SA(0, 0), cA, voffA); PG8_STAGE(PG8_SB(0, 1), cB + hstep, voffB); PG8_STAGE(PG8_SA(0, 1), cA + hstep, voffA);
    if (wr == 1) PG8_BAR;
    PG8_WAIT_V(4); PG8_BAR;
    PG8_STAGE(PG8_SB(1, 0), cB + kstep, voffB); PG8_STAGE(PG8_SA(1, 0), cA + kstep, voffA); PG8_STAGE(PG8_SB(1, 1), cB + hstep + kstep, voffB);
    PG8_WAIT_V(6); PG8_BAR;
    PG8_STAMP();
    for (;;) {
        const bool has_next = S.next(ui + 1, nxt);
        const char* nA = has_next ? (const char*)g.A + (size_t)nxt.pm * tstep : cA; const char* nB = has_next ? (const char*)g.Bt + (size_t)nxt.pn * tstep : cB;
        for (int t = 0; t < nt; t += 2) {
            const bool last = (t == nt - 2);
            const char* a1 = cA + (size_t)(t + 1) * kstep;
            const char* a2 = last ? nA : cA + (size_t)(t + 2) * kstep; const char* b2 = last ? nB : cB + (size_t)(t + 2) * kstep;
            const char* a3 = a2 + kstep; const char* b3 = b2 + kstep;
            if (last && has_next) S.a_ready(nxt);
            PG8_LDB(B0, 0, 0); PG8_SCHED; PG8_LDA(At, 0, 0); PG8_STAGE(PG8_SA(1, 1), a1 + hstep, voffA);
            PG8_WAIT_L(8); PG8_BAR; PG8_WAIT_L(0); PG8_MMA(0, 0, At, B0); PG8_BAR; PG8_SCHED;
            PG8_LDB(B1, 0, 1); PG8_STAGE(PG8_SB(0, 0), b2, voffB);
            PG8_BAR; PG8_WAIT_L(0); PG8_MMA(0, 1, At, B1); PG8_BAR;
            PG8_LDA(At, 0, 1); PG8_STAGE(PG8_SA(0, 0), a2, voffA);
            PG8_BAR; PG8_WAIT_L(0); PG8_MMA(1, 0, At, B0); PG8_BAR; PG8_SCHED;
            PG8_STAGE(PG8_SB(0, 1), b2 + hstep, voffB);
            PG8_WAIT_V(6); PG8_BAR; PG8_MMA(1, 1, At, B1); PG8_BAR;
            PG8_LDB(B0, 1, 0); PG8_SCHED; PG8_LDA(At, 1, 0); PG8_STAGE(PG8_SA(0, 1), a2 + hstep, voffA);
            PG8_WAIT_L(8); PG8_BAR; PG8_WAIT_L(0); PG8_MMA(0, 0, At, B0); PG8_BAR; PG8_SCHED;
            PG8_LDB(B1, 1, 1); PG8_STAGE(PG8_SB(1, 0), b3, voffB);
            PG8_BAR; PG8_WAIT_L(0); PG8_MMA(0, 1, At, B1); PG8_BAR;
            PG8_LDA(At, 1, 1); PG8_STAGE(PG8_SA(1, 0), a3, voffA);
            PG8_BAR; PG8_WAIT_L(0); PG8_MMA(1, 0, At, B0); PG8_BAR; PG8_SCHED;
            PG8_STAGE(PG8_SB(1, 1), b3 + hstep, voffB);
            PG8_WAIT_V(6); PG8_BAR; PG8_MMA(1, 1, At, B1); PG8_BAR;
        }
        PG8_STAMP();
        if constexpr (!Epi::AFTER_DRAIN) { E(acc, cur, wr, wc, fr, fq); S.done(cur); }
        PG8_STAMP();
        if (!has_next) break;
#pragma unroll
        for (int a = 0; a < 2; ++a)
#pragma unroll
            for (int b = 0; b < 2; ++b)
#pragma unroll
                for (int m = 0; m < 4; ++m)
#pragma unroll
                    for (int n = 0; n < 2; ++n) acc[a][b][m][n] = (f32x4){0.f, 0.f, 0.f, 0.f};
        cur = nxt; cA = nA; cB = nB; ++ui;
    }
    PG8_WAIT_V(0);
    if (wr == 0) PG8_BAR;
    PG8_BAR;
    if constexpr (Epi::AFTER_DRAIN) { E.fused(acc, cur, wr, wc, fr, fq, lds, wid, lane); S.done(cur); }
    PG8_STAMP();
    if (STAMP && wid == 0) { stamps[lane] = lane < nts ? (((unsigned long long)(unsigned)ts_hi << 32) | (unsigned)ts_lo) : 0ull;
        if (lane == 62) stamps[62] = rt_entry; if (lane == 63) stamps[63] = (unsigned long long)wall_clock64(); }
#undef PG8_STAMP
#undef PG8_SA
#undef PG8_SB
#undef PG8_STAGE
#undef PG8_LDA
#undef PG8_LDB
#undef PG8_MMA
#undef PG8_WAIT_V
#undef PG8_WAIT_L
#undef PG8_BAR
#undef PG8_SCHED
}
}

DI bf16x8 ld16_sum4(const bf16_t* p, size_t slab) {
  union { bf16x8 v; unsigned u[4]; } a, b, c, d, o;
  a.v = ld16(p); b.v = ld16(p + slab); c.v = ld16(p + 2 * slab); d.v = ld16(p + 3 * slab);
#pragma unroll
  for (int i = 0; i < 4; ++i)
    o.u[i] = pk2(lo_bf(a.u[i]) + lo_bf(b.u[i]) + lo_bf(c.u[i]) + lo_bf(d.u[i]), hi_bf(a.u[i]) + hi_bf(b.u[i]) + hi_bf(c.u[i]) + hi_bf(d.u[i]));
  return o.v;
}

template <int NI, bool TR = false, bool PF2 = true, bool ASUM4 = false>
DI void gemm_main(f32x16 (&acc)[2][NI], const bf16_t* Abase, int lda, int akoff, int astep, const bf16_t* Bt, int ldb, int K,
                  bf16_t* sm, int tid, bool act, size_t aslab = 0) {
  if (!act) {
    __syncthreads();
    for (int kt = 0; kt < (K >> 6); ++kt) __syncthreads();
    return;
  }
  const int lane = tid & 63, wid = tid >> 6, wm = wid >> 1, wn = wid & 1, r = lane & 31, h = lane >> 5;
  const int lrow = tid >> 3, lkc = tid & 7;
  const int aoff0 = lrow * lda + akoff, a32 = 32 * lda;
  const int boff0 = lrow * ldb + lkc * 8, b32 = 32 * ldb;
  const int soff0 = lrow * 64 + ((lkc ^ ((lrow >> 1) & 7)) * 8);
  bf16_t* As = sm;
  bf16_t* Bs = sm + 2 * 8192;
  bf16x8 ra0[4], rb0[2 * NI], ra1[4], rb1[2 * NI];
  const int nk = K >> 6;
#define GM_LOAD(RA, RB, t)                                                                          \
  {                                                                                                 \
    const bf16_t* An_ = Abase + (size_t)(t) * astep;                                                \
    const bf16_t* Bn_ = Bt + (t) * 64;                                                              \
    _Pragma("unroll") for (int i = 0; i < 4; ++i) RA[i] = ASUM4 ? ld16_sum4(An_ + aoff0 + i * a32, aslab) : ld16(An_ + aoff0 + i * a32); \
    _Pragma("unroll") for (int i = 0; i < 2 * NI; ++i) RB[i] = ld16(Bn_ + boff0 + i * b32);         \
  }
#define GM_STORE(RA, RB, buf)                                                                       \
  {                                                                                                 \
    bf16_t* An = As + (buf) * 8192 + soff0;                                                         \
    bf16_t* Bn = Bs + (buf) * 8192 + soff0;                                                         \
    _Pragma("unroll") for (int i = 0; i < 4; ++i) *reinterpret_cast<bf16x8*>(An + i * 2048) = RA[i];        \
    _Pragma("unroll") for (int i = 0; i < 2 * NI; ++i) *reinterpret_cast<bf16x8*>(Bn + i * 2048) = RB[i];   \
  }
#define GM_COMPUTE(buf)                                                                             \
  {                                                                                                 \
    const bf16_t* Ac = As + (buf) * 8192 + ar0 * 64;                                                \
    const bf16_t* Bc = Bs + (buf) * 8192 + br0 * 64;                                                \
    _Pragma("unroll") for (int ks = 0; ks < 4; ++ks) {                                              \
      bf16x8 a[2], b[NI];                                                                           \
      _Pragma("unroll") for (int i = 0; i < 2; ++i)                                                 \
        a[i] = *reinterpret_cast<const bf16x8*>(Ac + i * 2048 + (((ks * 2 + h) ^ asw) * 8));        \
      _Pragma("unroll") for (int i = 0; i < NI; ++i)                                                \
        b[i] = *reinterpret_cast<const bf16x8*>(Bc + i * 2048 + (((ks * 2 + h) ^ bsw) * 8));        \
      _Pragma("unroll") for (int mi = 0; mi < 2; ++mi)                                              \
        _Pragma("unroll") for (int ni = 0; ni < NI; ++ni)                                           \
          acc[mi][ni] = TR ? MFMA32(b[ni], a[mi], acc[mi][ni]) : MFMA32(a[mi], b[ni], acc[mi][ni]); \
    }                                                                                               \
  }
  const int ar0 = wm * 64 + r, br0 = wn * 32 * NI + r;
  const int asw = (ar0 >> 1) & 7, bsw = (br0 >> 1) & 7;
  if (!PF2) {
    GM_LOAD(ra0, rb0, 0)
    GM_STORE(ra0, rb0, 0)
    __syncthreads();
    for (int kt = 0; kt < nk; kt += 2) {
      GM_LOAD(ra0, rb0, kt + 1)
      GM_COMPUTE(0)
      GM_STORE(ra0, rb0, 1)
      __syncthreads();
      if (kt + 2 < nk) GM_LOAD(ra0, rb0, kt + 2)
      GM_COMPUTE(1)
      if (kt + 2 < nk) GM_STORE(ra0, rb0, 0)
      __syncthreads();
    }
    return;
  }
  GM_LOAD(ra0, rb0, 0)
  GM_LOAD(ra1, rb1, 1)
  GM_STORE(ra0, rb0, 0)
  __syncthreads();
  for (int kt = 0; kt < nk; kt += 2) {
    if (kt + 2 < nk) GM_LOAD(ra0, rb0, kt + 2)
    GM_COMPUTE(0)
    GM_STORE(ra1, rb1, 1)
    __syncthreads();
    if (kt + 3 < nk) GM_LOAD(ra1, rb1, kt + 3)
    GM_COMPUTE(1)
    if (kt + 2 < nk) GM_STORE(ra0, rb0, 0)
    __syncthreads();
  }
#undef GM_LOAD
#undef GM_STORE
#undef GM_COMPUTE
}

template <int NI>
DI void zero_acc(f32x16 (&acc)[2][NI]) {
#pragma unroll
  for (int a = 0; a < 2; ++a)
#pragma unroll
    for (int b = 0; b < NI; ++b)
#pragma unroll
      for (int i = 0; i < 16; ++i) acc[a][b][i] = 0.f;
}

DI void sincos_(float x, float* sn, float* cs) {
  float n = rintf(x * 0.63661977236758134f);
  float rr = fmaf(-n, 1.57079625129699707031f, x);
  rr = fmaf(-n, 7.54978941586159635335e-08f, rr);
  float r2 = rr * rr;
  float sp = rr + rr * r2 * (-1.6666654611e-1f + r2 * (8.3321608736e-3f + r2 * (-1.9515295891e-4f)));
  float cp = 1.f + r2 * (-0.5f + r2 * (4.166664568298827e-2f + r2 * (-1.388731625493765e-3f + r2 * 2.443315711809948e-5f)));
  int q = ((int)n) & 3;
  float s_ = (q & 1) ? cp : sp;
  float c_ = (q & 1) ? sp : cp;
  if (q == 1 || q == 2) c_ = -c_;
  if (q >= 2) s_ = -s_;
  *sn = s_;
  *cs = c_;
}

#define VSUB_SETUP                                                                                             \
  const int sub = tid >> 8, vt = tid & 255;                                                                    \
  const int vgrid = gridDim.x * 2, vb = blockIdx.x * 2 + sub;                                                  \
  bf16_t* smv = sm + sub * 32768;                                                                              \
  const int lane = vt & 63, wid = vt >> 6, wm = wid >> 1, wn = wid & 1, r = lane & 31, h = lane >> 5;          \
  (void)lane; (void)wm; (void)wn; (void)r; (void)h; (void)smv; (void)vgrid; (void)vb;

DI void prep_transpose(const float* src, int ld, bf16_t* dst, int K, int k0, int n0, float* tile, int tid) {
  const int nn = tid & 63, kq = tid >> 6;
#pragma unroll 4
  for (int i = 0; i < 8; ++i) {
    int kk = kq + 8 * i;
    tile[kk * 65 + nn] = src[(size_t)(k0 + kk) * ld + n0 + nn];
  }
  __syncthreads();
  {
    int n2 = tid >> 3, kc = tid & 7;
    uint4 w;
    w.x = pk2(tile[(kc * 8 + 0) * 65 + n2], tile[(kc * 8 + 1) * 65 + n2]);
    w.y = pk2(tile[(kc * 8 + 2) * 65 + n2], tile[(kc * 8 + 3) * 65 + n2]);
    w.z = pk2(tile[(kc * 8 + 4) * 65 + n2], tile[(kc * 8 + 5) * 65 + n2]);
    w.w = pk2(tile[(kc * 8 + 6) * 65 + n2], tile[(kc * 8 + 7) * 65 + n2]);
    *reinterpret_cast<uint4*>(dst + (size_t)(n0 + n2) * K + k0 + kc * 8) = w;
  }
  __syncthreads();
}

DI void prep_s5(const Params& p, int L, int g, float* sm, int tid) {
  float* apow = sm;
  float* fco = sm + 2176;
  float* bbar = sm + 2304;
  float* Kt = sm + 4352;
  float* Cl = sm + 12544;
  const size_t gm = (size_t)(L * 32 + g) * 65536;
  for (int d = 0; d < 2; ++d) {
    const int dg = (L * 2 + d) * 32 + g;
    if (tid < 64) {
      const int pp = tid;
      float dt = expf(p.s5_log_dt[dg]);
      float are = p.s5_a_re[dg * 64 + pp], aim = p.s5_a_im[dg * 64 + pp];
      float mag = expf(dt * are);
      float sn, cs;
      sincos_(dt * aim, &sn, &cs);
      float abr = mag * cs, abi = mag * sn;
      float den = are * are + aim * aim;
      float fr = ((abr - 1.f) * are + abi * aim) / den;
      float fi = (abi * are - (abr - 1.f) * aim) / den;
      fco[pp * 2] = fr;
      fco[pp * 2 + 1] = fi;
      float pr = 1.f, pi = 0.f;
      apow[pp * 2] = 1.f;
      apow[pp * 2 + 1] = 0.f;
      for (int t = 1; t <= 16; ++t) {
        float nr = pr * abr - pi * abi, ni = pr * abi + pi * abr;
        pr = nr; pi = ni;
        apow[(t * 64 + pp) * 2] = pr;
        apow[(t * 64 + pp) * 2 + 1] = pi;
      }
      p.A16()[(dg * 64 + pp) * 2] = pr;
      p.A16()[(dg * 64 + pp) * 2 + 1] = pi;
    }
    __syncthreads();
    for (int i = 0; i < 2; ++i) {
      int idx = tid + 512 * i;
      Cl[idx * 2] = p.s5_c_re[(size_t)dg * 1024 + idx];
      Cl[idx * 2 + 1] = p.s5_c_im[(size_t)dg * 1024 + idx];
    }
    for (int i = 0; i < 2; ++i) {
      int idx = tid + 512 * i;
      int pp = idx >> 4;
      float br = p.s5_b_re[(size_t)dg * 1024 + idx], bi = p.s5_b_im[(size_t)dg * 1024 + idx];
      float fr = fco[pp * 2], fi = fco[pp * 2 + 1];
      bbar[idx * 2] = fr * br - fi * bi;
      bbar[idx * 2 + 1] = fr * bi + fi * br;
    }
    __syncthreads();
    {
      const int th = tid >> 8, hp = (tid >> 4) & 15, hh = tid & 15;
      float kacc[8];
#pragma unroll
      for (int t = 0; t < 8; ++t) kacc[t] = 0.f;
      for (int pp = 0; pp < 64; ++pp) {
        float cr = Cl[(hp * 64 + pp) * 2], ci = Cl[(hp * 64 + pp) * 2 + 1];
        float br = bbar[(pp * 16 + hh) * 2], bi = bbar[(pp * 16 + hh) * 2 + 1];
        float xr = cr * br - ci * bi, xi = cr * bi + ci * br;
#pragma unroll
        for (int t = 0; t < 8; ++t)
          kacc[t] += xr * apow[((th * 8 + t) * 64 + pp) * 2] - xi * apow[((th * 8 + t) * 64 + pp) * 2 + 1];
      }
#pragma unroll
      for (int t = 0; t < 8; ++t) Kt[(d * 16 + th * 8 + t) * 256 + (tid & 255)] = kacc[t];
    }
    for (int i = 0; i < 64; ++i) {
      int idx = tid + 512 * i;
      int k = idx & 255, nn = idx >> 8;
      int pp = nn >> 1, ri = nn & 1, j = k >> 4, hh = k & 15;
      int e = (d == 0) ? (15 - j) : j;
      float ar = apow[(e * 64 + pp) * 2], ai = apow[(e * 64 + pp) * 2 + 1];
      float br = bbar[(pp * 16 + hh) * 2], bi = bbar[(pp * 16 + hh) * 2 + 1];
      float v = ri ? (ar * bi + ai * br) : (ar * br - ai * bi);
      p.S5We()[gm + (size_t)(d * 128 + nn) * 256 + k] = f2bf(v);
    }
    for (int i = 0; i < 64; ++i) {
      int idx = tid + 512 * i;
      int kk = idx & 127, n = idx >> 7;
      int pp = kk >> 1, ri = kk & 1, t16 = n >> 4, hp = n & 15;
      int pw = (d == 0) ? (t16 + 1) : (16 - t16);
      float cr = Cl[(hp * 64 + pp) * 2], ci = Cl[(hp * 64 + pp) * 2 + 1];
      float ar = apow[(pw * 64 + pp) * 2], ai = apow[(pw * 64 + pp) * 2 + 1];
      float v = ri ? -(cr * ai + ci * ar) : (cr * ar - ci * ai);
      p.S5R()[gm + (size_t)n * 256 + d * 128 + kk] = f2bf(v);
    }
    __syncthreads();
  }
  const float dval = p.s5_d[(L * 32 + g) * 16 + (tid & 15)];
  for (int i = 0; i < 128; ++i) {
    int idx = tid + 512 * i;
    int k = idx & 255, n = idx >> 8;
    int t16 = n >> 4, hp = n & 15, j = k >> 4, hh = k & 15;
    float v = 0.f;
    if (j <= t16) v += Kt[(0 * 16 + (t16 - j)) * 256 + hp * 16 + hh];
    if (j >= t16) v += Kt[(1 * 16 + (j - t16)) * 256 + hp * 16 + hh];
    if (j == t16 && hp == hh) v += dval;
    p.S5M()[gm + (size_t)n * 256 + k] = f2bf(v);
  }
  __syncthreads();
}

DI void prep_adaln(const Params& p, int L, int cb, float* sm, int tid) {
  float* sv = sm;
  float* red = sm + 3072;
  for (int idx = tid; idx < 3072; idx += 512) {
    int v = idx >> 10, k = idx & 1023;
    float cv = (v < 2) ? p.c[v * 1024 + k] : p.c_ctx[k];
    sv[idx] = siluf_(cv);
  }
  __syncthreads();
  const int cl = tid & 63, kq = tid >> 6, col = cb * 64 + cl;
  float a0 = 0.f, a1 = 0.f, a2 = 0.f;
  const float* w = p.w_ada + (size_t)L * 1024 * 3072 + col;
#pragma unroll 8
  for (int k = kq * 128; k < kq * 128 + 128; ++k) {
    float wv = w[(size_t)k * 3072];
    a0 += sv[k] * wv;
    a1 += sv[1024 + k] * wv;
    a2 += sv[2048 + k] * wv;
  }
  red[(kq * 3 + 0) * 64 + cl] = a0;
  red[(kq * 3 + 1) * 64 + cl] = a1;
  red[(kq * 3 + 2) * 64 + cl] = a2;
  __syncthreads();
  if (kq == 0) {
    float bb = p.b_ada[L * 3072 + col];
    for (int v = 0; v < 3; ++v) {
      float s = 0.f;
      for (int q = 0; q < 8; ++q) s += red[(q * 3 + v) * 64 + cl];
      p.MOD()[(L * 3 + v) * 3072 + col] = s + bb;
    }
  }
  __syncthreads();
}

struct TrDesc { const float* src; bf16_t* dst; int ld, K, k0, n0; };
DI TrDesc tr_decode(const Params& p, int it) {
  constexpr int N_TR_L = 3456;
  const int L = it / N_TR_L, tt = it % N_TR_L;
  TrDesc d;
  int kt, nt;
  if (tt < 2624) {
    kt = tt / 164; nt = tt % 164; d.src = p.w_in + (size_t)L * 1024 * 10496; d.ld = 10496; d.K = 1024;
    d.dst = p.WinT() + (size_t)L * 10496 * 1024;
  } else if (tt < 3136) {
    int t2 = tt - 2624; int kb = t2 / 128; int t3 = t2 % 128; kt = t3 / 16; nt = t3 % 16;
    d.src = p.w_br + (size_t)(L * 4 + kb) * 512 * 1024; d.ld = 1024; d.K = 512;
    d.dst = p.WbrT() + (size_t)(L * 4 + kb) * 1024 * 512;
  } else if (tt < 3392) {
    int t2 = tt - 3136; kt = t2 / 16; nt = t2 % 16; d.src = p.w_out + (size_t)L * 1024 * 1024; d.ld = 1024; d.K = 1024;
    d.dst = p.WoutT() + (size_t)L * 1024 * 1024;
  } else {
    int t2 = tt - 3392; kt = t2 / 8; nt = t2 % 8; d.src = p.s5_w_glu + (size_t)L * 512 * 512; d.ld = 512; d.K = 512;
    d.dst = p.WgluT() + (size_t)L * 512 * 512;
  }
  d.k0 = kt * 64; d.n0 = nt * 64;
  return d;
}

DI void phase_prep(const Params& p, float* sm, int tid) {
  constexpr int N_S5 = 128, N_ADA = 192, N_TR = 4 * 3456;
  constexpr int NPRE = N_S5 + N_ADA + 1;
  for (int item = blockIdx.x; item < NPRE; item += gridDim.x) {
    if (item < N_S5) {
      prep_s5(p, item >> 5, item & 31, sm, tid);
    } else if (item < N_S5 + N_ADA) {
      int it = item - N_S5;
      prep_adaln(p, it / 48, it % 48, sm, tid);
    } else {
      for (int idx = tid; idx < 256 * 16; idx += 512) {
        int pos = idx >> 4, i = idx & 15;
        float inv = exp2f(-(float)i * (13.287712379549449f / 16.f));
        float sn, cs;
        sincos_((float)pos * inv, &sn, &cs);
        p.ROPE()[idx * 2] = cs;
        p.ROPE()[idx * 2 + 1] = sn;
      }
      {
        const int wv = tid >> 6, ln = tid & 63;
        for (int LL = 0; LL < 4; ++LL) {
          float mb = 0.f;
          for (int j = tid; j < 8 * 465; j += 512) mb = fmaxf(mb, fabsf(p.na_rel_bias[LL * 8 * 465 + j]));
#pragma unroll
          for (int o = 32; o >= 1; o >>= 1) mb = fmaxf(mb, __shfl_xor(mb, o));
          if (ln == 0) sm[LL * 8 + wv] = mb;
        }
        __syncthreads();
        {
          const int LL = wv >> 1, ty = wv & 1;
          const float* gq = (ty ? p.gqa_q_g : p.na_q_g) + LL * 64;
          const float* gk = (ty ? p.gqa_k_g : p.na_k_g) + LL * 64;
          float mq = fabsf(gq[ln]), mk = fabsf(gk[ln]);
#pragma unroll
          for (int o = 32; o >= 1; o >>= 1) { mq = fmaxf(mq, __shfl_xor(mq, o)); mk = fmaxf(mk, __shfl_xor(mk, o)); }
          if (ln == 0) {
            float mb = 0.f;
            if (!ty) for (int q = 0; q < 8; ++q) mb = fmaxf(mb, sm[LL * 8 + q]);
            p.ROPE()[8192 + wv] = fminf(8.f * LOG2E * mq * mk + LOG2E * mb, 100.f);
          }
        }
        __syncthreads();
      }
    }
  }
  const int nn = tid & 63, kq = tid >> 6;
  for (int it0 = blockIdx.x; it0 < N_TR; it0 += 4 * gridDim.x) {
    float v[4][8];
#pragma unroll
    for (int u = 0; u < 4; ++u) {
      const int it = it0 + u * gridDim.x;
      if (it < N_TR) {
        const TrDesc d = tr_decode(p, it);
#pragma unroll
        for (int i = 0; i < 8; ++i) v[u][i] = d.src[(size_t)(d.k0 + kq + 8 * i) * d.ld + d.n0 + nn];
      }
    }
#pragma unroll
    for (int u = 0; u < 4; ++u)
#pragma unroll
      for (int i = 0; i < 8; ++i) sm[u * 4160 + (kq + 8 * i) * 65 + nn] = v[u][i];
    __syncthreads();
#pragma unroll
    for (int u = 0; u < 4; ++u) {
      const int it = it0 + u * gridDim.x;
      if (it < N_TR) {
        const TrDesc d = tr_decode(p, it);
        const float* tile = sm + u * 4160;
        const int n2 = tid >> 3, kc = tid & 7;
        uint4 w;
        w.x = pk2(tile[(kc * 8 + 0) * 65 + n2], tile[(kc * 8 + 1) * 65 + n2]);
        w.y = pk2(tile[(kc * 8 + 2) * 65 + n2], tile[(kc * 8 + 3) * 65 + n2]);
        w.z = pk2(tile[(kc * 8 + 4) * 65 + n2], tile[(kc * 8 + 5) * 65 + n2]);
        w.w = pk2(tile[(kc * 8 + 6) * 65 + n2], tile[(kc * 8 + 7) * 65 + n2]);
        *reinterpret_cast<uint4*>(d.dst + (size_t)(d.n0 + n2) * d.K + d.k0 + kc * 8) = w;
      }
    }
    __syncthreads();
  }
}

DI void phase_norm(const Params& p, int b, int L, int tid) {
  const int wid = tid >> 6, lane = tid & 63;
  const float* g = p.norm_g + L * 1024;
  for (int item = blockIdx.x; item < R / 8; item += gridDim.x) {
    const int row = item * 8 + wid;
    const float* src;
    const float* mod;
    if (row < NLAT) {
      src = (L == 0 ? p.x : (const float*)p.out) + ((size_t)b * NLAT + row) * 1024;
      mod = p.MOD() + (L * 3 + b) * 3072;
    } else {
      src = (L == 0 ? p.ctx : (const float*)p.CTXS()) + ((size_t)b * 256 + (row - NLAT)) * 1024;
      mod = p.MOD() + (L * 3 + 2) * 3072;
    }
    float4 v[4];
    float ss = 0.f;
#pragma unroll
    for (int j = 0; j < 4; ++j) {
      v[j] = *reinterpret_cast<const float4*>(src + j * 256 + lane * 4);
      ss += v[j].x * v[j].x + v[j].y * v[j].y + v[j].z * v[j].z + v[j].w * v[j].w;
    }
#pragma unroll
    for (int o = 32; o >= 1; o >>= 1) ss += __shfl_xor(ss, o);
    const float rs = rsqrtf(ss * (1.f / 1024.f) + 1e-6f);
#pragma unroll
    for (int j = 0; j < 4; ++j) {
      const int col = j * 256 + lane * 4;
      float4 g4 = *reinterpret_cast<const float4*>(g + col);
      float4 sh = *reinterpret_cast<const float4*>(mod + col);
      float4 sc = *reinterpret_cast<const float4*>(mod + 1024 + col);
      float y0 = v[j].x * rs * g4.x * (1.f + sc.x) + sh.x;
      float y1 = v[j].y * rs * g4.y * (1.f + sc.y) + sh.y;
      float y2 = v[j].z * rs * g4.z * (1.f + sc.z) + sh.z;
      float y3 = v[j].w * rs * g4.w * (1.f + sc.w) + sh.w;
      uint2 w;
      w.x = pk2(y0, y1);
      w.y = pk2(y2, y3);
      *reinterpret_cast<uint2*>(p.H() + (size_t)row * 1024 + col) = w;
    }
  }
}

struct EpiGlu {
  static constexpr bool PERM = true, AFTER_DRAIN = false;
  const bf16_t* Y; bf16_t* Zg;
  DI void operator()(const pg8::f32x4 (&acc)[2][2][4][2], const pg8::Unit& u, int wr, int wc, int fr, int fq) const {
    const int row0 = u.pm * 256 + wr * 64 + fr, col0 = u.pn * 256 + wc * 32 + 8 * fq;
#pragma unroll
    for (int ai = 0; ai < 2; ++ai)
#pragma unroll
      for (int mh = 0; mh < 2; ++mh) {
        uint4 yv[4], gv[4];
#pragma unroll
        for (int q = 0; q < 4; ++q) {
          const int m = mh * 2 + (q >> 1), bj = q & 1;
          const int row = row0 + ai * 128 + m * 16, col = col0 + bj * 128;
          yv[q] = *reinterpret_cast<const uint4*>(Y + (size_t)row * 512 + col);
          gv[q] = *reinterpret_cast<const uint4*>(Zg + (size_t)row * LDZ + col);
        }
#pragma unroll
        for (int q = 0; q < 4; ++q) {
          const int m = mh * 2 + (q >> 1), bj = q & 1;
          const int row = row0 + ai * 128 + m * 16, col = col0 + bj * 128;
          const pg8::f32x4 a0 = acc[ai][bj][m][0], a1 = acc[ai][bj][m][1];
          uint4 w;
          w.x = pk2(lo_bf(yv[q].x) * sigmoidf_(a0[0]) * siluf_(lo_bf(gv[q].x)), hi_bf(yv[q].x) * sigmoidf_(a0[1]) * siluf_(hi_bf(gv[q].x)));
          w.y = pk2(lo_bf(yv[q].y) * sigmoidf_(a0[2]) * siluf_(lo_bf(gv[q].y)), hi_bf(yv[q].y) * sigmoidf_(a0[3]) * siluf_(hi_bf(gv[q].y)));
          w.z = pk2(lo_bf(yv[q].z) * sigmoidf_(a1[0]) * siluf_(lo_bf(gv[q].z)), hi_bf(yv[q].z) * sigmoidf_(a1[1]) * siluf_(hi_bf(gv[q].z)));
          w.w = pk2(lo_bf(yv[q].w) * sigmoidf_(a1[2]) * siluf_(lo_bf(gv[q].w)), hi_bf(yv[q].w) * sigmoidf_(a1[3]) * siluf_(hi_bf(gv[q].w)));
          *reinterpret_cast<uint4*>(Zg + (size_t)row * LDZ + col) = w;
        }
        asm volatile("" ::: "memory");
      }
  }
};
struct EpiOutRes {
  static constexpr bool PERM = false, AFTER_DRAIN = false;
  const float* src; float* dst; const float* gate;
  DI void operator()(const pg8::f32x4 (&acc)[2][2][4][2], const pg8::Unit& u, int wr, int wc, int fr, int fq) const {
    const int row0 = u.pm * 256 + wr * 64 + fr, col0 = u.pn * 256 + wc * 32 + 4 * fq;
    pg8::f32x4 gv[2][2];
#pragma unroll
    for (int bj = 0; bj < 2; ++bj)
#pragma unroll
      for (int n = 0; n < 2; ++n) gv[bj][n] = *reinterpret_cast<const pg8::f32x4*>(gate + col0 + bj * 128 + n * 16);
#pragma unroll
    for (int ai = 0; ai < 2; ++ai)
#pragma unroll
      for (int mh = 0; mh < 2; ++mh) {
        pg8::f32x4 xv[8];
#pragma unroll
        for (int q = 0; q < 8; ++q) {
          const int m = mh * 2 + (q >> 2), bj = (q >> 1) & 1, n = q & 1;
          xv[q] = *reinterpret_cast<const pg8::f32x4*>(src + (size_t)(row0 + ai * 128 + m * 16) * 1024 + col0 + bj * 128 + n * 16);
        }
#pragma unroll
        for (int q = 0; q < 8; ++q) {
          const int m = mh * 2 + (q >> 2), bj = (q >> 1) & 1, n = q & 1;
          *reinterpret_cast<pg8::f32x4*>(dst + (size_t)(row0 + ai * 128 + m * 16) * 1024 + col0 + bj * 128 + n * 16) =
              xv[q] + gv[bj][n] * acc[ai][bj][m][n];
        }
        asm volatile("" ::: "memory");
      }
  }
};

#define LDS3(ptr) ((__attribute__((address_space(3))) unsigned char*)(ptr))

typedef unsigned u32x4_t __attribute__((ext_vector_type(4)));
typedef unsigned u32x2_t __attribute__((ext_vector_type(2)));
struct EpiP1 {
  static constexpr bool PERM = true, AFTER_DRAIN = false;
  bf16_t* Zp; bf16_t* SGp;
  DI void operator()(const pg8::f32x4 (&acc)[2][2][4][2], const pg8::Unit& u, int wr, int wc, int fr, int fq) const {
    const int row0 = u.pm * 256 + wr * 64 + fr;
    const int colt = u.pn * 256;
    const int col0 = wc * 32 + 8 * fq;
    if (colt < LDZ) {
#pragma unroll
      for (int ai = 0; ai < 2; ++ai)
#pragma unroll
        for (int m = 0; m < 4; ++m) {
          bf16_t* rowp = Zp + (size_t)(row0 + ai * 128 + m * 16) * LDZ + colt + col0;
#pragma unroll
          for (int bj = 0; bj < 2; ++bj) {
            const pg8::f32x4 v0 = acc[ai][bj][m][0], v1 = acc[ai][bj][m][1];
            u32x4_t w4 = {pk2(v0[0], v0[1]), pk2(v0[2], v0[3]), pk2(v1[0], v1[1]), pk2(v1[2], v1[3])};
            __builtin_nontemporal_store(w4, reinterpret_cast<u32x4_t*>(rowp + bj * 128));
          }
        }
    } else {
      const int gcol0 = colt - LDZ + col0;
#pragma unroll
      for (int ai = 0; ai < 2; ++ai)
#pragma unroll
        for (int m = 0; m < 4; ++m) {
          const int row = row0 + ai * 128 + m * 16;
#pragma unroll
          for (int bj = 0; bj < 2; ++bj) {
            const pg8::f32x4 v0 = acc[ai][bj][m][0], v1 = acc[ai][bj][m][1];
            u32x2_t w0v = {pk2(sigmoidf_(v0[0]), sigmoidf_(v0[1])), pk2(sigmoidf_(v0[2]), sigmoidf_(v0[3]))};
            u32x2_t w1v = {pk2(sigmoidf_(v1[0]), sigmoidf_(v1[1])), pk2(sigmoidf_(v1[2]), sigmoidf_(v1[3]))};
            bf16_t* q0 = SGp + sg_index(row, gcol0 + bj * 128);
            __builtin_nontemporal_store(w0v, reinterpret_cast<u32x2_t*>(q0));
            __builtin_nontemporal_store(w1v, reinterpret_cast<u32x2_t*>(q0 + 128));
          }
        }
    }
  }
};
constexpr int P1_UNITS_Z = 65 * 25, P1_UNITS_ALL = 65 * 41, P1_UNITS_MAIN = 2560, GLU_UNITS = 65 * 2;
struct P1Order {
  int lo, hi, G, c;
  DI static void map_unit(int wgid, int nM, int nN, pg8::Unit& u) {
    const int nwg = nM * nN;
    { const int q = nwg / pg8::NXCD, r = nwg % pg8::NXCD, xcd = wgid % pg8::NXCD, off = wgid / pg8::NXCD;
      wgid = (xcd < r ? xcd * (q + 1) : r * (q + 1) + (xcd - r) * q) + off; }
    const int nig = pg8::WGM * nN, gid = wgid / nig, fm = gid * pg8::WGM, gsz = (nM - fm) < pg8::WGM ? (nM - fm) : pg8::WGM;
    u.pm = fm + ((wgid % nig) % gsz); u.pn = (wgid % nig) / gsz;
  }
  DI bool next(int i, pg8::Unit& u) const {
    const int idx = lo + i * G + c;
    if (idx >= hi) return false;
    if (idx < P1_UNITS_Z) map_unit(idx, 65, 25, u);
    else { map_unit(idx - P1_UNITS_Z, 65, 16, u); u.pn += 25; }
    return true;
  }
  DI void a_ready(const pg8::Unit&) const {}
  DI void done(const pg8::Unit&) const {}
  DI int lda(const pg8::Gemm& g) const { return g.K; }
  DI const char* abase(const pg8::Gemm& g, const pg8::Unit& u) const { return (const char*)g.A + (size_t)u.pm * (size_t)pg8::BM * g.K * 2; }
  DI const char* bbase(const pg8::Gemm& g, const pg8::Unit& u) const { return (const char*)g.Bt + (size_t)u.pn * (size_t)pg8::BM * g.K * 2; }
};
DI bool p1_deferral() { return gridDim.x >= (unsigned)(GLU_UNITS + (P1_UNITS_ALL - P1_UNITS_MAIN)); }
DI void phase_p1(const Params& p, int b, int L, unsigned char* smraw) {
  P1Order S{0, p1_deferral() ? P1_UNITS_MAIN : P1_UNITS_ALL, (int)gridDim.x, (int)blockIdx.x};
  pg8::Gemm g{p.H(), p.WinT() + (size_t)L * 10496 * 1024, R, 10496, 1024};
  EpiP1 E{p.Z(), p.SG()};
  pg8::gemm_phase<EpiP1, P1Order, false>(LDS3(smraw), g, S, E, nullptr);
}

DI void post_item(const Params& p, int L, int rb, int slot, int lane) {
  int col; const float* gvec = nullptr; float mult = 1.f; bool rope = false; bf16_t* vt = nullptr;
  const bool latent = (rb * 64) < NLAT;
  if (slot < 8) { col = C_NQ + slot * 64; gvec = p.na_q_g + L * 64; mult = 0.125f * LOG2E; }
  else if (slot < 16) { col = C_NK + (slot - 8) * 64; gvec = p.na_k_g + L * 64; }
  else if (slot < 24) { col = C_GQ + (slot - 16) * 64; gvec = p.gqa_q_g + L * 64; mult = 0.125f * LOG2E; rope = latent; }
  else if (slot < 26) { col = C_GK + (slot - 24) * 64; gvec = p.gqa_k_g + L * 64; rope = latent; }
  else if (slot < 34) { col = C_NV + (slot - 26) * 64; vt = p.VtN() + (size_t)((slot - 26) * 64) * LDT; }
  else { col = C_GV + (slot - 34) * 64; vt = p.VtG() + (size_t)((slot - 34) * 64) * LDT; }
  if (vt) {
    const int row = rb * 64 + lane;
    const bf16_t* zp = p.Z() + (size_t)row * LDZ + col;
    uint4 raw[8];
#pragma unroll
    for (int j = 0; j < 8; ++j) raw[j] = *reinterpret_cast<const uint4*>(zp + j * 8);
    const int prow = (row & ~12) | ((row & 4) << 1) | ((row & 8) >> 1);
#pragma unroll
    for (int j = 0; j < 8; ++j) {
      const unsigned w[4] = {raw[j].x, raw[j].y, raw[j].z, raw[j].w};
#pragma unroll
      for (int q = 0; q < 4; ++q) {
        vt[(size_t)(j * 8 + q * 2) * LDT + prow] = (bf16_t)(w[q] & 0xffffu);
        vt[(size_t)(j * 8 + q * 2 + 1) * LDT + prow] = (bf16_t)(w[q] >> 16);
      }
    }
    return;
  }
  const int c = lane & 7, rsub = lane >> 3;
  float gv[8];
#pragma unroll
  for (int e = 0; e < 8; ++e) gv[e] = gvec[c * 8 + e] * mult;
  uint4 rawv[8];
#pragma unroll
  for (int ps = 0; ps < 8; ++ps)
    rawv[ps] = *reinterpret_cast<const uint4*>(p.Z() + (size_t)(rb * 64 + ps * 8 + rsub) * LDZ + col + c * 8);
#pragma unroll
  for (int ps = 0; ps < 8; ++ps) {
    const int row = rb * 64 + ps * 8 + rsub;
    bf16_t* zp = p.Z() + (size_t)row * LDZ + col + c * 8;
    const uint4 raw = rawv[ps];
    float x[8] = {lo_bf(raw.x), hi_bf(raw.x), lo_bf(raw.y), hi_bf(raw.y), lo_bf(raw.z), hi_bf(raw.z), lo_bf(raw.w), hi_bf(raw.w)};
    float ss = 0.f;
#pragma unroll
    for (int e = 0; e < 8; ++e) ss += x[e] * x[e];
    ss += __shfl_xor(ss, 1);
    ss += __shfl_xor(ss, 2);
    ss += __shfl_xor(ss, 4);
    const float rs = rsqrtf(ss * (1.f / 64.f) + 1e-6f);
#pragma unroll
    for (int e = 0; e < 8; ++e) x[e] = x[e] * rs * gv[e];
    if (rope) {
      const int pos = ((c & 3) < 2) ? (row >> 6) : (row & 63);
      const float* rt = p.ROPE() + (size_t)pos * 32 + ((c & 1) * 8) * 2;
#pragma unroll
      for (int e = 0; e < 8; ++e) {
        const float other = __shfl_xor(x[e], 4);
        const float cs = rt[e * 2], sn = rt[e * 2 + 1];
        x[e] = (c < 4) ? (x[e] * cs - other * sn) : (x[e] * cs + other * sn);
      }
    }
    uint4 w;
    w.x = pk2(x[0], x[1]); w.y = pk2(x[2], x[3]); w.z = pk2(x[4], x[5]); w.w = pk2(x[6], x[7]);
    *reinterpret_cast<uint4*>(zp) = w;
  }
}

DI void phase_s5e_conv_post(const Params& p, int b, int L, bf16_t* sm, int tid) {
  {
    VSUB_SETUP
    constexpr int NT_E = 32 * 9 * 2;
    const int nit = (NT_E + vgrid - 1) / vgrid;
    for (int it = 0; it < nit; ++it) {
      int item = it * vgrid + vb;
      const bool act = item < NT_E;
      if (!act) item = NT_E - 1;
      const int g = item / 18, rem = item % 18, mt = rem >> 1, nt = rem & 1;
      const int m0 = mt * 128, n0 = nt * 128;
      f32x16 acc[2][2];
      zero_acc<2>(acc);
      const bf16_t* Ub = p.Z() + C_S5U + g * 16;
      gemm_main<2>(acc, Ub + (size_t)m0 * 16 * LDZ, 16 * LDZ, ((vt & 7) >> 1) * LDZ + (vt & 1) * 8, 4 * LDZ,
                   p.S5We() + (size_t)(L * 32 + g) * 65536 + (size_t)n0 * 256, 256, 256, smv, vt, act);
      if (act) {
#pragma unroll
        for (int mi = 0; mi < 2; ++mi)
#pragma unroll
          for (int ni = 0; ni < 2; ++ni)
#pragma unroll
            for (int i = 0; i < 16; ++i) {
              int m = m0 + wm * 64 + mi * 32 + crow(i, h);
              int n = n0 + wn * 64 + ni * 32 + r;
              if (m < NCH) p.E()[((size_t)m * 32 + g) * 256 + n] = acc[mi][ni][i];
            }
      }
    }
  }
  constexpr int NT_C = R * 64 / 512;
  constexpr int NT_P = 260 * 36 / 8;
  for (int item = blockIdx.x; item < NT_C + NT_P; item += gridDim.x) {
    if (item >= NT_C) {
      const int w = (item - NT_C) * 8 + (tid >> 6);
      post_item(p, L, w / 36, w % 36, tid & 63);
      continue;
    }
    const int idx = item * 512 + tid;
    const int row = idx >> 6, ch = (idx & 63) * 8;
    const int lo = (row < NLAT) ? 0 : NLAT, hi = (row < NLAT) ? (NLAT - 1) : (R - 1);
    const bf16_t* zr = p.Z() + (size_t)row * LDZ;
    float zz[3][8];
#pragma unroll
    for (int t = 0; t < 3; ++t) {
      int rr = row + t - 1;
      if (rr >= lo && rr <= hi) {
        uint4 cv = *reinterpret_cast<const uint4*>(p.Z() + (size_t)rr * LDZ + C_CV + ch);
        uint4 cc = *reinterpret_cast<const uint4*>(p.Z() + (size_t)rr * LDZ + C_CC + ch);
        zz[t][0] = lo_bf(cv.x) * lo_bf(cc.x); zz[t][1] = hi_bf(cv.x) * hi_bf(cc.x);
        zz[t][2] = lo_bf(cv.y) * lo_bf(cc.y); zz[t][3] = hi_bf(cv.y) * hi_bf(cc.y);
        zz[t][4] = lo_bf(cv.z) * lo_bf(cc.z); zz[t][5] = hi_bf(cv.z) * hi_bf(cc.z);
        zz[t][6] = lo_bf(cv.w) * lo_bf(cc.w); zz[t][7] = hi_bf(cv.w) * hi_bf(cc.w);
      } else {
#pragma unroll
        for (int j = 0; j < 8; ++j) zz[t][j] = 0.f;
      }
    }
    uint4 cb = *reinterpret_cast<const uint4*>(zr + C_CB + ch);
    uint4 cg_ = *reinterpret_cast<const uint4*>(zr + C_CG + ch);
    float bv[8] = {lo_bf(cb.x), hi_bf(cb.x), lo_bf(cb.y), hi_bf(cb.y), lo_bf(cb.z), hi_bf(cb.z), lo_bf(cb.w), hi_bf(cb.w)};
    float gv[8] = {lo_bf(cg_.x), hi_bf(cg_.x), lo_bf(cg_.y), hi_bf(cg_.y), lo_bf(cg_.z), hi_bf(cg_.z), lo_bf(cg_.w), hi_bf(cg_.w)};
    float o[8];
#pragma unroll
    for (int j = 0; j < 8; ++j) {
      float y = p.conv_b[L * 512 + ch + j] + zz[0][j] * p.conv_w[(L * 3 + 0) * 512 + ch + j] +
                zz[1][j] * p.conv_w[(L * 3 + 1) * 512 + ch + j] + zz[2][j] * p.conv_w[(L * 3 + 2) * 512 + ch + j];
      o[j] = bv[j] * y * siluf_(gv[j]);
    }
    uint4 w;
    w.x = pk2(o[0], o[1]); w.y = pk2(o[2], o[3]); w.z = pk2(o[4], o[5]); w.w = pk2(o[6], o[7]);
    *reinterpret_cast<uint4*>(p.Z() + (size_t)row * LDZ + C_CG + ch) = w;
  }
}

DI void phase_s5y(const Params& p, int b, int L, bf16_t* sm, int tid) {
  VSUB_SETUP
  constexpr int NT = 32 * 18;
  const int nit = (NT + vgrid - 1) / vgrid;
  for (int it = 0; it < nit; ++it) {
    int item = it * vgrid + vb;
    const bool act = item < NT;
    if (!act) item = NT - 1;
    const int g = item / 18, rem = item % 18, mt = rem >> 1, nt = rem & 1;
    const int m0 = mt * 128, n0 = nt * 128;
    f32x16 acc[2][2];
    zero_acc<2>(acc);
    const bf16_t* Ub = p.Z() + C_S5U + g * 16;
    gemm_main<2>(acc, Ub + (size_t)m0 * 16 * LDZ, 16 * LDZ, ((vt & 7) >> 1) * LDZ + (vt & 1) * 8, 4 * LDZ,
                 p.S5M() + (size_t)(L * 32 + g) * 65536 + (size_t)n0 * 256, 256, 256, smv, vt, act);
    const bf16_t* Hb = p.HIN() + g * 256;
    gemm_main<2>(acc, Hb + (size_t)m0 * 8192, 8192, (vt & 7) * 8, 64,
                 p.S5R() + (size_t)(L * 32 + g) * 65536 + (size_t)n0 * 256, 256, 256, smv, vt, act);
    if (act) {
#pragma unroll
      for (int mi = 0; mi < 2; ++mi)
#pragma unroll
        for (int ni = 0; ni < 2; ++ni)
#pragma unroll
          for (int i = 0; i < 16; ++i) {
            int m = m0 + wm * 64 + mi * 32 + crow(i, h);
            int n = n0 + wn * 64 + ni * 32 + r;
            if (m < NCH) {
              float y = acc[mi][ni][i];
              float z = 1.5957691216057308f * (y + 0.044715f * y * y * y);
              y = y * sigmoidf_(z);
              p.Y()[(size_t)(m * 16 + (n >> 4)) * 512 + g * 16 + (n & 15)] = f2bf(y);
            }
          }
    }
  }
}

DI void phase_glu(const Params& p, int b, int L, unsigned char* smraw) {
  if (p1_deferral() && blockIdx.x >= (unsigned)GLU_UNITS) {
    P1Order S{P1_UNITS_MAIN, P1_UNITS_ALL, (int)gridDim.x - GLU_UNITS, (int)blockIdx.x - GLU_UNITS};
    pg8::Gemm g{p.H(), p.WinT() + (size_t)L * 10496 * 1024, R, 10496, 1024};
    EpiP1 E{p.Z(), p.SG()};
    pg8::gemm_phase<EpiP1, P1Order, false>(LDS3(smraw), g, S, E, nullptr);
    return;
  }
  pg8::StaticOrder S;
  S.init(R, 512, gridDim.x, blockIdx.x);
  pg8::Gemm g{p.Y(), p.WgluT() + (size_t)L * 512 * 512, R, 512, 512};
  EpiGlu E{p.Y(), p.Z() + C_S5G};
  pg8::gemm_phase<EpiGlu, pg8::StaticOrder, false>(LDS3(smraw), g, S, E, nullptr);
}

DI void attn_item(const Params& p, int L, int mode, int head, int q_row0, int na_r, const float* bias_s, bf16_t* wl, int lane) {
  const int r = lane & 31, h = lane >> 5;
  int qcol, kcol, gcol;
  const bf16_t* vt;
  if (mode == 0 || mode == 2) {
    qcol = C_NQ + head * 64; kcol = C_NK + head * 64; gcol = C_NG + head * 64;
    vt = p.VtN() + (size_t)(head * 64) * LDT;
  } else {
    qcol = C_GQ + head * 64; kcol = C_GK + (head >> 2) * 64; gcol = C_GG + head * 64;
    vt = p.VtG() + (size_t)((head >> 2) * 64) * LDT;
  }
  bf16_t* Ql = wl + 4096 + lane * 8;
  {
    const bf16_t* qp = p.Z() + (size_t)(q_row0 + r) * LDZ + qcol + h * 8;
#pragma unroll
    for (int ks = 0; ks < 4; ++ks) {
      *reinterpret_cast<bf16x8*>(Ql + ks * 512) = ld16(qp + (size_t)32 * LDZ + ks * 16);
      *reinterpret_cast<bf16x8*>(Ql + 2048 + ks * 512) = ld16(qp + ks * 16);
    }
  }
  float la = 0.f, lb = 0.f;
  const float shf = p.ROPE()[8192 + L * 2 + ((mode == 0 || mode == 2) ? 0 : 1)];
  f32x16 OA0, OA1, OB0, OB1;
#pragma unroll
  for (int i = 0; i < 16; ++i) { OA0[i] = 0.f; OA1[i] = 0.f; OB0[i] = 0.f; OB1[i] = 0.f; }
  const int rs = min(max(na_r - 4, 0), 256 - 8);
  const int csA = min(max(r - 8, 0), 48), csB = min(max(r + 24, 0), 48);
  int kt_lo = 0, nband = 0;
  if (mode == 0) nband = 16;
  else if (mode == 1) {
    kt_lo = max(0, (128 - q_row0) >> 5);
    int kt_hi = min(10, (NLAT - q_row0 + 128) >> 5);
    nband = kt_hi - kt_lo;
  }
  const int ntiles = 8 + nband;
  auto tile_row = [&](int j) -> int {
    if (j < 8) return NLAT + j * 32;
    const int kt = kt_lo + j - 8;
    if (mode == 0) return (rs + (kt >> 1)) * 64 + (kt & 1) * 32;
    return q_row0 - 128 + kt * 32;
  };
  const bf16_t* kg = p.Z() + (size_t)(lane >> 3) * LDZ + kcol + (lane & 7) * 8;
  const bf16_t* vg = vt + (size_t)(lane >> 2) * LDT + (lane & 3) * 8;
  bf16_t* Kl = wl;
  bf16_t* Vl = wl + 2048;
  const int kstE = (lane >> 3) * 64 + (((lane & 7) ^ ((lane >> 4) & 7)) * 8);
  const int kstO = ((lane >> 3) + 8) * 64 + (((lane & 7) ^ (((lane >> 4) + 4) & 7)) * 8);
  const int vst0 = (lane >> 2) * 32 + (((lane & 3) ^ ((lane >> 4) & 3)) * 8);
#define KST(i) ((((i) & 1) ? kstO : kstE) + ((i) >> 1) * 1024)
#define VST(i) (vst0 + (i) * 512)
  const int krd = r * 64, ksw = (r >> 1) & 7;
  const int vrd0 = r * 32, vrd1 = (32 + r) * 32, vsw = (r >> 2) & 3;
  bf16x8 rk[4], rv[4];
  {
    const int t0r = tile_row(0);
#pragma unroll
    for (int i = 0; i < 4; ++i) {
      rk[i] = ld16(kg + (size_t)(t0r + 8 * i) * LDZ);
      rv[i] = ld16(vg + (size_t)(16 * i) * LDT + t0r);
    }
#pragma unroll
    for (int i = 0; i < 4; ++i) {
      *reinterpret_cast<bf16x8*>(Kl + KST(i)) = rk[i];
      *reinterpret_cast<bf16x8*>(Vl + VST(i)) = rv[i];
    }
  }
  for (int j = 0; j < ntiles; ++j) {
    const int krow0 = tile_row(j);
    const bool more = (j + 1 < ntiles);
    if (more) {
      const int tn = tile_row(j + 1);
#pragma unroll
      for (int i = 0; i < 4; ++i) {
        rk[i] = ld16(kg + (size_t)(tn + 8 * i) * LDZ);
        rv[i] = ld16(vg + (size_t)(16 * i) * LDT + tn);
      }
    }
    f32x16 SA, SB;
#pragma unroll
    for (int i = 0; i < 16; ++i) { SA[i] = -shf; SB[i] = -shf; }
#pragma unroll
    for (int ks = 0; ks < 4; ++ks) {
      bf16x8 kf = *reinterpret_cast<const bf16x8*>(Kl + krd + (((ks * 2 + h) ^ ksw) * 8));
      SA = MFMA32(kf, *reinterpret_cast<const bf16x8*>(Ql + 2048 + ks * 512), SA);
      SB = MFMA32(kf, *reinterpret_cast<const bf16x8*>(Ql + ks * 512), SB);
    }
    union { bf16x8 v; unsigned u[4]; } pa0, pa1, pb0, pb1;
#define SOFTMAX_TILE(S_, cs_, qoff_, lsum_, p0_, p1_)                                                      \
    {                                                                                                      \
      if (j >= 8 && mode == 0) {                                                                           \
        const int kt = j - 8;                                                                              \
        const int kcb = (kt & 1) * 32;                                                                     \
        const int di = rs + (kt >> 1) - na_r + 7;                                                          \
        const float* brow = bias_s + 64 + head * 465 + di * 31 + (kcb + 4 * h - (r + qoff_) + 15);        \
        const int t0 = kcb + 4 * h - cs_;                                                                  \
        _Pragma("unroll") for (int i = 0; i < 16; ++i) {                                                   \
          const int ci = (i & 3) + 8 * (i >> 2);                                                           \
          S_[i] = ((unsigned)(t0 + ci) < 16u) ? (S_[i] + brow[ci]) : -INFINITY;                            \
        }                                                                                                  \
      } else if (j >= 8) {                                                                                 \
        const int d0 = krow0 + 4 * h - (q_row0 + qoff_ + r);                                               \
        _Pragma("unroll") for (int i = 0; i < 16; ++i) {                                                   \
          const int df = d0 + (i & 3) + 8 * (i >> 2);                                                      \
          S_[i] = (df <= 128 && df >= -128) ? S_[i] : -INFINITY;                                           \
        }                                                                                                  \
      }                                                                                                    \
      float rsum = 0.f;                                                                                    \
      _Pragma("unroll") for (int i = 0; i < 16; ++i) {                                                     \
        float pv = __builtin_amdgcn_exp2f(S_[i]);                                                          \
        S_[i] = pv;                                                                                        \
        rsum += pv;                                                                                        \
      }                                                                                                    \
      lsum_ += rsum;                                                                                       \
      _Pragma("unroll") for (int q = 0; q < 4; ++q) {                                                      \
        p0_.u[q] = pk2(S_[2 * q], S_[2 * q + 1]);                                                          \
        p1_.u[q] = pk2(S_[8 + 2 * q], S_[8 + 2 * q + 1]);                                                  \
      }                                                                                                    \
    }
    SOFTMAX_TILE(SA, csA, 0, la, pa0, pa1)
    asm volatile("" : "+v"(pa0.u[0]), "+v"(pa0.u[1]), "+v"(pa0.u[2]), "+v"(pa0.u[3]), "+v"(pa1.u[0]), "+v"(pa1.u[1]), "+v"(pa1.u[2]), "+v"(pa1.u[3]));
    SOFTMAX_TILE(SB, csB, 32, lb, pb0, pb1)
#undef SOFTMAX_TILE
    {
      bf16x8 v00 = *reinterpret_cast<const bf16x8*>(Vl + vrd0 + (((0 + h) ^ vsw) * 8));
      bf16x8 v01 = *reinterpret_cast<const bf16x8*>(Vl + vrd0 + (((2 + h) ^ vsw) * 8));
      OA0 = MFMA32(v00, pa0.v, OA0); OB0 = MFMA32(v00, pb0.v, OB0);
      OA0 = MFMA32(v01, pa1.v, OA0); OB0 = MFMA32(v01, pb1.v, OB0);
      bf16x8 v10 = *reinterpret_cast<const bf16x8*>(Vl + vrd1 + (((0 + h) ^ vsw) * 8));
      bf16x8 v11 = *reinterpret_cast<const bf16x8*>(Vl + vrd1 + (((2 + h) ^ vsw) * 8));
      OA1 = MFMA32(v10, pa0.v, OA1); OB1 = MFMA32(v10, pb0.v, OB1);
      OA1 = MFMA32(v11, pa1.v, OA1); OB1 = MFMA32(v11, pb1.v, OB1);
    }
    if (more) {
#pragma unroll
      for (int i = 0; i < 4; ++i) {
        *reinterpret_cast<bf16x8*>(Kl + KST(i)) = rk[i];
        *reinterpret_cast<bf16x8*>(Vl + VST(i)) = rv[i];
      }
    }
  }
  float l_a = la + __shfl_xor(la, 32), l_b = lb + __shfl_xor(lb, 32);
  if (mode == 1 || mode == 3) {
    const float sk = __builtin_amdgcn_exp2f(p.gqa_sink[L * 8 + head] * LOG2E - shf);
    l_a += sk; l_b += sk;
  }
  const float inva = 1.f / l_a, invb = 1.f / l_b;
  bf16_t* gpa = p.Z() + (size_t)(q_row0 + r) * LDZ + gcol + 4 * h;
  bf16_t* gpb = gpa + (size_t)32 * LDZ;
  {
    uint2 gA0[4], gA1[4], gB0[4], gB1[4];
#pragma unroll
    for (int i4 = 0; i4 < 4; ++i4) {
      gA0[i4] = *reinterpret_cast<const uint2*>(gpa + i4 * 8);
      gA1[i4] = *reinterpret_cast<const uint2*>(gpa + 32 + i4 * 8);
      gB0[i4] = *reinterpret_cast<const uint2*>(gpb + i4 * 8);
      gB1[i4] = *reinterpret_cast<const uint2*>(gpb + 32 + i4 * 8);
    }
#define ATT_OUT(O, G, gp, inv, off)                                                                                 \
    {                                                                                                               \
      const uint2 gt = G[i4];                                                                                       \
      uint2 w;                                                                                                      \
      w.x = pk2(O[i4 * 4 + 0] * inv * siluf_(lo_bf(gt.x)), O[i4 * 4 + 1] * inv * siluf_(hi_bf(gt.x)));              \
      w.y = pk2(O[i4 * 4 + 2] * inv * siluf_(lo_bf(gt.y)), O[i4 * 4 + 3] * inv * siluf_(hi_bf(gt.y)));              \
      *reinterpret_cast<uint2*>(gp + off + i4 * 8) = w;                                                             \
    }
#pragma unroll
    for (int i4 = 0; i4 < 4; ++i4) {
      ATT_OUT(OA0, gA0, gpa, inva, 0)
      ATT_OUT(OA1, gA1, gpa, inva, 32)
      ATT_OUT(OB0, gB0, gpb, invb, 0)
      ATT_OUT(OB1, gB1, gpb, invb, 32)
    }
#undef ATT_OUT
  }
#undef KST
#undef VST
}

DI void scan_wg(const Params& p, int L, int dgi, float* sm, int tid) {
  const int lane = tid & 63, w = tid >> 6;
  const int d = dgi >> 5, g = dgi & 31;
  const int dg = (L * 2 + d) * 32 + g;
  const float ar = p.A16()[(dg * 64 + lane) * 2], ai = p.A16()[(dg * 64 + lane) * 2 + 1];
  const int off = g * 256 + d * 128 + lane * 2;
  const int s_lo = w * 130;
  auto chunk_of = [&](int s) -> int { return (d == 0) ? (s < 16 ? 1024 + s : s - 16) : (NCH - 1 - s); };
  float hr = 0.f, hi = 0.f, pr = 1.f, pi = 0.f;
  float2 e[10], en[10];
#pragma unroll
  for (int u = 0; u < 10; ++u) e[u] = *reinterpret_cast<const float2*>(p.E() + (size_t)chunk_of(s_lo + u) * 8192 + off);
  for (int s0 = 0; s0 < 130; s0 += 10) {
    const int sn = (s0 + 10 < 130) ? (s0 + 10) : s0;
#pragma unroll
    for (int u = 0; u < 10; ++u) en[u] = *reinterpret_cast<const float2*>(p.E() + (size_t)chunk_of(s_lo + sn + u) * 8192 + off);
#pragma unroll
    for (int u = 0; u < 10; ++u) {
      float nr = ar * hr - ai * hi + e[u].x, ni = ar * hi + ai * hr + e[u].y;
      hr = nr; hi = ni;
      float qr = pr * ar - pi * ai, qi = pr * ai + pi * ar;
      pr = qr; pi = qi;
    }
#pragma unroll
    for (int u = 0; u < 10; ++u) e[u] = en[u];
  }
  sm[(w * 64 + lane) * 2] = hr;
  sm[(w * 64 + lane) * 2 + 1] = hi;
  __syncthreads();
  float cr = 0.f, ci = 0.f;
  for (int v = 0; v < w; ++v) {
    float tr = sm[(v * 64 + lane) * 2], ti = sm[(v * 64 + lane) * 2 + 1];
    float nr = pr * cr - pi * ci + tr, ni = pr * ci + pi * cr + ti;
    cr = nr; ci = ni;
  }
  __syncthreads();
  hr = cr; hi = ci;
#pragma unroll
  for (int u = 0; u < 10; ++u) e[u] = *reinterpret_cast<const float2*>(p.E() + (size_t)chunk_of(s_lo + u) * 8192 + off);
  for (int s0 = 0; s0 < 130; s0 += 10) {
    const int sn = (s0 + 10 < 130) ? (s0 + 10) : s0;
#pragma unroll
    for (int u = 0; u < 10; ++u) en[u] = *reinterpret_cast<const float2*>(p.E() + (size_t)chunk_of(s_lo + sn + u) * 8192 + off);
#pragma unroll
    for (int u = 0; u < 10; ++u) {
      *reinterpret_cast<unsigned*>(p.HIN() + (size_t)chunk_of(s_lo + s0 + u) * 8192 + off) = pk2(hr, hi);
      float nr = ar * hr - ai * hi + e[u].x, ni = ar * hi + ai * hr + e[u].y;
      hr = nr; hi = ni;
    }
#pragma unroll
    for (int u = 0; u < 10; ++u) e[u] = en[u];
  }
}

DI void phase_attn_scan(const Params& p, int b, int L, float* sm, int tid) {
  const int lane = tid & 63, wid = tid >> 6;
  float* bias_s = sm + 32768;
  bf16_t* wl = reinterpret_cast<bf16_t*>(sm) + wid * 8192;
  for (int idx = tid; idx < 8 * 465; idx += 512) bias_s[64 + idx] = p.na_rel_bias[L * 8 * 465 + idx] * LOG2E;
  __syncthreads();
  constexpr int N_SCAN = 64, N_ATT = 4096 / 8;
  for (int item = blockIdx.x; item < N_SCAN; item += gridDim.x) scan_wg(p, L, item, sm + 32768 + 3840, tid);
  int lat_it = 0, ci = 0;
  for (;;) {
    int item;
    const int lat = (int)blockIdx.x + lat_it * (int)gridDim.x;
    if (lat < N_ATT) { item = lat; ++lat_it; }
    else {
      while (ci < 8 && (unsigned)((64 + ci) % gridDim.x) != blockIdx.x) ++ci;
      if (ci >= 8) break;
      item = N_ATT + ci;
      ++ci;
    }
    int mode, head, q_row0, na_r = 0;
    if (item < N_ATT) {
      const int w = item * 8 + wid;
      if (w < 2048) { mode = 0; head = w & 7; na_r = w >> 3; q_row0 = na_r * 64; }
      else { const int w2 = w - 2048; mode = 1; head = w2 & 7; q_row0 = (w2 >> 3) * 64; }
    } else {
      const int cj = item - N_ATT;
      const int w2 = (cj & 3) * 8 + wid;
      mode = (cj < 4) ? 2 : 3; head = w2 & 7; q_row0 = NLAT + (w2 >> 3) * 64;
    }
    attn_item(p, L, mode, head, q_row0, na_r, bias_s, wl, lane);
  }
  __syncthreads();
}

DI void phase_merge(const Params& p, int b, int L, bf16_t* sm, int tid) {
  VSUB_SETUP
  constexpr int NT = 128 * 8;
  const int nit = (NT + vgrid - 1) / vgrid;
  for (int it = 0; it < nit; ++it) {
    int tile = it * vgrid + vb;
    const bool act = tile < NT;
    if (!act) tile = NT - 1;
    const int mt = tile >> 3, nt = tile & 7;
    const int m0 = mt * 128, n0 = nt * 128;
    f32x16 outv[2][2];
    zero_acc<2>(outv);
    for (int kb = 0; kb < 4; ++kb) {
      f32x16 acc[2][2];
      zero_acc<2>(acc);
      const int gc = (kb == 0) ? C_S5G : (kb == 1 ? C_CG : (kb == 2 ? C_NG : C_GG));
      const bf16_t* Ab = p.Z() + (size_t)m0 * LDZ + gc;
      gemm_main<2, true, false>(acc, Ab, LDZ, (vt & 7) * 8, 64, p.WbrT() + (size_t)(L * 4 + kb) * 1024 * 512 + (size_t)n0 * 512, 512,
                         512, smv, vt, act);
      if (act) {
#pragma unroll
        for (int mi = 0; mi < 2; ++mi) {
          const bf16_t* sgp = p.SG() + sg_index(m0 + wm * 64 + mi * 32 + r, kb * 1024 + n0 + wn * 64 + 4 * h);
#pragma unroll
          for (int ni = 0; ni < 2; ++ni)
#pragma unroll
            for (int i4 = 0; i4 < 4; ++i4) {
              uint2 sv = *reinterpret_cast<const uint2*>(sgp + (ni * 8 + i4 * 2) * 128);
              outv[mi][ni][i4 * 4 + 0] += lo_bf(sv.x) * acc[mi][ni][i4 * 4 + 0];
              outv[mi][ni][i4 * 4 + 1] += hi_bf(sv.x) * acc[mi][ni][i4 * 4 + 1];
              outv[mi][ni][i4 * 4 + 2] += lo_bf(sv.y) * acc[mi][ni][i4 * 4 + 2];
              outv[mi][ni][i4 * 4 + 3] += hi_bf(sv.y) * acc[mi][ni][i4 * 4 + 3];
            }
        }
      }
    }
    if (act) {
#pragma unroll
      for (int mi = 0; mi < 2; ++mi) {
        bf16_t* op = p.MIX() + (size_t)(m0 + wm * 64 + mi * 32 + r) * 1024 + n0 + wn * 64 + 4 * h;
#pragma unroll
        for (int ni = 0; ni < 2; ++ni)
#pragma unroll
          for (int i4 = 0; i4 < 4; ++i4) {
            uint2 w;
            w.x = pk2(outv[mi][ni][i4 * 4 + 0], outv[mi][ni][i4 * 4 + 1]);
            w.y = pk2(outv[mi][ni][i4 * 4 + 2], outv[mi][ni][i4 * 4 + 3]);
            *reinterpret_cast<uint2*>(op + ni * 32 + i4 * 8) = w;
          }
      }
    }
  }
  constexpr int NTC = 2 * 16 * 4;
  const int nitc = (L == 3) ? 0 : (NTC + vgrid - 1) / vgrid;
  for (int it = 0; it < nitc; ++it) {
    int item = it * vgrid + vb;
    const bool act = item < NTC;
    if (!act) item = NTC - 1;
    const int kb = item & 3, nt = (item >> 2) & 15, mt = item >> 6;
    const int m0 = NLAT + mt * 128, n0 = nt * 64;
    f32x16 acc[2][1];
    zero_acc<1>(acc);
    const int gc = (kb == 0) ? C_S5G : (kb == 1 ? C_CG : (kb == 2 ? C_NG : C_GG));
    gemm_main<1, true>(acc, p.Z() + (size_t)m0 * LDZ + gc, LDZ, (vt & 7) * 8, 64,
                       p.WbrT() + (size_t)(L * 4 + kb) * 1024 * 512 + (size_t)n0 * 512, 512, 512, smv, vt, act);
    if (act) {
#pragma unroll
      for (int mi = 0; mi < 2; ++mi) {
        const int row = m0 + wm * 64 + mi * 32 + r;
        const bf16_t* sgp = p.SG() + sg_index(row, kb * 1024 + n0 + wn * 32 + 4 * h);
        bf16_t* op = p.PCTX() + (size_t)kb * 256 * 1024 + (size_t)(row - NLAT) * 1024 + n0 + wn * 32 + 4 * h;
#pragma unroll
        for (int i4 = 0; i4 < 4; ++i4) {
          uint2 sv = *reinterpret_cast<const uint2*>(sgp + (i4 * 2) * 128);
          uint2 w;
          w.x = pk2(lo_bf(sv.x) * acc[mi][0][i4 * 4 + 0], hi_bf(sv.x) * acc[mi][0][i4 * 4 + 1]);
          w.y = pk2(lo_bf(sv.y) * acc[mi][0][i4 * 4 + 2], hi_bf(sv.y) * acc[mi][0][i4 * 4 + 3]);
          *reinterpret_cast<uint2*>(op + i4 * 8) = w;
        }
      }
    }
  }
}

DI void phase_out(const Params& p, int b, int L, unsigned char* smraw, int tid) {
  {
    pg8::StaticOrder S;
    S.init(NLAT, 1024, gridDim.x, blockIdx.x);
    pg8::Gemm g{p.MIX(), p.WoutT() + (size_t)L * 1024 * 1024, NLAT, 1024, 1024};
    EpiOutRes E{(L == 0 ? p.x : (const float*)p.out) + (size_t)b * NLAT * 1024, p.out + (size_t)b * NLAT * 1024,
                p.MOD() + (L * 3 + b) * 3072 + 2048};
    pg8::gemm_phase<EpiOutRes, pg8::StaticOrder, false>(LDS3(smraw), g, S, E, nullptr);
  }
  if (L == 3) return;
  __syncthreads();
  bf16_t* sm = reinterpret_cast<bf16_t*>(smraw);
  VSUB_SETUP
  constexpr int NT = 2 * 8;
  const int nit = (NT + vgrid - 1) / vgrid;
  for (int it = 0; it < nit; ++it) {
    int tile = it * vgrid + vb;
    const bool act = tile < NT;
    if (!act) tile = NT - 1;
    const int mt = tile >> 3, nt = tile & 7;
    const int m0 = NLAT + mt * 128, n0 = nt * 128;
    f32x16 acc[2][2];
    zero_acc<2>(acc);
    {
      const bf16_t* Ab = p.PCTX() + (size_t)(m0 - NLAT) * 1024;
      gemm_main<2, false, false, true>(acc, Ab, 1024, (vt & 7) * 8, 64, p.WoutT() + (size_t)L * 1024 * 1024 + (size_t)n0 * 1024,
                                       1024, 1024, smv, vt, act, (size_t)256 * 1024);
    }
    if (act) {
      const float* src = (L == 0 ? p.ctx : (const float*)p.CTXS()) + ((size_t)b * 256 + (m0 - NLAT)) * 1024;
      float* dst = p.CTXS() + ((size_t)b * 256 + (m0 - NLAT)) * 1024;
      const float* gate = p.MOD() + (L * 3 + 2) * 3072 + 2048;
#pragma unroll
      for (int ni = 0; ni < 2; ++ni) {
        const int col = n0 + wn * 64 + ni * 32 + r;
        const float gt = gate[col];
#pragma unroll
        for (int mi = 0; mi < 2; ++mi) {
          float xs[16];
#pragma unroll
          for (int i = 0; i < 16; ++i) xs[i] = src[(size_t)(wm * 64 + mi * 32 + crow(i, h)) * 1024 + col];
#pragma unroll
          for (int i = 0; i < 16; ++i) dst[(size_t)(wm * 64 + mi * 32 + crow(i, h)) * 1024 + col] = xs[i] + gt * acc[mi][ni][i];
        }
      }
    }
  }
}

#define XB_TMO      128
#define XB_XCNT(j)  (256  + 64 * (j))
#define XB_XSUB(j)  (1280 + 64 * (j))
#define XB_XGEN(j)  (2304 + 64 * (j))
#define XB_TOP      3328
#define XB_TOPGEN   3392
#define XCD_BAR_WORDS 3456
#define XB_SPIN_CAP (1u << 18)
#define LAS __attribute__((address_space(3)))

__device__ __forceinline__ unsigned xb_ld(unsigned* p)              { return __hip_atomic_load(p, __ATOMIC_RELAXED, __HIP_MEMORY_SCOPE_AGENT); }
__device__ __forceinline__ unsigned xb_add(unsigned* p, unsigned v) { return __hip_atomic_fetch_add(p, v, __ATOMIC_RELAXED, __HIP_MEMORY_SCOPE_AGENT); }
__device__ __forceinline__ unsigned xb_xcc_id() { return (unsigned)__builtin_amdgcn_s_getreg((3 << 11) | 20) & 0xFu; }
#define XB_SPIN(cond, bar) do { unsigned _sp = 0; while (cond) { __builtin_amdgcn_s_sleep(1); \
    if ((++_sp & 255u) == 0u) { if (xb_ld(&(bar)[XB_TMO])) break; if (_sp > XB_SPIN_CAP) { atomicAdd(&(bar)[XB_TMO], 1u); break; } } } } while (0)

struct XcdBarrier {
    unsigned* bar; unsigned x;
    volatile LAS unsigned* st;
};

__device__ __forceinline__ XcdBarrier xcd_barrier_post(unsigned* bar, volatile LAS unsigned* st) {
    XcdBarrier b; b.bar = bar; b.x = xb_xcc_id(); b.st = st;
    if (threadIdx.x == 0) (void)xb_add(&bar[XB_XCNT(b.x)], 1u);
    return b;
}
__device__ __forceinline__ void xcd_barrier_complete(unsigned* bar, unsigned x, unsigned& nloc, unsigned& nx) {
    const unsigned G = gridDim.x * gridDim.y * gridDim.z;
    unsigned sum, cnt, mine, sp = 0u;
    for (;;) {
        sum = 0u; cnt = 0u; mine = 0u;
#pragma unroll
        for (unsigned j = 0; j < 16; ++j) { const unsigned c = xb_ld(&bar[XB_XCNT(j)]); sum += c; cnt += (c > 0u) ? 1u : 0u; mine = (j == x) ? c : mine; }
        if (sum == G) break;
        __builtin_amdgcn_s_sleep(1);
        if ((++sp & 255u) == 0u) { if (xb_ld(&bar[XB_TMO])) break; if (sp > XB_SPIN_CAP) { atomicAdd(&bar[XB_TMO], 1u); break; } }
    }
    nloc = mine > 0u ? mine : 1u; nx = cnt > 0u ? cnt : 1u;
}

__device__ __forceinline__ void xcd_barrier(const XcdBarrier& b) {
    asm volatile("s_waitcnt vmcnt(0)" ::: "memory");
    __syncthreads();
    if (threadIdx.x == 0) {
        unsigned* bar = b.bar;
        __builtin_amdgcn_s_waitcnt(0);
        unsigned nloc = b.st[0], nx = b.st[1];
        if (nloc == 0u) { xcd_barrier_complete(bar, b.x, nloc, nx); b.st[0] = nloc; b.st[1] = nx; }
        const unsigned old = xb_add(&bar[XB_XSUB(b.x)], 1u);
        const unsigned gen = old / nloc;
        if (old + 1u == (gen + 1u) * nloc) {
            __builtin_amdgcn_fence(__ATOMIC_RELEASE, "agent");
            asm volatile("s_waitcnt vmcnt(0)" ::: "memory");
            const unsigned og = xb_add(&bar[XB_TOP], 1u);
            const unsigned tg = og / nx;
            if (og + 1u == (tg + 1u) * nx) xb_add(&bar[XB_TOPGEN], 1u);
            else XB_SPIN(xb_ld(&bar[XB_TOPGEN]) == tg, bar);
            __builtin_amdgcn_fence(__ATOMIC_ACQUIRE, "agent");
            xb_add(&bar[XB_XGEN(b.x)], 1u);
            asm volatile("s_waitcnt vmcnt(0)" ::: "memory");
        } else {
            XB_SPIN(xb_ld(&bar[XB_XGEN(b.x)]) == gen, bar);
            __builtin_amdgcn_fence(__ATOMIC_ACQUIRE, "agent");
            asm volatile("s_waitcnt vmcnt(0)" ::: "memory");
        }
    }
    __syncthreads();
}


__global__ void __launch_bounds__(512, 2) mega_kernel(Params p, int ph_lo, int ph_hi) {
  __shared__ __attribute__((aligned(1024))) unsigned char smem_raw[151552];
  __shared__ uint4 xb_words;
  bf16_t* smb = reinterpret_cast<bf16_t*>(smem_raw);
  float* smf = reinterpret_cast<float*>(smem_raw);
  if (threadIdx.x == 0) xb_words = make_uint4(0u, 0u, 0u, 0u);
  __syncthreads();
  XcdBarrier xb = xcd_barrier_post(p.bar, (volatile LAS unsigned*)&xb_words);
  if (ph_hi < 0) cg::this_grid().sync();
  for (int ph = ph_lo; ph < ph_hi; ++ph) {
    int tid = threadIdx.x;
    asm volatile("" : "+v"(tid));
    if (ph == 0) {
      phase_prep(p, smf, tid);
    } else {
      const int q = ph - 1;
      const int b = q >> 5, L = (q & 31) >> 3, sub = q & 7;
      switch (sub) {
        case 0: phase_norm(p, b, L, tid); break;
        case 1: phase_p1(p, b, L, smem_raw); break;
        case 2: phase_s5e_conv_post(p, b, L, smb, tid); break;
        case 3: phase_attn_scan(p, b, L, smf, tid); break;
        case 4: phase_s5y(p, b, L, smb, tid); break;
        case 5: phase_glu(p, b, L, smem_raw); break;
        case 6: phase_merge(p, b, L, smb, tid); break;
        default: phase_out(p, b, L, smem_raw, tid); break;
      }
    }
    if (ph + 1 < ph_hi) xcd_barrier(xb);
  }
}

extern "C" void kernel_launch(void* const* d_in, const int* in_sizes, int n_in, void* d_out, int out_size, void* d_ws,
                              size_t ws_size, hipStream_t stream) {
  Params p{};
  const float** fp = reinterpret_cast<const float**>(&p);
  for (int i = 0; i < 27; ++i) fp[i] = (const float*)d_in[i];
  p.out = (float*)d_out;
  p.ws = (char*)d_ws;
  p.bar = (unsigned*)((char*)d_ws + OFF_BAR);
  if (WS_TOTAL > ws_size) {
    fprintf(stderr, "workspace too small: need %zu have %zu\n", (size_t)WS_TOTAL, ws_size);
    return;
  }
  static int grid_blocks = 0;
  if (!grid_blocks) {
    int dev = 0, cus = 0, per_cu = 0;
    (void)hipGetDevice(&dev);
    (void)hipDeviceGetAttribute(&cus, hipDeviceAttributeMultiprocessorCount, dev);
    (void)hipOccupancyMaxActiveBlocksPerMultiprocessor(&per_cu, mega_kernel, 512, 0);
    if (per_cu > 1) per_cu = 1;
    if (per_cu < 1) per_cu = 1;
    grid_blocks = cus * per_cu;
  }
  (void)hipMemsetAsync(p.bar, 0, 4096 * 4, stream);
#if MULTI_LAUNCH
  for (int ph = 0; ph < NPHASE; ++ph) {
    hipLaunchKernelGGL(mega_kernel, dim3(grid_blocks), dim3(512), 0, stream, p, ph, ph + 1);
  }
#else
  int lo = 0, hi = NPHASE;
  void* args[] = {&p, &lo, &hi};
  hipError_t e = hipLaunchCooperativeKernel((void*)mega_kernel, dim3(grid_blocks), dim3(512), args, 0, stream);
  if (e != hipSuccess) fprintf(stderr, "cooperative launch failed: %s (grid %d)\n", hipGetErrorString(e), grid_blocks);
#endif
}
```

```cpp
#include <hip/hip_runtime.h>
#include <hip/hip_cooperative_groups.h>
#include <cstdio>
namespace cg = cooperative_groups;

#ifdef ONLY
#define ONLYP(i) (ONLY == (i))
#else
#define ONLYP(i) 1
#endif
#ifndef MULTI_LAUNCH
#define MULTI_LAUNCH 0
#endif

#define DI __device__ __forceinline__
typedef unsigned short bf16_t;
typedef __attribute__((ext_vector_type(8))) short bf16x8;
typedef __attribute__((ext_vector_type(16))) float f32x16;
typedef __attribute__((ext_vector_type(2))) float f32x2;
typedef __attribute__((ext_vector_type(2))) __bf16 bfx2;
#define MFMA32(a, b, c) __builtin_amdgcn_mfma_f32_32x32x16_bf16((a), (b), (c), 0, 0, 0)

constexpr int R = 16640;
constexpr int NLAT = 16384;
constexpr int LDZ = 6400;
constexpr int LDT = 16640;
constexpr int NCH = 1040;
constexpr float LOG2E = 1.4426950408889634f;
constexpr int C_S5U = 0, C_S5G = 512, C_CV = 1024, C_CB = 1536, C_CC = 2048, C_CG = 2560, C_NQ = 3072, C_NK = 3584,
              C_NV = 4096, C_NG = 4608, C_GQ = 5120, C_GK = 5632, C_GV = 5760, C_GG = 5888;
constexpr int NPHASE = 1 + 2 * 4 * 8;

constexpr size_t al256(size_t x) { return (x + 255) & ~(size_t)255; }
constexpr size_t OFF_H = 0;
constexpr size_t OFF_Z = OFF_H + al256((size_t)R * 1024 * 2);
constexpr size_t OFF_VTN = OFF_Z + al256((size_t)R * LDZ * 2);
constexpr size_t OFF_VTG = OFF_VTN + al256((size_t)512 * LDT * 2);
constexpr size_t OFF_Y = OFF_VTG + al256((size_t)128 * LDT * 2);
constexpr size_t OFF_HIN = OFF_Y + al256((size_t)R * 512 * 2);
constexpr size_t OFF_E = OFF_HIN + al256((size_t)NCH * 8192 * 2);
constexpr size_t OFF_MIX = OFF_E;
constexpr size_t OFF_SG = OFF_E + al256((size_t)R * 1024 * 2);
constexpr size_t OFF_CTXS = OFF_SG + al256((size_t)R * 4096 * 2);
constexpr size_t OFF_WINT = OFF_CTXS + al256((size_t)512 * 1024 * 4);
constexpr size_t OFF_WBRT = OFF_WINT + al256((size_t)4 * 10496 * 1024 * 2);
constexpr size_t OFF_WOUTT = OFF_WBRT + al256((size_t)16 * 1024 * 512 * 2);
constexpr size_t OFF_WGLUT = OFF_WOUTT + al256((size_t)4 * 1024 * 1024 * 2);
constexpr size_t OFF_S5M = OFF_WGLUT + al256((size_t)4 * 512 * 512 * 2);
constexpr size_t OFF_S5WE = OFF_S5M + al256((size_t)128 * 65536 * 2);
constexpr size_t OFF_S5R = OFF_S5WE + al256((size_t)128 * 65536 * 2);
constexpr size_t OFF_A16 = OFF_S5R + al256((size_t)128 * 65536 * 2);
constexpr size_t OFF_MOD = OFF_A16 + al256((size_t)4 * 2 * 32 * 64 * 2 * 4);
constexpr size_t OFF_ROPE = OFF_MOD + al256((size_t)4 * 3 * 3072 * 4);
constexpr size_t OFF_BAR = OFF_ROPE + al256((size_t)256 * 16 * 2 * 4 + 64);
constexpr size_t OFF_PCTX = OFF_BAR + al256((size_t)4096 * 4);
constexpr size_t WS_TOTAL = OFF_PCTX + al256((size_t)4 * 256 * 1024 * 2);

struct Params {
  const float *x, *c, *ctx, *c_ctx, *norm_g, *w_ada, *b_ada, *w_in, *s5_a_re, *s5_a_im, *s5_log_dt, *s5_b_re, *s5_b_im,
      *s5_c_re, *s5_c_im, *s5_d, *s5_w_glu, *conv_w, *conv_b, *na_q_g, *na_k_g, *na_rel_bias, *gqa_q_g, *gqa_k_g, *gqa_sink,
      *w_br, *w_out;
  float* out;
  char* ws;
  unsigned* bar;
  DI bf16_t* H() const { return (bf16_t*)(ws + OFF_H); }
  DI bf16_t* Z() const { return (bf16_t*)(ws + OFF_Z); }
  DI bf16_t* VtN() const { return (bf16_t*)(ws + OFF_VTN); }
  DI bf16_t* VtG() const { return (bf16_t*)(ws + OFF_VTG); }
  DI bf16_t* Y() const { return (bf16_t*)(ws + OFF_Y); }
  DI bf16_t* MIX() const { return (bf16_t*)(ws + OFF_MIX); }
  DI bf16_t* HIN() const { return (bf16_t*)(ws + OFF_HIN); }
  DI float* E() const { return (float*)(ws + OFF_E); }
  DI float* CTXS() const { return (float*)(ws + OFF_CTXS); }
  DI bf16_t* WinT() const { return (bf16_t*)(ws + OFF_WINT); }
  DI bf16_t* SG() const { return (bf16_t*)(ws + OFF_SG); }
  DI bf16_t* PCTX() const { return (bf16_t*)(ws + OFF_PCTX); }
  DI bf16_t* WbrT() const { return (bf16_t*)(ws + OFF_WBRT); }
  DI bf16_t* WoutT() const { return (bf16_t*)(ws + OFF_WOUTT); }
  DI bf16_t* WgluT() const { return (bf16_t*)(ws + OFF_WGLUT); }
  DI bf16_t* S5M() const { return (bf16_t*)(ws + OFF_S5M); }
  DI bf16_t* S5We() const { return (bf16_t*)(ws + OFF_S5WE); }
  DI bf16_t* S5R() const { return (bf16_t*)(ws + OFF_S5R); }
  DI float* A16() const { return (float*)(ws + OFF_A16); }
  DI float* MOD() const { return (float*)(ws + OFF_MOD); }
  DI float* ROPE() const { return (float*)(ws + OFF_ROPE); }
};

DI float bf2f(bf16_t v) { return __uint_as_float(((unsigned)v) << 16); }
DI unsigned pk2(float a, float b) {
  f32x2 v = {a, b};
  bfx2 r = __builtin_convertvector(v, bfx2);
  return __builtin_bit_cast(unsigned, r);
}
DI bf16_t f2bf(float a) { return (bf16_t)(pk2(a, 0.f) & 0xffffu); }
DI float lo_bf(unsigned u) { return __uint_as_float(u << 16); }
DI float hi_bf(unsigned u) { return __uint_as_float(u & 0xffff0000u); }
DI float sigmoidf_(float x) { return 1.f / (1.f + __expf(-x)); }
DI float siluf_(float x) { return x / (1.f + __expf(-x)); }
DI size_t sg_index(int row, int col) { return ((size_t)((row >> 5) * 1024 + (col >> 2)) * 32 + (row & 31)) * 4 + (col & 3); }
DI int crow(int i, int h) { return (i & 3) + 8 * (i >> 2) + 4 * h; }
DI bf16x8 ld16(const bf16_t* p) { return *reinterpret_cast<const bf16x8*>(p); }


namespace pg8 {
typedef unsigned short bf16_t;
#define PG8_LAS __attribute__((address_space(3)))
typedef short bf16x8 __attribute__((ext_vector_type(8)));
typedef float f32x4 __attribute__((ext_vector_type(4)));
typedef unsigned u32x4 __attribute__((ext_vector_type(4)));
constexpr int BM = 256, BK = 64, HALF = 128, HTB = HALF * BK * 2  , STAGE_BYTES = 8 * HTB, NXCD = 8, WGM = 8;

__host__ __device__ __forceinline__ int lds_byte(int r, int c) { const int st = (r >> 4) * 2 + (c >> 5), rr = r & 15, cc = c & 31, ob = rr * 64 + cc * 2; return st * 1024 + (ob ^ (((ob >> 9) & 1) << 5)); }
__host__ __device__ __forceinline__ void stage_rc(int b, int& R, int& C) { const int st = b / 1024, sb = b % 1024, swz = sb ^ (((sb >> 9) & 1) << 5); R = (st >> 1) * 16 + swz / 64; C = (st & 1) * 32 + (swz % 64) / 2; }
__host__ __device__ __forceinline__ int perm32(int rho) { const int n = rho >> 4, i = rho & 15; return 8 * (i >> 2) + 4 * n + (i & 3); }

struct Unit { int pm, pn; };
struct Gemm { const bf16_t* A; const bf16_t* Bt; int M, N, K; };

struct StaticOrder {
    int nM, nN, nwg, G, c;
    __host__ __device__ void init(int M, int N, int G_, int c_) { nM = M / BM; nN = N / BM; nwg = nM * nN; G = G_; c = c_; }
    __host__ __device__ bool next(int i, Unit& u) const {
        const long L = (long)i * G + c; if (L >= nwg) return false;
        int wgid = (int)L; { const int q = nwg / NXCD, r = nwg % NXCD, xcd = wgid % NXCD, off = wgid / NXCD; wgid = (xcd < r ? xcd * (q + 1) : r * (q + 1) + (xcd - r) * q) + off; }
        const int nig = WGM * nN, gid = wgid / nig, fm = gid * WGM, gsz = (nM - fm) < WGM ? (nM - fm) : WGM;
        u.pm = fm + ((wgid % nig) % gsz); u.pn = (wgid % nig) / gsz; return true;
    }
    __device__ __forceinline__ void a_ready(const Unit&) const {}
    __device__ __forceinline__ void done(const Unit&) const {}
};
struct CountedOrder : StaticOrder {
    const unsigned* ready; unsigned need; unsigned* tmo;
    __device__ __forceinline__ void a_ready(const Unit& u) const {
        if (threadIdx.x < 64) {
            const unsigned long long t0 = __builtin_amdgcn_s_memrealtime(); unsigned polls = 0;
            while ((unsigned)__builtin_amdgcn_readfirstlane(__hip_atomic_load(ready + 64 * u.pm, __ATOMIC_RELAXED, __HIP_MEMORY_SCOPE_AGENT)) < need) {
                if ((++polls & 255u) == 0u && __builtin_amdgcn_readfirstlane(__hip_atomic_load(tmo, __ATOMIC_RELAXED, __HIP_MEMORY_SCOPE_AGENT)) != 0u) break;
                if (__builtin_amdgcn_s_memrealtime() - t0 > 2000000ull) {
                    if (threadIdx.x == 0) { unsigned expect = 0u; __hip_atomic_compare_exchange_strong(tmo + 1, &expect, 0x600u | (unsigned)(u.pm & 0xff), __ATOMIC_RELAXED, __ATOMIC_RELAXED, __HIP_MEMORY_SCOPE_AGENT); __hip_atomic_store(tmo, 1u, __ATOMIC_RELAXED, __HIP_MEMORY_SCOPE_AGENT); }
                    break; }
                __builtin_amdgcn_s_sleep(2); }
            __builtin_amdgcn_fence(__ATOMIC_ACQUIRE, "agent");
            asm volatile("s_waitcnt vmcnt(0)" ::: "memory");
        }
#if !defined(BROKEN_HOOK_NO_BARRIER)
        asm volatile("" ::: "memory"); __builtin_amdgcn_s_barrier(); asm volatile("" ::: "memory");
#endif
    }
};

__device__ __forceinline__ unsigned cvt_pk_bf16(float lo, float hi) { unsigned r; asm volatile("v_cvt_pk_bf16_f32 %0, %1, %2" : "=v"(r) : "v"(lo), "v"(hi)); return r; }
typedef float f32x2 __attribute__((ext_vector_type(2)));
__device__ __forceinline__ f32x2 gelu_pk(f32x2 v) {
    const f32x2 av = __builtin_elementwise_abs(v), d = av * 0.2316418882f + 1.0f;
    f32x2 t; t.x = __builtin_amdgcn_rcpf(d.x); t.y = __builtin_amdgcn_rcpf(d.y);
    f32x2 q = t * 0.5307027145f + (-0.7265760135f); q = q * t + 0.7107068705f; q = q * t + (-0.142248368f); q = q * t + 0.127414796f; q = q * t;
    const f32x2 s = (v * v) * (-0.72134752044f);
    f32x2 e; e.x = __builtin_amdgcn_exp2f(s.x); e.y = __builtin_amdgcn_exp2f(s.y);
    const f32x2 m = v * (q * e), r = v - m;
    f32x2 o; o.x = v.x < 0.f ? m.x : r.x; o.y = v.y < 0.f ? m.y : r.y; return o;
}

struct EpiF32 {
    static constexpr bool PERM = false, AFTER_DRAIN = false;
    float* C; int ldc; const float* bias;
    __device__ __forceinline__ void operator()(const f32x4 (&acc)[2][2][4][2], const Unit& u, int wr, int wc, int fr, int fq) const {
        const int row0 = u.pm * BM + wr * 64 + fr, col0 = u.pn * BM + wc * 32 + 4 * fq;
        f32x4 bv[2][2];
#pragma unroll
        for (int bj = 0; bj < 2; ++bj)
#pragma unroll
            for (int n = 0; n < 2; ++n) bv[bj][n] = bias ? *(const f32x4*)(bias + col0 + bj * HALF + n * 16) : (f32x4){0.f, 0.f, 0.f, 0.f};
#pragma unroll
        for (int ai = 0; ai < 2; ++ai)
#pragma unroll
            for (int m = 0; m < 4; ++m) { float* rowp = C + (size_t)(row0 + ai * HALF + m * 16) * ldc + col0;
#pragma unroll
                for (int bj = 0; bj < 2; ++bj)
#pragma unroll
                    for (int n = 0; n < 2; ++n) *(f32x4*)(rowp + bj * HALF + n * 16) = acc[ai][bj][m][n] + bv[bj][n]; }
    }
};
template <int ACT  > struct EpiBf16 {
    static constexpr bool PERM = true, AFTER_DRAIN = false;
    bf16_t* O; int ldc; const float* bias; int split_cols; size_t split_stride;
    __device__ __forceinline__ void operator()(const f32x4 (&acc)[2][2][4][2], const Unit& u, int wr, int wc, int fr, int fq) const {
        const int row0 = u.pm * BM + wr * 64 + fr; int colt = u.pn * BM; bf16_t* base = O;
        if (split_cols) { const int t = colt / split_cols; base += (size_t)t * split_stride; colt -= t * split_cols; }
        const int col0 = colt + wc * 32 + 8 * fq, bcol0 = u.pn * BM + wc * 32 + 8 * fq;
        f32x4 bv[2][2];
#pragma unroll
        for (int bj = 0; bj < 2; ++bj)
#pragma unroll
            for (int n = 0; n < 2; ++n) bv[bj][n] = bias ? *(const f32x4*)(bias + bcol0 + bj * HALF + 4 * n) : (f32x4){0.f, 0.f, 0.f, 0.f};
#pragma unroll
        for (int ai = 0; ai < 2; ++ai)
#pragma unroll
            for (int m = 0; m < 4; ++m) { bf16_t* rowp = base + (size_t)(row0 + ai * HALF + m * 16) * ldc + col0;
#pragma unroll
                for (int bj = 0; bj < 2; ++bj) { f32x4 v0 = acc[ai][bj][m][0] + bv[bj][0], v1 = acc[ai][bj][m][1] + bv[bj][1];
                    if (ACT == 1) { f32x2 a = gelu_pk((f32x2){v0[0], v0[1]}), b = gelu_pk((f32x2){v0[2], v0[3]}), c = gelu_pk((f32x2){v1[0], v1[1]}), d = gelu_pk((f32x2){v1[2], v1[3]});
                        v0 = (f32x4){a.x, a.y, b.x, b.y}; v1 = (f32x4){c.x, c.y, d.x, d.y}; }
                    if (ACT == 2) {
#pragma unroll
                        for (int j = 0; j < 4; ++j) { v0[j] = 0.5f * v0[j] * (1.0f + erff(v0[j] * 0.70710678f)); v1[j] = 0.5f * v1[j] * (1.0f + erff(v1[j] * 0.70710678f)); } }
                    u32x4 w; w.x = cvt_pk_bf16(v0[0], v0[1]); w.y = cvt_pk_bf16(v0[2], v0[3]); w.z = cvt_pk_bf16(v1[0], v1[1]); w.w = cvt_pk_bf16(v1[2], v1[3]);
                    *(u32x4*)(rowp + bj * HALF) = w; } }
    }
};

struct PanelStats {
    unsigned* xbuf;
    unsigned* cnt;
    unsigned* tmo;
    int ntn; float eps;
    unsigned code;
    __device__ __forceinline__ bool run(const f32x4 (&v)[2][2][4][2], const Unit& u, int wr, int wc, int fr, int fq, PG8_LAS unsigned char* lds, int wid, int lane) const {
        typedef float f32x2v __attribute__((ext_vector_type(2)));
        PG8_LAS f32x2v* P = (PG8_LAS f32x2v*)lds;
        PG8_LAS f32x2v* S = (PG8_LAS f32x2v*)(lds + 8192);
        PG8_LAS unsigned* flag = (PG8_LAS unsigned*)(lds + 8192 + 2048);
#pragma unroll
        for (int ai = 0; ai < 2; ++ai)
#pragma unroll
            for (int m = 0; m < 4; ++m) {
                float s = 0.f;
#pragma unroll
                for (int bj = 0; bj < 2; ++bj)
#pragma unroll
                    for (int n = 0; n < 2; ++n) { const f32x4 x = v[ai][bj][m][n]; s += (x[0] + x[1]) + (x[2] + x[3]); }
                s += __shfl_xor(s, 16); s += __shfl_xor(s, 32);
                const float mw = s * (1.0f / 64.0f); float q = 0.f;
#pragma unroll
                for (int bj = 0; bj < 2; ++bj)
#pragma unroll
                    for (int n = 0; n < 2; ++n) { const f32x4 d = v[ai][bj][m][n] - mw; q += (d[0] * d[0] + d[1] * d[1]) + (d[2] * d[2] + d[3] * d[3]); }
                q += __shfl_xor(q, 16); q += __shfl_xor(q, 32);
                if (fq == 0) P[(ai * HALF + wr * 64 + m * 16 + fr) * 4 + wc] = (f32x2v){mw, q};
            }
        asm volatile("s_waitcnt lgkmcnt(0)" ::: "memory"); __builtin_amdgcn_s_barrier(); asm volatile("" ::: "memory");
#if defined(BROKEN_NO_WAIT)
        if (blockIdx.x >= 64) { const long long t0 = clock64(); while (clock64() - t0 < 60000) __builtin_amdgcn_s_sleep(8); }
#endif
        const int row = wid * 32 + (lane & 31);
        if (lane < 32) {
            const f32x2v a = P[row * 4 + 0], b = P[row * 4 + 1], c = P[row * 4 + 2], d = P[row * 4 + 3];
            const float mt = (a.x + b.x + c.x + d.x) * 0.25f;
            const float da = a.x - mt, db = b.x - mt, dc = c.x - mt, dd = d.x - mt;
            const float m2 = (a.y + b.y) + (c.y + d.y) + 64.0f * ((da * da + db * db) + (dc * dc + dd * dd));
            unsigned long long* slot = (unsigned long long*)xbuf + ((size_t)(u.pm * BM + row) * 4 + u.pn);
            __hip_atomic_store(slot, ((unsigned long long)__float_as_uint(m2) << 32) | __float_as_uint(mt), __ATOMIC_RELAXED, __HIP_MEMORY_SCOPE_AGENT);
        }
        asm volatile("s_waitcnt vmcnt(0)" ::: "memory");
        if (lane == 0) __hip_atomic_fetch_add(cnt + 64 * u.pm, 1u, __ATOMIC_RELAXED, __HIP_MEMORY_SCOPE_AGENT);
        if (wid == 0) {
            bool dead = false; const unsigned long long t0 = __builtin_amdgcn_s_memrealtime(); const unsigned want = 8u * (unsigned)ntn;
            for (;;) {
#if defined(BROKEN_NO_WAIT)
                break;
#endif
                if ((unsigned)__builtin_amdgcn_readfirstlane(__hip_atomic_load(cnt + 64 * u.pm, __ATOMIC_RELAXED, __HIP_MEMORY_SCOPE_AGENT)) >= want) break;
                if (__builtin_amdgcn_s_memrealtime() - t0 > 2000000ull) {
                    if (lane == 0) { unsigned expect = 0u; __hip_atomic_compare_exchange_strong(tmo + 1, &expect, code | (unsigned)(u.pm & 0xff), __ATOMIC_RELAXED, __ATOMIC_RELAXED, __HIP_MEMORY_SCOPE_AGENT);
                                     __hip_atomic_store(tmo, 1u, __ATOMIC_RELAXED, __HIP_MEMORY_SCOPE_AGENT); }
                    dead = true; break; }
                __builtin_amdgcn_s_sleep(2);
            }
            __builtin_amdgcn_fence(__ATOMIC_ACQUIRE, "agent");
            if (lane == 0) flag[0] = dead ? 1u : 0u;
        }
        asm volatile("s_waitcnt vmcnt(0) lgkmcnt(0)" ::: "memory"); __builtin_amdgcn_s_barrier(); asm volatile("" ::: "memory");
        const bool bad = flag[0] != 0u;
        if (lane < 32) {
            const unsigned long long* slot = (const unsigned long long*)xbuf + (size_t)(u.pm * BM + row) * 4; float mt[4], m2[4]; float ms = 0.f;
#pragma unroll
            for (int t = 0; t < 4; ++t) { if (t < ntn) { const unsigned long long w = __hip_atomic_load(slot + t, __ATOMIC_RELAXED, __HIP_MEMORY_SCOPE_AGENT); mt[t] = __uint_as_float((unsigned)w); m2[t] = __uint_as_float((unsigned)(w >> 32)); } else { mt[t] = 0.f; m2[t] = 0.f; } ms += mt[t]; }
            const float mean = ms / (float)ntn; float q = 0.f;
#pragma unroll
            for (int t = 0; t < 4; ++t) if (t < ntn) { const float dm = mt[t] - mean; q += m2[t] + 256.0f * dm * dm; }
            S[row] = (f32x2v){mean, 1.0f / sqrtf(q / (256.0f * (float)ntn) + eps)};
        }
        asm volatile("s_waitcnt lgkmcnt(0)" ::: "memory"); __builtin_amdgcn_s_barrier(); asm volatile("" ::: "memory");
        return bad;
    }
};
struct EpiLnRes {
    static constexpr bool PERM = false, AFTER_DRAIN = true;
    const float* base; float* out; int ldc; const float* bias; PanelStats st; unsigned poison;
    __device__ __forceinline__ void refuse(size_t i0, size_t stride, int M, int N) const { const float q = __builtin_nanf(""); for (size_t i = i0; i < (size_t)M * N; i += stride) out[(i / N) * ldc + i % N] = q;
        if (i0 == 0) { unsigned expect = 0u; __hip_atomic_compare_exchange_strong(st.tmo + 1, &expect, 0x7f0u, __ATOMIC_RELAXED, __ATOMIC_RELAXED, __HIP_MEMORY_SCOPE_AGENT); __hip_atomic_store(st.tmo, 1u, __ATOMIC_RELAXED, __HIP_MEMORY_SCOPE_AGENT); } }
    __device__ __forceinline__ void fused(f32x4 (&acc)[2][2][4][2], const Unit& u, int wr, int wc, int fr, int fq, PG8_LAS unsigned char* lds, int wid, int lane) const {
        typedef float f32x2v __attribute__((ext_vector_type(2)));
        const PG8_LAS f32x2v* S = (const PG8_LAS f32x2v*)(lds + 8192);
        const int col0 = u.pn * BM + wc * 32 + 4 * fq;
#pragma unroll
        for (int bj = 0; bj < 2; ++bj)
#pragma unroll
            for (int n = 0; n < 2; ++n) { const f32x4 bv = bias ? *(const f32x4*)(bias + col0 + bj * HALF + n * 16) : (f32x4){0.f, 0.f, 0.f, 0.f};
#pragma unroll
                for (int ai = 0; ai < 2; ++ai)
#pragma unroll
                    for (int m = 0; m < 4; ++m) acc[ai][bj][m][n] += bv; }
        const bool bad = st.run(acc, u, wr, wc, fr, fq, lds, wid, lane) || poison != 0u;
        const float qnan = __builtin_nanf("");
#pragma unroll
        for (int ai = 0; ai < 2; ++ai)
#pragma unroll
            for (int m = 0; m < 4; ++m) { const int r = ai * HALF + wr * 64 + m * 16 + fr; const f32x2v sr = S[r]; const size_t off = (size_t)(u.pm * BM + r) * ldc + col0;
#pragma unroll
                for (int bj = 0; bj < 2; ++bj)
#pragma unroll
                    for (int n = 0; n < 2; ++n) { const f32x4 bs = *(const f32x4*)(base + off + bj * HALF + n * 16); f32x4 o = bs + (acc[ai][bj][m][n] - sr.x) * sr.y;
                        if (bad) o = (f32x4){qnan, qnan, qnan, qnan}; *(f32x4*)(out + off + bj * HALF + n * 16) = o; }
                asm volatile("" ::: "memory"); }
    }
};
struct EpiLnResLn {
    static constexpr bool PERM = false, AFTER_DRAIN = true;
    const float* base; float* out; bf16_t* xn; int ldc; const float* bias; PanelStats st1, st2; unsigned poison;
    __device__ __forceinline__ void refuse(size_t i0, size_t stride, int M, int N) const { const float q = __builtin_nanf(""); for (size_t i = i0; i < (size_t)M * N; i += stride) { const size_t o = (i / N) * ldc + i % N; out[o] = q; xn[o] = (bf16_t)0x7fc0u; }
        if (i0 == 0) { unsigned expect = 0u; __hip_atomic_compare_exchange_strong(st1.tmo + 1, &expect, 0x7f0u, __ATOMIC_RELAXED, __ATOMIC_RELAXED, __HIP_MEMORY_SCOPE_AGENT); __hip_atomic_store(st1.tmo, 1u, __ATOMIC_RELAXED, __HIP_MEMORY_SCOPE_AGENT); } }
    __device__ __forceinline__ void fused(f32x4 (&acc)[2][2][4][2], const Unit& u, int wr, int wc, int fr, int fq, PG8_LAS unsigned char* lds, int wid, int lane) const {
        typedef float f32x2v __attribute__((ext_vector_type(2))); typedef unsigned u32x2v __attribute__((ext_vector_type(2)));
        const PG8_LAS f32x2v* S = (const PG8_LAS f32x2v*)(lds + 8192);
        const int col0 = u.pn * BM + wc * 32 + 4 * fq;
#pragma unroll
        for (int bj = 0; bj < 2; ++bj)
#pragma unroll
            for (int n = 0; n < 2; ++n) { const f32x4 bv = bias ? *(const f32x4*)(bias + col0 + bj * HALF + n * 16) : (f32x4){0.f, 0.f, 0.f, 0.f};
#pragma unroll
                for (int ai = 0; ai < 2; ++ai)
#pragma unroll
                    for (int m = 0; m < 4; ++m) acc[ai][bj][m][n] += bv; }
        bool bad = st1.run(acc, u, wr, wc, fr, fq, lds, wid, lane) || poison != 0u;
        const float qnan = __builtin_nanf("");
#pragma unroll
        for (int ai = 0; ai < 2; ++ai)
#pragma unroll
            for (int m = 0; m < 4; ++m) { const int r = ai * HALF + wr * 64 + m * 16 + fr; const f32x2v sr = S[r]; const size_t off = (size_t)(u.pm * BM + r) * ldc + col0;
#pragma unroll
                for (int bj = 0; bj < 2; ++bj)
#pragma unroll
                    for (int n = 0; n < 2; ++n) { const f32x4 bs = *(const f32x4*)(base + off + bj * HALF + n * 16); acc[ai][bj][m][n] = bs + (acc[ai][bj][m][n] - sr.x) * sr.y; }
                asm volatile("" : "+v"(acc[ai][0][m][0]), "+v"(acc[ai][0][m][1]), "+v"(acc[ai][1][m][0]), "+v"(acc[ai][1][m][1]));
                if (m & 1) asm volatile("" ::: "memory"); }
        const bool bad1 = bad;
        bad = st2.run(acc, u, wr, wc, fr, fq, lds, wid, lane) || bad;
#pragma unroll
        for (int ai = 0; ai < 2; ++ai)
#pragma unroll
            for (int m = 0; m < 4; ++m) { const int r = ai * HALF + wr * 64 + m * 16 + fr; const f32x2v sr = S[r]; const size_t off = (size_t)(u.pm * BM + r) * ldc + col0;
#pragma unroll
                for (int bj = 0; bj < 2; ++bj)
#pragma unroll
                    for (int n = 0; n < 2; ++n) { const f32x4 x1 = acc[ai][bj][m][n]; *(f32x4*)(out + off + bj * HALF + n * 16) = bad1 ? (f32x4){qnan, qnan, qnan, qnan} : x1;
                        const f32x4 o = (x1 - sr.x) * sr.y; u32x2v w; w.x = cvt_pk_bf16(o[0], o[1]); w.y = cvt_pk_bf16(o[2], o[3]);
                        if (bad) { w.x = 0x7fc07fc0u; w.y = 0x7fc07fc0u; } *(u32x2v*)(xn + off + bj * HALF + n * 16) = w; }
                asm volatile("" ::: "memory"); }
    }
};

template <class Epi, class Sched, bool STAMP = false>
__device__ __forceinline__ void gemm_phase(PG8_LAS unsigned char* lds, const Gemm g, const Sched& S, const Epi& E, unsigned long long* stamps) {
    int tid_ = threadIdx.x; asm volatile("" : "+v"(tid_)); const int tid = tid_, wid = __builtin_amdgcn_readfirstlane(tid >> 6), lane = tid & 63, wr = wid >> 2, wc = wid & 3, fr = lane & 15, fq = lane >> 4;
    const int K = g.K, nt = K / BK;
    int ts_lo = 0, ts_hi = 0, nts = 0; const unsigned long long rt_entry = STAMP ? (unsigned long long)wall_clock64() : 0ull;
#define PG8_STAMP() do { if (STAMP && wid == 0 && nts < 64) { const unsigned long long _c = (unsigned long long)clock64(); \
        ts_lo = (lane == nts) ? (int)(unsigned)_c : ts_lo; ts_hi = (lane == nts) ? (int)(unsigned)(_c >> 32) : ts_hi; ++nts; } } while (0)
    PG8_STAMP();
    unsigned voffA[2], voffB[2];
#pragma unroll
    for (int i = 0; i < 2; ++i) { int R, C; stage_rc(tid * 16 + i * 8192, R, C); const int Rb = Epi::PERM ? ((R & ~31) + perm32(R & 31)) : R;
        voffA[i] = (unsigned)(R * K + C) * 2u; voffB[i] = (unsigned)(Rb * K + C) * 2u; }
    const size_t kstep = (size_t)(BK * 2);
    const size_t hstep = (size_t)HALF * K * 2;
    const size_t tstep = 2 * hstep;
    const unsigned ldsw = (unsigned)wid * 1024u;
    const int aoff = lds_byte(wr * 64 + fr, fq * 8), boff = lds_byte(wc * 32 + fr, fq * 8);
#define PG8_SA(b, h) (((b) * 2 + (h)) * HTB)
#define PG8_SB(b, h) ((4 + (b) * 2 + (h)) * HTB)
#define PG8_STAGE(bufoff, gbase, voff) do { _Pragma("unroll") for (int _i = 0; _i < 2; ++_i) \
        __builtin_amdgcn_global_load_lds((const unsigned*)((const char*)(gbase) + (voff)[_i]), (PG8_LAS unsigned*)(lds + (bufoff) + ldsw + _i * 8192), 16, 0, 0); } while (0)
#define PG8_LDA(dst, b, h) do { _Pragma("unroll") for (int m = 0; m < 4; ++m) _Pragma("unroll") for (int k = 0; k < 2; ++k) dst[m][k] = *(const PG8_LAS bf16x8*)(lds + PG8_SA(b, h) + aoff + m * 2048 + k * 1024); } while (0)
#define PG8_LDB(dst, b, h) do { _Pragma("unroll") for (int n = 0; n < 2; ++n) _Pragma("unroll") for (int k = 0; k < 2; ++k) dst[n][k] = *(const PG8_LAS bf16x8*)(lds + PG8_SB(b, h) + boff + n * 2048 + k * 1024); } while (0)
#define PG8_MMA(ai, bj, At, Bt) do { __builtin_amdgcn_s_setprio(1); _Pragma("unroll") for (int m = 0; m < 4; ++m) _Pragma("unroll") for (int n = 0; n < 2; ++n) _Pragma("unroll") for (int k = 0; k < 2; ++k) \
        acc[ai][bj][m][n] = __builtin_amdgcn_mfma_f32_16x16x32_bf16(Bt[n][k], At[m][k], acc[ai][bj][m][n], 0, 0, 0); __builtin_amdgcn_s_setprio(0); } while (0)
#define PG8_WAIT_V(n) asm volatile("s_waitcnt vmcnt(" #n ")" ::: "memory")
#define PG8_WAIT_L(n) asm volatile("s_waitcnt lgkmcnt(" #n ")" ::: "memory")
#define PG8_BAR __builtin_amdgcn_s_barrier()
#define PG8_SCHED __builtin_amdgcn_sched_barrier(0)
    Unit cur, nxt; int ui = 0;
    if (!S.next(0, cur)) return;
    f32x4 acc[2][2][4][2];
#pragma unroll
    for (int a = 0; a < 2; ++a)
#pragma unroll
        for (int b = 0; b < 2; ++b)
#pragma unroll
            for (int m = 0; m < 4; ++m)
#pragma unroll
                for (int n = 0; n < 2; ++n) acc[a][b][m][n] = (f32x4){0.f, 0.f, 0.f, 0.f};
    bf16x8 At[4][2], B0[2][2], B1[2][2];
    const char* cA = (const char*)g.A + (size_t)cur.pm * tstep; const char* cB = (const char*)g.Bt + (size_t)cur.pn * tstep;
    S.a_ready(cur);
    PG8_STAGE(PG8_SB(0, 0), cB, voffB); PG8_STAGE(PG8_SA(0, 0), cA, voffA); PG8_STAGE(PG8_SB(0, 1), cB + hstep, voffB); PG8_STAGE(PG8_SA(0, 1), cA + hstep, voffA);
    if (wr == 1) PG8_BAR;
    PG8_WAIT_V(4); PG8_BAR;
    PG8_STAGE(PG8_SB(1, 0), cB + kstep, voffB); PG8_STAGE(PG8_SA(1, 0), cA + kstep, voffA); PG8_STAGE(PG8_SB(1, 1), cB + hstep + kstep, voffB);
    PG8_WAIT_V(6); PG8_BAR;
    PG8_STAMP();
    for (;;) {
        const bool has_next = S.next(ui + 1, nxt);
        const char* nA = has_next ? (const char*)g.A + (size_t)nxt.pm * tstep : cA; const char* nB = has_next ? (const char*)g.Bt + (size_t)nxt.pn * tstep : cB;
        for (int t = 0; t < nt; t += 2) {
            const bool last = (t == nt - 2);
            const char* a1 = cA + (size_t)(t + 1) * kstep;
            const char* a2 = last ? nA : cA + (size_t)(t + 2) * kstep; const char* b2 = last ? nB : cB + (size_t)(t + 2) * kstep;
            const char* a3 = a2 + kstep; const char* b3 = b2 + kstep;
            if (last && has_next) S.a_ready(nxt);
            PG8_LDB(B0, 0, 0); PG8_SCHED; PG8_LDA(At, 0, 0); PG8_STAGE(PG8_SA(1, 1), a1 + hstep, voffA);
            PG8_WAIT_L(8); PG8_BAR; PG8_WAIT_L(0); PG8_MMA(0, 0, At, B0); PG8_BAR; PG8_SCHED;
            PG8_LDB(B1, 0, 1); PG8_STAGE(PG8_SB(0, 0), b2, voffB);
            PG8_BAR; PG8_WAIT_L(0); PG8_MMA(0, 1, At, B1); PG8_BAR;
            PG8_LDA(At, 0, 1); PG8_STAGE(PG8_SA(0, 0), a2, voffA);
            PG8_BAR; PG8_WAIT_L(0); PG8_MMA(1, 0, At, B0); PG8_BAR; PG8_SCHED;
            PG8_STAGE(PG8_SB(0, 1), b2 + hstep, voffB);
            PG8_WAIT_V(6); PG8_BAR; PG8_MMA(1, 1, At, B1); PG8_BAR;
            PG8_LDB(B0, 1, 0); PG8_SCHED; PG8_LDA(At, 1, 0); PG8_STAGE(PG8_SA(0, 1), a2 + hstep, voffA);
            PG8_WAIT_L(8); PG8_BAR; PG8_WAIT_L(0); PG8_MMA(0, 0, At, B0); PG8_BAR; PG8_SCHED;
            PG8_LDB(B1, 1, 1); PG8_STAGE(PG8_SB(1, 0), b3, voffB);
            PG8_BAR; PG8_WAIT_L(0); PG8_MMA(0, 1, At, B1); PG8_BAR;
            PG8_LDA(At, 1, 1); PG8_STAGE(PG8_SA(1, 0), a3, voffA);
            PG8_BAR; PG8_WAIT_L(0); PG8_MMA(1, 0, At, B0); PG8_BAR; PG8_SCHED;
            PG8_STAGE(PG8_SB(1, 1), b3 + hstep, voffB);
            PG8_WAIT_V(6); PG8_BAR; PG8_MMA(1, 1, At, B1); PG8_BAR;
        }
        PG8_STAMP();
        if constexpr (!Epi::AFTER_DRAIN) { E(acc, cur, wr, wc, fr, fq); S.done(cur); }
        PG8_STAMP();
        if (!has_next) break;
#pragma unroll
        for (int a = 0; a < 2; ++a)
#pragma unroll
            for (int b = 0; b < 2; ++b)
#pragma unroll
                for (int m = 0; m < 4; ++m)
#pragma unroll
                    for (int n = 0; n < 2; ++n) acc[a][b][m][n] = (f32x4){0.f, 0.f, 0.f, 0.f};
        cur = nxt; cA = nA; cB = nB; ++ui;
    }
    PG8_WAIT_V(0);
    if (wr == 0) PG8_BAR;
    PG8_BAR;
    if constexpr (Epi::AFTER_DRAIN) { E.fused(acc, cur, wr, wc, fr, fq, lds, wid, lane); S.done(cur); }
    PG8_STAMP();
    if (STAMP && wid == 0) { stamps[lane] = lane < nts ? (((unsigned long long)(unsigned)ts_hi << 32) | (unsigned)ts_lo) : 0ull;
        if (lane == 62) stamps[62] = rt_entry; if (lane == 63) stamps[63] = (unsigned long long)wall_clock64(); }
#undef PG8_STAMP
#undef PG8_SA
#undef PG8_SB
#undef PG8_STAGE
#undef PG8_LDA
#undef PG8_LDB
#undef PG8_MMA
#undef PG8_WAIT_V
#undef PG8_WAIT_L
#undef PG8_BAR
#undef PG8_SCHED
}
}

__shared__ unsigned g_vsub_cnt[128];
DI void sub_barrier(unsigned* cnt) {
  asm volatile("" ::: "memory");
  unsigned target = 0;
  if ((threadIdx.x & 63) == 0) {
    const unsigned old = __hip_atomic_fetch_add(cnt, 1u, __ATOMIC_RELAXED, __HIP_MEMORY_SCOPE_WORKGROUP);
    target = (old & ~3u) + 4u;
  }
  target = __builtin_amdgcn_readfirstlane(target);
  while (__hip_atomic_load(cnt, __ATOMIC_RELAXED, __HIP_MEMORY_SCOPE_WORKGROUP) < target) __builtin_amdgcn_s_sleep(1);
  asm volatile("" ::: "memory");
}

DI bf16x8 ld16_sum4(const bf16_t* p, size_t slab) {
  union { bf16x8 v; unsigned u[4]; } a, b, c, d, o;
  a.v = ld16(p); b.v = ld16(p + slab); c.v = ld16(p + 2 * slab); d.v = ld16(p + 3 * slab);
#pragma unroll
  for (int i = 0; i < 4; ++i)
    o.u[i] = pk2(lo_bf(a.u[i]) + lo_bf(b.u[i]) + lo_bf(c.u[i]) + lo_bf(d.u[i]), hi_bf(a.u[i]) + hi_bf(b.u[i]) + hi_bf(c.u[i]) + hi_bf(d.u[i]));
  return o.v;
}

template <int NI, bool TR = false, bool PF2 = true, bool ASUM4 = false>
DI void gemm_main(f32x16 (&acc)[2][NI], const bf16_t* Abase, int lda, int akoff, int astep, const bf16_t* Bt, int ldb, int K,
                  bf16_t* sm, int tid, bool act, unsigned* bcnt, size_t aslab = 0) {
  if (!act) return;
  const int lane = tid & 63, wid = tid >> 6, wm = wid >> 1, wn = wid & 1, r = lane & 31, h = lane >> 5;
  const int lrow = tid >> 3, lkc = tid & 7;
  const int aoff0 = lrow * lda + akoff, a32 = 32 * lda;
  const int boff0 = lrow * ldb + lkc * 8, b32 = 32 * ldb;
  const int soff0 = lrow * 64 + ((lkc ^ ((lrow >> 1) & 7)) * 8);
  bf16_t* As = sm;
  bf16_t* Bs = sm + 2 * 8192;
  bf16x8 ra0[4], rb0[2 * NI], ra1[4], rb1[2 * NI];
  const int nk = K >> 6;
#define GM_LOAD(RA, RB, t)                                                                          \
  {                                                                                                 \
    const bf16_t* An_ = Abase + (size_t)(t) * astep;                                                \
    const bf16_t* Bn_ = Bt + (t) * 64;                                                              \
    _Pragma("unroll") for (int i = 0; i < 4; ++i) RA[i] = ASUM4 ? ld16_sum4(An_ + aoff0 + i * a32, aslab) : ld16(An_ + aoff0 + i * a32); \
    _Pragma("unroll") for (int i = 0; i < 2 * NI; ++i) RB[i] = ld16(Bn_ + boff0 + i * b32);         \
  }
#define GM_STORE(RA, RB, buf)                                                                       \
  {                                                                                                 \
    bf16_t* An = As + (buf) * 8192 + soff0;                                                         \
    bf16_t* Bn = Bs + (buf) * 8192 + soff0;                                                         \
    _Pragma("unroll") for (int i = 0; i < 4; ++i) *reinterpret_cast<bf16x8*>(An + i * 2048) = RA[i];        \
    _Pragma("unroll") for (int i = 0; i < 2 * NI; ++i) *reinterpret_cast<bf16x8*>(Bn + i * 2048) = RB[i];   \
  }
#define GM_COMPUTE(buf)                                                                             \
  {                                                                                                 \
    const bf16_t* Ac = As + (buf) * 8192 + ar0 * 64;                                                \
    const bf16_t* Bc = Bs + (buf) * 8192 + br0 * 64;                                                \
    _Pragma("unroll") for (int ks = 0; ks < 4; ++ks) {                                              \
      bf16x8 a[2], b[NI];                                                                           \
      _Pragma("unroll") for (int i = 0; i < 2; ++i)                                                 \
        a[i] = *reinterpret_cast<const bf16x8*>(Ac + i * 2048 + (((ks * 2 + h) ^ asw) * 8));        \
      _Pragma("unroll") for (int i = 0; i < NI; ++i)                                                \
        b[i] = *reinterpret_cast<const bf16x8*>(Bc + i * 2048 + (((ks * 2 + h) ^ bsw) * 8));        \
      _Pragma("unroll") for (int mi = 0; mi < 2; ++mi)                                              \
        _Pragma("unroll") for (int ni = 0; ni < NI; ++ni)                                           \
          acc[mi][ni] = TR ? MFMA32(b[ni], a[mi], acc[mi][ni]) : MFMA32(a[mi], b[ni], acc[mi][ni]); \
    }                                                                                               \
  }
  const int ar0 = wm * 64 + r, br0 = wn * 32 * NI + r;
  const int asw = (ar0 >> 1) & 7, bsw = (br0 >> 1) & 7;
  if (!PF2) {
    GM_LOAD(ra0, rb0, 0)
    GM_STORE(ra0, rb0, 0)
    sub_barrier(bcnt);
    for (int kt = 0; kt < nk; kt += 2) {
      GM_LOAD(ra0, rb0, kt + 1)
      GM_COMPUTE(0)
      GM_STORE(ra0, rb0, 1)
      sub_barrier(bcnt);
      if (kt + 2 < nk) GM_LOAD(ra0, rb0, kt + 2)
      GM_COMPUTE(1)
      if (kt + 2 < nk) GM_STORE(ra0, rb0, 0)
      sub_barrier(bcnt);
    }
    return;
  }
  GM_LOAD(ra0, rb0, 0)
  GM_LOAD(ra1, rb1, 1)
  GM_STORE(ra0, rb0, 0)
  sub_barrier(bcnt);
  for (int kt = 0; kt < nk; kt += 2) {
    if (kt + 2 < nk) GM_LOAD(ra0, rb0, kt + 2)
    GM_COMPUTE(0)
    GM_STORE(ra1, rb1, 1)
    sub_barrier(bcnt);
    if (kt + 3 < nk) GM_LOAD(ra1, rb1, kt + 3)
    GM_COMPUTE(1)
    if (kt + 2 < nk) GM_STORE(ra0, rb0, 0)
    sub_barrier(bcnt);
  }
#undef GM_LOAD
#undef GM_STORE
#undef GM_COMPUTE
}

template <int NI>
DI void zero_acc(f32x16 (&acc)[2][NI]) {
#pragma unroll
  for (int a = 0; a < 2; ++a)
#pragma unroll
    for (int b = 0; b < NI; ++b)
#pragma unroll
      for (int i = 0; i < 16; ++i) acc[a][b][i] = 0.f;
}

DI void sincos_(float x, float* sn, float* cs) {
  float n = rintf(x * 0.63661977236758134f);
  float rr = fmaf(-n, 1.57079625129699707031f, x);
  rr = fmaf(-n, 7.54978941586159635335e-08f, rr);
  float r2 = rr * rr;
  float sp = rr + rr * r2 * (-1.6666654611e-1f + r2 * (8.3321608736e-3f + r2 * (-1.9515295891e-4f)));
  float cp = 1.f + r2 * (-0.5f + r2 * (4.166664568298827e-2f + r2 * (-1.388731625493765e-3f + r2 * 2.443315711809948e-5f)));
  int q = ((int)n) & 3;
  float s_ = (q & 1) ? cp : sp;
  float c_ = (q & 1) ? sp : cp;
  if (q == 1 || q == 2) c_ = -c_;
  if (q >= 2) s_ = -s_;
  *sn = s_;
  *cs = c_;
}

#define VSUB_SETUP                                                                                             \
  const int sub = tid >> 8, vt = tid & 255;                                                                    \
  const int vgrid = gridDim.x * 2, vb = blockIdx.x * 2 + sub;                                                  \
  bf16_t* smv = sm + sub * 32768;                                                                              \
  unsigned* bcnt = g_vsub_cnt + sub * 64;                                                                      \
  const int lane = vt & 63, wid = vt >> 6, wm = wid >> 1, wn = wid & 1, r = lane & 31, h = lane >> 5;          \
  (void)lane; (void)wm; (void)wn; (void)r; (void)h; (void)smv; (void)vgrid; (void)vb; (void)bcnt;

DI void prep_transpose(const float* src, int ld, bf16_t* dst, int K, int k0, int n0, float* tile, int tid) {
  const int nn = tid & 63, kq = tid >> 6;
#pragma unroll 4
  for (int i = 0; i < 8; ++i) {
    int kk = kq + 8 * i;
    tile[kk * 65 + nn] = src[(size_t)(k0 + kk) * ld + n0 + nn];
  }
  __syncthreads();
  {
    int n2 = tid >> 3, kc = tid & 7;
    uint4 w;
    w.x = pk2(tile[(kc * 8 + 0) * 65 + n2], tile[(kc * 8 + 1) * 65 + n2]);
    w.y = pk2(tile[(kc * 8 + 2) * 65 + n2], tile[(kc * 8 + 3) * 65 + n2]);
    w.z = pk2(tile[(kc * 8 + 4) * 65 + n2], tile[(kc * 8 + 5) * 65 + n2]);
    w.w = pk2(tile[(kc * 8 + 6) * 65 + n2], tile[(kc * 8 + 7) * 65 + n2]);
    *reinterpret_cast<uint4*>(dst + (size_t)(n0 + n2) * K + k0 + kc * 8) = w;
  }
  __syncthreads();
}

DI void prep_s5(const Params& p, int L, int g, float* sm, int tid) {
  float* apow = sm;
  float* fco = sm + 2176;
  float* bbar = sm + 2304;
  float* Kt = sm + 4352;
  float* Cl = sm + 12544;
  const size_t gm = (size_t)(L * 32 + g) * 65536;
  for (int d = 0; d < 2; ++d) {
    const int dg = (L * 2 + d) * 32 + g;
    if (tid < 64) {
      const int pp = tid;
      float dt = expf(p.s5_log_dt[dg]);
      float are = p.s5_a_re[dg * 64 + pp], aim = p.s5_a_im[dg * 64 + pp];
      float mag = expf(dt * are);
      float sn, cs;
      sincos_(dt * aim, &sn, &cs);
      float abr = mag * cs, abi = mag * sn;
      float den = are * are + aim * aim;
      float fr = ((abr - 1.f) * are + abi * aim) / den;
      float fi = (abi * are - (abr - 1.f) * aim) / den;
      fco[pp * 2] = fr;
      fco[pp * 2 + 1] = fi;
      float pr = 1.f, pi = 0.f;
      apow[pp * 2] = 1.f;
      apow[pp * 2 + 1] = 0.f;
      for (int t = 1; t <= 16; ++t) {
        float nr = pr * abr - pi * abi, ni = pr * abi + pi * abr;
        pr = nr; pi = ni;
        apow[(t * 64 + pp) * 2] = pr;
        apow[(t * 64 + pp) * 2 + 1] = pi;
      }
      p.A16()[(dg * 64 + pp) * 2] = pr;
      p.A16()[(dg * 64 + pp) * 2 + 1] = pi;
    }
    __syncthreads();
    for (int i = 0; i < 2; ++i) {
      int idx = tid + 512 * i;
      Cl[idx * 2] = p.s5_c_re[(size_t)dg * 1024 + idx];
      Cl[idx * 2 + 1] = p.s5_c_im[(size_t)dg * 1024 + idx];
    }
    for (int i = 0; i < 2; ++i) {
      int idx = tid + 512 * i;
      int pp = idx >> 4;
      float br = p.s5_b_re[(size_t)dg * 1024 + idx], bi = p.s5_b_im[(size_t)dg * 1024 + idx];
      float fr = fco[pp * 2], fi = fco[pp * 2 + 1];
      bbar[idx * 2] = fr * br - fi * bi;
      bbar[idx * 2 + 1] = fr * bi + fi * br;
    }
    __syncthreads();
    {
      const int th = tid >> 8, hp = (tid >> 4) & 15, hh = tid & 15;
      float kacc[8];
#pragma unroll
      for (int t = 0; t < 8; ++t) kacc[t] = 0.f;
      for (int pp = 0; pp < 64; ++pp) {
        float cr = Cl[(hp * 64 + pp) * 2], ci = Cl[(hp * 64 + pp) * 2 + 1];
        float br = bbar[(pp * 16 + hh) * 2], bi = bbar[(pp * 16 + hh) * 2 + 1];
        float xr = cr * br - ci * bi, xi = cr * bi + ci * br;
#pragma unroll
        for (int t = 0; t < 8; ++t)
          kacc[t] += xr * apow[((th * 8 + t) * 64 + pp) * 2] - xi * apow[((th * 8 + t) * 64 + pp) * 2 + 1];
      }
#pragma unroll
      for (int t = 0; t < 8; ++t) Kt[(d * 16 + th * 8 + t) * 256 + (tid & 255)] = kacc[t];
    }
    for (int i = 0; i < 64; ++i) {
      int idx = tid + 512 * i;
      int k = idx & 255, nn = idx >> 8;
      int pp = nn >> 1, ri = nn & 1, j = k >> 4, hh = k & 15;
      int e = (d == 0) ? (15 - j) : j;
      float ar = apow[(e * 64 + pp) * 2], ai = apow[(e * 64 + pp) * 2 + 1];
      float br = bbar[(pp * 16 + hh) * 2], bi = bbar[(pp * 16 + hh) * 2 + 1];
      float v = ri ? (ar * bi + ai * br) : (ar * br - ai * bi);
      p.S5We()[gm + (size_t)(d * 128 + nn) * 256 + k] = f2bf(v);
    }
    for (int i = 0; i < 64; ++i) {
      int idx = tid + 512 * i;
      int kk = idx & 127, n = idx >> 7;
      int pp = kk >> 1, ri = kk & 1, t16 = n >> 4, hp = n & 15;
      int pw = (d == 0) ? (t16 + 1) : (16 - t16);
      float cr = Cl[(hp * 64 + pp) * 2], ci = Cl[(hp * 64 + pp) * 2 + 1];
      float ar = apow[(pw * 64 + pp) * 2], ai = apow[(pw * 64 + pp) * 2 + 1];
      float v = ri ? -(cr * ai + ci * ar) : (cr * ar - ci * ai);
      p.S5R()[gm + (size_t)n * 256 + d * 128 + kk] = f2bf(v);
    }
    __syncthreads();
  }
  const float dval = p.s5_d[(L * 32 + g) * 16 + (tid & 15)];
  for (int i = 0; i < 128; ++i) {
    int idx = tid + 512 * i;
    int k = idx & 255, n = idx >> 8;
    int t16 = n >> 4, hp = n & 15, j = k >> 4, hh = k & 15;
    float v = 0.f;
    if (j <= t16) v += Kt[(0 * 16 + (t16 - j)) * 256 + hp * 16 + hh];
    if (j >= t16) v += Kt[(1 * 16 + (j - t16)) * 256 + hp * 16 + hh];
    if (j == t16 && hp == hh) v += dval;
    p.S5M()[gm + (size_t)n * 256 + k] = f2bf(v);
  }
  __syncthreads();
}

DI void prep_adaln(const Params& p, int L, int cb, float* sm, int tid) {
  float* sv = sm;
  float* red = sm + 3072;
  for (int idx = tid; idx < 3072; idx += 512) {
    int v = idx >> 10, k = idx & 1023;
    float cv = (v < 2) ? p.c[v * 1024 + k] : p.c_ctx[k];
    sv[idx] = siluf_(cv);
  }
  __syncthreads();
  const int cl = tid & 63, kq = tid >> 6, col = cb * 64 + cl;
  float a0 = 0.f, a1 = 0.f, a2 = 0.f;
  const float* w = p.w_ada + (size_t)L * 1024 * 3072 + col;
#pragma unroll 8
  for (int k = kq * 128; k < kq * 128 + 128; ++k) {
    float wv = w[(size_t)k * 3072];
    a0 += sv[k] * wv;
    a1 += sv[1024 + k] * wv;
    a2 += sv[2048 + k] * wv;
  }
  red[(kq * 3 + 0) * 64 + cl] = a0;
  red[(kq * 3 + 1) * 64 + cl] = a1;
  red[(kq * 3 + 2) * 64 + cl] = a2;
  __syncthreads();
  if (kq == 0) {
    float bb = p.b_ada[L * 3072 + col];
    for (int v = 0; v < 3; ++v) {
      float s = 0.f;
      for (int q = 0; q < 8; ++q) s += red[(q * 3 + v) * 64 + cl];
      p.MOD()[(L * 3 + v) * 3072 + col] = s + bb;
    }
  }
  __syncthreads();
}

struct TrDesc { const float* src; bf16_t* dst; int ld, K, k0, n0; };
DI TrDesc tr_decode(const Params& p, int it) {
  constexpr int N_TR_L = 3456;
  const int L = it / N_TR_L, tt = it % N_TR_L;
  TrDesc d;
  int kt, nt;
  if (tt < 2624) {
    kt = tt / 164; nt = tt % 164; d.src = p.w_in + (size_t)L * 1024 * 10496; d.ld = 10496; d.K = 1024;
    d.dst = p.WinT() + (size_t)L * 10496 * 1024;
  } else if (tt < 3136) {
    int t2 = tt - 2624; int kb = t2 / 128; int t3 = t2 % 128; kt = t3 / 16; nt = t3 % 16;
    d.src = p.w_br + (size_t)(L * 4 + kb) * 512 * 1024; d.ld = 1024; d.K = 512;
    d.dst = p.WbrT() + (size_t)(L * 4 + kb) * 1024 * 512;
  } else if (tt < 3392) {
    int t2 = tt - 3136; kt = t2 / 16; nt = t2 % 16; d.src = p.w_out + (size_t)L * 1024 * 1024; d.ld = 1024; d.K = 1024;
    d.dst = p.WoutT() + (size_t)L * 1024 * 1024;
  } else {
    int t2 = tt - 3392; kt = t2 / 8; nt = t2 % 8; d.src = p.s5_w_glu + (size_t)L * 512 * 512; d.ld = 512; d.K = 512;
    d.dst = p.WgluT() + (size_t)L * 512 * 512;
  }
  d.k0 = kt * 64; d.n0 = nt * 64;
  return d;
}

DI void phase_prep(const Params& p, float* sm, int tid) {
  constexpr int N_S5 = 128, N_ADA = 192, N_TR = 4 * 3456;
  constexpr int NPRE = N_S5 + N_ADA + 1;
  for (int item = blockIdx.x; item < NPRE; item += gridDim.x) {
    if (item < N_S5) {
      prep_s5(p, item >> 5, item & 31, sm, tid);
    } else if (item < N_S5 + N_ADA) {
      int it = item - N_S5;
      prep_adaln(p, it / 48, it % 48, sm, tid);
    } else {
      for (int idx = tid; idx < 256 * 16; idx += 512) {
        int pos = idx >> 4, i = idx & 15;
        float inv = exp2f(-(float)i * (13.287712379549449f / 16.f));
        float sn, cs;
        sincos_((float)pos * inv, &sn, &cs);
        p.ROPE()[idx * 2] = cs;
        p.ROPE()[idx * 2 + 1] = sn;
      }
      {
        const int wv = tid >> 6, ln = tid & 63;
        for (int LL = 0; LL < 4; ++LL) {
          float mb = 0.f;
          for (int j = tid; j < 8 * 465; j += 512) mb = fmaxf(mb, fabsf(p.na_rel_bias[LL * 8 * 465 + j]));
#pragma unroll
          for (int o = 32; o >= 1; o >>= 1) mb = fmaxf(mb, __shfl_xor(mb, o));
          if (ln == 0) sm[LL * 8 + wv] = mb;
        }
        __syncthreads();
        {
          const int LL = wv >> 1, ty = wv & 1;
          const float* gq = (ty ? p.gqa_q_g : p.na_q_g) + LL * 64;
          const float* gk = (ty ? p.gqa_k_g : p.na_k_g) + LL * 64;
          float mq = fabsf(gq[ln]), mk = fabsf(gk[ln]);
#pragma unroll
          for (int o = 32; o >= 1; o >>= 1) { mq = fmaxf(mq, __shfl_xor(mq, o)); mk = fmaxf(mk, __shfl_xor(mk, o)); }
          if (ln == 0) {
            float mb = 0.f;
            if (!ty) for (int q = 0; q < 8; ++q) mb = fmaxf(mb, sm[LL * 8 + q]);
            p.ROPE()[8192 + wv] = fminf(8.f * LOG2E * mq * mk + LOG2E * mb, 100.f);
          }
        }
        __syncthreads();
      }
    }
  }
  const int nn = tid & 63, kq = tid >> 6;
  for (int it0 = blockIdx.x; it0 < N_TR; it0 += 4 * gridDim.x) {
    float v[4][8];
#pragma unroll
    for (int u = 0; u < 4; ++u) {
      const int it = it0 + u * gridDim.x;
      if (it < N_TR) {
        const TrDesc d = tr_decode(p, it);
#pragma unroll
        for (int i = 0; i < 8; ++i) v[u][i] = d.src[(size_t)(d.k0 + kq + 8 * i) * d.ld + d.n0 + nn];
      }
    }
#pragma unroll
    for (int u = 0; u < 4; ++u)
#pragma unroll
      for (int i = 0; i < 8; ++i) sm[u * 4160 + (kq + 8 * i) * 65 + nn] = v[u][i];
    __syncthreads();
#pragma unroll
    for (int u = 0; u < 4; ++u) {
      const int it = it0 + u * gridDim.x;
      if (it < N_TR) {
        const TrDesc d = tr_decode(p, it);
        const float* tile = sm + u * 4160;
        const int n2 = tid >> 3, kc = tid & 7;
        uint4 w;
        w.x = pk2(tile[(kc * 8 + 0) * 65 + n2], tile[(kc * 8 + 1) * 65 + n2]);
        w.y = pk2(tile[(kc * 8 + 2) * 65 + n2], tile[(kc * 8 + 3) * 65 + n2]);
        w.z = pk2(tile[(kc * 8 + 4) * 65 + n2], tile[(kc * 8 + 5) * 65 + n2]);
        w.w = pk2(tile[(kc * 8 + 6) * 65 + n2], tile[(kc * 8 + 7) * 65 + n2]);
        *reinterpret_cast<uint4*>(d.dst + (size_t)(d.n0 + n2) * d.K + d.k0 + kc * 8) = w;
      }
    }
    __syncthreads();
  }
}

DI void phase_norm(const Params& p, int b, int L, int tid) {
  const int wid = tid >> 6, lane = tid & 63;
  const float* g = p.norm_g + L * 1024;
  for (int item = blockIdx.x; item < R / 8; item += gridDim.x) {
    const int row = item * 8 + wid;
    const float* src;
    const float* mod;
    if (row < NLAT) {
      src = (L == 0 ? p.x : (const float*)p.out) + ((size_t)b * NLAT + row) * 1024;
      mod = p.MOD() + (L * 3 + b) * 3072;
    } else {
      src = (L == 0 ? p.ctx : (const float*)p.CTXS()) + ((size_t)b * 256 + (row - NLAT)) * 1024;
      mod = p.MOD() + (L * 3 + 2) * 3072;
    }
    float4 v[4];
    float ss = 0.f;
#pragma unroll
    for (int j = 0; j < 4; ++j) {
      v[j] = *reinterpret_cast<const float4*>(src + j * 256 + lane * 4);
      ss += v[j].x * v[j].x + v[j].y * v[j].y + v[j].z * v[j].z + v[j].w * v[j].w;
    }
#pragma unroll
    for (int o = 32; o >= 1; o >>= 1) ss += __shfl_xor(ss, o);
    const float rs = rsqrtf(ss * (1.f / 1024.f) + 1e-6f);
#pragma unroll
    for (int j = 0; j < 4; ++j) {
      const int col = j * 256 + lane * 4;
      float4 g4 = *reinterpret_cast<const float4*>(g + col);
      float4 sh = *reinterpret_cast<const float4*>(mod + col);
      float4 sc = *reinterpret_cast<const float4*>(mod + 1024 + col);
      float y0 = v[j].x * rs * g4.x * (1.f + sc.x) + sh.x;
      float y1 = v[j].y * rs * g4.y * (1.f + sc.y) + sh.y;
      float y2 = v[j].z * rs * g4.z * (1.f + sc.z) + sh.z;
      float y3 = v[j].w * rs * g4.w * (1.f + sc.w) + sh.w;
      uint2 w;
      w.x = pk2(y0, y1);
      w.y = pk2(y2, y3);
      *reinterpret_cast<uint2*>(p.H() + (size_t)row * 1024 + col) = w;
    }
  }
}

struct EpiGlu {
  static constexpr bool PERM = true, AFTER_DRAIN = false;
  const bf16_t* Y; bf16_t* Zg;
  DI void operator()(const pg8::f32x4 (&acc)[2][2][4][2], const pg8::Unit& u, int wr, int wc, int fr, int fq) const {
    const int row0 = u.pm * 256 + wr * 64 + fr, col0 = u.pn * 256 + wc * 32 + 8 * fq;
#pragma unroll
    for (int ai = 0; ai < 2; ++ai)
#pragma unroll
      for (int mh = 0; mh < 2; ++mh) {
        uint4 yv[4], gv[4];
#pragma unroll
        for (int q = 0; q < 4; ++q) {
          const int m = mh * 2 + (q >> 1), bj = q & 1;
          const int row = row0 + ai * 128 + m * 16, col = col0 + bj * 128;
          yv[q] = *reinterpret_cast<const uint4*>(Y + (size_t)row * 512 + col);
          gv[q] = *reinterpret_cast<const uint4*>(Zg + (size_t)row * LDZ + col);
        }
#pragma unroll
        for (int q = 0; q < 4; ++q) {
          const int m = mh * 2 + (q >> 1), bj = q & 1;
          const int row = row0 + ai * 128 + m * 16, col = col0 + bj * 128;
          const pg8::f32x4 a0 = acc[ai][bj][m][0], a1 = acc[ai][bj][m][1];
          uint4 w;
          w.x = pk2(lo_bf(yv[q].x) * sigmoidf_(a0[0]) * siluf_(lo_bf(gv[q].x)), hi_bf(yv[q].x) * sigmoidf_(a0[1]) * siluf_(hi_bf(gv[q].x)));
          w.y = pk2(lo_bf(yv[q].y) * sigmoidf_(a0[2]) * siluf_(lo_bf(gv[q].y)), hi_bf(yv[q].y) * sigmoidf_(a0[3]) * siluf_(hi_bf(gv[q].y)));
          w.z = pk2(lo_bf(yv[q].z) * sigmoidf_(a1[0]) * siluf_(lo_bf(gv[q].z)), hi_bf(yv[q].z) * sigmoidf_(a1[1]) * siluf_(hi_bf(gv[q].z)));
          w.w = pk2(lo_bf(yv[q].w) * sigmoidf_(a1[2]) * siluf_(lo_bf(gv[q].w)), hi_bf(yv[q].w) * sigmoidf_(a1[3]) * siluf_(hi_bf(gv[q].w)));
          *reinterpret_cast<uint4*>(Zg + (size_t)row * LDZ + col) = w;
        }
        asm volatile("" ::: "memory");
      }
  }
};
struct EpiOutRes {
  static constexpr bool PERM = false, AFTER_DRAIN = false;
  const float* src; float* dst; const float* gate;
  DI void operator()(const pg8::f32x4 (&acc)[2][2][4][2], const pg8::Unit& u, int wr, int wc, int fr, int fq) const {
    const int row0 = u.pm * 256 + wr * 64 + fr, col0 = u.pn * 256 + wc * 32 + 4 * fq;
    pg8::f32x4 gv[2][2];
#pragma unroll
    for (int bj = 0; bj < 2; ++bj)
#pragma unroll
      for (int n = 0; n < 2; ++n) gv[bj][n] = *reinterpret_cast<const pg8::f32x4*>(gate + col0 + bj * 128 + n * 16);
#pragma unroll
    for (int ai = 0; ai < 2; ++ai)
#pragma unroll
      for (int mh = 0; mh < 2; ++mh) {
        pg8::f32x4 xv[8];
#pragma unroll
        for (int q = 0; q < 8; ++q) {
          const int m = mh * 2 + (q >> 2), bj = (q >> 1) & 1, n = q & 1;
          xv[q] = *reinterpret_cast<const pg8::f32x4*>(src + (size_t)(row0 + ai * 128 + m * 16) * 1024 + col0 + bj * 128 + n * 16);
        }
#pragma unroll
        for (int q = 0; q < 8; ++q) {
          const int m = mh * 2 + (q >> 2), bj = (q >> 1) & 1, n = q & 1;
          *reinterpret_cast<pg8::f32x4*>(dst + (size_t)(row0 + ai * 128 + m * 16) * 1024 + col0 + bj * 128 + n * 16) =
              xv[q] + gv[bj][n] * acc[ai][bj][m][n];
        }
        asm volatile("" ::: "memory");
      }
  }
};

#define LDS3(ptr) ((__attribute__((address_space(3))) unsigned char*)(ptr))

typedef unsigned u32x4_t __attribute__((ext_vector_type(4)));
typedef unsigned u32x2_t __attribute__((ext_vector_type(2)));
struct EpiP1 {
  static constexpr bool PERM = true, AFTER_DRAIN = false;
  bf16_t* Zp; bf16_t* SGp;
  DI void operator()(const pg8::f32x4 (&acc)[2][2][4][2], const pg8::Unit& u, int wr, int wc, int fr, int fq) const {
    const int row0 = u.pm * 256 + wr * 64 + fr;
    const int colt = u.pn * 256;
    const int col0 = wc * 32 + 8 * fq;
    if (colt < LDZ) {
#pragma unroll
      for (int ai = 0; ai < 2; ++ai)
#pragma unroll
        for (int m = 0; m < 4; ++m) {
          bf16_t* rowp = Zp + (size_t)(row0 + ai * 128 + m * 16) * LDZ + colt + col0;
#pragma unroll
          for (int bj = 0; bj < 2; ++bj) {
            const pg8::f32x4 v0 = acc[ai][bj][m][0], v1 = acc[ai][bj][m][1];
            u32x4_t w4 = {pk2(v0[0], v0[1]), pk2(v0[2], v0[3]), pk2(v1[0], v1[1]), pk2(v1[2], v1[3])};
            __builtin_nontemporal_store(w4, reinterpret_cast<u32x4_t*>(rowp + bj * 128));
          }
        }
    } else {
      const int gcol0 = colt - LDZ + col0;
#pragma unroll
      for (int ai = 0; ai < 2; ++ai)
#pragma unroll
        for (int m = 0; m < 4; ++m) {
          const int row = row0 + ai * 128 + m * 16;
#pragma unroll
          for (int bj = 0; bj < 2; ++bj) {
            const pg8::f32x4 v0 = acc[ai][bj][m][0], v1 = acc[ai][bj][m][1];
            u32x2_t w0v = {pk2(sigmoidf_(v0[0]), sigmoidf_(v0[1])), pk2(sigmoidf_(v0[2]), sigmoidf_(v0[3]))};
            u32x2_t w1v = {pk2(sigmoidf_(v1[0]), sigmoidf_(v1[1])), pk2(sigmoidf_(v1[2]), sigmoidf_(v1[3]))};
            bf16_t* q0 = SGp + sg_index(row, gcol0 + bj * 128);
            __builtin_nontemporal_store(w0v, reinterpret_cast<u32x2_t*>(q0));
            __builtin_nontemporal_store(w1v, reinterpret_cast<u32x2_t*>(q0 + 128));
          }
        }
    }
  }
};
constexpr int P1_UNITS_Z = 65 * 25, P1_UNITS_ALL = 65 * 41, P1_UNITS_MAIN = 2560, GLU_UNITS = 65 * 2;
struct P1Order {
  int lo, hi, G, c;
  DI static void map_unit(int wgid, int nM, int nN, pg8::Unit& u) {
    const int nwg = nM * nN;
    { const int q = nwg / pg8::NXCD, r = nwg % pg8::NXCD, xcd = wgid % pg8::NXCD, off = wgid / pg8::NXCD;
      wgid = (xcd < r ? xcd * (q + 1) : r * (q + 1) + (xcd - r) * q) + off; }
    const int nig = pg8::WGM * nN, gid = wgid / nig, fm = gid * pg8::WGM, gsz = (nM - fm) < pg8::WGM ? (nM - fm) : pg8::WGM;
    u.pm = fm + ((wgid % nig) % gsz); u.pn = (wgid % nig) / gsz;
  }
  DI bool next(int i, pg8::Unit& u) const {
    const int idx = lo + i * G + c;
    if (idx >= hi) return false;
    if (idx < P1_UNITS_Z) map_unit(idx, 65, 25, u);
    else { map_unit(idx - P1_UNITS_Z, 65, 16, u); u.pn += 25; }
    return true;
  }
  DI void a_ready(const pg8::Unit&) const {}
  DI void done(const pg8::Unit&) const {}
  DI int lda(const pg8::Gemm& g) const { return g.K; }
  DI const char* abase(const pg8::Gemm& g, const pg8::Unit& u) const { return (const char*)g.A + (size_t)u.pm * (size_t)pg8::BM * g.K * 2; }
  DI const char* bbase(const pg8::Gemm& g, const pg8::Unit& u) const { return (const char*)g.Bt + (size_t)u.pn * (size_t)pg8::BM * g.K * 2; }
};
DI bool p1_deferral() { return gridDim.x >= (unsigned)(GLU_UNITS + (P1_UNITS_ALL - P1_UNITS_MAIN)); }
DI void phase_p1(const Params& p, int b, int L, unsigned char* smraw) {
  P1Order S{0, p1_deferral() ? P1_UNITS_MAIN : P1_UNITS_ALL, (int)gridDim.x, (int)blockIdx.x};
  pg8::Gemm g{p.H(), p.WinT() + (size_t)L * 10496 * 1024, R, 10496, 1024};
  EpiP1 E{p.Z(), p.SG()};
  pg8::gemm_phase<EpiP1, P1Order, false>(LDS3(smraw), g, S, E, nullptr);
}

DI void post_item(const Params& p, int L, int rb, int slot, int lane) {
  int col; const float* gvec = nullptr; float mult = 1.f; bool rope = false; bf16_t* vt = nullptr;
  const bool latent = (rb * 64) < NLAT;
  if (slot < 8) { col = C_NQ + slot * 64; gvec = p.na_q_g + L * 64; mult = 0.125f * LOG2E; }
  else if (slot < 16) { col = C_NK + (slot - 8) * 64; gvec = p.na_k_g + L * 64; }
  else if (slot < 24) { col = C_GQ + (slot - 16) * 64; gvec = p.gqa_q_g + L * 64; mult = 0.125f * LOG2E; rope = latent; }
  else if (slot < 26) { col = C_GK + (slot - 24) * 64; gvec = p.gqa_k_g + L * 64; rope = latent; }
  else if (slot < 34) { col = C_NV + (slot - 26) * 64; vt = p.VtN() + (size_t)((slot - 26) * 64) * LDT; }
  else { col = C_GV + (slot - 34) * 64; vt = p.VtG() + (size_t)((slot - 34) * 64) * LDT; }
  if (vt) {
    const int row = rb * 64 + lane;
    const bf16_t* zp = p.Z() + (size_t)row * LDZ + col;
    uint4 raw[8];
#pragma unroll
    for (int j = 0; j < 8; ++j) raw[j] = *reinterpret_cast<const uint4*>(zp + j * 8);
    const int prow = (row & ~12) | ((row & 4) << 1) | ((row & 8) >> 1);
#pragma unroll
    for (int j = 0; j < 8; ++j) {
      const unsigned w[4] = {raw[j].x, raw[j].y, raw[j].z, raw[j].w};
#pragma unroll
      for (int q = 0; q < 4; ++q) {
        vt[(size_t)(j * 8 + q * 2) * LDT + prow] = (bf16_t)(w[q] & 0xffffu);
        vt[(size_t)(j * 8 + q * 2 + 1) * LDT + prow] = (bf16_t)(w[q] >> 16);
      }
    }
    return;
  }
  const int c = lane & 7, rsub = lane >> 3;
  float gv[8];
#pragma unroll
  for (int e = 0; e < 8; ++e) gv[e] = gvec[c * 8 + e] * mult;
  uint4 rawv[8];
#pragma unroll
  for (int ps = 0; ps < 8; ++ps)
    rawv[ps] = *reinterpret_cast<const uint4*>(p.Z() + (size_t)(rb * 64 + ps * 8 + rsub) * LDZ + col + c * 8);
#pragma unroll
  for (int ps = 0; ps < 8; ++ps) {
    const int row = rb * 64 + ps * 8 + rsub;
    bf16_t* zp = p.Z() + (size_t)row * LDZ + col + c * 8;
    const uint4 raw = rawv[ps];
    float x[8] = {lo_bf(raw.x), hi_bf(raw.x), lo_bf(raw.y), hi_bf(raw.y), lo_bf(raw.z), hi_bf(raw.z), lo_bf(raw.w), hi_bf(raw.w)};
    float ss = 0.f;
#pragma unroll
    for (int e = 0; e < 8; ++e) ss += x[e] * x[e];
    ss += __shfl_xor(ss, 1);
    ss += __shfl_xor(ss, 2);
    ss += __shfl_xor(ss, 4);
    const float rs = rsqrtf(ss * (1.f / 64.f) + 1e-6f);
#pragma unroll
    for (int e = 0; e < 8; ++e) x[e] = x[e] * rs * gv[e];
    if (rope) {
      const int pos = ((c & 3) < 2) ? (row >> 6) : (row & 63);
      const float* rt = p.ROPE() + (size_t)pos * 32 + ((c & 1) * 8) * 2;
#pragma unroll
      for (int e = 0; e < 8; ++e) {
        const float other = __shfl_xor(x[e], 4);
        const float cs = rt[e * 2], sn = rt[e * 2 + 1];
        x[e] = (c < 4) ? (x[e] * cs - other * sn) : (x[e] * cs + other * sn);
      }
    }
    uint4 w;
    w.x = pk2(x[0], x[1]); w.y = pk2(x[2], x[3]); w.z = pk2(x[4], x[5]); w.w = pk2(x[6], x[7]);
    *reinterpret_cast<uint4*>(zp) = w;
  }
}

DI void phase_s5e_conv_post(const Params& p, int b, int L, bf16_t* sm, int tid) {
  {
    VSUB_SETUP
    constexpr int NT_E = 32 * 9 * 2;
    const int nit = (NT_E + vgrid - 1) / vgrid;
    for (int it = 0; it < nit; ++it) {
      int item = it * vgrid + vb;
      const bool act = item < NT_E;
      if (!act) item = NT_E - 1;
      const int g = item / 18, rem = item % 18, mt = rem >> 1, nt = rem & 1;
      const int m0 = mt * 128, n0 = nt * 128;
      f32x16 acc[2][2];
      zero_acc<2>(acc);
      const bf16_t* Ub = p.Z() + C_S5U + g * 16;
      gemm_main<2>(acc, Ub + (size_t)m0 * 16 * LDZ, 16 * LDZ, ((vt & 7) >> 1) * LDZ + (vt & 1) * 8, 4 * LDZ,
                   p.S5We() + (size_t)(L * 32 + g) * 65536 + (size_t)n0 * 256, 256, 256, smv, vt, act, bcnt);
      if (act) {
#pragma unroll
        for (int mi = 0; mi < 2; ++mi)
#pragma unroll
          for (int ni = 0; ni < 2; ++ni)
#pragma unroll
            for (int i = 0; i < 16; ++i) {
              int m = m0 + wm * 64 + mi * 32 + crow(i, h);
              int n = n0 + wn * 64 + ni * 32 + r;
              if (m < NCH) p.E()[((size_t)m * 32 + g) * 256 + n] = acc[mi][ni][i];
            }
      }
    }
  }
  constexpr int NT_C = R * 64 / 512;
  constexpr int NT_P = 260 * 36 / 8;
  for (int item = blockIdx.x; item < NT_C + NT_P; item += gridDim.x) {
    if (item >= NT_C) {
      const int w = (item - NT_C) * 8 + (tid >> 6);
      post_item(p, L, w / 36, w % 36, tid & 63);
      continue;
    }
    const int idx = item * 512 + tid;
    const int row = idx >> 6, ch = (idx & 63) * 8;
    const int lo = (row < NLAT) ? 0 : NLAT, hi = (row < NLAT) ? (NLAT - 1) : (R - 1);
    const bf16_t* zr = p.Z() + (size_t)row * LDZ;
    float zz[3][8];
#pragma unroll
    for (int t = 0; t < 3; ++t) {
      int rr = row + t - 1;
      if (rr >= lo && rr <= hi) {
        uint4 cv = *reinterpret_cast<const uint4*>(p.Z() + (size_t)rr * LDZ + C_CV + ch);
        uint4 cc = *reinterpret_cast<const uint4*>(p.Z() + (size_t)rr * LDZ + C_CC + ch);
        zz[t][0] = lo_bf(cv.x) * lo_bf(cc.x); zz[t][1] = hi_bf(cv.x) * hi_bf(cc.x);
        zz[t][2] = lo_bf(cv.y) * lo_bf(cc.y); zz[t][3] = hi_bf(cv.y) * hi_bf(cc.y);
        zz[t][4] = lo_bf(cv.z) * lo_bf(cc.z); zz[t][5] = hi_bf(cv.z) * hi_bf(cc.z);
        zz[t][6] = lo_bf(cv.w) * lo_bf(cc.w); zz[t][7] = hi_bf(cv.w) * hi_bf(cc.w);
      } else {
#pragma unroll
        for (int j = 0; j < 8; ++j) zz[t][j] = 0.f;
      }
    }
    uint4 cb = *reinterpret_cast<const uint4*>(zr + C_CB + ch);
    uint4 cg_ = *reinterpret_cast<const uint4*>(zr + C_CG + ch);
    float bv[8] = {lo_bf(cb.x), hi_bf(cb.x), lo_bf(cb.y), hi_bf(cb.y), lo_bf(cb.z), hi_bf(cb.z), lo_bf(cb.w), hi_bf(cb.w)};
    float gv[8] = {lo_bf(cg_.x), hi_bf(cg_.x), lo_bf(cg_.y), hi_bf(cg_.y), lo_bf(cg_.z), hi_bf(cg_.z), lo_bf(cg_.w), hi_bf(cg_.w)};
    float o[8];
#pragma unroll
    for (int j = 0; j < 8; ++j) {
      float y = p.conv_b[L * 512 + ch + j] + zz[0][j] * p.conv_w[(L * 3 + 0) * 512 + ch + j] +
                zz[1][j] * p.conv_w[(L * 3 + 1) * 512 + ch + j] + zz[2][j] * p.conv_w[(L * 3 + 2) * 512 + ch + j];
      o[j] = bv[j] * y * siluf_(gv[j]);
    }
    uint4 w;
    w.x = pk2(o[0], o[1]); w.y = pk2(o[2], o[3]); w.z = pk2(o[4], o[5]); w.w = pk2(o[6], o[7]);
    *reinterpret_cast<uint4*>(p.Z() + (size_t)row * LDZ + C_CG + ch) = w;
  }
}

DI void phase_s5y(const Params& p, int b, int L, bf16_t* sm, int tid) {
  VSUB_SETUP
  constexpr int NT = 32 * 18;
  const int nit = (NT + vgrid - 1) / vgrid;
  for (int it = 0; it < nit; ++it) {
    int item = it * vgrid + vb;
    const bool act = item < NT;
    if (!act) item = NT - 1;
    const int g = item / 18, rem = item % 18, mt = rem >> 1, nt = rem & 1;
    const int m0 = mt * 128, n0 = nt * 128;
    f32x16 acc[2][2];
    zero_acc<2>(acc);
    const bf16_t* Ub = p.Z() + C_S5U + g * 16;
    gemm_main<2>(acc, Ub + (size_t)m0 * 16 * LDZ, 16 * LDZ, ((vt & 7) >> 1) * LDZ + (vt & 1) * 8, 4 * LDZ,
                 p.S5M() + (size_t)(L * 32 + g) * 65536 + (size_t)n0 * 256, 256, 256, smv, vt, act, bcnt);
    const bf16_t* Hb = p.HIN() + g * 256;
    gemm_main<2>(acc, Hb + (size_t)m0 * 8192, 8192, (vt & 7) * 8, 64,
                 p.S5R() + (size_t)(L * 32 + g) * 65536 + (size_t)n0 * 256, 256, 256, smv, vt, act, bcnt);
    if (act) {
#pragma unroll
      for (int mi = 0; mi < 2; ++mi)
#pragma unroll
        for (int ni = 0; ni < 2; ++ni)
#pragma unroll
          for (int i = 0; i < 16; ++i) {
            int m = m0 + wm * 64 + mi * 32 + crow(i, h);
            int n = n0 + wn * 64 + ni * 32 + r;
            if (m < NCH) {
              float y = acc[mi][ni][i];
              float z = 1.5957691216057308f * (y + 0.044715f * y * y * y);
              y = y * sigmoidf_(z);
              p.Y()[(size_t)(m * 16 + (n >> 4)) * 512 + g * 16 + (n & 15)] = f2bf(y);
            }
          }
    }
  }
}

DI void phase_glu(const Params& p, int b, int L, unsigned char* smraw) {
  if (p1_deferral() && blockIdx.x >= (unsigned)GLU_UNITS) {
    P1Order S{P1_UNITS_MAIN, P1_UNITS_ALL, (int)gridDim.x - GLU_UNITS, (int)blockIdx.x - GLU_UNITS};
    pg8::Gemm g{p.H(), p.WinT() + (size_t)L * 10496 * 1024, R, 10496, 1024};
    EpiP1 E{p.Z(), p.SG()};
    pg8::gemm_phase<EpiP1, P1Order, false>(LDS3(smraw), g, S, E, nullptr);
    return;
  }
  pg8::StaticOrder S;
  S.init(R, 512, gridDim.x, blockIdx.x);
  pg8::Gemm g{p.Y(), p.WgluT() + (size_t)L * 512 * 512, R, 512, 512};
  EpiGlu E{p.Y(), p.Z() + C_S5G};
  pg8::gemm_phase<EpiGlu, pg8::StaticOrder, false>(LDS3(smraw), g, S, E, nullptr);
}

DI void attn_item(const Params& p, int L, int mode, int head, int q_row0, int na_r, const float* bias_s, bf16_t* wl, int lane) {
  const int r = lane & 31, h = lane >> 5;
  int qcol, kcol, gcol;
  const bf16_t* vt;
  if (mode == 0 || mode == 2) {
    qcol = C_NQ + head * 64; kcol = C_NK + head * 64; gcol = C_NG + head * 64;
    vt = p.VtN() + (size_t)(head * 64) * LDT;
  } else {
    qcol = C_GQ + head * 64; kcol = C_GK + (head >> 2) * 64; gcol = C_GG + head * 64;
    vt = p.VtG() + (size_t)((head >> 2) * 64) * LDT;
  }
  bf16_t* Ql = wl + 4096 + lane * 8;
  {
    const bf16_t* qp = p.Z() + (size_t)(q_row0 + r) * LDZ + qcol + h * 8;
#pragma unroll
    for (int ks = 0; ks < 4; ++ks) {
      *reinterpret_cast<bf16x8*>(Ql + ks * 512) = ld16(qp + (size_t)32 * LDZ + ks * 16);
      *reinterpret_cast<bf16x8*>(Ql + 2048 + ks * 512) = ld16(qp + ks * 16);
    }
  }
  float la = 0.f, lb = 0.f;
  const float shf = p.ROPE()[8192 + L * 2 + ((mode == 0 || mode == 2) ? 0 : 1)];
  f32x16 OA0, OA1, OB0, OB1;
#pragma unroll
  for (int i = 0; i < 16; ++i) { OA0[i] = 0.f; OA1[i] = 0.f; OB0[i] = 0.f; OB1[i] = 0.f; }
  const int rs = min(max(na_r - 4, 0), 256 - 8);
  const int csA = min(max(r - 8, 0), 48), csB = min(max(r + 24, 0), 48);
  int kt_lo = 0, nband = 0;
  if (mode == 0) nband = 16;
  else if (mode == 1) {
    kt_lo = max(0, (128 - q_row0) >> 5);
    int kt_hi = min(10, (NLAT - q_row0 + 128) >> 5);
    nband = kt_hi - kt_lo;
  }
  const int ntiles = 8 + nband;
  auto tile_row = [&](int j) -> int {
    if (j < 8) return NLAT + j * 32;
    const int kt = kt_lo + j - 8;
    if (mode == 0) return (rs + (kt >> 1)) * 64 + (kt & 1) * 32;
    return q_row0 - 128 + kt * 32;
  };
  const bf16_t* kg = p.Z() + (size_t)(lane >> 3) * LDZ + kcol + (lane & 7) * 8;
  const bf16_t* vg = vt + (size_t)(lane >> 2) * LDT + (lane & 3) * 8;
  bf16_t* Kl = wl;
  bf16_t* Vl = wl + 2048;
  const int kstE = (lane >> 3) * 64 + (((lane & 7) ^ ((lane >> 4) & 7)) * 8);
  const int kstO = ((lane >> 3) + 8) * 64 + (((lane & 7) ^ (((lane >> 4) + 4) & 7)) * 8);
  const int vst0 = (lane >> 2) * 32 + (((lane & 3) ^ ((lane >> 4) & 3)) * 8);
#define KST(i) ((((i) & 1) ? kstO : kstE) + ((i) >> 1) * 1024)
#define VST(i) (vst0 + (i) * 512)
  const int krd = r * 64, ksw = (r >> 1) & 7;
  const int vrd0 = r * 32, vrd1 = (32 + r) * 32, vsw = (r >> 2) & 3;
  bf16x8 rk[4], rv[4];
  {
    const int t0r = tile_row(0);
#pragma unroll
    for (int i = 0; i < 4; ++i) {
      rk[i] = ld16(kg + (size_t)(t0r + 8 * i) * LDZ);
      rv[i] = ld16(vg + (size_t)(16 * i) * LDT + t0r);
    }
#pragma unroll
    for (int i = 0; i < 4; ++i) {
      *reinterpret_cast<bf16x8*>(Kl + KST(i)) = rk[i];
      *reinterpret_cast<bf16x8*>(Vl + VST(i)) = rv[i];
    }
  }
  for (int j = 0; j < ntiles; ++j) {
    const int krow0 = tile_row(j);
    const bool more = (j + 1 < ntiles);
    if (more) {
      const int tn = tile_row(j + 1);
#pragma unroll
      for (int i = 0; i < 4; ++i) {
        rk[i] = ld16(kg + (size_t)(tn + 8 * i) * LDZ);
        rv[i] = ld16(vg + (size_t)(16 * i) * LDT + tn);
      }
    }
    f32x16 SA, SB;
#pragma unroll
    for (int i = 0; i < 16; ++i) { SA[i] = -shf; SB[i] = -shf; }
#pragma unroll
    for (int ks = 0; ks < 4; ++ks) {
      bf16x8 kf = *reinterpret_cast<const bf16x8*>(Kl + krd + (((ks * 2 + h) ^ ksw) * 8));
      SA = MFMA32(kf, *reinterpret_cast<const bf16x8*>(Ql + 2048 + ks * 512), SA);
      SB = MFMA32(kf, *reinterpret_cast<const bf16x8*>(Ql + ks * 512), SB);
    }
    union { bf16x8 v; unsigned u[4]; } pa0, pa1, pb0, pb1;
#define SOFTMAX_TILE(S_, cs_, qoff_, lsum_, p0_, p1_)                                                      \
    {                                                                                                      \
      if (j >= 8 && mode == 0) {                                                                           \
        const int kt = j - 8;                                                                              \
        const int kcb = (kt & 1) * 32;                                                                     \
        const int di = rs + (kt >> 1) - na_r + 7;                                                          \
        const float* brow = bias_s + 64 + head * 465 + di * 31 + (kcb + 4 * h - (r + qoff_) + 15);        \
        const int t0 = kcb + 4 * h - cs_;                                                                  \
        _Pragma("unroll") for (int i = 0; i < 16; ++i) {                                                   \
          const int ci = (i & 3) + 8 * (i >> 2);                                                           \
          S_[i] = ((unsigned)(t0 + ci) < 16u) ? (S_[i] + brow[ci]) : -INFINITY;                            \
        }                                                                                                  \
      } else if (j >= 8) {                                                                                 \
        const int d0 = krow0 + 4 * h - (q_row0 + qoff_ + r);                                               \
        _Pragma("unroll") for (int i = 0; i < 16; ++i) {                                                   \
          const int df = d0 + (i & 3) + 8 * (i >> 2);                                                      \
          S_[i] = (df <= 128 && df >= -128) ? S_[i] : -INFINITY;                                           \
        }                                                                                                  \
      }                                                                                                    \
      float rsum = 0.f;                                                                                    \
      _Pragma("unroll") for (int i = 0; i < 16; ++i) {                                                     \
        float pv = __builtin_amdgcn_exp2f(S_[i]);                                                          \
        S_[i] = pv;                                                                                        \
        rsum += pv;                                                                                        \
      }                                                                                                    \
      lsum_ += rsum;                                                                                       \
      _Pragma("unroll") for (int q = 0; q < 4; ++q) {                                                      \
        p0_.u[q] = pk2(S_[2 * q], S_[2 * q + 1]);                                                          \
        p1_.u[q] = pk2(S_[8 + 2 * q], S_[8 + 2 * q + 1]);                                                  \
      }                                                                                                    \
    }
    SOFTMAX_TILE(SA, csA, 0, la, pa0, pa1)
    asm volatile("" : "+v"(pa0.u[0]), "+v"(pa0.u[1]), "+v"(pa0.u[2]), "+v"(pa0.u[3]), "+v"(pa1.u[0]), "+v"(pa1.u[1]), "+v"(pa1.u[2]), "+v"(pa1.u[3]));
    SOFTMAX_TILE(SB, csB, 32, lb, pb0, pb1)
#undef SOFTMAX_TILE
    {
      bf16x8 v00 = *reinterpret_cast<const bf16x8*>(Vl + vrd0 + (((0 + h) ^ vsw) * 8));
      bf16x8 v01 = *reinterpret_cast<const bf16x8*>(Vl + vrd0 + (((2 + h) ^ vsw) * 8));
      OA0 = MFMA32(v00, pa0.v, OA0); OB0 = MFMA32(v00, pb0.v, OB0);
      OA0 = MFMA32(v01, pa1.v, OA0); OB0 = MFMA32(v01, pb1.v, OB0);
      bf16x8 v10 = *reinterpret_cast<const bf16x8*>(Vl + vrd1 + (((0 + h) ^ vsw) * 8));
      bf16x8 v11 = *reinterpret_cast<const bf16x8*>(Vl + vrd1 + (((2 + h) ^ vsw) * 8));
      OA1 = MFMA32(v10, pa0.v, OA1); OB1 = MFMA32(v10, pb0.v, OB1);
      OA1 = MFMA32(v11, pa1.v, OA1); OB1 = MFMA32(v11, pb1.v, OB1);
    }
    if (more) {
#pragma unroll
      for (int i = 0; i < 4; ++i) {
        *reinterpret_cast<bf16x8*>(Kl + KST(i)) = rk[i];
        *reinterpret_cast<bf16x8*>(Vl + VST(i)) = rv[i];
      }
    }
  }
  float l_a = la + __shfl_xor(la, 32), l_b = lb + __shfl_xor(lb, 32);
  if (mode == 1 || mode == 3) {
    const float sk = __builtin_amdgcn_exp2f(p.gqa_sink[L * 8 + head] * LOG2E - shf);
    l_a += sk; l_b += sk;
  }
  const float inva = 1.f / l_a, invb = 1.f / l_b;
  bf16_t* gpa = p.Z() + (size_t)(q_row0 + r) * LDZ + gcol + 4 * h;
  bf16_t* gpb = gpa + (size_t)32 * LDZ;
  {
    uint2 gA0[4], gA1[4], gB0[4], gB1[4];
#pragma unroll
    for (int i4 = 0; i4 < 4; ++i4) {
      gA0[i4] = *reinterpret_cast<const uint2*>(gpa + i4 * 8);
      gA1[i4] = *reinterpret_cast<const uint2*>(gpa + 32 + i4 * 8);
      gB0[i4] = *reinterpret_cast<const uint2*>(gpb + i4 * 8);
      gB1[i4] = *reinterpret_cast<const uint2*>(gpb + 32 + i4 * 8);
    }
#define ATT_OUT(O, G, gp, inv, off)                                                                                 \
    {                                                                                                               \
      const uint2 gt = G[i4];                                                                                       \
      uint2 w;                                                                                                      \
      w.x = pk2(O[i4 * 4 + 0] * inv * siluf_(lo_bf(gt.x)), O[i4 * 4 + 1] * inv * siluf_(hi_bf(gt.x)));              \
      w.y = pk2(O[i4 * 4 + 2] * inv * siluf_(lo_bf(gt.y)), O[i4 * 4 + 3] * inv * siluf_(hi_bf(gt.y)));              \
      *reinterpret_cast<uint2*>(gp + off + i4 * 8) = w;                                                             \
    }
#pragma unroll
    for (int i4 = 0; i4 < 4; ++i4) {
      ATT_OUT(OA0, gA0, gpa, inva, 0)
      ATT_OUT(OA1, gA1, gpa, inva, 32)
      ATT_OUT(OB0, gB0, gpb, invb, 0)
      ATT_OUT(OB1, gB1, gpb, invb, 32)
    }
#undef ATT_OUT
  }
#undef KST
#undef VST
}

DI void scan_wg(const Params& p, int L, int dgi, float* sm, int tid) {
  const int lane = tid & 63, w = tid >> 6;
  const int d = dgi >> 5, g = dgi & 31;
  const int dg = (L * 2 + d) * 32 + g;
  const float ar = p.A16()[(dg * 64 + lane) * 2], ai = p.A16()[(dg * 64 + lane) * 2 + 1];
  const int off = g * 256 + d * 128 + lane * 2;
  const int s_lo = w * 130;
  auto chunk_of = [&](int s) -> int { return (d == 0) ? (s < 16 ? 1024 + s : s - 16) : (NCH - 1 - s); };
  float hr = 0.f, hi = 0.f, pr = 1.f, pi = 0.f;
  float2 e[10], en[10];
#pragma unroll
  for (int u = 0; u < 10; ++u) e[u] = *reinterpret_cast<const float2*>(p.E() + (size_t)chunk_of(s_lo + u) * 8192 + off);
  for (int s0 = 0; s0 < 130; s0 += 10) {
    const int sn = (s0 + 10 < 130) ? (s0 + 10) : s0;
#pragma unroll
    for (int u = 0; u < 10; ++u) en[u] = *reinterpret_cast<const float2*>(p.E() + (size_t)chunk_of(s_lo + sn + u) * 8192 + off);
#pragma unroll
    for (int u = 0; u < 10; ++u) {
      float nr = ar * hr - ai * hi + e[u].x, ni = ar * hi + ai * hr + e[u].y;
      hr = nr; hi = ni;
      float qr = pr * ar - pi * ai, qi = pr * ai + pi * ar;
      pr = qr; pi = qi;
    }
#pragma unroll
    for (int u = 0; u < 10; ++u) e[u] = en[u];
  }
  sm[(w * 64 + lane) * 2] = hr;
  sm[(w * 64 + lane) * 2 + 1] = hi;
  __syncthreads();
  float cr = 0.f, ci = 0.f;
  for (int v = 0; v < w; ++v) {
    float tr = sm[(v * 64 + lane) * 2], ti = sm[(v * 64 + lane) * 2 + 1];
    float nr = pr * cr - pi * ci + tr, ni = pr * ci + pi * cr + ti;
    cr = nr; ci = ni;
  }
  __syncthreads();
  hr = cr; hi = ci;
#pragma unroll
  for (int u = 0; u < 10; ++u) e[u] = *reinterpret_cast<const float2*>(p.E() + (size_t)chunk_of(s_lo + u) * 8192 + off);
  for (int s0 = 0; s0 < 130; s0 += 10) {
    const int sn = (s0 + 10 < 130) ? (s0 + 10) : s0;
#pragma unroll
    for (int u = 0; u < 10; ++u) en[u] = *reinterpret_cast<const float2*>(p.E() + (size_t)chunk_of(s_lo + sn + u) * 8192 + off);
#pragma unroll
    for (int u = 0; u < 10; ++u) {
      *reinterpret_cast<unsigned*>(p.HIN() + (size_t)chunk_of(s_lo + s0 + u) * 8192 + off) = pk2(hr, hi);
      float nr = ar * hr - ai * hi + e[u].x, ni = ar * hi + ai * hr + e[u].y;
      hr = nr; hi = ni;
    }
#pragma unroll
    for (int u = 0; u < 10; ++u) e[u] = en[u];
  }
}

DI void phase_attn_scan(const Params& p, int b, int L, float* sm, int tid) {
  const int lane = tid & 63, wid = tid >> 6;
  float* bias_s = sm + 32768;
  bf16_t* wl = reinterpret_cast<bf16_t*>(sm) + wid * 8192;
  for (int idx = tid; idx < 8 * 465; idx += 512) bias_s[64 + idx] = p.na_rel_bias[L * 8 * 465 + idx] * LOG2E;
  __syncthreads();
  constexpr int N_SCAN = 64, N_ATT = 4096 / 8;
  for (int item = blockIdx.x; item < N_SCAN; item += gridDim.x) scan_wg(p, L, item, sm + 32768 + 3840, tid);
  int lat_it = 0, ci = 0;
  for (;;) {
    int item;
    const int lat = (int)blockIdx.x + lat_it * (int)gridDim.x;
    if (lat < N_ATT) { item = lat; ++lat_it; }
    else {
      while (ci < 8 && (unsigned)((64 + ci) % gridDim.x) != blockIdx.x) ++ci;
      if (ci >= 8) break;
      item = N_ATT + ci;
      ++ci;
    }
    int mode, head, q_row0, na_r = 0;
    if (item < N_ATT) {
      const int w = item * 8 + wid;
      if (w < 2048) { mode = 0; head = w & 7; na_r = w >> 3; q_row0 = na_r * 64; }
      else { const int w2 = w - 2048; mode = 1; head = w2 & 7; q_row0 = (w2 >> 3) * 64; }
    } else {
      const int cj = item - N_ATT;
      const int w2 = (cj & 3) * 8 + wid;
      mode = (cj < 4) ? 2 : 3; head = w2 & 7; q_row0 = NLAT + (w2 >> 3) * 64;
    }
    attn_item(p, L, mode, head, q_row0, na_r, bias_s, wl, lane);
  }
  __syncthreads();
}

DI void phase_merge(const Params& p, int b, int L, bf16_t* sm, int tid) {
  VSUB_SETUP
  constexpr int NT = 128 * 8;
  const int nit = (NT + vgrid - 1) / vgrid;
  for (int it = 0; it < nit; ++it) {
    int tile = it * vgrid + vb;
    const bool act = tile < NT;
    if (!act) tile = NT - 1;
    const int mt = tile >> 3, nt = tile & 7;
    const int m0 = mt * 128, n0 = nt * 128;
    f32x16 outv[2][2];
    zero_acc<2>(outv);
    for (int kb = 0; kb < 4; ++kb) {
      f32x16 acc[2][2];
      zero_acc<2>(acc);
      const int gc = (kb == 0) ? C_S5G : (kb == 1 ? C_CG : (kb == 2 ? C_NG : C_GG));
      const bf16_t* Ab = p.Z() + (size_t)m0 * LDZ + gc;
      gemm_main<2, true, false>(acc, Ab, LDZ, (vt & 7) * 8, 64, p.WbrT() + (size_t)(L * 4 + kb) * 1024 * 512 + (size_t)n0 * 512, 512,
                         512, smv, vt, act, bcnt);
      if (act) {
#pragma unroll
        for (int mi = 0; mi < 2; ++mi) {
          const bf16_t* sgp = p.SG() + sg_index(m0 + wm * 64 + mi * 32 + r, kb * 1024 + n0 + wn * 64 + 4 * h);
#pragma unroll
          for (int ni = 0; ni < 2; ++ni)
#pragma unroll
            for (int i4 = 0; i4 < 4; ++i4) {
              uint2 sv = *reinterpret_cast<const uint2*>(sgp + (ni * 8 + i4 * 2) * 128);
              outv[mi][ni][i4 * 4 + 0] += lo_bf(sv.x) * acc[mi][ni][i4 * 4 + 0];
              outv[mi][ni][i4 * 4 + 1] += hi_bf(sv.x) * acc[mi][ni][i4 * 4 + 1];
              outv[mi][ni][i4 * 4 + 2] += lo_bf(sv.y) * acc[mi][ni][i4 * 4 + 2];
              outv[mi][ni][i4 * 4 + 3] += hi_bf(sv.y) * acc[mi][ni][i4 * 4 + 3];
            }
        }
      }
    }
    if (act) {
#pragma unroll
      for (int mi = 0; mi < 2; ++mi) {
        bf16_t* op = p.MIX() + (size_t)(m0 + wm * 64 + mi * 32 + r) * 1024 + n0 + wn * 64 + 4 * h;
#pragma unroll
        for (int ni = 0; ni < 2; ++ni)
#pragma unroll
          for (int i4 = 0; i4 < 4; ++i4) {
            uint2 w;
            w.x = pk2(outv[mi][ni][i4 * 4 + 0], outv[mi][ni][i4 * 4 + 1]);
            w.y = pk2(outv[mi][ni][i4 * 4 + 2], outv[mi][ni][i4 * 4 + 3]);
            *reinterpret_cast<uint2*>(op + ni * 32 + i4 * 8) = w;
          }
      }
    }
  }
  constexpr int NTC = 2 * 16 * 4;
  const int nitc = (L == 3) ? 0 : (NTC + vgrid - 1) / vgrid;
  for (int it = 0; it < nitc; ++it) {
    int item = it * vgrid + vb;
    const bool act = item < NTC;
    if (!act) item = NTC - 1;
    const int kb = item & 3, nt = (item >> 2) & 15, mt = item >> 6;
    const int m0 = NLAT + mt * 128, n0 = nt * 64;
    f32x16 acc[2][1];
    zero_acc<1>(acc);
    const int gc = (kb == 0) ? C_S5G : (kb == 1 ? C_CG : (kb == 2 ? C_NG : C_GG));
    gemm_main<1, true>(acc, p.Z() + (size_t)m0 * LDZ + gc, LDZ, (vt & 7) * 8, 64,
                       p.WbrT() + (size_t)(L * 4 + kb) * 1024 * 512 + (size_t)n0 * 512, 512, 512, smv, vt, act, bcnt);
    if (act) {
#pragma unroll
      for (int mi = 0; mi < 2; ++mi) {
        const int row = m0 + wm * 64 + mi * 32 + r;
        const bf16_t* sgp = p.SG() + sg_index(row, kb * 1024 + n0 + wn * 32 + 4 * h);
        bf16_t* op = p.PCTX() + (size_t)kb * 256 * 1024 + (size_t)(row - NLAT) * 1024 + n0 + wn * 32 + 4 * h;
#pragma unroll
        for (int i4 = 0; i4 < 4; ++i4) {
          uint2 sv = *reinterpret_cast<const uint2*>(sgp + (i4 * 2) * 128);
          uint2 w;
          w.x = pk2(lo_bf(sv.x) * acc[mi][0][i4 * 4 + 0], hi_bf(sv.x) * acc[mi][0][i4 * 4 + 1]);
          w.y = pk2(lo_bf(sv.y) * acc[mi][0][i4 * 4 + 2], hi_bf(sv.y) * acc[mi][0][i4 * 4 + 3]);
          *reinterpret_cast<uint2*>(op + i4 * 8) = w;
        }
      }
    }
  }
}

DI void phase_out(const Params& p, int b, int L, unsigned char* smraw, int tid) {
  {
    pg8::StaticOrder S;
    S.init(NLAT, 1024, gridDim.x, blockIdx.x);
    pg8::Gemm g{p.MIX(), p.WoutT() + (size_t)L * 1024 * 1024, NLAT, 1024, 1024};
    EpiOutRes E{(L == 0 ? p.x : (const float*)p.out) + (size_t)b * NLAT * 1024, p.out + (size_t)b * NLAT * 1024,
                p.MOD() + (L * 3 + b) * 3072 + 2048};
    pg8::gemm_phase<EpiOutRes, pg8::StaticOrder, false>(LDS3(smraw), g, S, E, nullptr);
  }
  if (L == 3) return;
  __syncthreads();
  bf16_t* sm = reinterpret_cast<bf16_t*>(smraw);
  VSUB_SETUP
  constexpr int NT = 2 * 8;
  const int nit = (NT + vgrid - 1) / vgrid;
  for (int it = 0; it < nit; ++it) {
    int tile = it * vgrid + vb;
    const bool act = tile < NT;
    if (!act) tile = NT - 1;
    const int mt = tile >> 3, nt = tile & 7;
    const int m0 = NLAT + mt * 128, n0 = nt * 128;
    f32x16 acc[2][2];
    zero_acc<2>(acc);
    {
      const bf16_t* Ab = p.PCTX() + (size_t)(m0 - NLAT) * 1024;
      gemm_main<2, false, false, true>(acc, Ab, 1024, (vt & 7) * 8, 64, p.WoutT() + (size_t)L * 1024 * 1024 + (size_t)n0 * 1024,
                                       1024, 1024, smv, vt, act, bcnt, (size_t)256 * 1024);
    }
    if (act) {
      const float* src = (L == 0 ? p.ctx : (const float*)p.CTXS()) + ((size_t)b * 256 + (m0 - NLAT)) * 1024;
      float* dst = p.CTXS() + ((size_t)b * 256 + (m0 - NLAT)) * 1024;
      const float* gate = p.MOD() + (L * 3 + 2) * 3072 + 2048;
#pragma unroll
      for (int ni = 0; ni < 2; ++ni) {
        const int col = n0 + wn * 64 + ni * 32 + r;
        const float gt = gate[col];
#pragma unroll
        for (int mi = 0; mi < 2; ++mi) {
          float xs[16];
#pragma unroll
          for (int i = 0; i < 16; ++i) xs[i] = src[(size_t)(wm * 64 + mi * 32 + crow(i, h)) * 1024 + col];
#pragma unroll
          for (int i = 0; i < 16; ++i) dst[(size_t)(wm * 64 + mi * 32 + crow(i, h)) * 1024 + col] = xs[i] + gt * acc[mi][ni][i];
        }
      }
    }
  }
}

#define XB_TMO      128
#define XB_XCNT(j)  (256  + 64 * (j))
#define XB_XSUB(j)  (1280 + 64 * (j))
#define XB_XGEN(j)  (2304 + 64 * (j))
#define XB_TOP      3328
#define XB_TOPGEN   3392
#define XCD_BAR_WORDS 3456
#define XB_SPIN_CAP (1u << 18)
#define LAS __attribute__((address_space(3)))

__device__ __forceinline__ unsigned xb_ld(unsigned* p)              { return __hip_atomic_load(p, __ATOMIC_RELAXED, __HIP_MEMORY_SCOPE_AGENT); }
__device__ __forceinline__ unsigned xb_add(unsigned* p, unsigned v) { return __hip_atomic_fetch_add(p, v, __ATOMIC_RELAXED, __HIP_MEMORY_SCOPE_AGENT); }
__device__ __forceinline__ unsigned xb_xcc_id() { return (unsigned)__builtin_amdgcn_s_getreg((3 << 11) | 20) & 0xFu; }
#define XB_SPIN(cond, bar) do { unsigned _sp = 0; while (cond) { __builtin_amdgcn_s_sleep(1); \
    if ((++_sp & 255u) == 0u) { if (xb_ld(&(bar)[XB_TMO])) break; if (_sp > XB_SPIN_CAP) { atomicAdd(&(bar)[XB_TMO], 1u); break; } } } } while (0)

struct XcdBarrier {
    unsigned* bar; unsigned x;
    volatile LAS unsigned* st;
};

__device__ __forceinline__ XcdBarrier xcd_barrier_post(unsigned* bar, volatile LAS unsigned* st) {
    XcdBarrier b; b.bar = bar; b.x = xb_xcc_id(); b.st = st;
    if (threadIdx.x == 0) (void)xb_add(&bar[XB_XCNT(b.x)], 1u);
    return b;
}
__device__ __forceinline__ void xcd_barrier_complete(unsigned* bar, unsigned x, unsigned& nloc, unsigned& nx) {
    const unsigned G = gridDim.x * gridDim.y * gridDim.z;
    unsigned sum, cnt, mine, sp = 0u;
    for (;;) {
        sum = 0u; cnt = 0u; mine = 0u;
#pragma unroll
        for (unsigned j = 0; j < 16; ++j) { const unsigned c = xb_ld(&bar[XB_XCNT(j)]); sum += c; cnt += (c > 0u) ? 1u : 0u; mine = (j == x) ? c : mine; }
        if (sum == G) break;
        __builtin_amdgcn_s_sleep(1);
        if ((++sp & 255u) == 0u) { if (xb_ld(&bar[XB_TMO])) break; if (sp > XB_SPIN_CAP) { atomicAdd(&bar[XB_TMO], 1u); break; } }
    }
    nloc = mine > 0u ? mine : 1u; nx = cnt > 0u ? cnt : 1u;
}

__device__ __forceinline__ void xcd_barrier(const XcdBarrier& b) {
    asm volatile("s_waitcnt vmcnt(0)" ::: "memory");
    __syncthreads();
    if (threadIdx.x == 0) {
        unsigned* bar = b.bar;
        __builtin_amdgcn_s_waitcnt(0);
        unsigned nloc = b.st[0], nx = b.st[1];
        if (nloc == 0u) { xcd_barrier_complete(bar, b.x, nloc, nx); b.st[0] = nloc; b.st[1] = nx; }
        const unsigned old = xb_add(&bar[XB_XSUB(b.x)], 1u);
        const unsigned gen = old / nloc;
        if (old + 1u == (gen + 1u) * nloc) {
            __builtin_amdgcn_fence(__ATOMIC_RELEASE, "agent");
            asm volatile("s_waitcnt vmcnt(0)" ::: "memory");
            const unsigned og = xb_add(&bar[XB_TOP], 1u);
            const unsigned tg = og / nx;
            if (og + 1u == (tg + 1u) * nx) xb_add(&bar[XB_TOPGEN], 1u);
            else XB_SPIN(xb_ld(&bar[XB_TOPGEN]) == tg, bar);
            __builtin_amdgcn_fence(__ATOMIC_ACQUIRE, "agent");
            xb_add(&bar[XB_XGEN(b.x)], 1u);
            asm volatile("s_waitcnt vmcnt(0)" ::: "memory");
        } else {
            XB_SPIN(xb_ld(&bar[XB_XGEN(b.x)]) == gen, bar);
            __builtin_amdgcn_fence(__ATOMIC_ACQUIRE, "agent");
            asm volatile("s_waitcnt vmcnt(0)" ::: "memory");
        }
    }
    __syncthreads();
}


__global__ void __launch_bounds__(512, 2) mega_kernel(Params p, int ph_lo, int ph_hi) {
  __shared__ __attribute__((aligned(1024))) unsigned char smem_raw[151552];
  __shared__ uint4 xb_words;
  bf16_t* smb = reinterpret_cast<bf16_t*>(smem_raw);
  float* smf = reinterpret_cast<float*>(smem_raw);
  if (threadIdx.x == 0) xb_words = make_uint4(0u, 0u, 0u, 0u);
  if (threadIdx.x < 128) g_vsub_cnt[threadIdx.x] = 0u;
  __syncthreads();
  XcdBarrier xb = xcd_barrier_post(p.bar, (volatile LAS unsigned*)&xb_words);
  if (ph_hi < 0) cg::this_grid().sync();
  for (int ph = ph_lo; ph < ph_hi; ++ph) {
    int tid = threadIdx.x;
    asm volatile("" : "+v"(tid));
    if (ph == 0) {
      phase_prep(p, smf, tid);
    } else {
      const int q = ph - 1;
      const int b = q >> 5, L = (q & 31) >> 3, sub = q & 7;
      switch (sub) {
        case 0: phase_norm(p, b, L, tid); break;
        case 1: phase_p1(p, b, L, smem_raw); break;
        case 2: phase_s5e_conv_post(p, b, L, smb, tid); break;
        case 3: phase_attn_scan(p, b, L, smf, tid); break;
        case 4: phase_s5y(p, b, L, smb, tid); break;
        case 5: phase_glu(p, b, L, smem_raw); break;
        case 6: phase_merge(p, b, L, smb, tid); break;
        default: phase_out(p, b, L, smem_raw, tid); break;
      }
    }
    if (ph + 1 < ph_hi) xcd_barrier(xb);
  }
}

extern "C" void kernel_launch(void* const* d_in, const int* in_sizes, int n_in, void* d_out, int out_size, void* d_ws,
                              size_t ws_size, hipStream_t stream) {
  Params p{};
  const float** fp = reinterpret_cast<const float**>(&p);
  for (int i = 0; i < 27; ++i) fp[i] = (const float*)d_in[i];
  p.out = (float*)d_out;
  p.ws = (char*)d_ws;
  p.bar = (unsigned*)((char*)d_ws + OFF_BAR);
  if (WS_TOTAL > ws_size) {
    fprintf(stderr, "workspace too small: need %zu have %zu\n", (size_t)WS_TOTAL, ws_size);
    return;
  }
  static int grid_blocks = 0;
  if (!grid_blocks) {
    int dev = 0, cus = 0, per_cu = 0;
    (void)hipGetDevice(&dev);
    (void)hipDeviceGetAttribute(&cus, hipDeviceAttributeMultiprocessorCount, dev);
    (void)hipOccupancyMaxActiveBlocksPerMultiprocessor(&per_cu, mega_kernel, 512, 0);
    if (per_cu > 1) per_cu = 1;
    if (per_cu < 1) per_cu = 1;
    grid_blocks = cus * per_cu;
  }
  (void)hipMemsetAsync(p.bar, 0, 4096 * 4, stream);
#if MULTI_LAUNCH
  for (int ph = 0; ph < NPHASE; ++ph) {
    hipLaunchKernelGGL(mega_kernel, dim3(grid_blocks), dim3(512), 0, stream, p, ph, ph + 1);
  }
#else
  int lo = 0, hi = NPHASE;
  void* args[] = {&p, &lo, &hi};
  hipError_t e = hipLaunchCooperativeKernel((void*)mega_kernel, dim3(grid_blocks), dim3(512), args, 0, stream);
  if (e != hipSuccess) fprintf(stderr, "cooperative launch failed: %s (grid %d)\n", hipGetErrorString(e), grid_blocks);
#endif
}
```

```cpp
#include <hip/hip_runtime.h>
#include <hip/hip_cooperative_groups.h>
#include <cstdio>
namespace cg = cooperative_groups;

#ifdef ONLY
#define ONLYP(i) (ONLY == (i))
#else
#define ONLYP(i) 1
#endif
#ifndef MULTI_LAUNCH
#define MULTI_LAUNCH 0
#endif

#define DI __device__ __forceinline__
typedef unsigned short bf16_t;
typedef __attribute__((ext_vector_type(8))) short bf16x8;
typedef __attribute__((ext_vector_type(16))) float f32x16;
typedef __attribute__((ext_vector_type(2))) float f32x2;
typedef __attribute__((ext_vector_type(2))) __bf16 bfx2;
#define MFMA32(a, b, c) __builtin_amdgcn_mfma_f32_32x32x16_bf16((a), (b), (c), 0, 0, 0)

constexpr int R = 16640;
constexpr int NLAT = 16384;
constexpr int LDZ = 6400;
constexpr int LDT = 16640;
constexpr int NCH = 1040;
constexpr float LOG2E = 1.4426950408889634f;
constexpr int C_S5U = 0, C_S5G = 512, C_CV = 1024, C_CB = 1536, C_CC = 2048, C_CG = 2560, C_NQ = 3072, C_NK = 3584,
              C_NV = 4096, C_NG = 4608, C_GQ = 5120, C_GK = 5632, C_GV = 5760, C_GG = 5888;
constexpr int NPHASE = 1 + 2 * 4 * 8;

constexpr size_t al256(size_t x) { return (x + 255) & ~(size_t)255; }
constexpr size_t OFF_H = 0;
constexpr size_t OFF_Z = OFF_H + al256((size_t)R * 1024 * 2);
constexpr size_t OFF_VTN = OFF_Z + al256((size_t)R * LDZ * 2);
constexpr size_t OFF_VTG = OFF_VTN + al256((size_t)512 * LDT * 2);
constexpr size_t OFF_Y = OFF_VTG + al256((size_t)128 * LDT * 2);
constexpr size_t OFF_HIN = OFF_Y + al256((size_t)R * 512 * 2);
constexpr size_t OFF_E = OFF_HIN + al256((size_t)NCH * 8192 * 2);
constexpr size_t OFF_MIX = OFF_E;
constexpr size_t OFF_SG = OFF_E + al256((size_t)R * 1024 * 2);
constexpr size_t OFF_CTXS = OFF_SG + al256((size_t)R * 4096 * 2);
constexpr size_t OFF_WINT = OFF_CTXS + al256((size_t)512 * 1024 * 4);
constexpr size_t OFF_WBRT = OFF_WINT + al256((size_t)4 * 10496 * 1024 * 2);
constexpr size_t OFF_WOUTT = OFF_WBRT + al256((size_t)16 * 1024 * 512 * 2);
constexpr size_t OFF_WGLUT = OFF_WOUTT + al256((size_t)4 * 1024 * 1024 * 2);
constexpr size_t OFF_S5M = OFF_WGLUT + al256((size_t)4 * 512 * 512 * 2);
constexpr size_t OFF_S5WE = OFF_S5M + al256((size_t)128 * 65536 * 2);
constexpr size_t OFF_S5R = OFF_S5WE + al256((size_t)128 * 65536 * 2);
constexpr size_t OFF_A16 = OFF_S5R + al256((size_t)128 * 65536 * 2);
constexpr size_t OFF_MOD = OFF_A16 + al256((size_t)4 * 2 * 32 * 64 * 2 * 4);
constexpr size_t OFF_ROPE = OFF_MOD + al256((size_t)4 * 3 * 3072 * 4);
constexpr size_t OFF_BAR = OFF_ROPE + al256((size_t)256 * 16 * 2 * 4 + 64);
constexpr size_t OFF_PCTX = OFF_BAR + al256((size_t)4096 * 4);
constexpr size_t WS_TOTAL = OFF_PCTX + al256((size_t)4 * 256 * 1024 * 2);

struct Params {
  const float *x, *c, *ctx, *c_ctx, *norm_g, *w_ada, *b_ada, *w_in, *s5_a_re, *s5_a_im, *s5_log_dt, *s5_b_re, *s5_b_im,
      *s5_c_re, *s5_c_im, *s5_d, *s5_w_glu, *conv_w, *conv_b, *na_q_g, *na_k_g, *na_rel_bias, *gqa_q_g, *gqa_k_g, *gqa_sink,
      *w_br, *w_out;
  float* out;
  char* ws;
  unsigned* bar;
  DI bf16_t* H() const { return (bf16_t*)(ws + OFF_H); }
  DI bf16_t* Z() const { return (bf16_t*)(ws + OFF_Z); }
  DI bf16_t* VtN() const { return (bf16_t*)(ws + OFF_VTN); }
  DI bf16_t* VtG() const { return (bf16_t*)(ws + OFF_VTG); }
  DI bf16_t* Y() const { return (bf16_t*)(ws + OFF_Y); }
  DI bf16_t* MIX() const { return (bf16_t*)(ws + OFF_MIX); }
  DI bf16_t* HIN() const { return (bf16_t*)(ws + OFF_HIN); }
  DI float* E() const { return (float*)(ws + OFF_E); }
  DI float* CTXS() const { return (float*)(ws + OFF_CTXS); }
  DI bf16_t* WinT() const { return (bf16_t*)(ws + OFF_WINT); }
  DI bf16_t* SG() const { return (bf16_t*)(ws + OFF_SG); }
  DI bf16_t* PCTX() const { return (bf16_t*)(ws + OFF_PCTX); }
  DI bf16_t* WbrT() const { return (bf16_t*)(ws + OFF_WBRT); }
  DI bf16_t* WoutT() const { return (bf16_t*)(ws + OFF_WOUTT); }
  DI bf16_t* WgluT() const { return (bf16_t*)(ws + OFF_WGLUT); }
  DI bf16_t* S5M() const { return (bf16_t*)(ws + OFF_S5M); }
  DI bf16_t* S5We() const { return (bf16_t*)(ws + OFF_S5WE); }
  DI bf16_t* S5R() const { return (bf16_t*)(ws + OFF_S5R); }
  DI float* A16() const { return (float*)(ws + OFF_A16); }
  DI float* MOD() const { return (float*)(ws + OFF_MOD); }
  DI float* ROPE() const { return (float*)(ws + OFF_ROPE); }
};

DI float bf2f(bf16_t v) { return __uint_as_float(((unsigned)v) << 16); }
DI unsigned pk2(float a, float b) {
  f32x2 v = {a, b};
  bfx2 r = __builtin_convertvector(v, bfx2);
  return __builtin_bit_cast(unsigned, r);
}
DI bf16_t f2bf(float a) { return (bf16_t)(pk2(a, 0.f) & 0xffffu); }
DI float lo_bf(unsigned u) { return __uint_as_float(u << 16); }
DI float hi_bf(unsigned u) { return __uint_as_float(u & 0xffff0000u); }
DI float sigmoidf_(float x) { return __builtin_amdgcn_rcpf(1.f + __builtin_amdgcn_exp2f(-1.4426950408889634f * x)); }
DI float siluf_(float x) { return x * __builtin_amdgcn_rcpf(1.f + __builtin_amdgcn_exp2f(-1.4426950408889634f * x)); }
DI size_t sg_index(int row, int col) { return ((size_t)((row >> 5) * 1024 + (col >> 2)) * 32 + (row & 31)) * 4 + (col & 3); }
DI int crow(int i, int h) { return (i & 3) + 8 * (i >> 2) + 4 * h; }
DI bf16x8 ld16(const bf16_t* p) { return *reinterpret_cast<const bf16x8*>(p); }


namespace pg8 {
typedef unsigned short bf16_t;
#define PG8_LAS __attribute__((address_space(3)))
typedef short bf16x8 __attribute__((ext_vector_type(8)));
typedef float f32x4 __attribute__((ext_vector_type(4)));
typedef unsigned u32x4 __attribute__((ext_vector_type(4)));
constexpr int BM = 256, BK = 64, HALF = 128, HTB = HALF * BK * 2  , STAGE_BYTES = 8 * HTB, NXCD = 8, WGM = 8;

__host__ __device__ __forceinline__ int lds_byte(int r, int c) { const int st = (r >> 4) * 2 + (c >> 5), rr = r & 15, cc = c & 31, ob = rr * 64 + cc * 2; return st * 1024 + (ob ^ (((ob >> 9) & 1) << 5)); }
__host__ __device__ __forceinline__ void stage_rc(int b, int& R, int& C) { const int st = b / 1024, sb = b % 1024, swz = sb ^ (((sb >> 9) & 1) << 5); R = (st >> 1) * 16 + swz / 64; C = (st & 1) * 32 + (swz % 64) / 2; }
__host__ __device__ __forceinline__ int perm32(int rho) { const int n = rho >> 4, i = rho & 15; return 8 * (i >> 2) + 4 * n + (i & 3); }

struct Unit { int pm, pn; };
struct Gemm { const bf16_t* A; const bf16_t* Bt; int M, N, K; };

struct StaticOrder {
    int nM, nN, nwg, G, c;
    __host__ __device__ void init(int M, int N, int G_, int c_) { nM = M / BM; nN = N / BM; nwg = nM * nN; G = G_; c = c_; }
    __host__ __device__ bool next(int i, Unit& u) const {
        const long L = (long)i * G + c; if (L >= nwg) return false;
        int wgid = (int)L; { const int q = nwg / NXCD, r = nwg % NXCD, xcd = wgid % NXCD, off = wgid / NXCD; wgid = (xcd < r ? xcd * (q + 1) : r * (q + 1) + (xcd - r) * q) + off; }
        const int nig = WGM * nN, gid = wgid / nig, fm = gid * WGM, gsz = (nM - fm) < WGM ? (nM - fm) : WGM;
        u.pm = fm + ((wgid % nig) % gsz); u.pn = (wgid % nig) / gsz; return true;
    }
    __device__ __forceinline__ void a_ready(const Unit&) const {}
    __device__ __forceinline__ void done(const Unit&) const {}
};
struct CountedOrder : StaticOrder {
    const unsigned* ready; unsigned need; unsigned* tmo;
    __device__ __forceinline__ void a_ready(const Unit& u) const {
        if (threadIdx.x < 64) {
            const unsigned long long t0 = __builtin_amdgcn_s_memrealtime(); unsigned polls = 0;
            while ((unsigned)__builtin_amdgcn_readfirstlane(__hip_atomic_load(ready + 64 * u.pm, __ATOMIC_RELAXED, __HIP_MEMORY_SCOPE_AGENT)) < need) {
                if ((++polls & 255u) == 0u && __builtin_amdgcn_readfirstlane(__hip_atomic_load(tmo, __ATOMIC_RELAXED, __HIP_MEMORY_SCOPE_AGENT)) != 0u) break;
                if (__builtin_amdgcn_s_memrealtime() - t0 > 2000000ull) {
                    if (threadIdx.x == 0) { unsigned expect = 0u; __hip_atomic_compare_exchange_strong(tmo + 1, &expect, 0x600u | (unsigned)(u.pm & 0xff), __ATOMIC_RELAXED, __ATOMIC_RELAXED, __HIP_MEMORY_SCOPE_AGENT); __hip_atomic_store(tmo, 1u, __ATOMIC_RELAXED, __HIP_MEMORY_SCOPE_AGENT); }
                    break; }
                __builtin_amdgcn_s_sleep(2); }
            __builtin_amdgcn_fence(__ATOMIC_ACQUIRE, "agent");
            asm volatile("s_waitcnt vmcnt(0)" ::: "memory");
        }
#if !defined(BROKEN_HOOK_NO_BARRIER)
        asm volatile("" ::: "memory"); __builtin_amdgcn_s_barrier(); asm volatile("" ::: "memory");
#endif
    }
};

__device__ __forceinline__ unsigned cvt_pk_bf16(float lo, float hi) { unsigned r; asm volatile("v_cvt_pk_bf16_f32 %0, %1, %2" : "=v"(r) : "v"(lo), "v"(hi)); return r; }
typedef float f32x2 __attribute__((ext_vector_type(2)));
__device__ __forceinline__ f32x2 gelu_pk(f32x2 v) {
    const f32x2 av = __builtin_elementwise_abs(v), d = av * 0.2316418882f + 1.0f;
    f32x2 t; t.x = __builtin_amdgcn_rcpf(d.x); t.y = __builtin_amdgcn_rcpf(d.y);
    f32x2 q = t * 0.5307027145f + (-0.7265760135f); q = q * t + 0.7107068705f; q = q * t + (-0.142248368f); q = q * t + 0.127414796f; q = q * t;
    const f32x2 s = (v * v) * (-0.72134752044f);
    f32x2 e; e.x = __builtin_amdgcn_exp2f(s.x); e.y = __builtin_amdgcn_exp2f(s.y);
    const f32x2 m = v * (q * e), r = v - m;
    f32x2 o; o.x = v.x < 0.f ? m.x : r.x; o.y = v.y < 0.f ? m.y : r.y; return o;
}

struct EpiF32 {
    static constexpr bool PERM = false, AFTER_DRAIN = false;
    float* C; int ldc; const float* bias;
    __device__ __forceinline__ void operator()(const f32x4 (&acc)[2][2][4][2], const Unit& u, int wr, int wc, int fr, int fq) const {
        const int row0 = u.pm * BM + wr * 64 + fr, col0 = u.pn * BM + wc * 32 + 4 * fq;
        f32x4 bv[2][2];
#pragma unroll
        for (int bj = 0; bj < 2; ++bj)
#pragma unroll
            for (int n = 0; n < 2; ++n) bv[bj][n] = bias ? *(const f32x4*)(bias + col0 + bj * HALF + n * 16) : (f32x4){0.f, 0.f, 0.f, 0.f};
#pragma unroll
        for (int ai = 0; ai < 2; ++ai)
#pragma unroll
            for (int m = 0; m < 4; ++m) { float* rowp = C + (size_t)(row0 + ai * HALF + m * 16) * ldc + col0;
#pragma unroll
                for (int bj = 0; bj < 2; ++bj)
#pragma unroll
                    for (int n = 0; n < 2; ++n) *(f32x4*)(rowp + bj * HALF + n * 16) = acc[ai][bj][m][n] + bv[bj][n]; }
    }
};
template <int ACT  > struct EpiBf16 {
    static constexpr bool PERM = true, AFTER_DRAIN = false;
    bf16_t* O; int ldc; const float* bias; int split_cols; size_t split_stride;
    __device__ __forceinline__ void operator()(const f32x4 (&acc)[2][2][4][2], const Unit& u, int wr, int wc, int fr, int fq) const {
        const int row0 = u.pm * BM + wr * 64 + fr; int colt = u.pn * BM; bf16_t* base = O;
        if (split_cols) { const int t = colt / split_cols; base += (size_t)t * split_stride; colt -= t * split_cols; }
        const int col0 = colt + wc * 32 + 8 * fq, bcol0 = u.pn * BM + wc * 32 + 8 * fq;
        f32x4 bv[2][2];
#pragma unroll
        for (int bj = 0; bj < 2; ++bj)
#pragma unroll
            for (int n = 0; n < 2; ++n) bv[bj][n] = bias ? *(const f32x4*)(bias + bcol0 + bj * HALF + 4 * n) : (f32x4){0.f, 0.f, 0.f, 0.f};
#pragma unroll
        for (int ai = 0; ai < 2; ++ai)
#pragma unroll
            for (int m = 0; m < 4; ++m) { bf16_t* rowp = base + (size_t)(row0 + ai * HALF + m * 16) * ldc + col0;
#pragma unroll
                for (int bj = 0; bj < 2; ++bj) { f32x4 v0 = acc[ai][bj][m][0] + bv[bj][0], v1 = acc[ai][bj][m][1] + bv[bj][1];
                    if (ACT == 1) { f32x2 a = gelu_pk((f32x2){v0[0], v0[1]}), b = gelu_pk((f32x2){v0[2], v0[3]}), c = gelu_pk((f32x2){v1[0], v1[1]}), d = gelu_pk((f32x2){v1[2], v1[3]});
                        v0 = (f32x4){a.x, a.y, b.x, b.y}; v1 = (f32x4){c.x, c.y, d.x, d.y}; }
                    if (ACT == 2) {
#pragma unroll
                        for (int j = 0; j < 4; ++j) { v0[j] = 0.5f * v0[j] * (1.0f + erff(v0[j] * 0.70710678f)); v1[j] = 0.5f * v1[j] * (1.0f + erff(v1[j] * 0.70710678f)); } }
                    u32x4 w; w.x = cvt_pk_bf16(v0[0], v0[1]); w.y = cvt_pk_bf16(v0[2], v0[3]); w.z = cvt_pk_bf16(v1[0], v1[1]); w.w = cvt_pk_bf16(v1[2], v1[3]);
                    *(u32x4*)(rowp + bj * HALF) = w; } }
    }
};

struct PanelStats {
    unsigned* xbuf;
    unsigned* cnt;
    unsigned* tmo;
    int ntn; float eps;
    unsigned code;
    __device__ __forceinline__ bool run(const f32x4 (&v)[2][2][4][2], const Unit& u, int wr, int wc, int fr, int fq, PG8_LAS unsigned char* lds, int wid, int lane) const {
        typedef float f32x2v __attribute__((ext_vector_type(2)));
        PG8_LAS f32x2v* P = (PG8_LAS f32x2v*)lds;
        PG8_LAS f32x2v* S = (PG8_LAS f32x2v*)(lds + 8192);
        PG8_LAS unsigned* flag = (PG8_LAS unsigned*)(lds + 8192 + 2048);
#pragma unroll
        for (int ai = 0; ai < 2; ++ai)
#pragma unroll
            for (int m = 0; m < 4; ++m) {
                float s = 0.f;
#pragma unroll
                for (int bj = 0; bj < 2; ++bj)
#pragma unroll
                    for (int n = 0; n < 2; ++n) { const f32x4 x = v[ai][bj][m][n]; s += (x[0] + x[1]) + (x[2] + x[3]); }
                s += __shfl_xor(s, 16); s += __shfl_xor(s, 32);
                const float mw = s * (1.0f / 64.0f); float q = 0.f;
#pragma unroll
                for (int bj = 0; bj < 2; ++bj)
#pragma unroll
                    for (int n = 0; n < 2; ++n) { const f32x4 d = v[ai][bj][m][n] - mw; q += (d[0] * d[0] + d[1] * d[1]) + (d[2] * d[2] + d[3] * d[3]); }
                q += __shfl_xor(q, 16); q += __shfl_xor(q, 32);
                if (fq == 0) P[(ai * HALF + wr * 64 + m * 16 + fr) * 4 + wc] = (f32x2v){mw, q};
            }
        asm volatile("s_waitcnt lgkmcnt(0)" ::: "memory"); __builtin_amdgcn_s_barrier(); asm volatile("" ::: "memory");
#if defined(BROKEN_NO_WAIT)
        if (blockIdx.x >= 64) { const long long t0 = clock64(); while (clock64() - t0 < 60000) __builtin_amdgcn_s_sleep(8); }
#endif
        const int row = wid * 32 + (lane & 31);
        if (lane < 32) {
            const f32x2v a = P[row * 4 + 0], b = P[row * 4 + 1], c = P[row * 4 + 2], d = P[row * 4 + 3];
            const float mt = (a.x + b.x + c.x + d.x) * 0.25f;
            const float da = a.x - mt, db = b.x - mt, dc = c.x - mt, dd = d.x - mt;
            const float m2 = (a.y + b.y) + (c.y + d.y) + 64.0f * ((da * da + db * db) + (dc * dc + dd * dd));
            unsigned long long* slot = (unsigned long long*)xbuf + ((size_t)(u.pm * BM + row) * 4 + u.pn);
            __hip_atomic_store(slot, ((unsigned long long)__float_as_uint(m2) << 32) | __float_as_uint(mt), __ATOMIC_RELAXED, __HIP_MEMORY_SCOPE_AGENT);
        }
        asm volatile("s_waitcnt vmcnt(0)" ::: "memory");
        if (lane == 0) __hip_atomic_fetch_add(cnt + 64 * u.pm, 1u, __ATOMIC_RELAXED, __HIP_MEMORY_SCOPE_AGENT);
        if (wid == 0) {
            bool dead = false; const unsigned long long t0 = __builtin_amdgcn_s_memrealtime(); const unsigned want = 8u * (unsigned)ntn;
            for (;;) {
#if defined(BROKEN_NO_WAIT)
                break;
#endif
                if ((unsigned)__builtin_amdgcn_readfirstlane(__hip_atomic_load(cnt + 64 * u.pm, __ATOMIC_RELAXED, __HIP_MEMORY_SCOPE_AGENT)) >= want) break;
                if (__builtin_amdgcn_s_memrealtime() - t0 > 2000000ull) {
                    if (lane == 0) { unsigned expect = 0u; __hip_atomic_compare_exchange_strong(tmo + 1, &expect, code | (unsigned)(u.pm & 0xff), __ATOMIC_RELAXED, __ATOMIC_RELAXED, __HIP_MEMORY_SCOPE_AGENT);
                                     __hip_atomic_store(tmo, 1u, __ATOMIC_RELAXED, __HIP_MEMORY_SCOPE_AGENT); }
                    dead = true; break; }
                __builtin_amdgcn_s_sleep(2);
            }
            __builtin_amdgcn_fence(__ATOMIC_ACQUIRE, "agent");
            if (lane == 0) flag[0] = dead ? 1u : 0u;
        }
        asm volatile("s_waitcnt vmcnt(0) lgkmcnt(0)" ::: "memory"); __builtin_amdgcn_s_barrier(); asm volatile("" ::: "memory");
        const bool bad = flag[0] != 0u;
        if (lane < 32) {
            const unsigned long long* slot = (const unsigned long long*)xbuf + (size_t)(u.pm * BM + row) * 4; float mt[4], m2[4]; float ms = 0.f;
#pragma unroll
            for (int t = 0; t < 4; ++t) { if (t < ntn) { const unsigned long long w = __hip_atomic_load(slot + t, __ATOMIC_RELAXED, __HIP_MEMORY_SCOPE_AGENT); mt[t] = __uint_as_float((unsigned)w); m2[t] = __uint_as_float((unsigned)(w >> 32)); } else { mt[t] = 0.f; m2[t] = 0.f; } ms += mt[t]; }
            const float mean = ms / (float)ntn; float q = 0.f;
#pragma unroll
            for (int t = 0; t < 4; ++t) if (t < ntn) { const float dm = mt[t] - mean; q += m2[t] + 256.0f * dm * dm; }
            S[row] = (f32x2v){mean, 1.0f / sqrtf(q / (256.0f * (float)ntn) + eps)};
        }
        asm volatile("s_waitcnt lgkmcnt(0)" ::: "memory"); __builtin_amdgcn_s_barrier(); asm volatile("" ::: "memory");
        return bad;
    }
};
struct EpiLnRes {
    static constexpr bool PERM = false, AFTER_DRAIN = true;
    const float* base; float* out; int ldc; const float* bias; PanelStats st; unsigned poison;
    __device__ __forceinline__ void refuse(size_t i0, size_t stride, int M, int N) const { const float q = __builtin_nanf(""); for (size_t i = i0; i < (size_t)M * N; i += stride) out[(i / N) * ldc + i % N] = q;
        if (i0 == 0) { unsigned expect = 0u; __hip_atomic_compare_exchange_strong(st.tmo + 1, &expect, 0x7f0u, __ATOMIC_RELAXED, __ATOMIC_RELAXED, __HIP_MEMORY_SCOPE_AGENT); __hip_atomic_store(st.tmo, 1u, __ATOMIC_RELAXED, __HIP_MEMORY_SCOPE_AGENT); } }
    __device__ __forceinline__ void fused(f32x4 (&acc)[2][2][4][2], const Unit& u, int wr, int wc, int fr, int fq, PG8_LAS unsigned char* lds, int wid, int lane) const {
        typedef float f32x2v __attribute__((ext_vector_type(2)));
        const PG8_LAS f32x2v* S = (const PG8_LAS f32x2v*)(lds + 8192);
        const int col0 = u.pn * BM + wc * 32 + 4 * fq;
#pragma unroll
        for (int bj = 0; bj < 2; ++bj)
#pragma unroll
            for (int n = 0; n < 2; ++n) { const f32x4 bv = bias ? *(const f32x4*)(bias + col0 + bj * HALF + n * 16) : (f32x4){0.f, 0.f, 0.f, 0.f};
#pragma unroll
                for (int ai = 0; ai < 2; ++ai)
#pragma unroll
                    for (int m = 0; m < 4; ++m) acc[ai][bj][m][n] += bv; }
        const bool bad = st.run(acc, u, wr, wc, fr, fq, lds, wid, lane) || poison != 0u;
        const float qnan = __builtin_nanf("");
#pragma unroll
        for (int ai = 0; ai < 2; ++ai)
#pragma unroll
            for (int m = 0; m < 4; ++m) { const int r = ai * HALF + wr * 64 + m * 16 + fr; const f32x2v sr = S[r]; const size_t off = (size_t)(u.pm * BM + r) * ldc + col0;
#pragma unroll
                for (int bj = 0; bj < 2; ++bj)
#pragma unroll
                    for (int n = 0; n < 2; ++n) { const f32x4 bs = *(const f32x4*)(base + off + bj * HALF + n * 16); f32x4 o = bs + (acc[ai][bj][m][n] - sr.x) * sr.y;
                        if (bad) o = (f32x4){qnan, qnan, qnan, qnan}; *(f32x4*)(out + off + bj * HALF + n * 16) = o; }
                asm volatile("" ::: "memory"); }
    }
};
struct EpiLnResLn {
    static constexpr bool PERM = false, AFTER_DRAIN = true;
    const float* base; float* out; bf16_t* xn; int ldc; const float* bias; PanelStats st1, st2; unsigned poison;
    __device__ __forceinline__ void refuse(size_t i0, size_t stride, int M, int N) const { const float q = __builtin_nanf(""); for (size_t i = i0; i < (size_t)M * N; i += stride) { const size_t o = (i / N) * ldc + i % N; out[o] = q; xn[o] = (bf16_t)0x7fc0u; }
        if (i0 == 0) { unsigned expect = 0u; __hip_atomic_compare_exchange_strong(st1.tmo + 1, &expect, 0x7f0u, __ATOMIC_RELAXED, __ATOMIC_RELAXED, __HIP_MEMORY_SCOPE_AGENT); __hip_atomic_store(st1.tmo, 1u, __ATOMIC_RELAXED, __HIP_MEMORY_SCOPE_AGENT); } }
    __device__ __forceinline__ void fused(f32x4 (&acc)[2][2][4][2], const Unit& u, int wr, int wc, int fr, int fq, PG8_LAS unsigned char* lds, int wid, int lane) const {
        typedef float f32x2v __attribute__((ext_vector_type(2))); typedef unsigned u32x2v __attribute__((ext_vector_type(2)));
        const PG8_LAS f32x2v* S = (const PG8_LAS f32x2v*)(lds + 8192);
        const int col0 = u.pn * BM + wc * 32 + 4 * fq;
#pragma unroll
        for (int bj = 0; bj < 2; ++bj)
#pragma unroll
            for (int n = 0; n < 2; ++n) { const f32x4 bv = bias ? *(const f32x4*)(bias + col0 + bj * HALF + n * 16) : (f32x4){0.f, 0.f, 0.f, 0.f};
#pragma unroll
                for (int ai = 0; ai < 2; ++ai)
#pragma unroll
                    for (int m = 0; m < 4; ++m) acc[ai][bj][m][n] += bv; }
        bool bad = st1.run(acc, u, wr, wc, fr, fq, lds, wid, lane) || poison != 0u;
        const float qnan = __builtin_nanf("");
#pragma unroll
        for (int ai = 0; ai < 2; ++ai)
#pragma unroll
            for (int m = 0; m < 4; ++m) { const int r = ai * HALF + wr * 64 + m * 16 + fr; const f32x2v sr = S[r]; const size_t off = (size_t)(u.pm * BM + r) * ldc + col0;
#pragma unroll
                for (int bj = 0; bj < 2; ++bj)
#pragma unroll
                    for (int n = 0; n < 2; ++n) { const f32x4 bs = *(const f32x4*)(base + off + bj * HALF + n * 16); acc[ai][bj][m][n] = bs + (acc[ai][bj][m][n] - sr.x) * sr.y; }
                asm volatile("" : "+v"(acc[ai][0][m][0]), "+v"(acc[ai][0][m][1]), "+v"(acc[ai][1][m][0]), "+v"(acc[ai][1][m][1]));
                if (m & 1) asm volatile("" ::: "memory"); }
        const bool bad1 = bad;
        bad = st2.run(acc, u, wr, wc, fr, fq, lds, wid, lane) || bad;
#pragma unroll
        for (int ai = 0; ai < 2; ++ai)
#pragma unroll
            for (int m = 0; m < 4; ++m) { const int r = ai * HALF + wr * 64 + m * 16 + fr; const f32x2v sr = S[r]; const size_t off = (size_t)(u.pm * BM + r) * ldc + col0;
#pragma unroll
                for (int bj = 0; bj < 2; ++bj)
#pragma unroll
                    for (int n = 0; n < 2; ++n) { const f32x4 x1 = acc[ai][bj][m][n]; *(f32x4*)(out + off + bj * HALF + n * 16) = bad1 ? (f32x4){qnan, qnan, qnan, qnan} : x1;
                        const f32x4 o = (x1 - sr.x) * sr.y; u32x2v w; w.x = cvt_pk_bf16(o[0], o[1]); w.y = cvt_pk_bf16(o[2], o[3]);
                        if (bad) { w.x = 0x7fc07fc0u; w.y = 0x7fc07fc0u; } *(u32x2v*)(xn + off + bj * HALF + n * 16) = w; }
                asm volatile("" ::: "memory"); }
    }
};

template <class Epi, class Sched, bool STAMP = false>
__device__ __forceinline__ void gemm_phase(PG8_LAS unsigned char* lds, const Gemm g, const Sched& S, const Epi& E, unsigned long long* stamps) {
    int tid_ = threadIdx.x; asm volatile("" : "+v"(tid_)); const int tid = tid_, wid = __builtin_amdgcn_readfirstlane(tid >> 6), lane = tid & 63, wr = wid >> 2, wc = wid & 3, fr = lane & 15, fq = lane >> 4;
    const int K = g.K, nt = K / BK;
    int ts_lo = 0, ts_hi = 0, nts = 0; const unsigned long long rt_entry = STAMP ? (unsigned long long)wall_clock64() : 0ull;
#define PG8_STAMP() do { if (STAMP && wid == 0 && nts < 64) { const unsigned long long _c = (unsigned long long)clock64(); \
        ts_lo = (lane == nts) ? (int)(unsigned)_c : ts_lo; ts_hi = (lane == nts) ? (int)(unsigned)(_c >> 32) : ts_hi; ++nts; } } while (0)
    PG8_STAMP();
    unsigned voffA[2], voffB[2];
#pragma unroll
    for (int i = 0; i < 2; ++i) { int R, C; stage_rc(tid * 16 + i * 8192, R, C); const int Rb = Epi::PERM ? ((R & ~31) + perm32(R & 31)) : R;
        voffA[i] = (unsigned)(R * K + C) * 2u; voffB[i] = (unsigned)(Rb * K + C) * 2u; }
    const size_t kstep = (size_t)(BK * 2);
    const size_t hstep = (size_t)HALF * K * 2;
    const size_t tstep = 2 * hstep;
    const unsigned ldsw = (unsigned)wid * 1024u;
    const int aoff = lds_byte(wr * 64 + fr, fq * 8), boff = lds_byte(wc * 32 + fr, fq * 8);
#define PG8_SA(b, h) (((b) * 2 + (h)) * HTB)
#define PG8_SB(b, h) ((4 + (b) * 2 + (h)) * HTB)
#define PG8_STAGE(bufoff, gbase, voff) do { _Pragma("unroll") for (int _i = 0; _i < 2; ++_i) \
        __builtin_amdgcn_global_load_lds((const unsigned*)((const char*)(gbase) + (voff)[_i]), (PG8_LAS unsigned*)(lds + (bufoff) + ldsw + _i * 8192), 16, 0, 0); } while (0)
#define PG8_LDA(dst, b, h) do { _Pragma("unroll") for (int m = 0; m < 4; ++m) _Pragma("unroll") for (int k = 0; k < 2; ++k) dst[m][k] = *(const PG8_LAS bf16x8*)(lds + PG8_SA(b, h) + aoff + m * 2048 + k * 1024); } while (0)
#define PG8_LDB(dst, b, h) do { _Pragma("unroll") for (int n = 0; n < 2; ++n) _Pragma("unroll") for (int k = 0; k < 2; ++k) dst[n][k] = *(const PG8_LAS bf16x8*)(lds + PG8_SB(b, h) + boff + n * 2048 + k * 1024); } while (0)
#define PG8_MMA(ai, bj, At, Bt) do { __builtin_amdgcn_s_setprio(1); _Pragma("unroll") for (int m = 0; m < 4; ++m) _Pragma("unroll") for (int n = 0; n < 2; ++n) _Pragma("unroll") for (int k = 0; k < 2; ++k) \
        acc[ai][bj][m][n] = __builtin_amdgcn_mfma_f32_16x16x32_bf16(Bt[n][k], At[m][k], acc[ai][bj][m][n], 0, 0, 0); __builtin_amdgcn_s_setprio(0); } while (0)
#define PG8_WAIT_V(n) asm volatile("s_waitcnt vmcnt(" #n ")" ::: "memory")
#define PG8_WAIT_L(n) asm volatile("s_waitcnt lgkmcnt(" #n ")" ::: "memory")
#define PG8_BAR __builtin_amdgcn_s_barrier()
#define PG8_SCHED __builtin_amdgcn_sched_barrier(0)
    Unit cur, nxt; int ui = 0;
    if (!S.next(0, cur)) return;
    f32x4 acc[2][2][4][2];
#pragma unroll
    for (int a = 0; a < 2; ++a)
#pragma unroll
        for (int b = 0; b < 2; ++b)
#pragma unroll
            for (int m = 0; m < 4; ++m)
#pragma unroll
                for (int n = 0; n < 2; ++n) acc[a][b][m][n] = (f32x4){0.f, 0.f, 0.f, 0.f};
    bf16x8 At[4][2], B0[2][2], B1[2][2];
    const char* cA = (const char*)g.A + (size_t)cur.pm * tstep; const char* cB = (const char*)g.Bt + (size_t)cur.pn * tstep;
    S.a_ready(cur);
    PG8_STAGE(PG8_SB(0, 0), cB, voffB); PG8_STAGE(PG8_SA(0, 0), cA, voffA); PG8_STAGE(PG8_SB(0, 1), cB + hstep, voffB); PG8_STAGE(PG8_SA(0, 1), cA + hstep, voffA);
    if (wr == 1) PG8_BAR;
    PG8_WAIT_V(4); PG8_BAR;
    PG8_STAGE(PG8_SB(1, 0), cB + kstep, voffB); PG8_STAGE(PG8_SA(1, 0), cA + kstep, voffA); PG8_STAGE(PG8_SB(1, 1), cB + hstep + kstep, voffB);
    PG8_WAIT_V(6); PG8_BAR;
    PG8_STAMP();
    for (;;) {
        const bool has_next = S.next(ui + 1, nxt);
        const char* nA = has_next ? (const char*)g.A + (size_t)nxt.pm * tstep : cA; const char* nB = has_next ? (const char*)g.Bt + (size_t)nxt.pn * tstep : cB;
        for (int t = 0; t < nt; t += 2) {
            const bool last = (t == nt - 2);
            const char* a1 = cA + (size_t)(t + 1) * kstep;
            const char* a2 = last ? nA : cA + (size_t)(t + 2) * kstep; const char* b2 = last ? nB : cB + (size_t)(t + 2) * kstep;
            const char* a3 = a2 + kstep; const char* b3 = b2 + kstep;
            if (last && has_next) S.a_ready(nxt);
            PG8_LDB(B0, 0, 0); PG8_SCHED; PG8_LDA(At, 0, 0); PG8_STAGE(PG8_SA(1, 1), a1 + hstep, voffA);
            PG8_WAIT_L(8); PG8_BAR; PG8_WAIT_L(0); PG8_MMA(0, 0, At, B0); PG8_BAR; PG8_SCHED;
            PG8_LDB(B1, 0, 1); PG8_STAGE(PG8_SB(0, 0), b2, voffB);
            PG8_BAR; PG8_WAIT_L(0); PG8_MMA(0, 1, At, B1); PG8_BAR;
            PG8_LDA(At, 0, 1); PG8_STAGE(PG8_SA(0, 0), a2, voffA);
            PG8_BAR; PG8_WAIT_L(0); PG8_MMA(1, 0, At, B0); PG8_BAR; PG8_SCHED;
            PG8_STAGE(PG8_SB(0, 1), b2 + hstep, voffB);
            PG8_WAIT_V(6); PG8_BAR; PG8_MMA(1, 1, At, B1); PG8_BAR;
            PG8_LDB(B0, 1, 0); PG8_SCHED; PG8_LDA(At, 1, 0); PG8_STAGE(PG8_SA(0, 1), a2 + hstep, voffA);
            PG8_WAIT_L(8); PG8_BAR; PG8_WAIT_L(0); PG8_MMA(0, 0, At, B0); PG8_BAR; PG8_SCHED;
            PG8_LDB(B1, 1, 1); PG8_STAGE(PG8_SB(1, 0), b3, voffB);
            PG8_BAR; PG8_WAIT_L(0); PG8_MMA(0, 1, At, B1); PG8_BAR;
            PG8_LDA(At, 1, 1); PG8_STAGE(PG8_SA(1, 0), a3, voffA);
            PG8_BAR; PG8_WAIT_L(0); PG8_MMA(1, 0, At, B0); PG8_BAR; PG8_SCHED;
            PG8_STAGE(PG8_SB(1, 1), b3 + hstep, voffB);
            PG8_WAIT_V(6); PG8_BAR; PG8_MMA(1, 1, At, B1); PG8_BAR;
        }
        PG8_STAMP();
        if constexpr (!Epi::AFTER_DRAIN) { E(acc, cur, wr, wc, fr, fq); S.done(cur); }
        PG8_STAMP();
        if (!has_next) break;
#pragma unroll
        for (int a = 0; a < 2; ++a)
#pragma unroll
            for (int b = 0; b < 2; ++b)
#pragma unroll
                for (int m = 0; m < 4; ++m)
#pragma unroll
                    for (int n = 0; n < 2; ++n) acc[a][b][m][n] = (f32x4){0.f, 0.f, 0.f, 0.f};
        cur = nxt; cA = nA; cB = nB; ++ui;
    }
    PG8_WAIT_V(0);
    if (wr == 0) PG8_BAR;
    PG8_BAR;
    if constexpr (Epi::AFTER_DRAIN) { E.fused(acc, cur, wr, wc, fr, fq, lds, wid, lane); S.done(cur); }
    PG8_STAMP();
    if (STAMP && wid == 0) { stamps[lane] = lane < nts ? (((unsigned long long)(unsigned)ts_hi << 32) | (unsigned)ts_lo) : 0ull;
        if (lane == 62) stamps[62] = rt_entry; if (lane == 63) stamps[63] = (unsigned long long)wall_clock64(); }
#undef PG8_STAMP
#undef PG8_SA
#undef PG8_SB
#undef PG8_STAGE
#undef PG8_LDA
#undef PG8_LDB
#undef PG8_MMA
#undef PG8_WAIT_V
#undef PG8_WAIT_L
#undef PG8_BAR
#undef PG8_SCHED
}
}

__shared__ unsigned g_vsub_cnt[128];
DI void sub_barrier(unsigned* cnt) {
  asm volatile("" ::: "memory");
  unsigned target = 0;
  if ((threadIdx.x & 63) == 0) {
    const unsigned old = __hip_atomic_fetch_add(cnt, 1u, __ATOMIC_RELAXED, __HIP_MEMORY_SCOPE_WORKGROUP);
    target = (old & ~3u) + 4u;
  }
  target = __builtin_amdgcn_readfirstlane(target);
  while (__hip_atomic_load(cnt, __ATOMIC_RELAXED, __HIP_MEMORY_SCOPE_WORKGROUP) < target) __builtin_amdgcn_s_sleep(1);
  asm volatile("" ::: "memory");
}

DI bf16x8 ld16_sum4(const bf16_t* p, size_t slab) {
  union { bf16x8 v; unsigned u[4]; } a, b, c, d, o;
  a.v = ld16(p); b.v = ld16(p + slab); c.v = ld16(p + 2 * slab); d.v = ld16(p + 3 * slab);
#pragma unroll
  for (int i = 0; i < 4; ++i)
    o.u[i] = pk2(lo_bf(a.u[i]) + lo_bf(b.u[i]) + lo_bf(c.u[i]) + lo_bf(d.u[i]), hi_bf(a.u[i]) + hi_bf(b.u[i]) + hi_bf(c.u[i]) + hi_bf(d.u[i]));
  return o.v;
}

template <int NI, bool TR = false, bool PF2 = true, bool ASUM4 = false>
DI void gemm_main(f32x16 (&acc)[2][NI], const bf16_t* Abase, int lda, int akoff, int astep, const bf16_t* Bt, int ldb, int K,
                  bf16_t* sm, int tid, bool act, unsigned* bcnt, size_t aslab = 0) {
  if (!act) return;
  const int lane = tid & 63, wid = tid >> 6, wm = wid >> 1, wn = wid & 1, r = lane & 31, h = lane >> 5;
  const int lrow = tid >> 3, lkc = tid & 7;
  const int aoff0 = lrow * lda + akoff, a32 = 32 * lda;
  const int boff0 = lrow * ldb + lkc * 8, b32 = 32 * ldb;
  const int soff0 = lrow * 64 + ((lkc ^ ((lrow >> 1) & 7)) * 8);
  bf16_t* As = sm;
  bf16_t* Bs = sm + 2 * 8192;
  bf16x8 ra0[4], rb0[2 * NI], ra1[4], rb1[2 * NI];
  const int nk = K >> 6;
#define GM_LOAD(RA, RB, t)                                                                          \
  {                                                                                                 \
    const bf16_t* An_ = Abase + (size_t)(t) * astep;                                                \
    const bf16_t* Bn_ = Bt + (t) * 64;                                                              \
    _Pragma("unroll") for (int i = 0; i < 4; ++i) RA[i] = ASUM4 ? ld16_sum4(An_ + aoff0 + i * a32, aslab) : ld16(An_ + aoff0 + i * a32); \
    _Pragma("unroll") for (int i = 0; i < 2 * NI; ++i) RB[i] = ld16(Bn_ + boff0 + i * b32);         \
  }
#define GM_STORE(RA, RB, buf)                                                                       \
  {                                                                                                 \
    bf16_t* An = As + (buf) * 8192 + soff0;                                                         \
    bf16_t* Bn = Bs + (buf) * 8192 + soff0;                                                         \
    _Pragma("unroll") for (int i = 0; i < 4; ++i) *reinterpret_cast<bf16x8*>(An + i * 2048) = RA[i];        \
    _Pragma("unroll") for (int i = 0; i < 2 * NI; ++i) *reinterpret_cast<bf16x8*>(Bn + i * 2048) = RB[i];   \
  }
#define GM_COMPUTE(buf)                                                                             \
  {                                                                                                 \
    const bf16_t* Ac = As + (buf) * 8192 + ar0 * 64;                                                \
    const bf16_t* Bc = Bs + (buf) * 8192 + br0 * 64;                                                \
    _Pragma("unroll") for (int ks = 0; ks < 4; ++ks) {                                              \
      bf16x8 a[2], b[NI];                                                                           \
      _Pragma("unroll") for (int i = 0; i < 2; ++i)                                                 \
        a[i] = *reinterpret_cast<const bf16x8*>(Ac + i * 2048 + (((ks * 2 + h) ^ asw) * 8));        \
      _Pragma("unroll") for (int i = 0; i < NI; ++i)                                                \
        b[i] = *reinterpret_cast<const bf16x8*>(Bc + i * 2048 + (((ks * 2 + h) ^ bsw) * 8));        \
      _Pragma("unroll") for (int mi = 0; mi < 2; ++mi)                                              \
        _Pragma("unroll") for (int ni = 0; ni < NI; ++ni)                                           \
          acc[mi][ni] = TR ? MFMA32(b[ni], a[mi], acc[mi][ni]) : MFMA32(a[mi], b[ni], acc[mi][ni]); \
    }                                                                                               \
  }
  const int ar0 = wm * 64 + r, br0 = wn * 32 * NI + r;
  const int asw = (ar0 >> 1) & 7, bsw = (br0 >> 1) & 7;
  if (!PF2) {
    GM_LOAD(ra0, rb0, 0)
    GM_STORE(ra0, rb0, 0)
    sub_barrier(bcnt);
    for (int kt = 0; kt < nk; kt += 2) {
      GM_LOAD(ra0, rb0, kt + 1)
      GM_COMPUTE(0)
      GM_STORE(ra0, rb0, 1)
      sub_barrier(bcnt);
      if (kt + 2 < nk) GM_LOAD(ra0, rb0, kt + 2)
      GM_COMPUTE(1)
      if (kt + 2 < nk) GM_STORE(ra0, rb0, 0)
      sub_barrier(bcnt);
    }
    return;
  }
  GM_LOAD(ra0, rb0, 0)
  GM_LOAD(ra1, rb1, 1)
  GM_STORE(ra0, rb0, 0)
  sub_barrier(bcnt);
  for (int kt = 0; kt < nk; kt += 2) {
    if (kt + 2 < nk) GM_LOAD(ra0, rb0, kt + 2)
    GM_COMPUTE(0)
    GM_STORE(ra1, rb1, 1)
    sub_barrier(bcnt);
    if (kt + 3 < nk) GM_LOAD(ra1, rb1, kt + 3)
    GM_COMPUTE(1)
    if (kt + 2 < nk) GM_STORE(ra0, rb0, 0)
    sub_barrier(bcnt);
  }
#undef GM_LOAD
#undef GM_STORE
#undef GM_COMPUTE
}

template <int NI>
DI void zero_acc(f32x16 (&acc)[2][NI]) {
#pragma unroll
  for (int a = 0; a < 2; ++a)
#pragma unroll
    for (int b = 0; b < NI; ++b)
#pragma unroll
      for (int i = 0; i < 16; ++i) acc[a][b][i] = 0.f;
}

DI void sincos_(float x, float* sn, float* cs) {
  float n = rintf(x * 0.63661977236758134f);
  float rr = fmaf(-n, 1.57079625129699707031f, x);
  rr = fmaf(-n, 7.54978941586159635335e-08f, rr);
  float r2 = rr * rr;
  float sp = rr + rr * r2 * (-1.6666654611e-1f + r2 * (8.3321608736e-3f + r2 * (-1.9515295891e-4f)));
  float cp = 1.f + r2 * (-0.5f + r2 * (4.166664568298827e-2f + r2 * (-1.388731625493765e-3f + r2 * 2.443315711809948e-5f)));
  int q = ((int)n) & 3;
  float s_ = (q & 1) ? cp : sp;
  float c_ = (q & 1) ? sp : cp;
  if (q == 1 || q == 2) c_ = -c_;
  if (q >= 2) s_ = -s_;
  *sn = s_;
  *cs = c_;
}

#define VSUB_SETUP                                                                                             \
  const int sub = tid >> 8, vt = tid & 255;                                                                    \
  const int vgrid = gridDim.x * 2, vb = blockIdx.x * 2 + sub;                                                  \
  bf16_t* smv = sm + sub * 32768;                                                                              \
  unsigned* bcnt = g_vsub_cnt + sub * 64;                                                                      \
  const int lane = vt & 63, wid = vt >> 6, wm = wid >> 1, wn = wid & 1, r = lane & 31, h = lane >> 5;          \
  (void)lane; (void)wm; (void)wn; (void)r; (void)h; (void)smv; (void)vgrid; (void)vb; (void)bcnt;

DI void prep_transpose(const float* src, int ld, bf16_t* dst, int K, int k0, int n0, float* tile, int tid) {
  const int nn = tid & 63, kq = tid >> 6;
#pragma unroll 4
  for (int i = 0; i < 8; ++i) {
    int kk = kq + 8 * i;
    tile[kk * 65 + nn] = src[(size_t)(k0 + kk) * ld + n0 + nn];
  }
  __syncthreads();
  {
    int n2 = tid >> 3, kc = tid & 7;
    uint4 w;
    w.x = pk2(tile[(kc * 8 + 0) * 65 + n2], tile[(kc * 8 + 1) * 65 + n2]);
    w.y = pk2(tile[(kc * 8 + 2) * 65 + n2], tile[(kc * 8 + 3) * 65 + n2]);
    w.z = pk2(tile[(kc * 8 + 4) * 65 + n2], tile[(kc * 8 + 5) * 65 + n2]);
    w.w = pk2(tile[(kc * 8 + 6) * 65 + n2], tile[(kc * 8 + 7) * 65 + n2]);
    *reinterpret_cast<uint4*>(dst + (size_t)(n0 + n2) * K + k0 + kc * 8) = w;
  }
  __syncthreads();
}

DI void prep_s5(const Params& p, int L, int g, float* sm, int tid) {
  float* apow = sm;
  float* fco = sm + 2176;
  float* bbar = sm + 2304;
  float* Kt = sm + 4352;
  float* Cl = sm + 12544;
  const size_t gm = (size_t)(L * 32 + g) * 65536;
  for (int d = 0; d < 2; ++d) {
    const int dg = (L * 2 + d) * 32 + g;
    if (tid < 64) {
      const int pp = tid;
      float dt = expf(p.s5_log_dt[dg]);
      float are = p.s5_a_re[dg * 64 + pp], aim = p.s5_a_im[dg * 64 + pp];
      float mag = expf(dt * are);
      float sn, cs;
      sincos_(dt * aim, &sn, &cs);
      float abr = mag * cs, abi = mag * sn;
      float den = are * are + aim * aim;
      float fr = ((abr - 1.f) * are + abi * aim) / den;
      float fi = (abi * are - (abr - 1.f) * aim) / den;
      fco[pp * 2] = fr;
      fco[pp * 2 + 1] = fi;
      float pr = 1.f, pi = 0.f;
      apow[pp * 2] = 1.f;
      apow[pp * 2 + 1] = 0.f;
      for (int t = 1; t <= 16; ++t) {
        float nr = pr * abr - pi * abi, ni = pr * abi + pi * abr;
        pr = nr; pi = ni;
        apow[(t * 64 + pp) * 2] = pr;
        apow[(t * 64 + pp) * 2 + 1] = pi;
      }
      p.A16()[(dg * 64 + pp) * 2] = pr;
      p.A16()[(dg * 64 + pp) * 2 + 1] = pi;
    }
    __syncthreads();
    for (int i = 0; i < 2; ++i) {
      int idx = tid + 512 * i;
      Cl[idx * 2] = p.s5_c_re[(size_t)dg * 1024 + idx];
      Cl[idx * 2 + 1] = p.s5_c_im[(size_t)dg * 1024 + idx];
    }
    for (int i = 0; i < 2; ++i) {
      int idx = tid + 512 * i;
      int pp = idx >> 4;
      float br = p.s5_b_re[(size_t)dg * 1024 + idx], bi = p.s5_b_im[(size_t)dg * 1024 + idx];
      float fr = fco[pp * 2], fi = fco[pp * 2 + 1];
      bbar[idx * 2] = fr * br - fi * bi;
      bbar[idx * 2 + 1] = fr * bi + fi * br;
    }
    __syncthreads();
    {
      const int th = tid >> 8, hp = (tid >> 4) & 15, hh = tid & 15;
      float kacc[8];
#pragma unroll
      for (int t = 0; t < 8; ++t) kacc[t] = 0.f;
      for (int pp = 0; pp < 64; ++pp) {
        float cr = Cl[(hp * 64 + pp) * 2], ci = Cl[(hp * 64 + pp) * 2 + 1];
        float br = bbar[(pp * 16 + hh) * 2], bi = bbar[(pp * 16 + hh) * 2 + 1];
        float xr = cr * br - ci * bi, xi = cr * bi + ci * br;
#pragma unroll
        for (int t = 0; t < 8; ++t)
          kacc[t] += xr * apow[((th * 8 + t) * 64 + pp) * 2] - xi * apow[((th * 8 + t) * 64 + pp) * 2 + 1];
      }
#pragma unroll
      for (int t = 0; t < 8; ++t) Kt[(d * 16 + th * 8 + t) * 256 + (tid & 255)] = kacc[t];
    }
    for (int i = 0; i < 64; ++i) {
      int idx = tid + 512 * i;
      int k = idx & 255, nn = idx >> 8;
      int pp = nn >> 1, ri = nn & 1, j = k >> 4, hh = k & 15;
      int e = (d == 0) ? (15 - j) : j;
      float ar = apow[(e * 64 + pp) * 2], ai = apow[(e * 64 + pp) * 2 + 1];
      float br = bbar[(pp * 16 + hh) * 2], bi = bbar[(pp * 16 + hh) * 2 + 1];
      float v = ri ? (ar * bi + ai * br) : (ar * br - ai * bi);
      p.S5We()[gm + (size_t)(d * 128 + nn) * 256 + k] = f2bf(v);
    }
    for (int i = 0; i < 64; ++i) {
      int idx = tid + 512 * i;
      int kk = idx & 127, n = idx >> 7;
      int pp = kk >> 1, ri = kk & 1, t16 = n >> 4, hp = n & 15;
      int pw = (d == 0) ? (t16 + 1) : (16 - t16);
      float cr = Cl[(hp * 64 + pp) * 2], ci = Cl[(hp * 64 + pp) * 2 + 1];
      float ar = apow[(pw * 64 + pp) * 2], ai = apow[(pw * 64 + pp) * 2 + 1];
      float v = ri ? -(cr * ai + ci * ar) : (cr * ar - ci * ai);
      p.S5R()[gm + (size_t)n * 256 + d * 128 + kk] = f2bf(v);
    }
    __syncthreads();
  }
  const float dval = p.s5_d[(L * 32 + g) * 16 + (tid & 15)];
  for (int i = 0; i < 128; ++i) {
    int idx = tid + 512 * i;
    int k = idx & 255, n = idx >> 8;
    int t16 = n >> 4, hp = n & 15, j = k >> 4, hh = k & 15;
    float v = 0.f;
    if (j <= t16) v += Kt[(0 * 16 + (t16 - j)) * 256 + hp * 16 + hh];
    if (j >= t16) v += Kt[(1 * 16 + (j - t16)) * 256 + hp * 16 + hh];
    if (j == t16 && hp == hh) v += dval;
    p.S5M()[gm + (size_t)n * 256 + k] = f2bf(v);
  }
  __syncthreads();
}

DI void prep_adaln(const Params& p, int L, int cb, float* sm, int tid) {
  float* sv = sm;
  float* red = sm + 3072;
  for (int idx = tid; idx < 3072; idx += 512) {
    int v = idx >> 10, k = idx & 1023;
    float cv = (v < 2) ? p.c[v * 1024 + k] : p.c_ctx[k];
    sv[idx] = siluf_(cv);
  }
  __syncthreads();
  const int cl = tid & 63, kq = tid >> 6, col = cb * 64 + cl;
  float a0 = 0.f, a1 = 0.f, a2 = 0.f;
  const float* w = p.w_ada + (size_t)L * 1024 * 3072 + col;
#pragma unroll 8
  for (int k = kq * 128; k < kq * 128 + 128; ++k) {
    float wv = w[(size_t)k * 3072];
    a0 += sv[k] * wv;
    a1 += sv[1024 + k] * wv;
    a2 += sv[2048 + k] * wv;
  }
  red[(kq * 3 + 0) * 64 + cl] = a0;
  red[(kq * 3 + 1) * 64 + cl] = a1;
  red[(kq * 3 + 2) * 64 + cl] = a2;
  __syncthreads();
  if (kq == 0) {
    float bb = p.b_ada[L * 3072 + col];
    for (int v = 0; v < 3; ++v) {
      float s = 0.f;
      for (int q = 0; q < 8; ++q) s += red[(q * 3 + v) * 64 + cl];
      p.MOD()[(L * 3 + v) * 3072 + col] = s + bb;
    }
  }
  __syncthreads();
}

struct TrDesc { const float* src; bf16_t* dst; int ld, K, k0, n0; };
DI TrDesc tr_decode(const Params& p, int it) {
  constexpr int N_TR_L = 3456;
  const int L = it / N_TR_L, tt = it % N_TR_L;
  TrDesc d;
  int kt, nt;
  if (tt < 2624) {
    kt = tt / 164; nt = tt % 164; d.src = p.w_in + (size_t)L * 1024 * 10496; d.ld = 10496; d.K = 1024;
    d.dst = p.WinT() + (size_t)L * 10496 * 1024;
  } else if (tt < 3136) {
    int t2 = tt - 2624; int kb = t2 / 128; int t3 = t2 % 128; kt = t3 / 16; nt = t3 % 16;
    d.src = p.w_br + (size_t)(L * 4 + kb) * 512 * 1024; d.ld = 1024; d.K = 512;
    d.dst = p.WbrT() + (size_t)(L * 4 + kb) * 1024 * 512;
  } else if (tt < 3392) {
    int t2 = tt - 3136; kt = t2 / 16; nt = t2 % 16; d.src = p.w_out + (size_t)L * 1024 * 1024; d.ld = 1024; d.K = 1024;
    d.dst = p.WoutT() + (size_t)L * 1024 * 1024;
  } else {
    int t2 = tt - 3392; kt = t2 / 8; nt = t2 % 8; d.src = p.s5_w_glu + (size_t)L * 512 * 512; d.ld = 512; d.K = 512;
    d.dst = p.WgluT() + (size_t)L * 512 * 512;
  }
  d.k0 = kt * 64; d.n0 = nt * 64;
  return d;
}

DI void phase_prep(const Params& p, float* sm, int tid) {
  constexpr int N_S5 = 128, N_ADA = 192, N_TR = 4 * 3456;
  constexpr int NPRE = N_S5 + N_ADA + 1;
  for (int item = blockIdx.x; item < NPRE; item += gridDim.x) {
    if (item < N_S5) {
      prep_s5(p, item >> 5, item & 31, sm, tid);
    } else if (item < N_S5 + N_ADA) {
      int it = item - N_S5;
      prep_adaln(p, it / 48, it % 48, sm, tid);
    } else {
      for (int idx = tid; idx < 256 * 16; idx += 512) {
        int pos = idx >> 4, i = idx & 15;
        float inv = exp2f(-(float)i * (13.287712379549449f / 16.f));
        float sn, cs;
        sincos_((float)pos * inv, &sn, &cs);
        p.ROPE()[idx * 2] = cs;
        p.ROPE()[idx * 2 + 1] = sn;
      }
      {
        const int wv = tid >> 6, ln = tid & 63;
        for (int LL = 0; LL < 4; ++LL) {
          float mb = 0.f;
          for (int j = tid; j < 8 * 465; j += 512) mb = fmaxf(mb, fabsf(p.na_rel_bias[LL * 8 * 465 + j]));
#pragma unroll
          for (int o = 32; o >= 1; o >>= 1) mb = fmaxf(mb, __shfl_xor(mb, o));
          if (ln == 0) sm[LL * 8 + wv] = mb;
        }
        __syncthreads();
        {
          const int LL = wv >> 1, ty = wv & 1;
          const float* gq = (ty ? p.gqa_q_g : p.na_q_g) + LL * 64;
          const float* gk = (ty ? p.gqa_k_g : p.na_k_g) + LL * 64;
          float mq = fabsf(gq[ln]), mk = fabsf(gk[ln]);
#pragma unroll
          for (int o = 32; o >= 1; o >>= 1) { mq = fmaxf(mq, __shfl_xor(mq, o)); mk = fmaxf(mk, __shfl_xor(mk, o)); }
          if (ln == 0) {
            float mb = 0.f;
            if (!ty) for (int q = 0; q < 8; ++q) mb = fmaxf(mb, sm[LL * 8 + q]);
            p.ROPE()[8192 + wv] = fminf(8.f * LOG2E * mq * mk + LOG2E * mb, 100.f);
          }
        }
        __syncthreads();
      }
    }
  }
  const int nn = tid & 63, kq = tid >> 6;
  for (int it0 = blockIdx.x; it0 < N_TR; it0 += 4 * gridDim.x) {
    float v[4][8];
#pragma unroll
    for (int u = 0; u < 4; ++u) {
      const int it = it0 + u * gridDim.x;
      if (it < N_TR) {
        const TrDesc d = tr_decode(p, it);
#pragma unroll
        for (int i = 0; i < 8; ++i) v[u][i] = d.src[(size_t)(d.k0 + kq + 8 * i) * d.ld + d.n0 + nn];
      }
    }
#pragma unroll
    for (int u = 0; u < 4; ++u)
#pragma unroll
      for (int i = 0; i < 8; ++i) sm[u * 4160 + (kq + 8 * i) * 65 + nn] = v[u][i];
    __syncthreads();
#pragma unroll
    for (int u = 0; u < 4; ++u) {
      const int it = it0 + u * gridDim.x;
      if (it < N_TR) {
        const TrDesc d = tr_decode(p, it);
        const float* tile = sm + u * 4160;
        const int n2 = tid >> 3, kc = tid & 7;
        uint4 w;
        w.x = pk2(tile[(kc * 8 + 0) * 65 + n2], tile[(kc * 8 + 1) * 65 + n2]);
        w.y = pk2(tile[(kc * 8 + 2) * 65 + n2], tile[(kc * 8 + 3) * 65 + n2]);
        w.z = pk2(tile[(kc * 8 + 4) * 65 + n2], tile[(kc * 8 + 5) * 65 + n2]);
        w.w = pk2(tile[(kc * 8 + 6) * 65 + n2], tile[(kc * 8 + 7) * 65 + n2]);
        *reinterpret_cast<uint4*>(d.dst + (size_t)(d.n0 + n2) * d.K + d.k0 + kc * 8) = w;
      }
    }
    __syncthreads();
  }
}

DI void phase_norm(const Params& p, int b, int L, int tid) {
  const int wid = tid >> 6, lane = tid & 63;
  const float* g = p.norm_g + L * 1024;
  for (int item = blockIdx.x; item < R / 8; item += gridDim.x) {
    const int row = item * 8 + wid;
    const float* src;
    const float* mod;
    if (row < NLAT) {
      src = (L == 0 ? p.x : (const float*)p.out) + ((size_t)b * NLAT + row) * 1024;
      mod = p.MOD() + (L * 3 + b) * 3072;
    } else {
      src = (L == 0 ? p.ctx : (const float*)p.CTXS()) + ((size_t)b * 256 + (row - NLAT)) * 1024;
      mod = p.MOD() + (L * 3 + 2) * 3072;
    }
    float4 v[4];
    float ss = 0.f;
#pragma unroll
    for (int j = 0; j < 4; ++j) {
      v[j] = *reinterpret_cast<const float4*>(src + j * 256 + lane * 4);
      ss += v[j].x * v[j].x + v[j].y * v[j].y + v[j].z * v[j].z + v[j].w * v[j].w;
    }
#pragma unroll
    for (int o = 32; o >= 1; o >>= 1) ss += __shfl_xor(ss, o);
    const float rs = rsqrtf(ss * (1.f / 1024.f) + 1e-6f);
#pragma unroll
    for (int j = 0; j < 4; ++j) {
      const int col = j * 256 + lane * 4;
      float4 g4 = *reinterpret_cast<const float4*>(g + col);
      float4 sh = *reinterpret_cast<const float4*>(mod + col);
      float4 sc = *reinterpret_cast<const float4*>(mod + 1024 + col);
      float y0 = v[j].x * rs * g4.x * (1.f + sc.x) + sh.x;
      float y1 = v[j].y * rs * g4.y * (1.f + sc.y) + sh.y;
      float y2 = v[j].z * rs * g4.z * (1.f + sc.z) + sh.z;
      float y3 = v[j].w * rs * g4.w * (1.f + sc.w) + sh.w;
      uint2 w;
      w.x = pk2(y0, y1);
      w.y = pk2(y2, y3);
      *reinterpret_cast<uint2*>(p.H() + (size_t)row * 1024 + col) = w;
    }
  }
}

struct EpiGlu {
  static constexpr bool PERM = true, AFTER_DRAIN = false;
  const bf16_t* Y; bf16_t* Zg;
  DI void operator()(const pg8::f32x4 (&acc)[2][2][4][2], const pg8::Unit& u, int wr, int wc, int fr, int fq) const {
    const int row0 = u.pm * 256 + wr * 64 + fr, col0 = u.pn * 256 + wc * 32 + 8 * fq;
#pragma unroll
    for (int ai = 0; ai < 2; ++ai)
#pragma unroll
      for (int mh = 0; mh < 2; ++mh) {
        uint4 yv[4], gv[4];
#pragma unroll
        for (int q = 0; q < 4; ++q) {
          const int m = mh * 2 + (q >> 1), bj = q & 1;
          const int row = row0 + ai * 128 + m * 16, col = col0 + bj * 128;
          yv[q] = *reinterpret_cast<const uint4*>(Y + (size_t)row * 512 + col);
          gv[q] = *reinterpret_cast<const uint4*>(Zg + (size_t)row * LDZ + col);
        }
#pragma unroll
        for (int q = 0; q < 4; ++q) {
          const int m = mh * 2 + (q >> 1), bj = q & 1;
          const int row = row0 + ai * 128 + m * 16, col = col0 + bj * 128;
          const pg8::f32x4 a0 = acc[ai][bj][m][0], a1 = acc[ai][bj][m][1];
          uint4 w;
          w.x = pk2(lo_bf(yv[q].x) * sigmoidf_(a0[0]) * siluf_(lo_bf(gv[q].x)), hi_bf(yv[q].x) * sigmoidf_(a0[1]) * siluf_(hi_bf(gv[q].x)));
          w.y = pk2(lo_bf(yv[q].y) * sigmoidf_(a0[2]) * siluf_(lo_bf(gv[q].y)), hi_bf(yv[q].y) * sigmoidf_(a0[3]) * siluf_(hi_bf(gv[q].y)));
          w.z = pk2(lo_bf(yv[q].z) * sigmoidf_(a1[0]) * siluf_(lo_bf(gv[q].z)), hi_bf(yv[q].z) * sigmoidf_(a1[1]) * siluf_(hi_bf(gv[q].z)));
          w.w = pk2(lo_bf(yv[q].w) * sigmoidf_(a1[2]) * siluf_(lo_bf(gv[q].w)), hi_bf(yv[q].w) * sigmoidf_(a1[3]) * siluf_(hi_bf(gv[q].w)));
          *reinterpret_cast<uint4*>(Zg + (size_t)row * LDZ + col) = w;
        }
        asm volatile("" ::: "memory");
      }
  }
};
struct EpiOutRes {
  static constexpr bool PERM = false, AFTER_DRAIN = false;
  const float* src; float* dst; const float* gate;
  DI void operator()(const pg8::f32x4 (&acc)[2][2][4][2], const pg8::Unit& u, int wr, int wc, int fr, int fq) const {
    const int row0 = u.pm * 256 + wr * 64 + fr, col0 = u.pn * 256 + wc * 32 + 4 * fq;
    pg8::f32x4 gv[2][2];
#pragma unroll
    for (int bj = 0; bj < 2; ++bj)
#pragma unroll
      for (int n = 0; n < 2; ++n) gv[bj][n] = *reinterpret_cast<const pg8::f32x4*>(gate + col0 + bj * 128 + n * 16);
#pragma unroll
    for (int ai = 0; ai < 2; ++ai)
#pragma unroll
      for (int mh = 0; mh < 2; ++mh) {
        pg8::f32x4 xv[8];
#pragma unroll
        for (int q = 0; q < 8; ++q) {
          const int m = mh * 2 + (q >> 2), bj = (q >> 1) & 1, n = q & 1;
          xv[q] = *reinterpret_cast<const pg8::f32x4*>(src + (size_t)(row0 + ai * 128 + m * 16) * 1024 + col0 + bj * 128 + n * 16);
        }
#pragma unroll
        for (int q = 0; q < 8; ++q) {
          const int m = mh * 2 + (q >> 2), bj = (q >> 1) & 1, n = q & 1;
          *reinterpret_cast<pg8::f32x4*>(dst + (size_t)(row0 + ai * 128 + m * 16) * 1024 + col0 + bj * 128 + n * 16) =
              xv[q] + gv[bj][n] * acc[ai][bj][m][n];
        }
        asm volatile("" ::: "memory");
      }
  }
};

#define LDS3(ptr) ((__attribute__((address_space(3))) unsigned char*)(ptr))

typedef unsigned u32x4_t __attribute__((ext_vector_type(4)));
typedef unsigned u32x2_t __attribute__((ext_vector_type(2)));
struct EpiP1 {
  static constexpr bool PERM = true, AFTER_DRAIN = false;
  bf16_t* Zp; bf16_t* SGp;
  DI void operator()(const pg8::f32x4 (&acc)[2][2][4][2], const pg8::Unit& u, int wr, int wc, int fr, int fq) const {
    const int row0 = u.pm * 256 + wr * 64 + fr;
    const int colt = u.pn * 256;
    const int col0 = wc * 32 + 8 * fq;
    if (colt < LDZ) {
#pragma unroll
      for (int ai = 0; ai < 2; ++ai)
#pragma unroll
        for (int m = 0; m < 4; ++m) {
          bf16_t* rowp = Zp + (size_t)(row0 + ai * 128 + m * 16) * LDZ + colt + col0;
#pragma unroll
          for (int bj = 0; bj < 2; ++bj) {
            const pg8::f32x4 v0 = acc[ai][bj][m][0], v1 = acc[ai][bj][m][1];
            u32x4_t w4 = {pk2(v0[0], v0[1]), pk2(v0[2], v0[3]), pk2(v1[0], v1[1]), pk2(v1[2], v1[3])};
            __builtin_nontemporal_store(w4, reinterpret_cast<u32x4_t*>(rowp + bj * 128));
          }
        }
    } else {
      const int gcol0 = colt - LDZ + col0;
#pragma unroll
      for (int ai = 0; ai < 2; ++ai)
#pragma unroll
        for (int m = 0; m < 4; ++m) {
          const int row = row0 + ai * 128 + m * 16;
#pragma unroll
          for (int bj = 0; bj < 2; ++bj) {
            const pg8::f32x4 v0 = acc[ai][bj][m][0], v1 = acc[ai][bj][m][1];
            u32x2_t w0v = {pk2(sigmoidf_(v0[0]), sigmoidf_(v0[1])), pk2(sigmoidf_(v0[2]), sigmoidf_(v0[3]))};
            u32x2_t w1v = {pk2(sigmoidf_(v1[0]), sigmoidf_(v1[1])), pk2(sigmoidf_(v1[2]), sigmoidf_(v1[3]))};
            bf16_t* q0 = SGp + sg_index(row, gcol0 + bj * 128);
            __builtin_nontemporal_store(w0v, reinterpret_cast<u32x2_t*>(q0));
            __builtin_nontemporal_store(w1v, reinterpret_cast<u32x2_t*>(q0 + 128));
          }
        }
    }
  }
};
constexpr int P1_UNITS_Z = 65 * 25, P1_UNITS_ALL = 65 * 41, P1_UNITS_MAIN = 2560, GLU_UNITS = 65 * 2;
struct P1Order {
  int lo, hi, G, c;
  DI static void map_unit(int wgid, int nM, int nN, pg8::Unit& u) {
    const int nwg = nM * nN;
    { const int q = nwg / pg8::NXCD, r = nwg % pg8::NXCD, xcd = wgid % pg8::NXCD, off = wgid / pg8::NXCD;
      wgid = (xcd < r ? xcd * (q + 1) : r * (q + 1) + (xcd - r) * q) + off; }
    const int nig = pg8::WGM * nN, gid = wgid / nig, fm = gid * pg8::WGM, gsz = (nM - fm) < pg8::WGM ? (nM - fm) : pg8::WGM;
    u.pm = fm + ((wgid % nig) % gsz); u.pn = (wgid % nig) / gsz;
  }
  DI bool next(int i, pg8::Unit& u) const {
    const int idx = lo + i * G + c;
    if (idx >= hi) return false;
    if (idx < P1_UNITS_Z) map_unit(idx, 65, 25, u);
    else { map_unit(idx - P1_UNITS_Z, 65, 16, u); u.pn += 25; }
    return true;
  }
  DI void a_ready(const pg8::Unit&) const {}
  DI void done(const pg8::Unit&) const {}
  DI int lda(const pg8::Gemm& g) const { return g.K; }
  DI const char* abase(const pg8::Gemm& g, const pg8::Unit& u) const { return (const char*)g.A + (size_t)u.pm * (size_t)pg8::BM * g.K * 2; }
  DI const char* bbase(const pg8::Gemm& g, const pg8::Unit& u) const { return (const char*)g.Bt + (size_t)u.pn * (size_t)pg8::BM * g.K * 2; }
};
DI bool p1_deferral() { return gridDim.x >= (unsigned)(GLU_UNITS + (P1_UNITS_ALL - P1_UNITS_MAIN)); }
DI void phase_p1(const Params& p, int b, int L, unsigned char* smraw) {
  P1Order S{0, p1_deferral() ? P1_UNITS_MAIN : P1_UNITS_ALL, (int)gridDim.x, (int)blockIdx.x};
  pg8::Gemm g{p.H(), p.WinT() + (size_t)L * 10496 * 1024, R, 10496, 1024};
  EpiP1 E{p.Z(), p.SG()};
  pg8::gemm_phase<EpiP1, P1Order, false>(LDS3(smraw), g, S, E, nullptr);
}

DI void post_item(const Params& p, int L, int rb, int slot, int lane) {
  int col; const float* gvec = nullptr; float mult = 1.f; bool rope = false; bf16_t* vt = nullptr;
  const bool latent = (rb * 64) < NLAT;
  if (slot < 8) { col = C_NQ + slot * 64; gvec = p.na_q_g + L * 64; mult = 0.125f * LOG2E; }
  else if (slot < 16) { col = C_NK + (slot - 8) * 64; gvec = p.na_k_g + L * 64; }
  else if (slot < 24) { col = C_GQ + (slot - 16) * 64; gvec = p.gqa_q_g + L * 64; mult = 0.125f * LOG2E; rope = latent; }
  else if (slot < 26) { col = C_GK + (slot - 24) * 64; gvec = p.gqa_k_g + L * 64; rope = latent; }
  else if (slot < 34) { col = C_NV + (slot - 26) * 64; vt = p.VtN() + (size_t)((slot - 26) * 64) * LDT; }
  else { col = C_GV + (slot - 34) * 64; vt = p.VtG() + (size_t)((slot - 34) * 64) * LDT; }
  if (vt) {
    const int row = rb * 64 + lane;
    const bf16_t* zp = p.Z() + (size_t)row * LDZ + col;
    uint4 raw[8];
#pragma unroll
    for (int j = 0; j < 8; ++j) raw[j] = *reinterpret_cast<const uint4*>(zp + j * 8);
    const int prow = (row & ~12) | ((row & 4) << 1) | ((row & 8) >> 1);
#pragma unroll
    for (int j = 0; j < 8; ++j) {
      const unsigned w[4] = {raw[j].x, raw[j].y, raw[j].z, raw[j].w};
#pragma unroll
      for (int q = 0; q < 4; ++q) {
        vt[(size_t)(j * 8 + q * 2) * LDT + prow] = (bf16_t)(w[q] & 0xffffu);
        vt[(size_t)(j * 8 + q * 2 + 1) * LDT + prow] = (bf16_t)(w[q] >> 16);
      }
    }
    return;
  }
  const int c = lane & 7, rsub = lane >> 3;
  float gv[8];
#pragma unroll
  for (int e = 0; e < 8; ++e) gv[e] = gvec[c * 8 + e] * mult;
  uint4 rawv[8];
#pragma unroll
  for (int ps = 0; ps < 8; ++ps)
    rawv[ps] = *reinterpret_cast<const uint4*>(p.Z() + (size_t)(rb * 64 + ps * 8 + rsub) * LDZ + col + c * 8);
#pragma unroll
  for (int ps = 0; ps < 8; ++ps) {
    const int row = rb * 64 + ps * 8 + rsub;
    bf16_t* zp = p.Z() + (size_t)row * LDZ + col + c * 8;
    const uint4 raw = rawv[ps];
    float x[8] = {lo_bf(raw.x), hi_bf(raw.x), lo_bf(raw.y), hi_bf(raw.y), lo_bf(raw.z), hi_bf(raw.z), lo_bf(raw.w), hi_bf(raw.w)};
    float ss = 0.f;
#pragma unroll
    for (int e = 0; e < 8; ++e) ss += x[e] * x[e];
    ss += __shfl_xor(ss, 1);
    ss += __shfl_xor(ss, 2);
    ss += __shfl_xor(ss, 4);
    const float rs = rsqrtf(ss * (1.f / 64.f) + 1e-6f);
#pragma unroll
    for (int e = 0; e < 8; ++e) x[e] = x[e] * rs * gv[e];
    if (rope) {
      const int pos = ((c & 3) < 2) ? (row >> 6) : (row & 63);
      const float* rt = p.ROPE() + (size_t)pos * 32 + ((c & 1) * 8) * 2;
#pragma unroll
      for (int e = 0; e < 8; ++e) {
        const float other = __shfl_xor(x[e], 4);
        const float cs = rt[e * 2], sn = rt[e * 2 + 1];
        x[e] = (c < 4) ? (x[e] * cs - other * sn) : (x[e] * cs + other * sn);
      }
    }
    uint4 w;
    w.x = pk2(x[0], x[1]); w.y = pk2(x[2], x[3]); w.z = pk2(x[4], x[5]); w.w = pk2(x[6], x[7]);
    *reinterpret_cast<uint4*>(zp) = w;
  }
}

DI void phase_s5e_conv_post(const Params& p, int b, int L, bf16_t* sm, int tid) {
  {
    VSUB_SETUP
    constexpr int NT_E = 32 * 9 * 2;
    const int nit = (NT_E + vgrid - 1) / vgrid;
    for (int it = 0; it < nit; ++it) {
      int item = it * vgrid + vb;
      const bool act = item < NT_E;
      if (!act) item = NT_E - 1;
      const int g = item / 18, rem = item % 18, mt = rem >> 1, nt = rem & 1;
      const int m0 = mt * 128, n0 = nt * 128;
      f32x16 acc[2][2];
      zero_acc<2>(acc);
      const bf16_t* Ub = p.Z() + C_S5U + g * 16;
      gemm_main<2>(acc, Ub + (size_t)m0 * 16 * LDZ, 16 * LDZ, ((vt & 7) >> 1) * LDZ + (vt & 1) * 8, 4 * LDZ,
                   p.S5We() + (size_t)(L * 32 + g) * 65536 + (size_t)n0 * 256, 256, 256, smv, vt, act, bcnt);
      if (act) {
#pragma unroll
        for (int mi = 0; mi < 2; ++mi)
#pragma unroll
          for (int ni = 0; ni < 2; ++ni)
#pragma unroll
            for (int i = 0; i < 16; ++i) {
              int m = m0 + wm * 64 + mi * 32 + crow(i, h);
              int n = n0 + wn * 64 + ni * 32 + r;
              if (m < NCH) p.E()[((size_t)m * 32 + g) * 256 + n] = acc[mi][ni][i];
            }
      }
    }
  }
  constexpr int NT_C = R * 64 / 512;
  constexpr int NT_P = 260 * 36 / 8;
  for (int item = blockIdx.x; item < NT_C + NT_P; item += gridDim.x) {
    if (item >= NT_C) {
      const int w = (item - NT_C) * 8 + (tid >> 6);
      post_item(p, L, w / 36, w % 36, tid & 63);
      continue;
    }
    const int idx = item * 512 + tid;
    const int row = idx >> 6, ch = (idx & 63) * 8;
    const int lo = (row < NLAT) ? 0 : NLAT, hi = (row < NLAT) ? (NLAT - 1) : (R - 1);
    const bf16_t* zr = p.Z() + (size_t)row * LDZ;
    float zz[3][8];
#pragma unroll
    for (int t = 0; t < 3; ++t) {
      int rr = row + t - 1;
      if (rr >= lo && rr <= hi) {
        uint4 cv = *reinterpret_cast<const uint4*>(p.Z() + (size_t)rr * LDZ + C_CV + ch);
        uint4 cc = *reinterpret_cast<const uint4*>(p.Z() + (size_t)rr * LDZ + C_CC + ch);
        zz[t][0] = lo_bf(cv.x) * lo_bf(cc.x); zz[t][1] = hi_bf(cv.x) * hi_bf(cc.x);
        zz[t][2] = lo_bf(cv.y) * lo_bf(cc.y); zz[t][3] = hi_bf(cv.y) * hi_bf(cc.y);
        zz[t][4] = lo_bf(cv.z) * lo_bf(cc.z); zz[t][5] = hi_bf(cv.z) * hi_bf(cc.z);
        zz[t][6] = lo_bf(cv.w) * lo_bf(cc.w); zz[t][7] = hi_bf(cv.w) * hi_bf(cc.w);
      } else {
#pragma unroll
        for (int j = 0; j < 8; ++j) zz[t][j] = 0.f;
      }
    }
    uint4 cb = *reinterpret_cast<const uint4*>(zr + C_CB + ch);
    uint4 cg_ = *reinterpret_cast<const uint4*>(zr + C_CG + ch);
    float bv[8] = {lo_bf(cb.x), hi_bf(cb.x), lo_bf(cb.y), hi_bf(cb.y), lo_bf(cb.z), hi_bf(cb.z), lo_bf(cb.w), hi_bf(cb.w)};
    float gv[8] = {lo_bf(cg_.x), hi_bf(cg_.x), lo_bf(cg_.y), hi_bf(cg_.y), lo_bf(cg_.z), hi_bf(cg_.z), lo_bf(cg_.w), hi_bf(cg_.w)};
    float o[8];
#pragma unroll
    for (int j = 0; j < 8; ++j) {
      float y = p.conv_b[L * 512 + ch + j] + zz[0][j] * p.conv_w[(L * 3 + 0) * 512 + ch + j] +
                zz[1][j] * p.conv_w[(L * 3 + 1) * 512 + ch + j] + zz[2][j] * p.conv_w[(L * 3 + 2) * 512 + ch + j];
      o[j] = bv[j] * y * siluf_(gv[j]);
    }
    uint4 w;
    w.x = pk2(o[0], o[1]); w.y = pk2(o[2], o[3]); w.z = pk2(o[4], o[5]); w.w = pk2(o[6], o[7]);
    *reinterpret_cast<uint4*>(p.Z() + (size_t)row * LDZ + C_CG + ch) = w;
  }
}

DI void phase_s5y(const Params& p, int b, int L, bf16_t* sm, int tid) {
  VSUB_SETUP
  constexpr int NT = 32 * 18;
  const int nit = (NT + vgrid - 1) / vgrid;
  for (int it = 0; it < nit; ++it) {
    int item = it * vgrid + vb;
    const bool act = item < NT;
    if (!act) item = NT - 1;
    const int g = item / 18, rem = item % 18, mt = rem >> 1, nt = rem & 1;
    const int m0 = mt * 128, n0 = nt * 128;
    f32x16 acc[2][2];
    zero_acc<2>(acc);
    const bf16_t* Ub = p.Z() + C_S5U + g * 16;
    gemm_main<2>(acc, Ub + (size_t)m0 * 16 * LDZ, 16 * LDZ, ((vt & 7) >> 1) * LDZ + (vt & 1) * 8, 4 * LDZ,
                 p.S5M() + (size_t)(L * 32 + g) * 65536 + (size_t)n0 * 256, 256, 256, smv, vt, act, bcnt);
    const bf16_t* Hb = p.HIN() + g * 256;
    gemm_main<2>(acc, Hb + (size_t)m0 * 8192, 8192, (vt & 7) * 8, 64,
                 p.S5R() + (size_t)(L * 32 + g) * 65536 + (size_t)n0 * 256, 256, 256, smv, vt, act, bcnt);
    if (act) {
#pragma unroll
      for (int mi = 0; mi < 2; ++mi)
#pragma unroll
        for (int ni = 0; ni < 2; ++ni)
#pragma unroll
          for (int i = 0; i < 16; ++i) {
            int m = m0 + wm * 64 + mi * 32 + crow(i, h);
            int n = n0 + wn * 64 + ni * 32 + r;
            if (m < NCH) {
              float y = acc[mi][ni][i];
              float z = 1.5957691216057308f * (y + 0.044715f * y * y * y);
              y = y * sigmoidf_(z);
              p.Y()[(size_t)(m * 16 + (n >> 4)) * 512 + g * 16 + (n & 15)] = f2bf(y);
            }
          }
    }
  }
}

DI void phase_glu(const Params& p, int b, int L, unsigned char* smraw) {
  if (p1_deferral() && blockIdx.x >= (unsigned)GLU_UNITS) {
    P1Order S{P1_UNITS_MAIN, P1_UNITS_ALL, (int)gridDim.x - GLU_UNITS, (int)blockIdx.x - GLU_UNITS};
    pg8::Gemm g{p.H(), p.WinT() + (size_t)L * 10496 * 1024, R, 10496, 1024};
    EpiP1 E{p.Z(), p.SG()};
    pg8::gemm_phase<EpiP1, P1Order, false>(LDS3(smraw), g, S, E, nullptr);
    return;
  }
  pg8::StaticOrder S;
  S.init(R, 512, gridDim.x, blockIdx.x);
  pg8::Gemm g{p.Y(), p.WgluT() + (size_t)L * 512 * 512, R, 512, 512};
  EpiGlu E{p.Y(), p.Z() + C_S5G};
  pg8::gemm_phase<EpiGlu, pg8::StaticOrder, false>(LDS3(smraw), g, S, E, nullptr);
}

DI void attn_item(const Params& p, int L, int mode, int head, int q_row0, int na_r, const float* bias_s, bf16_t* wl, int lane) {
  const int r = lane & 31, h = lane >> 5;
  int qcol, kcol, gcol;
  const bf16_t* vt;
  if (mode == 0 || mode == 2) {
    qcol = C_NQ + head * 64; kcol = C_NK + head * 64; gcol = C_NG + head * 64;
    vt = p.VtN() + (size_t)(head * 64) * LDT;
  } else {
    qcol = C_GQ + head * 64; kcol = C_GK + (head >> 2) * 64; gcol = C_GG + head * 64;
    vt = p.VtG() + (size_t)((head >> 2) * 64) * LDT;
  }
  bf16_t* Ql = wl + 4096 + lane * 8;
  {
    const bf16_t* qp = p.Z() + (size_t)(q_row0 + r) * LDZ + qcol + h * 8;
#pragma unroll
    for (int ks = 0; ks < 4; ++ks) {
      *reinterpret_cast<bf16x8*>(Ql + ks * 512) = ld16(qp + (size_t)32 * LDZ + ks * 16);
      *reinterpret_cast<bf16x8*>(Ql + 2048 + ks * 512) = ld16(qp + ks * 16);
    }
  }
  float la = 0.f, lb = 0.f;
  const float shf = p.ROPE()[8192 + L * 2 + ((mode == 0 || mode == 2) ? 0 : 1)];
  f32x16 OA0, OA1, OB0, OB1;
#pragma unroll
  for (int i = 0; i < 16; ++i) { OA0[i] = 0.f; OA1[i] = 0.f; OB0[i] = 0.f; OB1[i] = 0.f; }
  const int rs = min(max(na_r - 4, 0), 256 - 8);
  const int csA = min(max(r - 8, 0), 48), csB = min(max(r + 24, 0), 48);
  int kt_lo = 0, nband = 0;
  if (mode == 0) nband = 16;
  else if (mode == 1) {
    kt_lo = max(0, (128 - q_row0) >> 5);
    int kt_hi = min(10, (NLAT - q_row0 + 128) >> 5);
    nband = kt_hi - kt_lo;
  }
  const int ntiles = 8 + nband;
  auto tile_row = [&](int j) -> int {
    if (j < 8) return NLAT + j * 32;
    const int kt = kt_lo + j - 8;
    if (mode == 0) return (rs + (kt >> 1)) * 64 + (kt & 1) * 32;
    return q_row0 - 128 + kt * 32;
  };
  const bf16_t* kg = p.Z() + (size_t)(lane >> 3) * LDZ + kcol + (lane & 7) * 8;
  const bf16_t* vg = vt + (size_t)(lane >> 2) * LDT + (lane & 3) * 8;
  bf16_t* Kl = wl;
  bf16_t* Vl = wl + 2048;
  const int kstE = (lane >> 3) * 64 + (((lane & 7) ^ ((lane >> 4) & 7)) * 8);
  const int kstO = ((lane >> 3) + 8) * 64 + (((lane & 7) ^ (((lane >> 4) + 4) & 7)) * 8);
  const int vst0 = (lane >> 2) * 32 + (((lane & 3) ^ ((lane >> 4) & 3)) * 8);
#define KST(i) ((((i) & 1) ? kstO : kstE) + ((i) >> 1) * 1024)
#define VST(i) (vst0 + (i) * 512)
  const int krd = r * 64, ksw = (r >> 1) & 7;
  const int vrd0 = r * 32, vrd1 = (32 + r) * 32, vsw = (r >> 2) & 3;
  bf16x8 rk[4], rv[4];
  {
    const int t0r = tile_row(0);
#pragma unroll
    for (int i = 0; i < 4; ++i) {
      rk[i] = ld16(kg + (size_t)(t0r + 8 * i) * LDZ);
      rv[i] = ld16(vg + (size_t)(16 * i) * LDT + t0r);
    }
#pragma unroll
    for (int i = 0; i < 4; ++i) {
      *reinterpret_cast<bf16x8*>(Kl + KST(i)) = rk[i];
      *reinterpret_cast<bf16x8*>(Vl + VST(i)) = rv[i];
    }
  }
  for (int j = 0; j < ntiles; ++j) {
    const int krow0 = tile_row(j);
    const bool more = (j + 1 < ntiles);
    if (more) {
      const int tn = tile_row(j + 1);
#pragma unroll
      for (int i = 0; i < 4; ++i) {
        rk[i] = ld16(kg + (size_t)(tn + 8 * i) * LDZ);
        rv[i] = ld16(vg + (size_t)(16 * i) * LDT + tn);
      }
    }
    f32x16 SA, SB;
#pragma unroll
    for (int i = 0; i < 16; ++i) { SA[i] = -shf; SB[i] = -shf; }
#pragma unroll
    for (int ks = 0; ks < 4; ++ks) {
      bf16x8 kf = *reinterpret_cast<const bf16x8*>(Kl + krd + (((ks * 2 + h) ^ ksw) * 8));
      SA = MFMA32(kf, *reinterpret_cast<const bf16x8*>(Ql + 2048 + ks * 512), SA);
      SB = MFMA32(kf, *reinterpret_cast<const bf16x8*>(Ql + ks * 512), SB);
    }
    union { bf16x8 v; unsigned u[4]; } pa0, pa1, pb0, pb1;
#define SOFTMAX_TILE(S_, cs_, qoff_, lsum_, p0_, p1_)                                                      \
    {                                                                                                      \
      if (j >= 8 && mode == 0) {                                                                           \
        const int kt = j - 8;                                                                              \
        const int kcb = (kt & 1) * 32;                                                                     \
        const int di = rs + (kt >> 1) - na_r + 7;                                                          \
        const float* brow = bias_s + 64 + head * 465 + di * 31 + (kcb + 4 * h - (r + qoff_) + 15);        \
        const int t0 = kcb + 4 * h - cs_;                                                                  \
        _Pragma("unroll") for (int i = 0; i < 16; ++i) {                                                   \
          const int ci = (i & 3) + 8 * (i >> 2);                                                           \
          S_[i] = ((unsigned)(t0 + ci) < 16u) ? (S_[i] + brow[ci]) : -INFINITY;                            \
        }                                                                                                  \
      } else if (j >= 8) {                                                                                 \
        const int d0 = krow0 + 4 * h - (q_row0 + qoff_ + r);                                               \
        _Pragma("unroll") for (int i = 0; i < 16; ++i) {                                                   \
          const int df = d0 + (i & 3) + 8 * (i >> 2);                                                      \
          S_[i] = (df <= 128 && df >= -128) ? S_[i] : -INFINITY;                                           \
        }                                                                                                  \
      }                                                                                                    \
      float rsum = 0.f;                                                                                    \
      _Pragma("unroll") for (int i = 0; i < 16; ++i) {                                                     \
        float pv = __builtin_amdgcn_exp2f(S_[i]);                                                          \
        S_[i] = pv;                                                                                        \
        rsum += pv;                                                                                        \
      }                                                                                                    \
      lsum_ += rsum;                                                                                       \
      _Pragma("unroll") for (int q = 0; q < 4; ++q) {                                                      \
        p0_.u[q] = pk2(S_[2 * q], S_[2 * q + 1]);                                                          \
        p1_.u[q] = pk2(S_[8 + 2 * q], S_[8 + 2 * q + 1]);                                                  \
      }                                                                                                    \
    }
    SOFTMAX_TILE(SA, csA, 0, la, pa0, pa1)
    asm volatile("" : "+v"(pa0.u[0]), "+v"(pa0.u[1]), "+v"(pa0.u[2]), "+v"(pa0.u[3]), "+v"(pa1.u[0]), "+v"(pa1.u[1]), "+v"(pa1.u[2]), "+v"(pa1.u[3]));
    SOFTMAX_TILE(SB, csB, 32, lb, pb0, pb1)
#undef SOFTMAX_TILE
    {
      bf16x8 v00 = *reinterpret_cast<const bf16x8*>(Vl + vrd0 + (((0 + h) ^ vsw) * 8));
      bf16x8 v01 = *reinterpret_cast<const bf16x8*>(Vl + vrd0 + (((2 + h) ^ vsw) * 8));
      OA0 = MFMA32(v00, pa0.v, OA0); OB0 = MFMA32(v00, pb0.v, OB0);
      OA0 = MFMA32(v01, pa1.v, OA0); OB0 = MFMA32(v01, pb1.v, OB0);
      bf16x8 v10 = *reinterpret_cast<const bf16x8*>(Vl + vrd1 + (((0 + h) ^ vsw) * 8));
      bf16x8 v11 = *reinterpret_cast<const bf16x8*>(Vl + vrd1 + (((2 + h) ^ vsw) * 8));
      OA1 = MFMA32(v10, pa0.v, OA1); OB1 = MFMA32(v10, pb0.v, OB1);
      OA1 = MFMA32(v11, pa1.v, OA1); OB1 = MFMA32(v11, pb1.v, OB1);
    }
    if (more) {
#pragma unroll
      for (int i = 0; i < 4; ++i) {
        *reinterpret_cast<bf16x8*>(Kl + KST(i)) = rk[i];
        *reinterpret_cast<bf16x8*>(Vl + VST(i)) = rv[i];
      }
    }
  }
  float l_a = la + __shfl_xor(la, 32), l_b = lb + __shfl_xor(lb, 32);
  if (mode == 1 || mode == 3) {
    const float sk = __builtin_amdgcn_exp2f(p.gqa_sink[L * 8 + head] * LOG2E - shf);
    l_a += sk; l_b += sk;
  }
  const float inva = __builtin_amdgcn_rcpf(l_a), invb = __builtin_amdgcn_rcpf(l_b);
  bf16_t* gpa = p.Z() + (size_t)(q_row0 + r) * LDZ + gcol + 4 * h;
  bf16_t* gpb = gpa + (size_t)32 * LDZ;
  {
    uint2 gA0[4], gA1[4], gB0[4], gB1[4];
#pragma unroll
    for (int i4 = 0; i4 < 4; ++i4) {
      gA0[i4] = *reinterpret_cast<const uint2*>(gpa + i4 * 8);
      gA1[i4] = *reinterpret_cast<const uint2*>(gpa + 32 + i4 * 8);
      gB0[i4] = *reinterpret_cast<const uint2*>(gpb + i4 * 8);
      gB1[i4] = *reinterpret_cast<const uint2*>(gpb + 32 + i4 * 8);
    }
#define ATT_OUT(O, G, gp, inv, off)                                                                                 \
    {                                                                                                               \
      const uint2 gt = G[i4];                                                                                       \
      uint2 w;                                                                                                      \
      w.x = pk2(O[i4 * 4 + 0] * inv * siluf_(lo_bf(gt.x)), O[i4 * 4 + 1] * inv * siluf_(hi_bf(gt.x)));              \
      w.y = pk2(O[i4 * 4 + 2] * inv * siluf_(lo_bf(gt.y)), O[i4 * 4 + 3] * inv * siluf_(hi_bf(gt.y)));              \
      *reinterpret_cast<uint2*>(gp + off + i4 * 8) = w;                                                             \
    }
#pragma unroll
    for (int i4 = 0; i4 < 4; ++i4) {
      ATT_OUT(OA0, gA0, gpa, inva, 0)
      ATT_OUT(OA1, gA1, gpa, inva, 32)
      ATT_OUT(OB0, gB0, gpb, invb, 0)
      ATT_OUT(OB1, gB1, gpb, invb, 32)
    }
#undef ATT_OUT
  }
#undef KST
#undef VST
}

DI void scan_wg(const Params& p, int L, int dgi, float* sm, int tid) {
  const int lane = tid & 63, w = tid >> 6;
  const int d = dgi >> 5, g = dgi & 31;
  const int dg = (L * 2 + d) * 32 + g;
  const float ar = p.A16()[(dg * 64 + lane) * 2], ai = p.A16()[(dg * 64 + lane) * 2 + 1];
  const int off = g * 256 + d * 128 + lane * 2;
  const int s_lo = w * 130;
  auto chunk_of = [&](int s) -> int { return (d == 0) ? (s < 16 ? 1024 + s : s - 16) : (NCH - 1 - s); };
  float hr = 0.f, hi = 0.f, pr = 1.f, pi = 0.f;
  float2 e[10], en[10];
#pragma unroll
  for (int u = 0; u < 10; ++u) e[u] = *reinterpret_cast<const float2*>(p.E() + (size_t)chunk_of(s_lo + u) * 8192 + off);
  for (int s0 = 0; s0 < 130; s0 += 10) {
    const int sn = (s0 + 10 < 130) ? (s0 + 10) : s0;
#pragma unroll
    for (int u = 0; u < 10; ++u) en[u] = *reinterpret_cast<const float2*>(p.E() + (size_t)chunk_of(s_lo + sn + u) * 8192 + off);
#pragma unroll
    for (int u = 0; u < 10; ++u) {
      float nr = ar * hr - ai * hi + e[u].x, ni = ar * hi + ai * hr + e[u].y;
      hr = nr; hi = ni;
      float qr = pr * ar - pi * ai, qi = pr * ai + pi * ar;
      pr = qr; pi = qi;
    }
#pragma unroll
    for (int u = 0; u < 10; ++u) e[u] = en[u];
  }
  sm[(w * 64 + lane) * 2] = hr;
  sm[(w * 64 + lane) * 2 + 1] = hi;
  __syncthreads();
  float cr = 0.f, ci = 0.f;
  for (int v = 0; v < w; ++v) {
    float tr = sm[(v * 64 + lane) * 2], ti = sm[(v * 64 + lane) * 2 + 1];
    float nr = pr * cr - pi * ci + tr, ni = pr * ci + pi * cr + ti;
    cr = nr; ci = ni;
  }
  __syncthreads();
  hr = cr; hi = ci;
#pragma unroll
  for (int u = 0; u < 10; ++u) e[u] = *reinterpret_cast<const float2*>(p.E() + (size_t)chunk_of(s_lo + u) * 8192 + off);
  for (int s0 = 0; s0 < 130; s0 += 10) {
    const int sn = (s0 + 10 < 130) ? (s0 + 10) : s0;
#pragma unroll
    for (int u = 0; u < 10; ++u) en[u] = *reinterpret_cast<const float2*>(p.E() + (size_t)chunk_of(s_lo + sn + u) * 8192 + off);
#pragma unroll
    for (int u = 0; u < 10; ++u) {
      *reinterpret_cast<unsigned*>(p.HIN() + (size_t)chunk_of(s_lo + s0 + u) * 8192 + off) = pk2(hr, hi);
      float nr = ar * hr - ai * hi + e[u].x, ni = ar * hi + ai * hr + e[u].y;
      hr = nr; hi = ni;
    }
#pragma unroll
    for (int u = 0; u < 10; ++u) e[u] = en[u];
  }
}

DI void phase_attn_scan(const Params& p, int b, int L, float* sm, int tid) {
  const int lane = tid & 63, wid = tid >> 6;
  float* bias_s = sm + 32768;
  bf16_t* wl = reinterpret_cast<bf16_t*>(sm) + wid * 8192;
  for (int idx = tid; idx < 8 * 465; idx += 512) bias_s[64 + idx] = p.na_rel_bias[L * 8 * 465 + idx] * LOG2E;
  __syncthreads();
  constexpr int N_SCAN = 64, N_ATT = 4096 / 8;
  for (int item = blockIdx.x; item < N_SCAN; item += gridDim.x) scan_wg(p, L, item, sm + 32768 + 3840, tid);
  int lat_it = 0, ci = 0;
  for (;;) {
    int item;
    const int lat = (int)blockIdx.x + lat_it * (int)gridDim.x;
    if (lat < N_ATT) { item = lat; ++lat_it; }
    else {
      while (ci < 8 && (unsigned)((64 + ci) % gridDim.x) != blockIdx.x) ++ci;
      if (ci >= 8) break;
      item = N_ATT + ci;
      ++ci;
    }
    int mode, head, q_row0, na_r = 0;
    if (item < N_ATT) {
      const int w = item * 8 + wid;
      if (w < 2048) { mode = 0; head = w & 7; na_r = w >> 3; q_row0 = na_r * 64; }
      else { const int w2 = w - 2048; mode = 1; head = w2 & 7; q_row0 = (w2 >> 3) * 64; }
    } else {
      const int cj = item - N_ATT;
      const int w2 = (cj & 3) * 8 + wid;
      mode = (cj < 4) ? 2 : 3; head = w2 & 7; q_row0 = NLAT + (w2 >> 3) * 64;
    }
    attn_item(p, L, mode, head, q_row0, na_r, bias_s, wl, lane);
  }
  __syncthreads();
}

DI void phase_merge(const Params& p, int b, int L, bf16_t* sm, int tid) {
  VSUB_SETUP
  constexpr int NT = 128 * 8;
  const int nit = (NT + vgrid - 1) / vgrid;
  for (int it = 0; it < nit; ++it) {
    int tile = it * vgrid + vb;
    const bool act = tile < NT;
    if (!act) tile = NT - 1;
    const int mt = tile >> 3, nt = tile & 7;
    const int m0 = mt * 128, n0 = nt * 128;
    f32x16 outv[2][2];
    zero_acc<2>(outv);
    for (int kb = 0; kb < 4; ++kb) {
      f32x16 acc[2][2];
      zero_acc<2>(acc);
      const int gc = (kb == 0) ? C_S5G : (kb == 1 ? C_CG : (kb == 2 ? C_NG : C_GG));
      const bf16_t* Ab = p.Z() + (size_t)m0 * LDZ + gc;
      gemm_main<2, true, false>(acc, Ab, LDZ, (vt & 7) * 8, 64, p.WbrT() + (size_t)(L * 4 + kb) * 1024 * 512 + (size_t)n0 * 512, 512,
                         512, smv, vt, act, bcnt);
      if (act) {
#pragma unroll
        for (int mi = 0; mi < 2; ++mi) {
          const bf16_t* sgp = p.SG() + sg_index(m0 + wm * 64 + mi * 32 + r, kb * 1024 + n0 + wn * 64 + 4 * h);
#pragma unroll
          for (int ni = 0; ni < 2; ++ni)
#pragma unroll
            for (int i4 = 0; i4 < 4; ++i4) {
              uint2 sv = *reinterpret_cast<const uint2*>(sgp + (ni * 8 + i4 * 2) * 128);
              outv[mi][ni][i4 * 4 + 0] += lo_bf(sv.x) * acc[mi][ni][i4 * 4 + 0];
              outv[mi][ni][i4 * 4 + 1] += hi_bf(sv.x) * acc[mi][ni][i4 * 4 + 1];
              outv[mi][ni][i4 * 4 + 2] += lo_bf(sv.y) * acc[mi][ni][i4 * 4 + 2];
              outv[mi][ni][i4 * 4 + 3] += hi_bf(sv.y) * acc[mi][ni][i4 * 4 + 3];
            }
        }
      }
    }
    if (act) {
#pragma unroll
      for (int mi = 0; mi < 2; ++mi) {
        bf16_t* op = p.MIX() + (size_t)(m0 + wm * 64 + mi * 32 + r) * 1024 + n0 + wn * 64 + 4 * h;
#pragma unroll
        for (int ni = 0; ni < 2; ++ni)
#pragma unroll
          for (int i4 = 0; i4 < 4; ++i4) {
            uint2 w;
            w.x = pk2(outv[mi][ni][i4 * 4 + 0], outv[mi][ni][i4 * 4 + 1]);
            w.y = pk2(outv[mi][ni][i4 * 4 + 2], outv[mi][ni][i4 * 4 + 3]);
            *reinterpret_cast<uint2*>(op + ni * 32 + i4 * 8) = w;
          }
      }
    }
  }
  constexpr int NTC = 2 * 16 * 4;
  const int nitc = (L == 3) ? 0 : (NTC + vgrid - 1) / vgrid;
  for (int it = 0; it < nitc; ++it) {
    int item = it * vgrid + vb;
    const bool act = item < NTC;
    if (!act) item = NTC - 1;
    const int kb = item & 3, nt = (item >> 2) & 15, mt = item >> 6;
    const int m0 = NLAT + mt * 128, n0 = nt * 64;
    f32x16 acc[2][1];
    zero_acc<1>(acc);
    const int gc = (kb == 0) ? C_S5G : (kb == 1 ? C_CG : (kb == 2 ? C_NG : C_GG));
    gemm_main<1, true>(acc, p.Z() + (size_t)m0 * LDZ + gc, LDZ, (vt & 7) * 8, 64,
                       p.WbrT() + (size_t)(L * 4 + kb) * 1024 * 512 + (size_t)n0 * 512, 512, 512, smv, vt, act, bcnt);
    if (act) {
#pragma unroll
      for (int mi = 0; mi < 2; ++mi) {
        const int row = m0 + wm * 64 + mi * 32 + r;
        const bf16_t* sgp = p.SG() + sg_index(row, kb * 1024 + n0 + wn * 32 + 4 * h);
        bf16_t* op = p.PCTX() + (size_t)kb * 256 * 1024 + (size_t)(row - NLAT) * 1024 + n0 + wn * 32 + 4 * h;
#pragma unroll
        for (int i4 = 0; i4 < 4; ++i4) {
          uint2 sv = *reinterpret_cast<const uint2*>(sgp + (i4 * 2) * 128);
          uint2 w;
          w.x = pk2(lo_bf(sv.x) * acc[mi][0][i4 * 4 + 0], hi_bf(sv.x) * acc[mi][0][i4 * 4 + 1]);
          w.y = pk2(lo_bf(sv.y) * acc[mi][0][i4 * 4 + 2], hi_bf(sv.y) * acc[mi][0][i4 * 4 + 3]);
          *reinterpret_cast<uint2*>(op + i4 * 8) = w;
        }
      }
    }
  }
}

DI void phase_out(const Params& p, int b, int L, unsigned char* smraw, int tid) {
  {
    pg8::StaticOrder S;
    S.init(NLAT, 1024, gridDim.x, blockIdx.x);
    pg8::Gemm g{p.MIX(), p.WoutT() + (size_t)L * 1024 * 1024, NLAT, 1024, 1024};
    EpiOutRes E{(L == 0 ? p.x : (const float*)p.out) + (size_t)b * NLAT * 1024, p.out + (size_t)b * NLAT * 1024,
                p.MOD() + (L * 3 + b) * 3072 + 2048};
    pg8::gemm_phase<EpiOutRes, pg8::StaticOrder, false>(LDS3(smraw), g, S, E, nullptr);
  }
  if (L == 3) return;
  __syncthreads();
  bf16_t* sm = reinterpret_cast<bf16_t*>(smraw);
  VSUB_SETUP
  constexpr int NT = 2 * 8;
  const int nit = (NT + vgrid - 1) / vgrid;
  for (int it = 0; it < nit; ++it) {
    int tile = it * vgrid + vb;
    const bool act = tile < NT;
    if (!act) tile = NT - 1;
    const int mt = tile >> 3, nt = tile & 7;
    const int m0 = NLAT + mt * 128, n0 = nt * 128;
    f32x16 acc[2][2];
    zero_acc<2>(acc);
    {
      const bf16_t* Ab = p.PCTX() + (size_t)(m0 - NLAT) * 1024;
      gemm_main<2, false, false, true>(acc, Ab, 1024, (vt & 7) * 8, 64, p.WoutT() + (size_t)L * 1024 * 1024 + (size_t)n0 * 1024,
                                       1024, 1024, smv, vt, act, bcnt, (size_t)256 * 1024);
    }
    if (act) {
      const float* src = (L == 0 ? p.ctx : (const float*)p.CTXS()) + ((size_t)b * 256 + (m0 - NLAT)) * 1024;
      float* dst = p.CTXS() + ((size_t)b * 256 + (m0 - NLAT)) * 1024;
      const float* gate = p.MOD() + (L * 3 + 2) * 3072 + 2048;
#pragma unroll
      for (int ni = 0; ni < 2; ++ni) {
        const int col = n0 + wn * 64 + ni * 32 + r;
        const float gt = gate[col];
#pragma unroll
        for (int mi = 0; mi < 2; ++mi) {
          float xs[16];
#pragma unroll
          for (int i = 0; i < 16; ++i) xs[i] = src[(size_t)(wm * 64 + mi * 32 + crow(i, h)) * 1024 + col];
#pragma unroll
          for (int i = 0; i < 16; ++i) dst[(size_t)(wm * 64 + mi * 32 + crow(i, h)) * 1024 + col] = xs[i] + gt * acc[mi][ni][i];
        }
      }
    }
  }
}

#define XB_TMO      128
#define XB_XCNT(j)  (256  + 64 * (j))
#define XB_XSUB(j)  (1280 + 64 * (j))
#define XB_XGEN(j)  (2304 + 64 * (j))
#define XB_TOP      3328
#define XB_TOPGEN   3392
#define XCD_BAR_WORDS 3456
#define XB_SPIN_CAP (1u << 18)
#define LAS __attribute__((address_space(3)))

__device__ __forceinline__ unsigned xb_ld(unsigned* p)              { return __hip_atomic_load(p, __ATOMIC_RELAXED, __HIP_MEMORY_SCOPE_AGENT); }
__device__ __forceinline__ unsigned xb_add(unsigned* p, unsigned v) { return __hip_atomic_fetch_add(p, v, __ATOMIC_RELAXED, __HIP_MEMORY_SCOPE_AGENT); }
__device__ __forceinline__ unsigned xb_xcc_id() { return (unsigned)__builtin_amdgcn_s_getreg((3 << 11) | 20) & 0xFu; }
#define XB_SPIN(cond, bar) do { unsigned _sp = 0; while (cond) { __builtin_amdgcn_s_sleep(1); \
    if ((++_sp & 255u) == 0u) { if (xb_ld(&(bar)[XB_TMO])) break; if (_sp > XB_SPIN_CAP) { atomicAdd(&(bar)[XB_TMO], 1u); break; } } } } while (0)

struct XcdBarrier {
    unsigned* bar; unsigned x;
    volatile LAS unsigned* st;
};

__device__ __forceinline__ XcdBarrier xcd_barrier_post(unsigned* bar, volatile LAS unsigned* st) {
    XcdBarrier b; b.bar = bar; b.x = xb_xcc_id(); b.st = st;
    if (threadIdx.x == 0) (void)xb_add(&bar[XB_XCNT(b.x)], 1u);
    return b;
}
__device__ __forceinline__ void xcd_barrier_complete(unsigned* bar, unsigned x, unsigned& nloc, unsigned& nx) {
    const unsigned G = gridDim.x * gridDim.y * gridDim.z;
    unsigned sum, cnt, mine, sp = 0u;
    for (;;) {
        sum = 0u; cnt = 0u; mine = 0u;
#pragma unroll
        for (unsigned j = 0; j < 16; ++j) { const unsigned c = xb_ld(&bar[XB_XCNT(j)]); sum += c; cnt += (c > 0u) ? 1u : 0u; mine = (j == x) ? c : mine; }
        if (sum == G) break;
        __builtin_amdgcn_s_sleep(1);
        if ((++sp & 255u) == 0u) { if (xb_ld(&bar[XB_TMO])) break; if (sp > XB_SPIN_CAP) { atomicAdd(&bar[XB_TMO], 1u); break; } }
    }
    nloc = mine > 0u ? mine : 1u; nx = cnt > 0u ? cnt : 1u;
}

__device__ __forceinline__ void xcd_barrier(const XcdBarrier& b) {
    asm volatile("s_waitcnt vmcnt(0)" ::: "memory");
    __syncthreads();
    if (threadIdx.x == 0) {
        unsigned* bar = b.bar;
        __builtin_amdgcn_s_waitcnt(0);
        unsigned nloc = b.st[0], nx = b.st[1];
        if (nloc == 0u) { xcd_barrier_complete(bar, b.x, nloc, nx); b.st[0] = nloc; b.st[1] = nx; }
        const unsigned old = xb_add(&bar[XB_XSUB(b.x)], 1u);
        const unsigned gen = old / nloc;
        if (old + 1u == (gen + 1u) * nloc) {
            __builtin_amdgcn_fence(__ATOMIC_RELEASE, "agent");
            asm volatile("s_waitcnt vmcnt(0)" ::: "memory");
            const unsigned og = xb_add(&bar[XB_TOP], 1u);
            const unsigned tg = og / nx;
            if (og + 1u == (tg + 1u) * nx) xb_add(&bar[XB_TOPGEN], 1u);
            else XB_SPIN(xb_ld(&bar[XB_TOPGEN]) == tg, bar);
            __builtin_amdgcn_fence(__ATOMIC_ACQUIRE, "agent");
            xb_add(&bar[XB_XGEN(b.x)], 1u);
            asm volatile("s_waitcnt vmcnt(0)" ::: "memory");
        } else {
            XB_SPIN(xb_ld(&bar[XB_XGEN(b.x)]) == gen, bar);
            __builtin_amdgcn_fence(__ATOMIC_ACQUIRE, "agent");
            asm volatile("s_waitcnt vmcnt(0)" ::: "memory");
        }
    }
    __syncthreads();
}


__global__ void __launch_bounds__(512, 2) mega_kernel(Params p, int ph_lo, int ph_hi) {
  __shared__ __attribute__((aligned(1024))) unsigned char smem_raw[151552];
  __shared__ uint4 xb_words;
  bf16_t* smb = reinterpret_cast<bf16_t*>(smem_raw);
  float* smf = reinterpret_cast<float*>(smem_raw);
  if (threadIdx.x == 0) xb_words = make_uint4(0u, 0u, 0u, 0u);
  if (threadIdx.x < 128) g_vsub_cnt[threadIdx.x] = 0u;
  __syncthreads();
  XcdBarrier xb = xcd_barrier_post(p.bar, (volatile LAS unsigned*)&xb_words);
  if (ph_hi < 0) cg::this_grid().sync();
  for (int ph = ph_lo; ph < ph_hi; ++ph) {
    int tid = threadIdx.x;
    asm volatile("" : "+v"(tid));
    if (ph == 0) {
      phase_prep(p, smf, tid);
    } else {
      const int q = ph - 1;
      const int b = q >> 5, L = (q & 31) >> 3, sub = q & 7;
      switch (sub) {
        case 0: phase_norm(p, b, L, tid); break;
        case 1: phase_p1(p, b, L, smem_raw); break;
        case 2: phase_s5e_conv_post(p, b, L, smb, tid); break;
        case 3: phase_attn_scan(p, b, L, smf, tid); break;
        case 4: phase_s5y(p, b, L, smb, tid); break;
        case 5: phase_glu(p, b, L, smem_raw); break;
        case 6: phase_merge(p, b, L, smb, tid); break;
        default: phase_out(p, b, L, smem_raw, tid); break;
      }
    }
    if (ph + 1 < ph_hi) xcd_barrier(xb);
  }
}

extern "C" void kernel_launch(void* const* d_in, const int* in_sizes, int n_in, void* d_out, int out_size, void* d_ws,
                              size_t ws_size, hipStream_t stream) {
  Params p{};
  const float** fp = reinterpret_cast<const float**>(&p);
  for (int i = 0; i < 27; ++i) fp[i] = (const float*)d_in[i];
  p.out = (float*)d_out;
  p.ws = (char*)d_ws;
  p.bar = (unsigned*)((char*)d_ws + OFF_BAR);
  if (WS_TOTAL > ws_size) {
    fprintf(stderr, "workspace too small: need %zu have %zu\n", (size_t)WS_TOTAL, ws_size);
    return;
  }
  static int grid_blocks = 0;
  if (!grid_blocks) {
    int dev = 0, cus = 0, per_cu = 0;
    (void)hipGetDevice(&dev);
    (void)hipDeviceGetAttribute(&cus, hipDeviceAttributeMultiprocessorCount, dev);
    (void)hipOccupancyMaxActiveBlocksPerMultiprocessor(&per_cu, mega_kernel, 512, 0);
    if (per_cu > 1) per_cu = 1;
    if (per_cu < 1) per_cu = 1;
    grid_blocks = cus * per_cu;
  }
  (void)hipMemsetAsync(p.bar, 0, 4096 * 4, stream);
#if MULTI_LAUNCH
  for (int ph = 0; ph < NPHASE; ++ph) {
    hipLaunchKernelGGL(mega_kernel, dim3(grid_blocks), dim3(512), 0, stream, p, ph, ph + 1);
  }
#else
  int lo = 0, hi = NPHASE;
  void* args[] = {&p, &lo, &hi};
  hipError_t e = hipLaunchCooperativeKernel((void*)mega_kernel, dim3(grid_blocks), dim3(512), args, 0, stream);
  if (e != hipSuccess) fprintf(stderr, "cooperative launch failed: %s (grid %d)\n", hipGetErrorString(e), grid_blocks);
#endif
}
```

```cpp
#include <hip/hip_runtime.h>
#include <hip/hip_cooperative_groups.h>
#include <cstdio>
namespace cg = cooperative_groups;

#ifdef ONLY
#define ONLYP(i) (ONLY == (i))
#else
#define ONLYP(i) 1
#endif
#ifndef MULTI_LAUNCH
#define MULTI_LAUNCH 0
#endif

#define DI __device__ __forceinline__
typedef unsigned short bf16_t;
typedef __attribute__((ext_vector_type(8))) short bf16x8;
typedef __attribute__((ext_vector_type(16))) float f32x16;
typedef __attribute__((ext_vector_type(2))) float f32x2;
typedef __attribute__((ext_vector_type(2))) __bf16 bfx2;
#define MFMA32(a, b, c) __builtin_amdgcn_mfma_f32_32x32x16_bf16((a), (b), (c), 0, 0, 0)

constexpr int R = 16640;
constexpr int NLAT = 16384;
constexpr int ZCOLS = 6400;
constexpr int LDZ = 6464;
constexpr int LDT = 16640;
constexpr int NCH = 1040;
constexpr float LOG2E = 1.4426950408889634f;
constexpr int C_S5U = 0, C_S5G = 512, C_CV = 1024, C_CB = 1536, C_CC = 2048, C_CG = 2560, C_NQ = 3072, C_NK = 3584,
              C_NV = 4096, C_NG = 4608, C_GQ = 5120, C_GK = 5632, C_GV = 5760, C_GG = 5888;
constexpr int NPHASE = 1 + 2 * 4 * 8;

constexpr size_t al256(size_t x) { return (x + 255) & ~(size_t)255; }
constexpr size_t OFF_H = 0;
constexpr size_t OFF_Z = OFF_H + al256((size_t)R * 1024 * 2);
constexpr size_t OFF_VTN = OFF_Z + al256((size_t)R * LDZ * 2);
constexpr size_t OFF_VTG = OFF_VTN + al256((size_t)512 * LDT * 2);
constexpr size_t OFF_Y = OFF_VTG + al256((size_t)128 * LDT * 2);
constexpr size_t OFF_HIN = OFF_Y + al256((size_t)R * 512 * 2);
constexpr size_t OFF_E = OFF_HIN + al256((size_t)NCH * 8192 * 2);
constexpr size_t OFF_MIX = OFF_E;
constexpr size_t OFF_SG = OFF_E + al256((size_t)R * 1024 * 2);
constexpr size_t OFF_CTXS = OFF_SG + al256((size_t)R * 4096 * 2);
constexpr size_t OFF_WINT = OFF_CTXS + al256((size_t)512 * 1024 * 4);
constexpr size_t OFF_WBRT = OFF_WINT + al256((size_t)4 * 10496 * 1024 * 2);
constexpr size_t OFF_WOUTT = OFF_WBRT + al256((size_t)16 * 1024 * 512 * 2);
constexpr size_t OFF_WGLUT = OFF_WOUTT + al256((size_t)4 * 1024 * 1024 * 2);
constexpr size_t OFF_S5M = OFF_WGLUT + al256((size_t)4 * 512 * 512 * 2);
constexpr size_t OFF_S5WE = OFF_S5M + al256((size_t)128 * 65536 * 2);
constexpr size_t OFF_S5R = OFF_S5WE + al256((size_t)128 * 65536 * 2);
constexpr size_t OFF_A16 = OFF_S5R + al256((size_t)128 * 65536 * 2);
constexpr size_t OFF_MOD = OFF_A16 + al256((size_t)4 * 2 * 32 * 64 * 2 * 4);
constexpr size_t OFF_ROPE = OFF_MOD + al256((size_t)4 * 3 * 3072 * 4);
constexpr size_t OFF_BAR = OFF_ROPE + al256((size_t)256 * 16 * 2 * 4 + 64);
constexpr size_t OFF_PCTX = OFF_BAR + al256((size_t)4096 * 4);
constexpr size_t WS_TOTAL = OFF_PCTX + al256((size_t)4 * 256 * 1024 * 2);

struct Params {
  const float *x, *c, *ctx, *c_ctx, *norm_g, *w_ada, *b_ada, *w_in, *s5_a_re, *s5_a_im, *s5_log_dt, *s5_b_re, *s5_b_im,
      *s5_c_re, *s5_c_im, *s5_d, *s5_w_glu, *conv_w, *conv_b, *na_q_g, *na_k_g, *na_rel_bias, *gqa_q_g, *gqa_k_g, *gqa_sink,
      *w_br, *w_out;
  float* out;
  char* ws;
  unsigned* bar;
  DI bf16_t* H() const { return (bf16_t*)(ws + OFF_H); }
  DI bf16_t* Z() const { return (bf16_t*)(ws + OFF_Z); }
  DI bf16_t* VtN() const { return (bf16_t*)(ws + OFF_VTN); }
  DI bf16_t* VtG() const { return (bf16_t*)(ws + OFF_VTG); }
  DI bf16_t* Y() const { return (bf16_t*)(ws + OFF_Y); }
  DI bf16_t* MIX() const { return (bf16_t*)(ws + OFF_MIX); }
  DI bf16_t* HIN() const { return (bf16_t*)(ws + OFF_HIN); }
  DI float* E() const { return (float*)(ws + OFF_E); }
  DI float* CTXS() const { return (float*)(ws + OFF_CTXS); }
  DI bf16_t* WinT() const { return (bf16_t*)(ws + OFF_WINT); }
  DI bf16_t* SG() const { return (bf16_t*)(ws + OFF_SG); }
  DI bf16_t* PCTX() const { return (bf16_t*)(ws + OFF_PCTX); }
  DI bf16_t* WbrT() const { return (bf16_t*)(ws + OFF_WBRT); }
  DI bf16_t* WoutT() const { return (bf16_t*)(ws + OFF_WOUTT); }
  DI bf16_t* WgluT() const { return (bf16_t*)(ws + OFF_WGLUT); }
  DI bf16_t* S5M() const { return (bf16_t*)(ws + OFF_S5M); }
  DI bf16_t* S5We() const { return (bf16_t*)(ws + OFF_S5WE); }
  DI bf16_t* S5R() const { return (bf16_t*)(ws + OFF_S5R); }
  DI float* A16() const { return (float*)(ws + OFF_A16); }
  DI float* MOD() const { return (float*)(ws + OFF_MOD); }
  DI float* ROPE() const { return (float*)(ws + OFF_ROPE); }
};

DI float bf2f(bf16_t v) { return __uint_as_float(((unsigned)v) << 16); }
DI unsigned pk2(float a, float b) {
  f32x2 v = {a, b};
  bfx2 r = __builtin_convertvector(v, bfx2);
  return __builtin_bit_cast(unsigned, r);
}
DI bf16_t f2bf(float a) { return (bf16_t)(pk2(a, 0.f) & 0xffffu); }
DI float lo_bf(unsigned u) { return __uint_as_float(u << 16); }
DI float hi_bf(unsigned u) { return __uint_as_float(u & 0xffff0000u); }
DI float sigmoidf_(float x) { return __builtin_amdgcn_rcpf(1.f + __builtin_amdgcn_exp2f(-1.4426950408889634f * x)); }
DI float siluf_(float x) { return x * __builtin_amdgcn_rcpf(1.f + __builtin_amdgcn_exp2f(-1.4426950408889634f * x)); }
DI size_t sg_index(int row, int col) { return ((size_t)((row >> 5) * 1024 + (col >> 2)) * 32 + (row & 31)) * 4 + (col & 3); }
DI int crow(int i, int h) { return (i & 3) + 8 * (i >> 2) + 4 * h; }
DI bf16x8 ld16(const bf16_t* p) { return *reinterpret_cast<const bf16x8*>(p); }


namespace pg8 {
typedef unsigned short bf16_t;
#define PG8_LAS __attribute__((address_space(3)))
typedef short bf16x8 __attribute__((ext_vector_type(8)));
typedef float f32x4 __attribute__((ext_vector_type(4)));
typedef unsigned u32x4 __attribute__((ext_vector_type(4)));
constexpr int BM = 256, BK = 64, HALF = 128, HTB = HALF * BK * 2  , STAGE_BYTES = 8 * HTB, NXCD = 8, WGM = 8;

__host__ __device__ __forceinline__ int lds_byte(int r, int c) { const int st = (r >> 4) * 2 + (c >> 5), rr = r & 15, cc = c & 31, ob = rr * 64 + cc * 2; return st * 1024 + (ob ^ (((ob >> 9) & 1) << 5)); }
__host__ __device__ __forceinline__ void stage_rc(int b, int& R, int& C) { const int st = b / 1024, sb = b % 1024, swz = sb ^ (((sb >> 9) & 1) << 5); R = (st >> 1) * 16 + swz / 64; C = (st & 1) * 32 + (swz % 64) / 2; }
__host__ __device__ __forceinline__ int perm32(int rho) { const int n = rho >> 4, i = rho & 15; return 8 * (i >> 2) + 4 * n + (i & 3); }

struct Unit { int pm, pn; };
struct Gemm { const bf16_t* A; const bf16_t* Bt; int M, N, K; };

struct StaticOrder {
    int nM, nN, nwg, G, c;
    __host__ __device__ void init(int M, int N, int G_, int c_) { nM = M / BM; nN = N / BM; nwg = nM * nN; G = G_; c = c_; }
    __host__ __device__ bool next(int i, Unit& u) const {
        const long L = (long)i * G + c; if (L >= nwg) return false;
        int wgid = (int)L; { const int q = nwg / NXCD, r = nwg % NXCD, xcd = wgid % NXCD, off = wgid / NXCD; wgid = (xcd < r ? xcd * (q + 1) : r * (q + 1) + (xcd - r) * q) + off; }
        const int nig = WGM * nN, gid = wgid / nig, fm = gid * WGM, gsz = (nM - fm) < WGM ? (nM - fm) : WGM;
        u.pm = fm + ((wgid % nig) % gsz); u.pn = (wgid % nig) / gsz; return true;
    }
    __device__ __forceinline__ void a_ready(const Unit&) const {}
    __device__ __forceinline__ void done(const Unit&) const {}
};
struct CountedOrder : StaticOrder {
    const unsigned* ready; unsigned need; unsigned* tmo;
    __device__ __forceinline__ void a_ready(const Unit& u) const {
        if (threadIdx.x < 64) {
            const unsigned long long t0 = __builtin_amdgcn_s_memrealtime(); unsigned polls = 0;
            while ((unsigned)__builtin_amdgcn_readfirstlane(__hip_atomic_load(ready + 64 * u.pm, __ATOMIC_RELAXED, __HIP_MEMORY_SCOPE_AGENT)) < need) {
                if ((++polls & 255u) == 0u && __builtin_amdgcn_readfirstlane(__hip_atomic_load(tmo, __ATOMIC_RELAXED, __HIP_MEMORY_SCOPE_AGENT)) != 0u) break;
                if (__builtin_amdgcn_s_memrealtime() - t0 > 2000000ull) {
                    if (threadIdx.x == 0) { unsigned expect = 0u; __hip_atomic_compare_exchange_strong(tmo + 1, &expect, 0x600u | (unsigned)(u.pm & 0xff), __ATOMIC_RELAXED, __ATOMIC_RELAXED, __HIP_MEMORY_SCOPE_AGENT); __hip_atomic_store(tmo, 1u, __ATOMIC_RELAXED, __HIP_MEMORY_SCOPE_AGENT); }
                    break; }
                __builtin_amdgcn_s_sleep(2); }
            __builtin_amdgcn_fence(__ATOMIC_ACQUIRE, "agent");
            asm volatile("s_waitcnt vmcnt(0)" ::: "memory");
        }
#if !defined(BROKEN_HOOK_NO_BARRIER)
        asm volatile("" ::: "memory"); __builtin_amdgcn_s_barrier(); asm volatile("" ::: "memory");
#endif
    }
};

__device__ __forceinline__ unsigned cvt_pk_bf16(float lo, float hi) { unsigned r; asm volatile("v_cvt_pk_bf16_f32 %0, %1, %2" : "=v"(r) : "v"(lo), "v"(hi)); return r; }
typedef float f32x2 __attribute__((ext_vector_type(2)));
__device__ __forceinline__ f32x2 gelu_pk(f32x2 v) {
    const f32x2 av = __builtin_elementwise_abs(v), d = av * 0.2316418882f + 1.0f;
    f32x2 t; t.x = __builtin_amdgcn_rcpf(d.x); t.y = __builtin_amdgcn_rcpf(d.y);
    f32x2 q = t * 0.5307027145f + (-0.7265760135f); q = q * t + 0.7107068705f; q = q * t + (-0.142248368f); q = q * t + 0.127414796f; q = q * t;
    const f32x2 s = (v * v) * (-0.72134752044f);
    f32x2 e; e.x = __builtin_amdgcn_exp2f(s.x); e.y = __builtin_amdgcn_exp2f(s.y);
    const f32x2 m = v * (q * e), r = v - m;
    f32x2 o; o.x = v.x < 0.f ? m.x : r.x; o.y = v.y < 0.f ? m.y : r.y; return o;
}

struct EpiF32 {
    static constexpr bool PERM = false, AFTER_DRAIN = false;
    float* C; int ldc; const float* bias;
    __device__ __forceinline__ void operator()(const f32x4 (&acc)[2][2][4][2], const Unit& u, int wr, int wc, int fr, int fq) const {
        const int row0 = u.pm * BM + wr * 64 + fr, col0 = u.pn * BM + wc * 32 + 4 * fq;
        f32x4 bv[2][2];
#pragma unroll
        for (int bj = 0; bj < 2; ++bj)
#pragma unroll
            for (int n = 0; n < 2; ++n) bv[bj][n] = bias ? *(const f32x4*)(bias + col0 + bj * HALF + n * 16) : (f32x4){0.f, 0.f, 0.f, 0.f};
#pragma unroll
        for (int ai = 0; ai < 2; ++ai)
#pragma unroll
            for (int m = 0; m < 4; ++m) { float* rowp = C + (size_t)(row0 + ai * HALF + m * 16) * ldc + col0;
#pragma unroll
                for (int bj = 0; bj < 2; ++bj)
#pragma unroll
                    for (int n = 0; n < 2; ++n) *(f32x4*)(rowp + bj * HALF + n * 16) = acc[ai][bj][m][n] + bv[bj][n]; }
    }
};
template <int ACT  > struct EpiBf16 {
    static constexpr bool PERM = true, AFTER_DRAIN = false;
    bf16_t* O; int ldc; const float* bias; int split_cols; size_t split_stride;
    __device__ __forceinline__ void operator()(const f32x4 (&acc)[2][2][4][2], const Unit& u, int wr, int wc, int fr, int fq) const {
        const int row0 = u.pm * BM + wr * 64 + fr; int colt = u.pn * BM; bf16_t* base = O;
        if (split_cols) { const int t = colt / split_cols; base += (size_t)t * split_stride; colt -= t * split_cols; }
        const int col0 = colt + wc * 32 + 8 * fq, bcol0 = u.pn * BM + wc * 32 + 8 * fq;
        f32x4 bv[2][2];
#pragma unroll
        for (int bj = 0; bj < 2; ++bj)
#pragma unroll
            for (int n = 0; n < 2; ++n) bv[bj][n] = bias ? *(const f32x4*)(bias + bcol0 + bj * HALF + 4 * n) : (f32x4){0.f, 0.f, 0.f, 0.f};
#pragma unroll
        for (int ai = 0; ai < 2; ++ai)
#pragma unroll
            for (int m = 0; m < 4; ++m) { bf16_t* rowp = base + (size_t)(row0 + ai * HALF + m * 16) * ldc + col0;
#pragma unroll
                for (int bj = 0; bj < 2; ++bj) { f32x4 v0 = acc[ai][bj][m][0] + bv[bj][0], v1 = acc[ai][bj][m][1] + bv[bj][1];
                    if (ACT == 1) { f32x2 a = gelu_pk((f32x2){v0[0], v0[1]}), b = gelu_pk((f32x2){v0[2], v0[3]}), c = gelu_pk((f32x2){v1[0], v1[1]}), d = gelu_pk((f32x2){v1[2], v1[3]});
                        v0 = (f32x4){a.x, a.y, b.x, b.y}; v1 = (f32x4){c.x, c.y, d.x, d.y}; }
                    if (ACT == 2) {
#pragma unroll
                        for (int j = 0; j < 4; ++j) { v0[j] = 0.5f * v0[j] * (1.0f + erff(v0[j] * 0.70710678f)); v1[j] = 0.5f * v1[j] * (1.0f + erff(v1[j] * 0.70710678f)); } }
                    u32x4 w; w.x = cvt_pk_bf16(v0[0], v0[1]); w.y = cvt_pk_bf16(v0[2], v0[3]); w.z = cvt_pk_bf16(v1[0], v1[1]); w.w = cvt_pk_bf16(v1[2], v1[3]);
                    *(u32x4*)(rowp + bj * HALF) = w; } }
    }
};

struct PanelStats {
    unsigned* xbuf;
    unsigned* cnt;
    unsigned* tmo;
    int ntn; float eps;
    unsigned code;
    __device__ __forceinline__ bool run(const f32x4 (&v)[2][2][4][2], const Unit& u, int wr, int wc, int fr, int fq, PG8_LAS unsigned char* lds, int wid, int lane) const {
        typedef float f32x2v __attribute__((ext_vector_type(2)));
        PG8_LAS f32x2v* P = (PG8_LAS f32x2v*)lds;
        PG8_LAS f32x2v* S = (PG8_LAS f32x2v*)(lds + 8192);
        PG8_LAS unsigned* flag = (PG8_LAS unsigned*)(lds + 8192 + 2048);
#pragma unroll
        for (int ai = 0; ai < 2; ++ai)
#pragma unroll
            for (int m = 0; m < 4; ++m) {
                float s = 0.f;
#pragma unroll
                for (int bj = 0; bj < 2; ++bj)
#pragma unroll
                    for (int n = 0; n < 2; ++n) { const f32x4 x = v[ai][bj][m][n]; s += (x[0] + x[1]) + (x[2] + x[3]); }
                s += __shfl_xor(s, 16); s += __shfl_xor(s, 32);
                const float mw = s * (1.0f / 64.0f); float q = 0.f;
#pragma unroll
                for (int bj = 0; bj < 2; ++bj)
#pragma unroll
                    for (int n = 0; n < 2; ++n) { const f32x4 d = v[ai][bj][m][n] - mw; q += (d[0] * d[0] + d[1] * d[1]) + (d[2] * d[2] + d[3] * d[3]); }
                q += __shfl_xor(q, 16); q += __shfl_xor(q, 32);
                if (fq == 0) P[(ai * HALF + wr * 64 + m * 16 + fr) * 4 + wc] = (f32x2v){mw, q};
            }
        asm volatile("s_waitcnt lgkmcnt(0)" ::: "memory"); __builtin_amdgcn_s_barrier(); asm volatile("" ::: "memory");
#if defined(BROKEN_NO_WAIT)
        if (blockIdx.x >= 64) { const long long t0 = clock64(); while (clock64() - t0 < 60000) __builtin_amdgcn_s_sleep(8); }
#endif
        const int row = wid * 32 + (lane & 31);
        if (lane < 32) {
            const f32x2v a = P[row * 4 + 0], b = P[row * 4 + 1], c = P[row * 4 + 2], d = P[row * 4 + 3];
            const float mt = (a.x + b.x + c.x + d.x) * 0.25f;
            const float da = a.x - mt, db = b.x - mt, dc = c.x - mt, dd = d.x - mt;
            const float m2 = (a.y + b.y) + (c.y + d.y) + 64.0f * ((da * da + db * db) + (dc * dc + dd * dd));
            unsigned long long* slot = (unsigned long long*)xbuf + ((size_t)(u.pm * BM + row) * 4 + u.pn);
            __hip_atomic_store(slot, ((unsigned long long)__float_as_uint(m2) << 32) | __float_as_uint(mt), __ATOMIC_RELAXED, __HIP_MEMORY_SCOPE_AGENT);
        }
        asm volatile("s_waitcnt vmcnt(0)" ::: "memory");
        if (lane == 0) __hip_atomic_fetch_add(cnt + 64 * u.pm, 1u, __ATOMIC_RELAXED, __HIP_MEMORY_SCOPE_AGENT);
        if (wid == 0) {
            bool dead = false; const unsigned long long t0 = __builtin_amdgcn_s_memrealtime(); const unsigned want = 8u * (unsigned)ntn;
            for (;;) {
#if defined(BROKEN_NO_WAIT)
                break;
#endif
                if ((unsigned)__builtin_amdgcn_readfirstlane(__hip_atomic_load(cnt + 64 * u.pm, __ATOMIC_RELAXED, __HIP_MEMORY_SCOPE_AGENT)) >= want) break;
                if (__builtin_amdgcn_s_memrealtime() - t0 > 2000000ull) {
                    if (lane == 0) { unsigned expect = 0u; __hip_atomic_compare_exchange_strong(tmo + 1, &expect, code | (unsigned)(u.pm & 0xff), __ATOMIC_RELAXED, __ATOMIC_RELAXED, __HIP_MEMORY_SCOPE_AGENT);
                                     __hip_atomic_store(tmo, 1u, __ATOMIC_RELAXED, __HIP_MEMORY_SCOPE_AGENT); }
                    dead = true; break; }
                __builtin_amdgcn_s_sleep(2);
            }
            __builtin_amdgcn_fence(__ATOMIC_ACQUIRE, "agent");
            if (lane == 0) flag[0] = dead ? 1u : 0u;
        }
        asm volatile("s_waitcnt vmcnt(0) lgkmcnt(0)" ::: "memory"); __builtin_amdgcn_s_barrier(); asm volatile("" ::: "memory");
        const bool bad = flag[0] != 0u;
        if (lane < 32) {
            const unsigned long long* slot = (const unsigned long long*)xbuf + (size_t)(u.pm * BM + row) * 4; float mt[4], m2[4]; float ms = 0.f;
#pragma unroll
            for (int t = 0; t < 4; ++t) { if (t < ntn) { const unsigned long long w = __hip_atomic_load(slot + t, __ATOMIC_RELAXED, __HIP_MEMORY_SCOPE_AGENT); mt[t] = __uint_as_float((unsigned)w); m2[t] = __uint_as_float((unsigned)(w >> 32)); } else { mt[t] = 0.f; m2[t] = 0.f; } ms += mt[t]; }
            const float mean = ms / (float)ntn; float q = 0.f;
#pragma unroll
            for (int t = 0; t < 4; ++t) if (t < ntn) { const float dm = mt[t] - mean; q += m2[t] + 256.0f * dm * dm; }
            S[row] = (f32x2v){mean, 1.0f / sqrtf(q / (256.0f * (float)ntn) + eps)};
        }
        asm volatile("s_waitcnt lgkmcnt(0)" ::: "memory"); __builtin_amdgcn_s_barrier(); asm volatile("" ::: "memory");
        return bad;
    }
};
struct EpiLnRes {
    static constexpr bool PERM = false, AFTER_DRAIN = true;
    const float* base; float* out; int ldc; const float* bias; PanelStats st; unsigned poison;
    __device__ __forceinline__ void refuse(size_t i0, size_t stride, int M, int N) const { const float q = __builtin_nanf(""); for (size_t i = i0; i < (size_t)M * N; i += stride) out[(i / N) * ldc + i % N] = q;
        if (i0 == 0) { unsigned expect = 0u; __hip_atomic_compare_exchange_strong(st.tmo + 1, &expect, 0x7f0u, __ATOMIC_RELAXED, __ATOMIC_RELAXED, __HIP_MEMORY_SCOPE_AGENT); __hip_atomic_store(st.tmo, 1u, __ATOMIC_RELAXED, __HIP_MEMORY_SCOPE_AGENT); } }
    __device__ __forceinline__ void fused(f32x4 (&acc)[2][2][4][2], const Unit& u, int wr, int wc, int fr, int fq, PG8_LAS unsigned char* lds, int wid, int lane) const {
        typedef float f32x2v __attribute__((ext_vector_type(2)));
        const PG8_LAS f32x2v* S = (const PG8_LAS f32x2v*)(lds + 8192);
        const int col0 = u.pn * BM + wc * 32 + 4 * fq;
#pragma unroll
        for (int bj = 0; bj < 2; ++bj)
#pragma unroll
            for (int n = 0; n < 2; ++n) { const f32x4 bv = bias ? *(const f32x4*)(bias + col0 + bj * HALF + n * 16) : (f32x4){0.f, 0.f, 0.f, 0.f};
#pragma unroll
                for (int ai = 0; ai < 2; ++ai)
#pragma unroll
                    for (int m = 0; m < 4; ++m) acc[ai][bj][m][n] += bv; }
        const bool bad = st.run(acc, u, wr, wc, fr, fq, lds, wid, lane) || poison != 0u;
        const float qnan = __builtin_nanf("");
#pragma unroll
        for (int ai = 0; ai < 2; ++ai)
#pragma unroll
            for (int m = 0; m < 4; ++m) { const int r = ai * HALF + wr * 64 + m * 16 + fr; const f32x2v sr = S[r]; const size_t off = (size_t)(u.pm * BM + r) * ldc + col0;
#pragma unroll
                for (int bj = 0; bj < 2; ++bj)
#pragma unroll
                    for (int n = 0; n < 2; ++n) { const f32x4 bs = *(const f32x4*)(base + off + bj * HALF + n * 16); f32x4 o = bs + (acc[ai][bj][m][n] - sr.x) * sr.y;
                        if (bad) o = (f32x4){qnan, qnan, qnan, qnan}; *(f32x4*)(out + off + bj * HALF + n * 16) = o; }
                asm volatile("" ::: "memory"); }
    }
};
struct EpiLnResLn {
    static constexpr bool PERM = false, AFTER_DRAIN = true;
    const float* base; float* out; bf16_t* xn; int ldc; const float* bias; PanelStats st1, st2; unsigned poison;
    __device__ __forceinline__ void refuse(size_t i0, size_t stride, int M, int N) const { const float q = __builtin_nanf(""); for (size_t i = i0; i < (size_t)M * N; i += stride) { const size_t o = (i / N) * ldc + i % N; out[o] = q; xn[o] = (bf16_t)0x7fc0u; }
        if (i0 == 0) { unsigned expect = 0u; __hip_atomic_compare_exchange_strong(st1.tmo + 1, &expect, 0x7f0u, __ATOMIC_RELAXED, __ATOMIC_RELAXED, __HIP_MEMORY_SCOPE_AGENT); __hip_atomic_store(st1.tmo, 1u, __ATOMIC_RELAXED, __HIP_MEMORY_SCOPE_AGENT); } }
    __device__ __forceinline__ void fused(f32x4 (&acc)[2][2][4][2], const Unit& u, int wr, int wc, int fr, int fq, PG8_LAS unsigned char* lds, int wid, int lane) const {
        typedef float f32x2v __attribute__((ext_vector_type(2))); typedef unsigned u32x2v __attribute__((ext_vector_type(2)));
        const PG8_LAS f32x2v* S = (const PG8_LAS f32x2v*)(lds + 8192);
        const int col0 = u.pn * BM + wc * 32 + 4 * fq;
#pragma unroll
        for (int bj = 0; bj < 2; ++bj)
#pragma unroll
            for (int n = 0; n < 2; ++n) { const f32x4 bv = bias ? *(const f32x4*)(bias + col0 + bj * HALF + n * 16) : (f32x4){0.f, 0.f, 0.f, 0.f};
#pragma unroll
                for (int ai = 0; ai < 2; ++ai)
#pragma unroll
                    for (int m = 0; m < 4; ++m) acc[ai][bj][m][n] += bv; }
        bool bad = st1.run(acc, u, wr, wc, fr, fq, lds, wid, lane) || poison != 0u;
        const float qnan = __builtin_nanf("");
#pragma unroll
        for (int ai = 0; ai < 2; ++ai)
#pragma unroll
            for (int m = 0; m < 4; ++m) { const int r = ai * HALF + wr * 64 + m * 16 + fr; const f32x2v sr = S[r]; const size_t off = (size_t)(u.pm * BM + r) * ldc + col0;
#pragma unroll
                for (int bj = 0; bj < 2; ++bj)
#pragma unroll
                    for (int n = 0; n < 2; ++n) { const f32x4 bs = *(const f32x4*)(base + off + bj * HALF + n * 16); acc[ai][bj][m][n] = bs + (acc[ai][bj][m][n] - sr.x) * sr.y; }
                asm volatile("" : "+v"(acc[ai][0][m][0]), "+v"(acc[ai][0][m][1]), "+v"(acc[ai][1][m][0]), "+v"(acc[ai][1][m][1]));
                if (m & 1) asm volatile("" ::: "memory"); }
        const bool bad1 = bad;
        bad = st2.run(acc, u, wr, wc, fr, fq, lds, wid, lane) || bad;
#pragma unroll
        for (int ai = 0; ai < 2; ++ai)
#pragma unroll
            for (int m = 0; m < 4; ++m) { const int r = ai * HALF + wr * 64 + m * 16 + fr; const f32x2v sr = S[r]; const size_t off = (size_t)(u.pm * BM + r) * ldc + col0;
#pragma unroll
                for (int bj = 0; bj < 2; ++bj)
#pragma unroll
                    for (int n = 0; n < 2; ++n) { const f32x4 x1 = acc[ai][bj][m][n]; *(f32x4*)(out + off + bj * HALF + n * 16) = bad1 ? (f32x4){qnan, qnan, qnan, qnan} : x1;
                        const f32x4 o = (x1 - sr.x) * sr.y; u32x2v w; w.x = cvt_pk_bf16(o[0], o[1]); w.y = cvt_pk_bf16(o[2], o[3]);
                        if (bad) { w.x = 0x7fc07fc0u; w.y = 0x7fc07fc0u; } *(u32x2v*)(xn + off + bj * HALF + n * 16) = w; }
                asm volatile("" ::: "memory"); }
    }
};

template <class Epi, class Sched, bool STAMP = false>
__device__ __forceinline__ void gemm_phase(PG8_LAS unsigned char* lds, const Gemm g, const Sched& S, const Epi& E, unsigned long long* stamps) {
    int tid_ = threadIdx.x; asm volatile("" : "+v"(tid_)); const int tid = tid_, wid = __builtin_amdgcn_readfirstlane(tid >> 6), lane = tid & 63, wr = wid >> 2, wc = wid & 3, fr = lane & 15, fq = lane >> 4;
    const int K = g.K, nt = K / BK;
    int ts_lo = 0, ts_hi = 0, nts = 0; const unsigned long long rt_entry = STAMP ? (unsigned long long)wall_clock64() : 0ull;
#define PG8_STAMP() do { if (STAMP && wid == 0 && nts < 64) { const unsigned long long _c = (unsigned long long)clock64(); \
        ts_lo = (lane == nts) ? (int)(unsigned)_c : ts_lo; ts_hi = (lane == nts) ? (int)(unsigned)(_c >> 32) : ts_hi; ++nts; } } while (0)
    PG8_STAMP();
    unsigned voffA[2], voffB[2];
#pragma unroll
    for (int i = 0; i < 2; ++i) { int R, C; stage_rc(tid * 16 + i * 8192, R, C); const int Rb = Epi::PERM ? ((R & ~31) + perm32(R & 31)) : R;
        voffA[i] = (unsigned)(R * K + C) * 2u; voffB[i] = (unsigned)(Rb * K + C) * 2u; }
    const size_t kstep = (size_t)(BK * 2);
    const size_t hstep = (size_t)HALF * K * 2;
    const size_t tstep = 2 * hstep;
    const unsigned ldsw = (unsigned)wid * 1024u;
    const int aoff = lds_byte(wr * 64 + fr, fq * 8), boff = lds_byte(wc * 32 + fr, fq * 8);
#define PG8_SA(b, h) (((b) * 2 + (h)) * HTB)
#define PG8_SB(b, h) ((4 + (b) * 2 + (h)) * HTB)
#define PG8_STAGE(bufoff, gbase, voff) do { _Pragma("unroll") for (int _i = 0; _i < 2; ++_i) \
        __builtin_amdgcn_global_load_lds((const unsigned*)((const char*)(gbase) + (voff)[_i]), (PG8_LAS unsigned*)(lds + (bufoff) + ldsw + _i * 8192), 16, 0, 0); } while (0)
#define PG8_LDA(dst, b, h) do { _Pragma("unroll") for (int m = 0; m < 4; ++m) _Pragma("unroll") for (int k = 0; k < 2; ++k) dst[m][k] = *(const PG8_LAS bf16x8*)(lds + PG8_SA(b, h) + aoff + m * 2048 + k * 1024); } while (0)
#define PG8_LDB(dst, b, h) do { _Pragma("unroll") for (int n = 0; n < 2; ++n) _Pragma("unroll") for (int k = 0; k < 2; ++k) dst[n][k] = *(const PG8_LAS bf16x8*)(lds + PG8_SB(b, h) + boff + n * 2048 + k * 1024); } while (0)
#define PG8_MMA(ai, bj, At, Bt) do { __builtin_amdgcn_s_setprio(1); _Pragma("unroll") for (int m = 0; m < 4; ++m) _Pragma("unroll") for (int n = 0; n < 2; ++n) _Pragma("unroll") for (int k = 0; k < 2; ++k) \
        acc[ai][bj][m][n] = __builtin_amdgcn_mfma_f32_16x16x32_bf16(Bt[n][k], At[m][k], acc[ai][bj][m][n], 0, 0, 0); __builtin_amdgcn_s_setprio(0); } while (0)
#define PG8_WAIT_V(n) asm volatile("s_waitcnt vmcnt(" #n ")" ::: "memory")
#define PG8_WAIT_L(n) asm volatile("s_waitcnt lgkmcnt(" #n ")" ::: "memory")
#define PG8_BAR __builtin_amdgcn_s_barrier()
#define PG8_SCHED __builtin_amdgcn_sched_barrier(0)
    Unit cur, nxt; int ui = 0;
    if (!S.next(0, cur)) return;
    f32x4 acc[2][2][4][2];
#pragma unroll
    for (int a = 0; a < 2; ++a)
#pragma unroll
        for (int b = 0; b < 2; ++b)
#pragma unroll
            for (int m = 0; m < 4; ++m)
#pragma unroll
                for (int n = 0; n < 2; ++n) acc[a][b][m][n] = (f32x4){0.f, 0.f, 0.f, 0.f};
    bf16x8 At[4][2], B0[2][2], B1[2][2];
    const char* cA = (const char*)g.A + (size_t)cur.pm * tstep; const char* cB = (const char*)g.Bt + (size_t)cur.pn * tstep;
    S.a_ready(cur);
    PG8_STAGE(PG8_SB(0, 0), cB, voffB); PG8_STAGE(PG8_SA(0, 0), cA, voffA); PG8_STAGE(PG8_SB(0, 1), cB + hstep, voffB); PG8_STAGE(PG8_SA(0, 1), cA + hstep, voffA);
    if (wr == 1) PG8_BAR;
    PG8_WAIT_V(4); PG8_BAR;
    PG8_STAGE(PG8_SB(1, 0), cB + kstep, voffB); PG8_STAGE(PG8_SA(1, 0), cA + kstep, voffA); PG8_STAGE(PG8_SB(1, 1), cB + hstep + kstep, voffB);
    PG8_WAIT_V(6); PG8_BAR;
    PG8_STAMP();
    for (;;) {
        const bool has_next = S.next(ui + 1, nxt);
        const char* nA = has_next ? (const char*)g.A + (size_t)nxt.pm * tstep : cA; const char* nB = has_next ? (const char*)g.Bt + (size_t)nxt.pn * tstep : cB;
        for (int t = 0; t < nt; t += 2) {
            const bool last = (t == nt - 2);
            const char* a1 = cA + (size_t)(t + 1) * kstep;
            const char* a2 = last ? nA : cA + (size_t)(t + 2) * kstep; const char* b2 = last ? nB : cB + (size_t)(t + 2) * kstep;
            const char* a3 = a2 + kstep; const char* b3 = b2 + kstep;
            if (last && has_next) S.a_ready(nxt);
            PG8_LDB(B0, 0, 0); PG8_SCHED; PG8_LDA(At, 0, 0); PG8_STAGE(PG8_SA(1, 1), a1 + hstep, voffA);
            PG8_WAIT_L(8); PG8_BAR; PG8_WAIT_L(0); PG8_MMA(0, 0, At, B0); PG8_BAR; PG8_SCHED;
            PG8_LDB(B1, 0, 1); PG8_STAGE(PG8_SB(0, 0), b2, voffB);
            PG8_BAR; PG8_WAIT_L(0); PG8_MMA(0, 1, At, B1); PG8_BAR;
            PG8_LDA(At, 0, 1); PG8_STAGE(PG8_SA(0, 0), a2, voffA);
            PG8_BAR; PG8_WAIT_L(0); PG8_MMA(1, 0, At, B0); PG8_BAR; PG8_SCHED;
            PG8_STAGE(PG8_SB(0, 1), b2 + hstep, voffB);
            PG8_WAIT_V(6); PG8_BAR; PG8_MMA(1, 1, At, B1); PG8_BAR;
            PG8_LDB(B0, 1, 0); PG8_SCHED; PG8_LDA(At, 1, 0); PG8_STAGE(PG8_SA(0, 1), a2 + hstep, voffA);
            PG8_WAIT_L(8); PG8_BAR; PG8_WAIT_L(0); PG8_MMA(0, 0, At, B0); PG8_BAR; PG8_SCHED;
            PG8_LDB(B1, 1, 1); PG8_STAGE(PG8_SB(1, 0), b3, voffB);
            PG8_BAR; PG8_WAIT_L(0); PG8_MMA(0, 1, At, B1); PG8_BAR;
            PG8_LDA(At, 1, 1); PG8_STAGE(PG8_SA(1, 0), a3, voffA);
            PG8_BAR; PG8_WAIT_L(0); PG8_MMA(1, 0, At, B0); PG8_BAR; PG8_SCHED;
            PG8_STAGE(PG8_SB(1, 1), b3 + hstep, voffB);
            PG8_WAIT_V(6); PG8_BAR; PG8_MMA(1, 1, At, B1); PG8_BAR;
        }
        PG8_STAMP();
        if constexpr (!Epi::AFTER_DRAIN) { E(acc, cur, wr, wc, fr, fq); S.done(cur); }
        PG8_STAMP();
        if (!has_next) break;
#pragma unroll
        for (int a = 0; a < 2; ++a)
#pragma unroll
            for (int b = 0; b < 2; ++b)
#pragma unroll
                for (int m = 0; m < 4; ++m)
#pragma unroll
                    for (int n = 0; n < 2; ++n) acc[a][b][m][n] = (f32x4){0.f, 0.f, 0.f, 0.f};
        cur = nxt; cA = nA; cB = nB; ++ui;
    }
    PG8_WAIT_V(0);
    if (wr == 0) PG8_BAR;
    PG8_BAR;
    if constexpr (Epi::AFTER_DRAIN) { E.fused(acc, cur, wr, wc, fr, fq, lds, wid, lane); S.done(cur); }
    PG8_STAMP();
    if (STAMP && wid == 0) { stamps[lane] = lane < nts ? (((unsigned long long)(unsigned)ts_hi << 32) | (unsigned)ts_lo) : 0ull;
        if (lane == 62) stamps[62] = rt_entry; if (lane == 63) stamps[63] = (unsigned long long)wall_clock64(); }
#undef PG8_STAMP
#undef PG8_SA
#undef PG8_SB
#undef PG8_STAGE
#undef PG8_LDA
#undef PG8_LDB
#undef PG8_MMA
#undef PG8_WAIT_V
#undef PG8_WAIT_L
#undef PG8_BAR
#undef PG8_SCHED
}
}

__shared__ unsigned g_vsub_cnt[128];
DI void sub_barrier(unsigned* cnt) {
  asm volatile("" ::: "memory");
  unsigned target = 0;
  if ((threadIdx.x & 63) == 0) {
    const unsigned old = __hip_atomic_fetch_add(cnt, 1u, __ATOMIC_RELAXED, __HIP_MEMORY_SCOPE_WORKGROUP);
    target = (old & ~3u) + 4u;
  }
  target = __builtin_amdgcn_readfirstlane(target);
  while (__hip_atomic_load(cnt, __ATOMIC_RELAXED, __HIP_MEMORY_SCOPE_WORKGROUP) < target) __builtin_amdgcn_s_sleep(1);
  asm volatile("" ::: "memory");
}

DI bf16x8 ld16_sum4(const bf16_t* p, size_t slab) {
  union { bf16x8 v; unsigned u[4]; } a, b, c, d, o;
  a.v = ld16(p); b.v = ld16(p + slab); c.v = ld16(p + 2 * slab); d.v = ld16(p + 3 * slab);
#pragma unroll
  for (int i = 0; i < 4; ++i)
    o.u[i] = pk2(lo_bf(a.u[i]) + lo_bf(b.u[i]) + lo_bf(c.u[i]) + lo_bf(d.u[i]), hi_bf(a.u[i]) + hi_bf(b.u[i]) + hi_bf(c.u[i]) + hi_bf(d.u[i]));
  return o.v;
}

template <int NI, bool TR = false, bool PF2 = true, bool ASUM4 = false>
DI void gemm_main(f32x16 (&acc)[2][NI], const bf16_t* Abase, int lda, int akoff, int astep, const bf16_t* Bt, int ldb, int K,
                  bf16_t* sm, int tid, bool act, unsigned* bcnt, size_t aslab = 0) {
  if (!act) return;
  const int lane = tid & 63, wid = tid >> 6, wm = wid >> 1, wn = wid & 1, r = lane & 31, h = lane >> 5;
  const int lrow = tid >> 3, lkc = tid & 7;
  const int aoff0 = lrow * lda + akoff, a32 = 32 * lda;
  const int boff0 = lrow * ldb + lkc * 8, b32 = 32 * ldb;
  const int soff0 = lrow * 64 + ((lkc ^ ((lrow >> 1) & 7)) * 8);
  bf16_t* As = sm;
  bf16_t* Bs = sm + 2 * 8192;
  bf16x8 ra0[4], rb0[2 * NI], ra1[4], rb1[2 * NI];
  const int nk = K >> 6;
#define GM_LOAD(RA, RB, t)                                                                          \
  {                                                                                                 \
    const bf16_t* An_ = Abase + (size_t)(t) * astep;                                                \
    const bf16_t* Bn_ = Bt + (t) * 64;                                                              \
    _Pragma("unroll") for (int i = 0; i < 4; ++i) RA[i] = ASUM4 ? ld16_sum4(An_ + aoff0 + i * a32, aslab) : ld16(An_ + aoff0 + i * a32); \
    _Pragma("unroll") for (int i = 0; i < 2 * NI; ++i) RB[i] = ld16(Bn_ + boff0 + i * b32);         \
  }
#define GM_STORE(RA, RB, buf)                                                                       \
  {                                                                                                 \
    bf16_t* An = As + (buf) * 8192 + soff0;                                                         \
    bf16_t* Bn = Bs + (buf) * 8192 + soff0;                                                         \
    _Pragma("unroll") for (int i = 0; i < 4; ++i) *reinterpret_cast<bf16x8*>(An + i * 2048) = RA[i];        \
    _Pragma("unroll") for (int i = 0; i < 2 * NI; ++i) *reinterpret_cast<bf16x8*>(Bn + i * 2048) = RB[i];   \
  }
#define GM_COMPUTE(buf)                                                                             \
  {                                                                                                 \
    const bf16_t* Ac = As + (buf) * 8192 + ar0 * 64;                                                \
    const bf16_t* Bc = Bs + (buf) * 8192 + br0 * 64;                                                \
    _Pragma("unroll") for (int ks = 0; ks < 4; ++ks) {                                              \
      bf16x8 a[2], b[NI];                                                                           \
      _Pragma("unroll") for (int i = 0; i < 2; ++i)                                                 \
        a[i] = *reinterpret_cast<const bf16x8*>(Ac + i * 2048 + (((ks * 2 + h) ^ asw) * 8));        \
      _Pragma("unroll") for (int i = 0; i < NI; ++i)                                                \
        b[i] = *reinterpret_cast<const bf16x8*>(Bc + i * 2048 + (((ks * 2 + h) ^ bsw) * 8));        \
      _Pragma("unroll") for (int mi = 0; mi < 2; ++mi)                                              \
        _Pragma("unroll") for (int ni = 0; ni < NI; ++ni)                                           \
          acc[mi][ni] = TR ? MFMA32(b[ni], a[mi], acc[mi][ni]) : MFMA32(a[mi], b[ni], acc[mi][ni]); \
    }                                                                                               \
  }
  const int ar0 = wm * 64 + r, br0 = wn * 32 * NI + r;
  const int asw = (ar0 >> 1) & 7, bsw = (br0 >> 1) & 7;
  if (!PF2) {
    GM_LOAD(ra0, rb0, 0)
    GM_STORE(ra0, rb0, 0)
    sub_barrier(bcnt);
    for (int kt = 0; kt < nk; kt += 2) {
      GM_LOAD(ra0, rb0, kt + 1)
      GM_COMPUTE(0)
      GM_STORE(ra0, rb0, 1)
      sub_barrier(bcnt);
      if (kt + 2 < nk) GM_LOAD(ra0, rb0, kt + 2)
      GM_COMPUTE(1)
      if (kt + 2 < nk) GM_STORE(ra0, rb0, 0)
      sub_barrier(bcnt);
    }
    return;
  }
  GM_LOAD(ra0, rb0, 0)
  GM_LOAD(ra1, rb1, 1)
  GM_STORE(ra0, rb0, 0)
  sub_barrier(bcnt);
  for (int kt = 0; kt < nk; kt += 2) {
    if (kt + 2 < nk) GM_LOAD(ra0, rb0, kt + 2)
    GM_COMPUTE(0)
    GM_STORE(ra1, rb1, 1)
    sub_barrier(bcnt);
    if (kt + 3 < nk) GM_LOAD(ra1, rb1, kt + 3)
    GM_COMPUTE(1)
    if (kt + 2 < nk) GM_STORE(ra0, rb0, 0)
    sub_barrier(bcnt);
  }
#undef GM_LOAD
#undef GM_STORE
#undef GM_COMPUTE
}

template <int NI>
DI void zero_acc(f32x16 (&acc)[2][NI]) {
#pragma unroll
  for (int a = 0; a < 2; ++a)
#pragma unroll
    for (int b = 0; b < NI; ++b)
#pragma unroll
      for (int i = 0; i < 16; ++i) acc[a][b][i] = 0.f;
}

DI void sincos_(float x, float* sn, float* cs) {
  float n = rintf(x * 0.63661977236758134f);
  float rr = fmaf(-n, 1.57079625129699707031f, x);
  rr = fmaf(-n, 7.54978941586159635335e-08f, rr);
  float r2 = rr * rr;
  float sp = rr + rr * r2 * (-1.6666654611e-1f + r2 * (8.3321608736e-3f + r2 * (-1.9515295891e-4f)));
  float cp = 1.f + r2 * (-0.5f + r2 * (4.166664568298827e-2f + r2 * (-1.388731625493765e-3f + r2 * 2.443315711809948e-5f)));
  int q = ((int)n) & 3;
  float s_ = (q & 1) ? cp : sp;
  float c_ = (q & 1) ? sp : cp;
  if (q == 1 || q == 2) c_ = -c_;
  if (q >= 2) s_ = -s_;
  *sn = s_;
  *cs = c_;
}

#define VSUB_SETUP                                                                                             \
  const int sub = tid >> 8, vt = tid & 255;                                                                    \
  const int vgrid = gridDim.x * 2, vb = blockIdx.x * 2 + sub;                                                  \
  bf16_t* smv = sm + sub * 32768;                                                                              \
  unsigned* bcnt = g_vsub_cnt + sub * 64;                                                                      \
  const int lane = vt & 63, wid = vt >> 6, wm = wid >> 1, wn = wid & 1, r = lane & 31, h = lane >> 5;          \
  (void)lane; (void)wm; (void)wn; (void)r; (void)h; (void)smv; (void)vgrid; (void)vb; (void)bcnt;

DI void prep_transpose(const float* src, int ld, bf16_t* dst, int K, int k0, int n0, float* tile, int tid) {
  const int nn = tid & 63, kq = tid >> 6;
#pragma unroll 4
  for (int i = 0; i < 8; ++i) {
    int kk = kq + 8 * i;
    tile[kk * 65 + nn] = src[(size_t)(k0 + kk) * ld + n0 + nn];
  }
  __syncthreads();
  {
    int n2 = tid >> 3, kc = tid & 7;
    uint4 w;
    w.x = pk2(tile[(kc * 8 + 0) * 65 + n2], tile[(kc * 8 + 1) * 65 + n2]);
    w.y = pk2(tile[(kc * 8 + 2) * 65 + n2], tile[(kc * 8 + 3) * 65 + n2]);
    w.z = pk2(tile[(kc * 8 + 4) * 65 + n2], tile[(kc * 8 + 5) * 65 + n2]);
    w.w = pk2(tile[(kc * 8 + 6) * 65 + n2], tile[(kc * 8 + 7) * 65 + n2]);
    *reinterpret_cast<uint4*>(dst + (size_t)(n0 + n2) * K + k0 + kc * 8) = w;
  }
  __syncthreads();
}

DI void prep_s5(const Params& p, int L, int g, float* sm, int tid) {
  float* apow = sm;
  float* fco = sm + 2176;
  float* bbar = sm + 2304;
  float* Kt = sm + 4352;
  float* Cl = sm + 12544;
  const size_t gm = (size_t)(L * 32 + g) * 65536;
  for (int d = 0; d < 2; ++d) {
    const int dg = (L * 2 + d) * 32 + g;
    if (tid < 64) {
      const int pp = tid;
      float dt = expf(p.s5_log_dt[dg]);
      float are = p.s5_a_re[dg * 64 + pp], aim = p.s5_a_im[dg * 64 + pp];
      float mag = expf(dt * are);
      float sn, cs;
      sincos_(dt * aim, &sn, &cs);
      float abr = mag * cs, abi = mag * sn;
      float den = are * are + aim * aim;
      float fr = ((abr - 1.f) * are + abi * aim) / den;
      float fi = (abi * are - (abr - 1.f) * aim) / den;
      fco[pp * 2] = fr;
      fco[pp * 2 + 1] = fi;
      float pr = 1.f, pi = 0.f;
      apow[pp * 2] = 1.f;
      apow[pp * 2 + 1] = 0.f;
      for (int t = 1; t <= 16; ++t) {
        float nr = pr * abr - pi * abi, ni = pr * abi + pi * abr;
        pr = nr; pi = ni;
        apow[(t * 64 + pp) * 2] = pr;
        apow[(t * 64 + pp) * 2 + 1] = pi;
      }
      p.A16()[(dg * 64 + pp) * 2] = pr;
      p.A16()[(dg * 64 + pp) * 2 + 1] = pi;
    }
    __syncthreads();
    for (int i = 0; i < 2; ++i) {
      int idx = tid + 512 * i;
      Cl[idx * 2] = p.s5_c_re[(size_t)dg * 1024 + idx];
      Cl[idx * 2 + 1] = p.s5_c_im[(size_t)dg * 1024 + idx];
    }
    for (int i = 0; i < 2; ++i) {
      int idx = tid + 512 * i;
      int pp = idx >> 4;
      float br = p.s5_b_re[(size_t)dg * 1024 + idx], bi = p.s5_b_im[(size_t)dg * 1024 + idx];
      float fr = fco[pp * 2], fi = fco[pp * 2 + 1];
      bbar[idx * 2] = fr * br - fi * bi;
      bbar[idx * 2 + 1] = fr * bi + fi * br;
    }
    __syncthreads();
    {
      const int th = tid >> 8, hp = (tid >> 4) & 15, hh = tid & 15;
      float kacc[8];
#pragma unroll
      for (int t = 0; t < 8; ++t) kacc[t] = 0.f;
      for (int pp = 0; pp < 64; ++pp) {
        float cr = Cl[(hp * 64 + pp) * 2], ci = Cl[(hp * 64 + pp) * 2 + 1];
        float br = bbar[(pp * 16 + hh) * 2], bi = bbar[(pp * 16 + hh) * 2 + 1];
        float xr = cr * br - ci * bi, xi = cr * bi + ci * br;
#pragma unroll
        for (int t = 0; t < 8; ++t)
          kacc[t] += xr * apow[((th * 8 + t) * 64 + pp) * 2] - xi * apow[((th * 8 + t) * 64 + pp) * 2 + 1];
      }
#pragma unroll
      for (int t = 0; t < 8; ++t) Kt[(d * 16 + th * 8 + t) * 256 + (tid & 255)] = kacc[t];
    }
    for (int i = 0; i < 64; ++i) {
      int idx = tid + 512 * i;
      int k = idx & 255, nn = idx >> 8;
      int pp = nn >> 1, ri = nn & 1, j = k >> 4, hh = k & 15;
      int e = (d == 0) ? (15 - j) : j;
      float ar = apow[(e * 64 + pp) * 2], ai = apow[(e * 64 + pp) * 2 + 1];
      float br = bbar[(pp * 16 + hh) * 2], bi = bbar[(pp * 16 + hh) * 2 + 1];
      float v = ri ? (ar * bi + ai * br) : (ar * br - ai * bi);
      p.S5We()[gm + (size_t)(d * 128 + nn) * 256 + k] = f2bf(v);
    }
    for (int i = 0; i < 64; ++i) {
      int idx = tid + 512 * i;
      int kk = idx & 127, n = idx >> 7;
      int pp = kk >> 1, ri = kk & 1, t16 = n >> 4, hp = n & 15;
      int pw = (d == 0) ? (t16 + 1) : (16 - t16);
      float cr = Cl[(hp * 64 + pp) * 2], ci = Cl[(hp * 64 + pp) * 2 + 1];
      float ar = apow[(pw * 64 + pp) * 2], ai = apow[(pw * 64 + pp) * 2 + 1];
      float v = ri ? -(cr * ai + ci * ar) : (cr * ar - ci * ai);
      p.S5R()[gm + (size_t)n * 256 + d * 128 + kk] = f2bf(v);
    }
    __syncthreads();
  }
  const float dval = p.s5_d[(L * 32 + g) * 16 + (tid & 15)];
  for (int i = 0; i < 128; ++i) {
    int idx = tid + 512 * i;
    int k = idx & 255, n = idx >> 8;
    int t16 = n >> 4, hp = n & 15, j = k >> 4, hh = k & 15;
    float v = 0.f;
    if (j <= t16) v += Kt[(0 * 16 + (t16 - j)) * 256 + hp * 16 + hh];
    if (j >= t16) v += Kt[(1 * 16 + (j - t16)) * 256 + hp * 16 + hh];
    if (j == t16 && hp == hh) v += dval;
    p.S5M()[gm + (size_t)n * 256 + k] = f2bf(v);
  }
  __syncthreads();
}

DI void prep_adaln(const Params& p, int L, int cb, float* sm, int tid) {
  float* sv = sm;
  float* red = sm + 3072;
  for (int idx = tid; idx < 3072; idx += 512) {
    int v = idx >> 10, k = idx & 1023;
    float cv = (v < 2) ? p.c[v * 1024 + k] : p.c_ctx[k];
    sv[idx] = siluf_(cv);
  }
  __syncthreads();
  const int cl = tid & 63, kq = tid >> 6, col = cb * 64 + cl;
  float a0 = 0.f, a1 = 0.f, a2 = 0.f;
  const float* w = p.w_ada + (size_t)L * 1024 * 3072 + col;
#pragma unroll 8
  for (int k = kq * 128; k < kq * 128 + 128; ++k) {
    float wv = w[(size_t)k * 3072];
    a0 += sv[k] * wv;
    a1 += sv[1024 + k] * wv;
    a2 += sv[2048 + k] * wv;
  }
  red[(kq * 3 + 0) * 64 + cl] = a0;
  red[(kq * 3 + 1) * 64 + cl] = a1;
  red[(kq * 3 + 2) * 64 + cl] = a2;
  __syncthreads();
  if (kq == 0) {
    float bb = p.b_ada[L * 3072 + col];
    for (int v = 0; v < 3; ++v) {
      float s = 0.f;
      for (int q = 0; q < 8; ++q) s += red[(q * 3 + v) * 64 + cl];
      p.MOD()[(L * 3 + v) * 3072 + col] = s + bb;
    }
  }
  __syncthreads();
}

struct TrDesc { const float* src; bf16_t* dst; int ld, K, k0, n0; };
DI TrDesc tr_decode(const Params& p, int it) {
  constexpr int N_TR_L = 3456;
  const int L = it / N_TR_L, tt = it % N_TR_L;
  TrDesc d;
  int kt, nt;
  if (tt < 2624) {
    kt = tt / 164; nt = tt % 164; d.src = p.w_in + (size_t)L * 1024 * 10496; d.ld = 10496; d.K = 1024;
    d.dst = p.WinT() + (size_t)L * 10496 * 1024;
  } else if (tt < 3136) {
    int t2 = tt - 2624; int kb = t2 / 128; int t3 = t2 % 128; kt = t3 / 16; nt = t3 % 16;
    d.src = p.w_br + (size_t)(L * 4 + kb) * 512 * 1024; d.ld = 1024; d.K = 512;
    d.dst = p.WbrT() + (size_t)(L * 4 + kb) * 1024 * 512;
  } else if (tt < 3392) {
    int t2 = tt - 3136; kt = t2 / 16; nt = t2 % 16; d.src = p.w_out + (size_t)L * 1024 * 1024; d.ld = 1024; d.K = 1024;
    d.dst = p.WoutT() + (size_t)L * 1024 * 1024;
  } else {
    int t2 = tt - 3392; kt = t2 / 8; nt = t2 % 8; d.src = p.s5_w_glu + (size_t)L * 512 * 512; d.ld = 512; d.K = 512;
    d.dst = p.WgluT() + (size_t)L * 512 * 512;
  }
  d.k0 = kt * 64; d.n0 = nt * 64;
  return d;
}

DI void phase_prep(const Params& p, float* sm, int tid) {
  constexpr int N_S5 = 128, N_ADA = 192, N_TR = 4 * 3456;
  constexpr int NPRE = N_S5 + N_ADA + 1;
  for (int item = blockIdx.x; item < NPRE; item += gridDim.x) {
    if (item < N_S5) {
      prep_s5(p, item >> 5, item & 31, sm, tid);
    } else if (item < N_S5 + N_ADA) {
      int it = item - N_S5;
      prep_adaln(p, it / 48, it % 48, sm, tid);
    } else {
      for (int idx = tid; idx < 256 * 16; idx += 512) {
        int pos = idx >> 4, i = idx & 15;
        float inv = exp2f(-(float)i * (13.287712379549449f / 16.f));
        float sn, cs;
        sincos_((float)pos * inv, &sn, &cs);
        p.ROPE()[idx * 2] = cs;
        p.ROPE()[idx * 2 + 1] = sn;
      }
      {
        const int wv = tid >> 6, ln = tid & 63;
        for (int LL = 0; LL < 4; ++LL) {
          float mb = 0.f;
          for (int j = tid; j < 8 * 465; j += 512) mb = fmaxf(mb, fabsf(p.na_rel_bias[LL * 8 * 465 + j]));
#pragma unroll
          for (int o = 32; o >= 1; o >>= 1) mb = fmaxf(mb, __shfl_xor(mb, o));
          if (ln == 0) sm[LL * 8 + wv] = mb;
        }
        __syncthreads();
        {
          const int LL = wv >> 1, ty = wv & 1;
          const float* gq = (ty ? p.gqa_q_g : p.na_q_g) + LL * 64;
          const float* gk = (ty ? p.gqa_k_g : p.na_k_g) + LL * 64;
          float mq = fabsf(gq[ln]), mk = fabsf(gk[ln]);
#pragma unroll
          for (int o = 32; o >= 1; o >>= 1) { mq = fmaxf(mq, __shfl_xor(mq, o)); mk = fmaxf(mk, __shfl_xor(mk, o)); }
          if (ln == 0) {
            float mb = 0.f;
            if (!ty) for (int q = 0; q < 8; ++q) mb = fmaxf(mb, sm[LL * 8 + q]);
            p.ROPE()[8192 + wv] = fminf(8.f * LOG2E * mq * mk + LOG2E * mb, 100.f);
          }
        }
        __syncthreads();
      }
    }
  }
  const int nn = tid & 63, kq = tid >> 6;
  for (int it0 = blockIdx.x; it0 < N_TR; it0 += 4 * gridDim.x) {
    float v[4][8];
#pragma unroll
    for (int u = 0; u < 4; ++u) {
      const int it = it0 + u * gridDim.x;
      if (it < N_TR) {
        const TrDesc d = tr_decode(p, it);
#pragma unroll
        for (int i = 0; i < 8; ++i) v[u][i] = d.src[(size_t)(d.k0 + kq + 8 * i) * d.ld + d.n0 + nn];
      }
    }
#pragma unroll
    for (int u = 0; u < 4; ++u)
#pragma unroll
      for (int i = 0; i < 8; ++i) sm[u * 4160 + (kq + 8 * i) * 65 + nn] = v[u][i];
    __syncthreads();
#pragma unroll
    for (int u = 0; u < 4; ++u) {
      const int it = it0 + u * gridDim.x;
      if (it < N_TR) {
        const TrDesc d = tr_decode(p, it);
        const float* tile = sm + u * 4160;
        const int n2 = tid >> 3, kc = tid & 7;
        uint4 w;
        w.x = pk2(tile[(kc * 8 + 0) * 65 + n2], tile[(kc * 8 + 1) * 65 + n2]);
        w.y = pk2(tile[(kc * 8 + 2) * 65 + n2], tile[(kc * 8 + 3) * 65 + n2]);
        w.z = pk2(tile[(kc * 8 + 4) * 65 + n2], tile[(kc * 8 + 5) * 65 + n2]);
        w.w = pk2(tile[(kc * 8 + 6) * 65 + n2], tile[(kc * 8 + 7) * 65 + n2]);
        *reinterpret_cast<uint4*>(d.dst + (size_t)(d.n0 + n2) * d.K + d.k0 + kc * 8) = w;
      }
    }
    __syncthreads();
  }
}

DI void phase_norm(const Params& p, int b, int L, int tid) {
  const int wid = tid >> 6, lane = tid & 63;
  const float* g = p.norm_g + L * 1024;
  for (int item = blockIdx.x; item < R / 8; item += gridDim.x) {
    const int row = item * 8 + wid;
    const float* src;
    const float* mod;
    if (row < NLAT) {
      src = (L == 0 ? p.x : (const float*)p.out) + ((size_t)b * NLAT + row) * 1024;
      mod = p.MOD() + (L * 3 + b) * 3072;
    } else {
      src = (L == 0 ? p.ctx : (const float*)p.CTXS()) + ((size_t)b * 256 + (row - NLAT)) * 1024;
      mod = p.MOD() + (L * 3 + 2) * 3072;
    }
    float4 v[4];
    float ss = 0.f;
#pragma unroll
    for (int j = 0; j < 4; ++j) {
      v[j] = *reinterpret_cast<const float4*>(src + j * 256 + lane * 4);
      ss += v[j].x * v[j].x + v[j].y * v[j].y + v[j].z * v[j].z + v[j].w * v[j].w;
    }
#pragma unroll
    for (int o = 32; o >= 1; o >>= 1) ss += __shfl_xor(ss, o);
    const float rs = rsqrtf(ss * (1.f / 1024.f) + 1e-6f);
#pragma unroll
    for (int j = 0; j < 4; ++j) {
      const int col = j * 256 + lane * 4;
      float4 g4 = *reinterpret_cast<const float4*>(g + col);
      float4 sh = *reinterpret_cast<const float4*>(mod + col);
      float4 sc = *reinterpret_cast<const float4*>(mod + 1024 + col);
      float y0 = v[j].x * rs * g4.x * (1.f + sc.x) + sh.x;
      float y1 = v[j].y * rs * g4.y * (1.f + sc.y) + sh.y;
      float y2 = v[j].z * rs * g4.z * (1.f + sc.z) + sh.z;
      float y3 = v[j].w * rs * g4.w * (1.f + sc.w) + sh.w;
      uint2 w;
      w.x = pk2(y0, y1);
      w.y = pk2(y2, y3);
      *reinterpret_cast<uint2*>(p.H() + (size_t)row * 1024 + col) = w;
    }
  }
}

struct EpiGlu {
  static constexpr bool PERM = true, AFTER_DRAIN = false;
  const bf16_t* Y; bf16_t* Zg;
  DI void operator()(const pg8::f32x4 (&acc)[2][2][4][2], const pg8::Unit& u, int wr, int wc, int fr, int fq) const {
    const int row0 = u.pm * 256 + wr * 64 + fr, col0 = u.pn * 256 + wc * 32 + 8 * fq;
#pragma unroll
    for (int ai = 0; ai < 2; ++ai)
#pragma unroll
      for (int mh = 0; mh < 2; ++mh) {
        uint4 yv[4], gv[4];
#pragma unroll
        for (int q = 0; q < 4; ++q) {
          const int m = mh * 2 + (q >> 1), bj = q & 1;
          const int row = row0 + ai * 128 + m * 16, col = col0 + bj * 128;
          yv[q] = *reinterpret_cast<const uint4*>(Y + (size_t)row * 512 + col);
          gv[q] = *reinterpret_cast<const uint4*>(Zg + (size_t)row * LDZ + col);
        }
#pragma unroll
        for (int q = 0; q < 4; ++q) {
          const int m = mh * 2 + (q >> 1), bj = q & 1;
          const int row = row0 + ai * 128 + m * 16, col = col0 + bj * 128;
          const pg8::f32x4 a0 = acc[ai][bj][m][0], a1 = acc[ai][bj][m][1];
          uint4 w;
          w.x = pk2(lo_bf(yv[q].x) * sigmoidf_(a0[0]) * siluf_(lo_bf(gv[q].x)), hi_bf(yv[q].x) * sigmoidf_(a0[1]) * siluf_(hi_bf(gv[q].x)));
          w.y = pk2(lo_bf(yv[q].y) * sigmoidf_(a0[2]) * siluf_(lo_bf(gv[q].y)), hi_bf(yv[q].y) * sigmoidf_(a0[3]) * siluf_(hi_bf(gv[q].y)));
          w.z = pk2(lo_bf(yv[q].z) * sigmoidf_(a1[0]) * siluf_(lo_bf(gv[q].z)), hi_bf(yv[q].z) * sigmoidf_(a1[1]) * siluf_(hi_bf(gv[q].z)));
          w.w = pk2(lo_bf(yv[q].w) * sigmoidf_(a1[2]) * siluf_(lo_bf(gv[q].w)), hi_bf(yv[q].w) * sigmoidf_(a1[3]) * siluf_(hi_bf(gv[q].w)));
          *reinterpret_cast<uint4*>(Zg + (size_t)row * LDZ + col) = w;
        }
        asm volatile("" ::: "memory");
      }
  }
};
struct EpiOutRes {
  static constexpr bool PERM = false, AFTER_DRAIN = false;
  const float* src; float* dst; const float* gate;
  DI void operator()(const pg8::f32x4 (&acc)[2][2][4][2], const pg8::Unit& u, int wr, int wc, int fr, int fq) const {
    const int row0 = u.pm * 256 + wr * 64 + fr, col0 = u.pn * 256 + wc * 32 + 4 * fq;
    pg8::f32x4 gv[2][2];
#pragma unroll
    for (int bj = 0; bj < 2; ++bj)
#pragma unroll
      for (int n = 0; n < 2; ++n) gv[bj][n] = *reinterpret_cast<const pg8::f32x4*>(gate + col0 + bj * 128 + n * 16);
#pragma unroll
    for (int ai = 0; ai < 2; ++ai)
#pragma unroll
      for (int mh = 0; mh < 2; ++mh) {
        pg8::f32x4 xv[8];
#pragma unroll
        for (int q = 0; q < 8; ++q) {
          const int m = mh * 2 + (q >> 2), bj = (q >> 1) & 1, n = q & 1;
          xv[q] = *reinterpret_cast<const pg8::f32x4*>(src + (size_t)(row0 + ai * 128 + m * 16) * 1024 + col0 + bj * 128 + n * 16);
        }
#pragma unroll
        for (int q = 0; q < 8; ++q) {
          const int m = mh * 2 + (q >> 2), bj = (q >> 1) & 1, n = q & 1;
          *reinterpret_cast<pg8::f32x4*>(dst + (size_t)(row0 + ai * 128 + m * 16) * 1024 + col0 + bj * 128 + n * 16) =
              xv[q] + gv[bj][n] * acc[ai][bj][m][n];
        }
        asm volatile("" ::: "memory");
      }
  }
};

#define LDS3(ptr) ((__attribute__((address_space(3))) unsigned char*)(ptr))

typedef unsigned u32x4_t __attribute__((ext_vector_type(4)));
typedef unsigned u32x2_t __attribute__((ext_vector_type(2)));
struct EpiP1 {
  static constexpr bool PERM = true, AFTER_DRAIN = false;
  bf16_t* Zp; bf16_t* SGp;
  DI void operator()(const pg8::f32x4 (&acc)[2][2][4][2], const pg8::Unit& u, int wr, int wc, int fr, int fq) const {
    const int row0 = u.pm * 256 + wr * 64 + fr;
    const int colt = u.pn * 256;
    const int col0 = wc * 32 + 8 * fq;
    if (colt < ZCOLS) {
#pragma unroll
      for (int ai = 0; ai < 2; ++ai)
#pragma unroll
        for (int m = 0; m < 4; ++m) {
          bf16_t* rowp = Zp + (size_t)(row0 + ai * 128 + m * 16) * LDZ + colt + col0;
#pragma unroll
          for (int bj = 0; bj < 2; ++bj) {
            const pg8::f32x4 v0 = acc[ai][bj][m][0], v1 = acc[ai][bj][m][1];
            u32x4_t w4 = {pk2(v0[0], v0[1]), pk2(v0[2], v0[3]), pk2(v1[0], v1[1]), pk2(v1[2], v1[3])};
            __builtin_nontemporal_store(w4, reinterpret_cast<u32x4_t*>(rowp + bj * 128));
          }
        }
    } else {
      const int gcol0 = colt - ZCOLS + col0;
#pragma unroll
      for (int ai = 0; ai < 2; ++ai)
#pragma unroll
        for (int m = 0; m < 4; ++m) {
          const int row = row0 + ai * 128 + m * 16;
#pragma unroll
          for (int bj = 0; bj < 2; ++bj) {
            const pg8::f32x4 v0 = acc[ai][bj][m][0], v1 = acc[ai][bj][m][1];
            u32x2_t w0v = {pk2(sigmoidf_(v0[0]), sigmoidf_(v0[1])), pk2(sigmoidf_(v0[2]), sigmoidf_(v0[3]))};
            u32x2_t w1v = {pk2(sigmoidf_(v1[0]), sigmoidf_(v1[1])), pk2(sigmoidf_(v1[2]), sigmoidf_(v1[3]))};
            bf16_t* q0 = SGp + sg_index(row, gcol0 + bj * 128);
            __builtin_nontemporal_store(w0v, reinterpret_cast<u32x2_t*>(q0));
            __builtin_nontemporal_store(w1v, reinterpret_cast<u32x2_t*>(q0 + 128));
          }
        }
    }
  }
};
constexpr int P1_UNITS_Z = 65 * 25, P1_UNITS_ALL = 65 * 41, P1_UNITS_MAIN = 2560, GLU_UNITS = 65 * 2;
struct P1Order {
  int lo, hi, G, c;
  DI static void map_unit(int wgid, int nM, int nN, pg8::Unit& u) {
    const int nwg = nM * nN;
    { const int q = nwg / pg8::NXCD, r = nwg % pg8::NXCD, xcd = wgid % pg8::NXCD, off = wgid / pg8::NXCD;
      wgid = (xcd < r ? xcd * (q + 1) : r * (q + 1) + (xcd - r) * q) + off; }
    const int nig = pg8::WGM * nN, gid = wgid / nig, fm = gid * pg8::WGM, gsz = (nM - fm) < pg8::WGM ? (nM - fm) : pg8::WGM;
    u.pm = fm + ((wgid % nig) % gsz); u.pn = (wgid % nig) / gsz;
  }
  DI bool next(int i, pg8::Unit& u) const {
    const int idx = lo + i * G + c;
    if (idx >= hi) return false;
    if (idx < P1_UNITS_Z) map_unit(idx, 65, 25, u);
    else { map_unit(idx - P1_UNITS_Z, 65, 16, u); u.pn += 25; }
    return true;
  }
  DI void a_ready(const pg8::Unit&) const {}
  DI void done(const pg8::Unit&) const {}
  DI int lda(const pg8::Gemm& g) const { return g.K; }
  DI const char* abase(const pg8::Gemm& g, const pg8::Unit& u) const { return (const char*)g.A + (size_t)u.pm * (size_t)pg8::BM * g.K * 2; }
  DI const char* bbase(const pg8::Gemm& g, const pg8::Unit& u) const { return (const char*)g.Bt + (size_t)u.pn * (size_t)pg8::BM * g.K * 2; }
};
DI bool p1_deferral() { return gridDim.x >= (unsigned)(GLU_UNITS + (P1_UNITS_ALL - P1_UNITS_MAIN)); }
DI void phase_p1(const Params& p, int b, int L, unsigned char* smraw) {
  P1Order S{0, p1_deferral() ? P1_UNITS_MAIN : P1_UNITS_ALL, (int)gridDim.x, (int)blockIdx.x};
  pg8::Gemm g{p.H(), p.WinT() + (size_t)L * 10496 * 1024, R, 10496, 1024};
  EpiP1 E{p.Z(), p.SG()};
  pg8::gemm_phase<EpiP1, P1Order, false>(LDS3(smraw), g, S, E, nullptr);
}

DI void post_item(const Params& p, int L, int rb, int slot, int lane) {
  int col; const float* gvec = nullptr; float mult = 1.f; bool rope = false; bf16_t* vt = nullptr;
  const bool latent = (rb * 64) < NLAT;
  if (slot < 8) { col = C_NQ + slot * 64; gvec = p.na_q_g + L * 64; mult = 0.125f * LOG2E; }
  else if (slot < 16) { col = C_NK + (slot - 8) * 64; gvec = p.na_k_g + L * 64; }
  else if (slot < 24) { col = C_GQ + (slot - 16) * 64; gvec = p.gqa_q_g + L * 64; mult = 0.125f * LOG2E; rope = latent; }
  else if (slot < 26) { col = C_GK + (slot - 24) * 64; gvec = p.gqa_k_g + L * 64; rope = latent; }
  else if (slot < 34) { col = C_NV + (slot - 26) * 64; vt = p.VtN() + (size_t)((slot - 26) * 64) * LDT; }
  else { col = C_GV + (slot - 34) * 64; vt = p.VtG() + (size_t)((slot - 34) * 64) * LDT; }
  if (vt) {
    const int row = rb * 64 + lane;
    const bf16_t* zp = p.Z() + (size_t)row * LDZ + col;
    uint4 raw[8];
#pragma unroll
    for (int j = 0; j < 8; ++j) raw[j] = *reinterpret_cast<const uint4*>(zp + j * 8);
    const int prow = (row & ~12) | ((row & 4) << 1) | ((row & 8) >> 1);
#pragma unroll
    for (int j = 0; j < 8; ++j) {
      const unsigned w[4] = {raw[j].x, raw[j].y, raw[j].z, raw[j].w};
#pragma unroll
      for (int q = 0; q < 4; ++q) {
        vt[(size_t)(j * 8 + q * 2) * LDT + prow] = (bf16_t)(w[q] & 0xffffu);
        vt[(size_t)(j * 8 + q * 2 + 1) * LDT + prow] = (bf16_t)(w[q] >> 16);
      }
    }
    return;
  }
  const int c = lane & 7, rsub = lane >> 3;
  float gv[8];
#pragma unroll
  for (int e = 0; e < 8; ++e) gv[e] = gvec[c * 8 + e] * mult;
  uint4 rawv[8];
#pragma unroll
  for (int ps = 0; ps < 8; ++ps)
    rawv[ps] = *reinterpret_cast<const uint4*>(p.Z() + (size_t)(rb * 64 + ps * 8 + rsub) * LDZ + col + c * 8);
#pragma unroll
  for (int ps = 0; ps < 8; ++ps) {
    const int row = rb * 64 + ps * 8 + rsub;
    bf16_t* zp = p.Z() + (size_t)row * LDZ + col + c * 8;
    const uint4 raw = rawv[ps];
    float x[8] = {lo_bf(raw.x), hi_bf(raw.x), lo_bf(raw.y), hi_bf(raw.y), lo_bf(raw.z), hi_bf(raw.z), lo_bf(raw.w), hi_bf(raw.w)};
    float ss = 0.f;
#pragma unroll
    for (int e = 0; e < 8; ++e) ss += x[e] * x[e];
    ss += __shfl_xor(ss, 1);
    ss += __shfl_xor(ss, 2);
    ss += __shfl_xor(ss, 4);
    const float rs = rsqrtf(ss * (1.f / 64.f) + 1e-6f);
#pragma unroll
    for (int e = 0; e < 8; ++e) x[e] = x[e] * rs * gv[e];
    if (rope) {
      const int pos = ((c & 3) < 2) ? (row >> 6) : (row & 63);
      const float* rt = p.ROPE() + (size_t)pos * 32 + ((c & 1) * 8) * 2;
#pragma unroll
      for (int e = 0; e < 8; ++e) {
        const float other = __shfl_xor(x[e], 4);
        const float cs = rt[e * 2], sn = rt[e * 2 + 1];
        x[e] = (c < 4) ? (x[e] * cs - other * sn) : (x[e] * cs + other * sn);
      }
    }
    uint4 w;
    w.x = pk2(x[0], x[1]); w.y = pk2(x[2], x[3]); w.z = pk2(x[4], x[5]); w.w = pk2(x[6], x[7]);
    *reinterpret_cast<uint4*>(zp) = w;
  }
}

DI void phase_s5e_conv_post(const Params& p, int b, int L, bf16_t* sm, int tid) {
  {
    VSUB_SETUP
    constexpr int NT_E = 32 * 9 * 2;
    const int nit = (NT_E + vgrid - 1) / vgrid;
    for (int it = 0; it < nit; ++it) {
      int item = it * vgrid + vb;
      const bool act = item < NT_E;
      if (!act) item = NT_E - 1;
      const int g = item / 18, rem = item % 18, mt = rem >> 1, nt = rem & 1;
      const int m0 = mt * 128, n0 = nt * 128;
      f32x16 acc[2][2];
      zero_acc<2>(acc);
      const bf16_t* Ub = p.Z() + C_S5U + g * 16;
      gemm_main<2>(acc, Ub + (size_t)m0 * 16 * LDZ, 16 * LDZ, ((vt & 7) >> 1) * LDZ + (vt & 1) * 8, 4 * LDZ,
                   p.S5We() + (size_t)(L * 32 + g) * 65536 + (size_t)n0 * 256, 256, 256, smv, vt, act, bcnt);
      if (act) {
#pragma unroll
        for (int mi = 0; mi < 2; ++mi)
#pragma unroll
          for (int ni = 0; ni < 2; ++ni)
#pragma unroll
            for (int i = 0; i < 16; ++i) {
              int m = m0 + wm * 64 + mi * 32 + crow(i, h);
              int n = n0 + wn * 64 + ni * 32 + r;
              if (m < NCH) p.E()[((size_t)m * 32 + g) * 256 + n] = acc[mi][ni][i];
            }
      }
    }
  }
  constexpr int NT_C = R * 64 / 512;
  constexpr int NT_P = 260 * 36 / 8;
  for (int item = blockIdx.x; item < NT_C + NT_P; item += gridDim.x) {
    if (item >= NT_C) {
      const int w = (item - NT_C) * 8 + (tid >> 6);
      post_item(p, L, w / 36, w % 36, tid & 63);
      continue;
    }
    const int idx = item * 512 + tid;
    const int row = idx >> 6, ch = (idx & 63) * 8;
    const int lo = (row < NLAT) ? 0 : NLAT, hi = (row < NLAT) ? (NLAT - 1) : (R - 1);
    const bf16_t* zr = p.Z() + (size_t)row * LDZ;
    float zz[3][8];
#pragma unroll
    for (int t = 0; t < 3; ++t) {
      int rr = row + t - 1;
      if (rr >= lo && rr <= hi) {
        uint4 cv = *reinterpret_cast<const uint4*>(p.Z() + (size_t)rr * LDZ + C_CV + ch);
        uint4 cc = *reinterpret_cast<const uint4*>(p.Z() + (size_t)rr * LDZ + C_CC + ch);
        zz[t][0] = lo_bf(cv.x) * lo_bf(cc.x); zz[t][1] = hi_bf(cv.x) * hi_bf(cc.x);
        zz[t][2] = lo_bf(cv.y) * lo_bf(cc.y); zz[t][3] = hi_bf(cv.y) * hi_bf(cc.y);
        zz[t][4] = lo_bf(cv.z) * lo_bf(cc.z); zz[t][5] = hi_bf(cv.z) * hi_bf(cc.z);
        zz[t][6] = lo_bf(cv.w) * lo_bf(cc.w); zz[t][7] = hi_bf(cv.w) * hi_bf(cc.w);
      } else {
#pragma unroll
        for (int j = 0; j < 8; ++j) zz[t][j] = 0.f;
      }
    }
    uint4 cb = *reinterpret_cast<const uint4*>(zr + C_CB + ch);
    uint4 cg_ = *reinterpret_cast<const uint4*>(zr + C_CG + ch);
    float bv[8] = {lo_bf(cb.x), hi_bf(cb.x), lo_bf(cb.y), hi_bf(cb.y), lo_bf(cb.z), hi_bf(cb.z), lo_bf(cb.w), hi_bf(cb.w)};
    float gv[8] = {lo_bf(cg_.x), hi_bf(cg_.x), lo_bf(cg_.y), hi_bf(cg_.y), lo_bf(cg_.z), hi_bf(cg_.z), lo_bf(cg_.w), hi_bf(cg_.w)};
    float o[8];
#pragma unroll
    for (int j = 0; j < 8; ++j) {
      float y = p.conv_b[L * 512 + ch + j] + zz[0][j] * p.conv_w[(L * 3 + 0) * 512 + ch + j] +
                zz[1][j] * p.conv_w[(L * 3 + 1) * 512 + ch + j] + zz[2][j] * p.conv_w[(L * 3 + 2) * 512 + ch + j];
      o[j] = bv[j] * y * siluf_(gv[j]);
    }
    uint4 w;
    w.x = pk2(o[0], o[1]); w.y = pk2(o[2], o[3]); w.z = pk2(o[4], o[5]); w.w = pk2(o[6], o[7]);
    *reinterpret_cast<uint4*>(p.Z() + (size_t)row * LDZ + C_CG + ch) = w;
  }
}

DI void phase_s5y(const Params& p, int b, int L, bf16_t* sm, int tid) {
  VSUB_SETUP
  constexpr int NT = 32 * 18;
  const int nit = (NT + vgrid - 1) / vgrid;
  for (int it = 0; it < nit; ++it) {
    int item = it * vgrid + vb;
    const bool act = item < NT;
    if (!act) item = NT - 1;
    const int g = item / 18, rem = item % 18, mt = rem >> 1, nt = rem & 1;
    const int m0 = mt * 128, n0 = nt * 128;
    f32x16 acc[2][2];
    zero_acc<2>(acc);
    const bf16_t* Ub = p.Z() + C_S5U + g * 16;
    gemm_main<2>(acc, Ub + (size_t)m0 * 16 * LDZ, 16 * LDZ, ((vt & 7) >> 1) * LDZ + (vt & 1) * 8, 4 * LDZ,
                 p.S5M() + (size_t)(L * 32 + g) * 65536 + (size_t)n0 * 256, 256, 256, smv, vt, act, bcnt);
    const bf16_t* Hb = p.HIN() + g * 256;
    gemm_main<2>(acc, Hb + (size_t)m0 * 8192, 8192, (vt & 7) * 8, 64,
                 p.S5R() + (size_t)(L * 32 + g) * 65536 + (size_t)n0 * 256, 256, 256, smv, vt, act, bcnt);
    if (act) {
#pragma unroll
      for (int mi = 0; mi < 2; ++mi)
#pragma unroll
        for (int ni = 0; ni < 2; ++ni)
#pragma unroll
          for (int i = 0; i < 16; ++i) {
            int m = m0 + wm * 64 + mi * 32 + crow(i, h);
            int n = n0 + wn * 64 + ni * 32 + r;
            if (m < NCH) {
              float y = acc[mi][ni][i];
              float z = 1.5957691216057308f * (y + 0.044715f * y * y * y);
              y = y * sigmoidf_(z);
              p.Y()[(size_t)(m * 16 + (n >> 4)) * 512 + g * 16 + (n & 15)] = f2bf(y);
            }
          }
    }
  }
}

DI void phase_glu(const Params& p, int b, int L, unsigned char* smraw) {
  if (p1_deferral() && blockIdx.x >= (unsigned)GLU_UNITS) {
    P1Order S{P1_UNITS_MAIN, P1_UNITS_ALL, (int)gridDim.x - GLU_UNITS, (int)blockIdx.x - GLU_UNITS};
    pg8::Gemm g{p.H(), p.WinT() + (size_t)L * 10496 * 1024, R, 10496, 1024};
    EpiP1 E{p.Z(), p.SG()};
    pg8::gemm_phase<EpiP1, P1Order, false>(LDS3(smraw), g, S, E, nullptr);
    return;
  }
  pg8::StaticOrder S;
  S.init(R, 512, gridDim.x, blockIdx.x);
  pg8::Gemm g{p.Y(), p.WgluT() + (size_t)L * 512 * 512, R, 512, 512};
  EpiGlu E{p.Y(), p.Z() + C_S5G};
  pg8::gemm_phase<EpiGlu, pg8::StaticOrder, false>(LDS3(smraw), g, S, E, nullptr);
}

DI void attn_item(const Params& p, int L, int mode, int head, int q_row0, int na_r, const float* bias_s, bf16_t* wl, int lane) {
  const int r = lane & 31, h = lane >> 5;
  int qcol, kcol, gcol;
  const bf16_t* vt;
  if (mode == 0 || mode == 2) {
    qcol = C_NQ + head * 64; kcol = C_NK + head * 64; gcol = C_NG + head * 64;
    vt = p.VtN() + (size_t)(head * 64) * LDT;
  } else {
    qcol = C_GQ + head * 64; kcol = C_GK + (head >> 2) * 64; gcol = C_GG + head * 64;
    vt = p.VtG() + (size_t)((head >> 2) * 64) * LDT;
  }
  bf16_t* Ql = wl + 4096 + lane * 8;
  {
    const bf16_t* qp = p.Z() + (size_t)(q_row0 + r) * LDZ + qcol + h * 8;
#pragma unroll
    for (int ks = 0; ks < 4; ++ks) {
      *reinterpret_cast<bf16x8*>(Ql + ks * 512) = ld16(qp + (size_t)32 * LDZ + ks * 16);
      *reinterpret_cast<bf16x8*>(Ql + 2048 + ks * 512) = ld16(qp + ks * 16);
    }
  }
  float la = 0.f, lb = 0.f;
  const float shf = p.ROPE()[8192 + L * 2 + ((mode == 0 || mode == 2) ? 0 : 1)];
  f32x16 OA0, OA1, OB0, OB1;
#pragma unroll
  for (int i = 0; i < 16; ++i) { OA0[i] = 0.f; OA1[i] = 0.f; OB0[i] = 0.f; OB1[i] = 0.f; }
  const int rs = min(max(na_r - 4, 0), 256 - 8);
  const int csA = min(max(r - 8, 0), 48), csB = min(max(r + 24, 0), 48);
  int kt_lo = 0, nband = 0;
  if (mode == 0) nband = 16;
  else if (mode == 1) {
    kt_lo = max(0, (128 - q_row0) >> 5);
    int kt_hi = min(10, (NLAT - q_row0 + 128) >> 5);
    nband = kt_hi - kt_lo;
  }
  const int ntiles = 8 + nband;
  auto tile_row = [&](int j) -> int {
    if (j < 8) return NLAT + j * 32;
    const int kt = kt_lo + j - 8;
    if (mode == 0) return (rs + (kt >> 1)) * 64 + (kt & 1) * 32;
    return q_row0 - 128 + kt * 32;
  };
  const bf16_t* kg = p.Z() + (size_t)(lane >> 3) * LDZ + kcol + (lane & 7) * 8;
  const bf16_t* vg = vt + (size_t)(lane >> 2) * LDT + (lane & 3) * 8;
  bf16_t* Kl = wl;
  bf16_t* Vl = wl + 2048;
  const int kstE = (lane >> 3) * 64 + (((lane & 7) ^ ((lane >> 4) & 7)) * 8);
  const int kstO = ((lane >> 3) + 8) * 64 + (((lane & 7) ^ (((lane >> 4) + 4) & 7)) * 8);
  const int vst0 = (lane >> 2) * 32 + (((lane & 3) ^ ((lane >> 4) & 3)) * 8);
#define KST(i) ((((i) & 1) ? kstO : kstE) + ((i) >> 1) * 1024)
#define VST(i) (vst0 + (i) * 512)
  const int krd = r * 64, ksw = (r >> 1) & 7;
  const int vrd0 = r * 32, vrd1 = (32 + r) * 32, vsw = (r >> 2) & 3;
  bf16x8 rk[4], rv[4];
  {
    const int t0r = tile_row(0);
#pragma unroll
    for (int i = 0; i < 4; ++i) {
      rk[i] = ld16(kg + (size_t)(t0r + 8 * i) * LDZ);
      rv[i] = ld16(vg + (size_t)(16 * i) * LDT + t0r);
    }
#pragma unroll
    for (int i = 0; i < 4; ++i) {
      *reinterpret_cast<bf16x8*>(Kl + KST(i)) = rk[i];
      *reinterpret_cast<bf16x8*>(Vl + VST(i)) = rv[i];
    }
  }
  for (int j = 0; j < ntiles; ++j) {
    const int krow0 = tile_row(j);
    const bool more = (j + 1 < ntiles);
    if (more) {
      const int tn = tile_row(j + 1);
#pragma unroll
      for (int i = 0; i < 4; ++i) {
        rk[i] = ld16(kg + (size_t)(tn + 8 * i) * LDZ);
        rv[i] = ld16(vg + (size_t)(16 * i) * LDT + tn);
      }
    }
    f32x16 SA, SB;
#pragma unroll
    for (int i = 0; i < 16; ++i) { SA[i] = -shf; SB[i] = -shf; }
#pragma unroll
    for (int ks = 0; ks < 4; ++ks) {
      bf16x8 kf = *reinterpret_cast<const bf16x8*>(Kl + krd + (((ks * 2 + h) ^ ksw) * 8));
      SA = MFMA32(kf, *reinterpret_cast<const bf16x8*>(Ql + 2048 + ks * 512), SA);
      SB = MFMA32(kf, *reinterpret_cast<const bf16x8*>(Ql + ks * 512), SB);
    }
    union { bf16x8 v; unsigned u[4]; } pa0, pa1, pb0, pb1;
#define SOFTMAX_TILE(S_, cs_, qoff_, lsum_, p0_, p1_)                                                      \
    {                                                                                                      \
      if (j >= 8 && mode == 0) {                                                                           \
        const int kt = j - 8;                                                                              \
        const int kcb = (kt & 1) * 32;                                                                     \
        const int di = rs + (kt >> 1) - na_r + 7;                                                          \
        const float* brow = bias_s + 64 + head * 465 + di * 31 + (kcb + 4 * h - (r + qoff_) + 15);        \
        const int t0 = kcb + 4 * h - cs_;                                                                  \
        _Pragma("unroll") for (int i = 0; i < 16; ++i) {                                                   \
          const int ci = (i & 3) + 8 * (i >> 2);                                                           \
          S_[i] = ((unsigned)(t0 + ci) < 16u) ? (S_[i] + brow[ci]) : -INFINITY;                            \
        }                                                                                                  \
      } else if (j >= 8) {                                                                                 \
        const int d0 = krow0 + 4 * h - (q_row0 + qoff_ + r);                                               \
        _Pragma("unroll") for (int i = 0; i < 16; ++i) {                                                   \
          const int df = d0 + (i & 3) + 8 * (i >> 2);                                                      \
          S_[i] = (df <= 128 && df >= -128) ? S_[i] : -INFINITY;                                           \
        }                                                                                                  \
      }                                                                                                    \
      float rsum = 0.f;                                                                                    \
      _Pragma("unroll") for (int i = 0; i < 16; ++i) {                                                     \
        float pv = __builtin_amdgcn_exp2f(S_[i]);                                                          \
        S_[i] = pv;                                                                                        \
        rsum += pv;                                                                                        \
      }                                                                                                    \
      lsum_ += rsum;                                                                                       \
      _Pragma("unroll") for (int q = 0; q < 4; ++q) {                                                      \
        p0_.u[q] = pk2(S_[2 * q], S_[2 * q + 1]);                                                          \
        p1_.u[q] = pk2(S_[8 + 2 * q], S_[8 + 2 * q + 1]);                                                  \
      }                                                                                                    \
    }
    SOFTMAX_TILE(SA, csA, 0, la, pa0, pa1)
    asm volatile("" : "+v"(pa0.u[0]), "+v"(pa0.u[1]), "+v"(pa0.u[2]), "+v"(pa0.u[3]), "+v"(pa1.u[0]), "+v"(pa1.u[1]), "+v"(pa1.u[2]), "+v"(pa1.u[3]));
    SOFTMAX_TILE(SB, csB, 32, lb, pb0, pb1)
#undef SOFTMAX_TILE
    {
      bf16x8 v00 = *reinterpret_cast<const bf16x8*>(Vl + vrd0 + (((0 + h) ^ vsw) * 8));
      bf16x8 v01 = *reinterpret_cast<const bf16x8*>(Vl + vrd0 + (((2 + h) ^ vsw) * 8));
      OA0 = MFMA32(v00, pa0.v, OA0); OB0 = MFMA32(v00, pb0.v, OB0);
      OA0 = MFMA32(v01, pa1.v, OA0); OB0 = MFMA32(v01, pb1.v, OB0);
      bf16x8 v10 = *reinterpret_cast<const bf16x8*>(Vl + vrd1 + (((0 + h) ^ vsw) * 8));
      bf16x8 v11 = *reinterpret_cast<const bf16x8*>(Vl + vrd1 + (((2 + h) ^ vsw) * 8));
      OA1 = MFMA32(v10, pa0.v, OA1); OB1 = MFMA32(v10, pb0.v, OB1);
      OA1 = MFMA32(v11, pa1.v, OA1); OB1 = MFMA32(v11, pb1.v, OB1);
    }
    if (more) {
#pragma unroll
      for (int i = 0; i < 4; ++i) {
        *reinterpret_cast<bf16x8*>(Kl + KST(i)) = rk[i];
        *reinterpret_cast<bf16x8*>(Vl + VST(i)) = rv[i];
      }
    }
  }
  float l_a = la + __shfl_xor(la, 32), l_b = lb + __shfl_xor(lb, 32);
  if (mode == 1 || mode == 3) {
    const float sk = __builtin_amdgcn_exp2f(p.gqa_sink[L * 8 + head] * LOG2E - shf);
    l_a += sk; l_b += sk;
  }
  const float inva = __builtin_amdgcn_rcpf(l_a), invb = __builtin_amdgcn_rcpf(l_b);
  bf16_t* gpa = p.Z() + (size_t)(q_row0 + r) * LDZ + gcol + 4 * h;
  bf16_t* gpb = gpa + (size_t)32 * LDZ;
  {
    uint2 gA0[4], gA1[4], gB0[4], gB1[4];
#pragma unroll
    for (int i4 = 0; i4 < 4; ++i4) {
      gA0[i4] = *reinterpret_cast<const uint2*>(gpa + i4 * 8);
      gA1[i4] = *reinterpret_cast<const uint2*>(gpa + 32 + i4 * 8);
      gB0[i4] = *reinterpret_cast<const uint2*>(gpb + i4 * 8);
      gB1[i4] = *reinterpret_cast<const uint2*>(gpb + 32 + i4 * 8);
    }
#define ATT_OUT(O, G, gp, inv, off)                                                                                 \
    {                                                                                                               \
      const uint2 gt = G[i4];                                                                                       \
      uint2 w;                                                                                                      \
      w.x = pk2(O[i4 * 4 + 0] * inv * siluf_(lo_bf(gt.x)), O[i4 * 4 + 1] * inv * siluf_(hi_bf(gt.x)));              \
      w.y = pk2(O[i4 * 4 + 2] * inv * siluf_(lo_bf(gt.y)), O[i4 * 4 + 3] * inv * siluf_(hi_bf(gt.y)));              \
      *reinterpret_cast<uint2*>(gp + off + i4 * 8) = w;                                                             \
    }
#pragma unroll
    for (int i4 = 0; i4 < 4; ++i4) {
      ATT_OUT(OA0, gA0, gpa, inva, 0)
      ATT_OUT(OA1, gA1, gpa, inva, 32)
      ATT_OUT(OB0, gB0, gpb, invb, 0)
      ATT_OUT(OB1, gB1, gpb, invb, 32)
    }
#undef ATT_OUT
  }
#undef KST
#undef VST
}

DI void scan_wg(const Params& p, int L, int dgi, float* sm, int tid) {
  const int lane = tid & 63, w = tid >> 6;
  const int d = dgi >> 5, g = dgi & 31;
  const int dg = (L * 2 + d) * 32 + g;
  const float ar = p.A16()[(dg * 64 + lane) * 2], ai = p.A16()[(dg * 64 + lane) * 2 + 1];
  const int off = g * 256 + d * 128 + lane * 2;
  const int s_lo = w * 130;
  auto chunk_of = [&](int s) -> int { return (d == 0) ? (s < 16 ? 1024 + s : s - 16) : (NCH - 1 - s); };
  float hr = 0.f, hi = 0.f, pr = 1.f, pi = 0.f;
  float2 e[10], en[10];
#pragma unroll
  for (int u = 0; u < 10; ++u) e[u] = *reinterpret_cast<const float2*>(p.E() + (size_t)chunk_of(s_lo + u) * 8192 + off);
  for (int s0 = 0; s0 < 130; s0 += 10) {
    const int sn = (s0 + 10 < 130) ? (s0 + 10) : s0;
#pragma unroll
    for (int u = 0; u < 10; ++u) en[u] = *reinterpret_cast<const float2*>(p.E() + (size_t)chunk_of(s_lo + sn + u) * 8192 + off);
#pragma unroll
    for (int u = 0; u < 10; ++u) {
      float nr = ar * hr - ai * hi + e[u].x, ni = ar * hi + ai * hr + e[u].y;
      hr = nr; hi = ni;
      float qr = pr * ar - pi * ai, qi = pr * ai + pi * ar;
      pr = qr; pi = qi;
    }
#pragma unroll
    for (int u = 0; u < 10; ++u) e[u] = en[u];
  }
  sm[(w * 64 + lane) * 2] = hr;
  sm[(w * 64 + lane) * 2 + 1] = hi;
  __syncthreads();
  float cr = 0.f, ci = 0.f;
  for (int v = 0; v < w; ++v) {
    float tr = sm[(v * 64 + lane) * 2], ti = sm[(v * 64 + lane) * 2 + 1];
    float nr = pr * cr - pi * ci + tr, ni = pr * ci + pi * cr + ti;
    cr = nr; ci = ni;
  }
  __syncthreads();
  hr = cr; hi = ci;
#pragma unroll
  for (int u = 0; u < 10; ++u) e[u] = *reinterpret_cast<const float2*>(p.E() + (size_t)chunk_of(s_lo + u) * 8192 + off);
  for (int s0 = 0; s0 < 130; s0 += 10) {
    const int sn = (s0 + 10 < 130) ? (s0 + 10) : s0;
#pragma unroll
    for (int u = 0; u < 10; ++u) en[u] = *reinterpret_cast<const float2*>(p.E() + (size_t)chunk_of(s_lo + sn + u) * 8192 + off);
#pragma unroll
    for (int u = 0; u < 10; ++u) {
      *reinterpret_cast<unsigned*>(p.HIN() + (size_t)chunk_of(s_lo + s0 + u) * 8192 + off) = pk2(hr, hi);
      float nr = ar * hr - ai * hi + e[u].x, ni = ar * hi + ai * hr + e[u].y;
      hr = nr; hi = ni;
    }
#pragma unroll
    for (int u = 0; u < 10; ++u) e[u] = en[u];
  }
}

DI void phase_attn_scan(const Params& p, int b, int L, float* sm, int tid) {
  const int lane = tid & 63, wid = tid >> 6;
  float* bias_s = sm + 32768;
  bf16_t* wl = reinterpret_cast<bf16_t*>(sm) + wid * 8192;
  for (int idx = tid; idx < 8 * 465; idx += 512) bias_s[64 + idx] = p.na_rel_bias[L * 8 * 465 + idx] * LOG2E;
  __syncthreads();
  constexpr int N_SCAN = 64, N_ATT = 4096 / 8;
  for (int item = blockIdx.x; item < N_SCAN; item += gridDim.x) scan_wg(p, L, item, sm + 32768 + 3840, tid);
  int lat_it = 0, ci = 0;
  for (;;) {
    int item;
    const int lat = (int)blockIdx.x + lat_it * (int)gridDim.x;
    if (lat < N_ATT) { item = lat; ++lat_it; }
    else {
      while (ci < 8 && (unsigned)((64 + ci) % gridDim.x) != blockIdx.x) ++ci;
      if (ci >= 8) break;
      item = N_ATT + ci;
      ++ci;
    }
    int mode, head, q_row0, na_r = 0;
    if (item < N_ATT) {
      const int w = item * 8 + wid;
      if (w < 2048) { mode = 0; head = w & 7; na_r = w >> 3; q_row0 = na_r * 64; }
      else { const int w2 = w - 2048; mode = 1; head = w2 & 7; q_row0 = (w2 >> 3) * 64; }
    } else {
      const int cj = item - N_ATT;
      const int w2 = (cj & 3) * 8 + wid;
      mode = (cj < 4) ? 2 : 3; head = w2 & 7; q_row0 = NLAT + (w2 >> 3) * 64;
    }
    attn_item(p, L, mode, head, q_row0, na_r, bias_s, wl, lane);
  }
  __syncthreads();
}

DI void phase_merge(const Params& p, int b, int L, bf16_t* sm, int tid) {
  VSUB_SETUP
  constexpr int NT = 128 * 8;
  const int nit = (NT + vgrid - 1) / vgrid;
  for (int it = 0; it < nit; ++it) {
    int tile = it * vgrid + vb;
    const bool act = tile < NT;
    if (!act) tile = NT - 1;
    const int mt = tile >> 3, nt = tile & 7;
    const int m0 = mt * 128, n0 = nt * 128;
    f32x16 outv[2][2];
    zero_acc<2>(outv);
    for (int kb = 0; kb < 4; ++kb) {
      f32x16 acc[2][2];
      zero_acc<2>(acc);
      const int gc = (kb == 0) ? C_S5G : (kb == 1 ? C_CG : (kb == 2 ? C_NG : C_GG));
      const bf16_t* Ab = p.Z() + (size_t)m0 * LDZ + gc;
      gemm_main<2, true, false>(acc, Ab, LDZ, (vt & 7) * 8, 64, p.WbrT() + (size_t)(L * 4 + kb) * 1024 * 512 + (size_t)n0 * 512, 512,
                         512, smv, vt, act, bcnt);
      if (act) {
#pragma unroll
        for (int mi = 0; mi < 2; ++mi) {
          const bf16_t* sgp = p.SG() + sg_index(m0 + wm * 64 + mi * 32 + r, kb * 1024 + n0 + wn * 64 + 4 * h);
#pragma unroll
          for (int ni = 0; ni < 2; ++ni)
#pragma unroll
            for (int i4 = 0; i4 < 4; ++i4) {
              uint2 sv = *reinterpret_cast<const uint2*>(sgp + (ni * 8 + i4 * 2) * 128);
              outv[mi][ni][i4 * 4 + 0] += lo_bf(sv.x) * acc[mi][ni][i4 * 4 + 0];
              outv[mi][ni][i4 * 4 + 1] += hi_bf(sv.x) * acc[mi][ni][i4 * 4 + 1];
              outv[mi][ni][i4 * 4 + 2] += lo_bf(sv.y) * acc[mi][ni][i4 * 4 + 2];
              outv[mi][ni][i4 * 4 + 3] += hi_bf(sv.y) * acc[mi][ni][i4 * 4 + 3];
            }
        }
      }
    }
    if (act) {
#pragma unroll
      for (int mi = 0; mi < 2; ++mi) {
        bf16_t* op = p.MIX() + (size_t)(m0 + wm * 64 + mi * 32 + r) * 1024 + n0 + wn * 64 + 4 * h;
#pragma unroll
        for (int ni = 0; ni < 2; ++ni)
#pragma unroll
          for (int i4 = 0; i4 < 4; ++i4) {
            uint2 w;
            w.x = pk2(outv[mi][ni][i4 * 4 + 0], outv[mi][ni][i4 * 4 + 1]);
            w.y = pk2(outv[mi][ni][i4 * 4 + 2], outv[mi][ni][i4 * 4 + 3]);
            *reinterpret_cast<uint2*>(op + ni * 32 + i4 * 8) = w;
          }
      }
    }
  }
  constexpr int NTC = 2 * 16 * 4;
  const int nitc = (L == 3) ? 0 : (NTC + vgrid - 1) / vgrid;
  for (int it = 0; it < nitc; ++it) {
    int item = it * vgrid + vb;
    const bool act = item < NTC;
    if (!act) item = NTC - 1;
    const int kb = item & 3, nt = (item >> 2) & 15, mt = item >> 6;
    const int m0 = NLAT + mt * 128, n0 = nt * 64;
    f32x16 acc[2][1];
    zero_acc<1>(acc);
    const int gc = (kb == 0) ? C_S5G : (kb == 1 ? C_CG : (kb == 2 ? C_NG : C_GG));
    gemm_main<1, true>(acc, p.Z() + (size_t)m0 * LDZ + gc, LDZ, (vt & 7) * 8, 64,
                       p.WbrT() + (size_t)(L * 4 + kb) * 1024 * 512 + (size_t)n0 * 512, 512, 512, smv, vt, act, bcnt);
    if (act) {
#pragma unroll
      for (int mi = 0; mi < 2; ++mi) {
        const int row = m0 + wm * 64 + mi * 32 + r;
        const bf16_t* sgp = p.SG() + sg_index(row, kb * 1024 + n0 + wn * 32 + 4 * h);
        bf16_t* op = p.PCTX() + (size_t)kb * 256 * 1024 + (size_t)(row - NLAT) * 1024 + n0 + wn * 32 + 4 * h;
#pragma unroll
        for (int i4 = 0; i4 < 4; ++i4) {
          uint2 sv = *reinterpret_cast<const uint2*>(sgp + (i4 * 2) * 128);
          uint2 w;
          w.x = pk2(lo_bf(sv.x) * acc[mi][0][i4 * 4 + 0], hi_bf(sv.x) * acc[mi][0][i4 * 4 + 1]);
          w.y = pk2(lo_bf(sv.y) * acc[mi][0][i4 * 4 + 2], hi_bf(sv.y) * acc[mi][0][i4 * 4 + 3]);
          *reinterpret_cast<uint2*>(op + i4 * 8) = w;
        }
      }
    }
  }
}

DI void phase_out(const Params& p, int b, int L, unsigned char* smraw, int tid) {
  {
    pg8::StaticOrder S;
    S.init(NLAT, 1024, gridDim.x, blockIdx.x);
    pg8::Gemm g{p.MIX(), p.WoutT() + (size_t)L * 1024 * 1024, NLAT, 1024, 1024};
    EpiOutRes E{(L == 0 ? p.x : (const float*)p.out) + (size_t)b * NLAT * 1024, p.out + (size_t)b * NLAT * 1024,
                p.MOD() + (L * 3 + b) * 3072 + 2048};
    pg8::gemm_phase<EpiOutRes, pg8::StaticOrder, false>(LDS3(smraw), g, S, E, nullptr);
  }
  if (L == 3) return;
  __syncthreads();
  bf16_t* sm = reinterpret_cast<bf16_t*>(smraw);
  VSUB_SETUP
  constexpr int NT = 2 * 8;
  const int nit = (NT + vgrid - 1) / vgrid;
  for (int it = 0; it < nit; ++it) {
    int tile = it * vgrid + vb;
    const bool act = tile < NT;
    if (!act) tile = NT - 1;
    const int mt = tile >> 3, nt = tile & 7;
    const int m0 = NLAT + mt * 128, n0 = nt * 128;
    f32x16 acc[2][2];
    zero_acc<2>(acc);
    {
      const bf16_t* Ab = p.PCTX() + (size_t)(m0 - NLAT) * 1024;
      gemm_main<2, false, false, true>(acc, Ab, 1024, (vt & 7) * 8, 64, p.WoutT() + (size_t)L * 1024 * 1024 + (size_t)n0 * 1024,
                                       1024, 1024, smv, vt, act, bcnt, (size_t)256 * 1024);
    }
    if (act) {
      const float* src = (L == 0 ? p.ctx : (const float*)p.CTXS()) + ((size_t)b * 256 + (m0 - NLAT)) * 1024;
      float* dst = p.CTXS() + ((size_t)b * 256 + (m0 - NLAT)) * 1024;
      const float* gate = p.MOD() + (L * 3 + 2) * 3072 + 2048;
#pragma unroll
      for (int ni = 0; ni < 2; ++ni) {
        const int col = n0 + wn * 64 + ni * 32 + r;
        const float gt = gate[col];
#pragma unroll
        for (int mi = 0; mi < 2; ++mi) {
          float xs[16];
#pragma unroll
          for (int i = 0; i < 16; ++i) xs[i] = src[(size_t)(wm * 64 + mi * 32 + crow(i, h)) * 1024 + col];
#pragma unroll
          for (int i = 0; i < 16; ++i) dst[(size_t)(wm * 64 + mi * 32 + crow(i, h)) * 1024 + col] = xs[i] + gt * acc[mi][ni][i];
        }
      }
    }
  }
}

#define XB_TMO      128
#define XB_XCNT(j)  (256  + 64 * (j))
#define XB_XSUB(j)  (1280 + 64 * (j))
#define XB_XGEN(j)  (2304 + 64 * (j))
#define XB_TOP      3328
#define XB_TOPGEN   3392
#define XCD_BAR_WORDS 3456
#define XB_SPIN_CAP (1u << 18)
#define LAS __attribute__((address_space(3)))

__device__ __forceinline__ unsigned xb_ld(unsigned* p)              { return __hip_atomic_load(p, __ATOMIC_RELAXED, __HIP_MEMORY_SCOPE_AGENT); }
__device__ __forceinline__ unsigned xb_add(unsigned* p, unsigned v) { return __hip_atomic_fetch_add(p, v, __ATOMIC_RELAXED, __HIP_MEMORY_SCOPE_AGENT); }
__device__ __forceinline__ unsigned xb_xcc_id() { return (unsigned)__builtin_amdgcn_s_getreg((3 << 11) | 20) & 0xFu; }
#define XB_SPIN(cond, bar) do { unsigned _sp = 0; while (cond) { __builtin_amdgcn_s_sleep(1); \
    if ((++_sp & 255u) == 0u) { if (xb_ld(&(bar)[XB_TMO])) break; if (_sp > XB_SPIN_CAP) { atomicAdd(&(bar)[XB_TMO], 1u); break; } } } } while (0)

struct XcdBarrier {
    unsigned* bar; unsigned x;
    volatile LAS unsigned* st;
};

__device__ __forceinline__ XcdBarrier xcd_barrier_post(unsigned* bar, volatile LAS unsigned* st) {
    XcdBarrier b; b.bar = bar; b.x = xb_xcc_id(); b.st = st;
    if (threadIdx.x == 0) (void)xb_add(&bar[XB_XCNT(b.x)], 1u);
    return b;
}
__device__ __forceinline__ void xcd_barrier_complete(unsigned* bar, unsigned x, unsigned& nloc, unsigned& nx) {
    const unsigned G = gridDim.x * gridDim.y * gridDim.z;
    unsigned sum, cnt, mine, sp = 0u;
    for (;;) {
        sum = 0u; cnt = 0u; mine = 0u;
#pragma unroll
        for (unsigned j = 0; j < 16; ++j) { const unsigned c = xb_ld(&bar[XB_XCNT(j)]); sum += c; cnt += (c > 0u) ? 1u : 0u; mine = (j == x) ? c : mine; }
        if (sum == G) break;
        __builtin_amdgcn_s_sleep(1);
        if ((++sp & 255u) == 0u) { if (xb_ld(&bar[XB_TMO])) break; if (sp > XB_SPIN_CAP) { atomicAdd(&bar[XB_TMO], 1u); break; } }
    }
    nloc = mine > 0u ? mine : 1u; nx = cnt > 0u ? cnt : 1u;
}

__device__ __forceinline__ void xcd_barrier(const XcdBarrier& b) {
    asm volatile("s_waitcnt vmcnt(0)" ::: "memory");
    __syncthreads();
    if (threadIdx.x == 0) {
        unsigned* bar = b.bar;
        __builtin_amdgcn_s_waitcnt(0);
        unsigned nloc = b.st[0], nx = b.st[1];
        if (nloc == 0u) { xcd_barrier_complete(bar, b.x, nloc, nx); b.st[0] = nloc; b.st[1] = nx; }
        const unsigned old = xb_add(&bar[XB_XSUB(b.x)], 1u);
        const unsigned gen = old / nloc;
        if (old + 1u == (gen + 1u) * nloc) {
            __builtin_amdgcn_fence(__ATOMIC_RELEASE, "agent");
            asm volatile("s_waitcnt vmcnt(0)" ::: "memory");
            const unsigned og = xb_add(&bar[XB_TOP], 1u);
            const unsigned tg = og / nx;
            if (og + 1u == (tg + 1u) * nx) xb_add(&bar[XB_TOPGEN], 1u);
            else XB_SPIN(xb_ld(&bar[XB_TOPGEN]) == tg, bar);
            __builtin_amdgcn_fence(__ATOMIC_ACQUIRE, "agent");
            xb_add(&bar[XB_XGEN(b.x)], 1u);
            asm volatile("s_waitcnt vmcnt(0)" ::: "memory");
        } else {
            XB_SPIN(xb_ld(&bar[XB_XGEN(b.x)]) == gen, bar);
            __builtin_amdgcn_fence(__ATOMIC_ACQUIRE, "agent");
            asm volatile("s_waitcnt vmcnt(0)" ::: "memory");
        }
    }
    __syncthreads();
}


__global__ void __launch_bounds__(512, 2) mega_kernel(Params p, int ph_lo, int ph_hi) {
  __shared__ __attribute__((aligned(1024))) unsigned char smem_raw[151552];
  __shared__ uint4 xb_words;
  bf16_t* smb = reinterpret_cast<bf16_t*>(smem_raw);
  float* smf = reinterpret_cast<float*>(smem_raw);
  if (threadIdx.x == 0) xb_words = make_uint4(0u, 0u, 0u, 0u);
  if (threadIdx.x < 128) g_vsub_cnt[threadIdx.x] = 0u;
  __syncthreads();
  XcdBarrier xb = xcd_barrier_post(p.bar, (volatile LAS unsigned*)&xb_words);
  if (ph_hi < 0) cg::this_grid().sync();
  for (int ph = ph_lo; ph < ph_hi; ++ph) {
    int tid = threadIdx.x;
    asm volatile("" : "+v"(tid));
    if (ph == 0) {
      phase_prep(p, smf, tid);
    } else {
      const int q = ph - 1;
      const int b = q >> 5, L = (q & 31) >> 3, sub = q & 7;
      switch (sub) {
        case 0: phase_norm(p, b, L, tid); break;
        case 1: phase_p1(p, b, L, smem_raw); break;
        case 2: phase_s5e_conv_post(p, b, L, smb, tid); break;
        case 3: phase_attn_scan(p, b, L, smf, tid); break;
        case 4: phase_s5y(p, b, L, smb, tid); break;
        case 5: phase_glu(p, b, L, smem_raw); break;
        case 6: phase_merge(p, b, L, smb, tid); break;
        default: phase_out(p, b, L, smem_raw, tid); break;
      }
    }
    if (ph + 1 < ph_hi) xcd_barrier(xb);
  }
}

extern "C" void kernel_launch(void* const* d_in, const int* in_sizes, int n_in, void* d_out, int out_size, void* d_ws,
                              size_t ws_size, hipStream_t stream) {
  Params p{};
  const float** fp = reinterpret_cast<const float**>(&p);
  for (int i = 0; i < 27; ++i) fp[i] = (const float*)d_in[i];
  p.out = (float*)d_out;
  p.ws = (char*)d_ws;
  p.bar = (unsigned*)((char*)d_ws + OFF_BAR);
  if (WS_TOTAL > ws_size) {
    fprintf(stderr, "workspace too small: need %zu have %zu\n", (size_t)WS_TOTAL, ws_size);
    return;
  }
  static int grid_blocks = 0;
  if (!grid_blocks) {
    int dev = 0, cus = 0, per_cu = 0;
    (void)hipGetDevice(&dev);
    (void)hipDeviceGetAttribute(&cus, hipDeviceAttributeMultiprocessorCount, dev);
    (void)hipOccupancyMaxActiveBlocksPerMultiprocessor(&per_cu, mega_kernel, 512, 0);
    if (per_cu > 1) per_cu = 1;
    if (per_cu < 1) per_cu = 1;
    grid_blocks = cus * per_cu;
  }
  (void)hipMemsetAsync(p.bar, 0, 4096 * 4, stream);
#if MULTI_LAUNCH
  for (int ph = 0; ph < NPHASE; ++ph) {
    hipLaunchKernelGGL(mega_kernel, dim3(grid_blocks), dim3(512), 0, stream, p, ph, ph + 1);
  }
#else
  int lo = 0, hi = NPHASE;
  void* args[] = {&p, &lo, &hi};
  hipError_t e = hipLaunchCooperativeKernel((void*)mega_kernel, dim3(grid_blocks), dim3(512), args, 0, stream);
  if (e != hipSuccess) fprintf(stderr, "cooperative launch failed: %s (grid %d)\n", hipGetErrorString(e), grid_blocks);
#endif
}
```
